# Optimizing an MI355X kernel written in HIP

```python
import jax, jax.numpy as jnp
from jax import lax
import numpy as np


D_MODEL = 1024
BATCH = 2
SEQ = 16384
DEPTH = 2

CTX_LEN = 256
GRID_W = 64
EPS = 1e-6

MIX_WIDTH = D_MODEL
A_WIDTH = MIX_WIDTH // 2
A_HEADS = 4
A_DV = A_WIDTH // A_HEADS
A_DK = A_DV
A_QK = A_HEADS * A_DK
A_CHUNK = 64
B_WIDTH = MIX_WIDTH // 4
B_HEADS = 4
B_HEAD_DIM = B_WIDTH // B_HEADS
B_CONV = 4
CONV_LEFT = B_CONV // 2
CONV_RIGHT = B_CONV - 1 - CONV_LEFT
LRU_C = 8.0
C_WIDTH = MIX_WIDTH - A_WIDTH - B_WIDTH
C_GROUPS = 4
C_GROUP_DIM = C_WIDTH // C_GROUPS
IN_SPLITS = (A_QK, 2 * A_QK, 3 * A_QK, 3 * A_QK + A_WIDTH, 3 * A_QK + 2 * A_WIDTH,
             3 * A_QK + 2 * A_WIDTH + B_WIDTH, 3 * A_QK + 2 * A_WIDTH + 2 * B_WIDTH)
IN_WIDTH = 3 * A_QK + 2 * A_WIDTH + 2 * B_WIDTH + C_WIDTH
N_EXPERTS = 256
TOP_K = 8
N_GROUPS = 8
TOPK_GROUPS = 4
EXPERTS_PER_GROUP = N_EXPERTS // N_GROUPS
EXPERT_HIDDEN = D_MODEL // 4
SHARED_HIDDEN = D_MODEL // 4
ROUTE_SCALE = 2.5
MOE_BLOCK = 128

kernel_name = 'hybrid_hgrn2_rglru_fnet_moe_dit'


def _rms_norm(x, g):
    xf = x.astype(jnp.float32)
    y = xf * lax.rsqrt(jnp.mean(xf * xf, axis=-1, keepdims=True) + EPS)
    return (y * g.astype(jnp.float32)).astype(x.dtype)


def _hgrn2_gates(z, lb):
    z = z.astype(jnp.float32)
    logf = jnp.logaddexp(jnp.log(lb), jnp.log1p(-lb) + jax.nn.log_sigmoid(z))
    k = (1.0 - lb) * jax.nn.sigmoid(-z)
    return k, logf


def _hgrn2_chunk_scan(q, k, v, logf, s0):
    Bn, L = q.shape[0], q.shape[1]
    nc = L // A_CHUNK

    def to_chunks(t):
        return t.reshape(Bn, nc, A_CHUNK, A_HEADS, t.shape[-1]).transpose(1, 0, 3, 2, 4)

    causal = jnp.tril(jnp.ones((A_CHUNK, A_CHUNK), bool))[None, None, :, :, None]

    def step(S, inp):
        qc, kc, vc, lfc = inp
        b = jnp.cumsum(lfc, axis=2)
        o_inter = jnp.einsum('bhtk,bhkv->bhtv', qc * jnp.exp(b), S)
        diff = jnp.where(causal, b[:, :, :, None, :] - b[:, :, None, :, :], -jnp.inf)
        scores = jnp.einsum('bhtk,bhsk,bhtsk->bhts', qc, kc, jnp.exp(diff))
        o = o_inter + jnp.einsum('bhts,bhsv->bhtv', scores, vc)
        b_last = b[:, :, -1:, :]
        S = jnp.exp(b_last[:, :, 0, :, None]) * S + jnp.einsum('bhsk,bhsv->bhkv', kc * jnp.exp(b_last - b), vc)
        return S, o

    S, o = lax.scan(step, s0, (to_chunks(q), to_chunks(k), to_chunks(v), to_chunks(logf)))
    o = o.transpose(1, 0, 3, 2, 4).reshape(Bn, L, A_HEADS, -1)
    return o, S


def _hgrn2_direction(q, v, k, logf, reverse):
    flip = (lambda t: jnp.flip(t, axis=1)) if reverse else (lambda t: t)
    s0 = jnp.zeros((q[0].shape[0], A_HEADS, A_DK, A_DV), jnp.float32)
    o_c, s_c = _hgrn2_chunk_scan(flip(q[0]), flip(k[0]), flip(v[0]), flip(logf[0]), s0)
    o_l, _ = _hgrn2_chunk_scan(flip(q[1]), flip(k[1]), flip(v[1]), flip(logf[1]), s_c)
    return flip(o_c), flip(o_l)


def _head_norm_gate(o, g, gain):
    o = o * lax.rsqrt(jnp.mean(o * o, axis=-1, keepdims=True) + EPS) * gain.astype(jnp.float32)
    o = o * jax.nn.silu(g.astype(jnp.float32).reshape(o.shape))
    return o.reshape(o.shape[0], o.shape[1], A_WIDTH)


def _to_colmajor(t):
    Bn, L, W = t.shape
    rows = L // GRID_W
    return t.reshape(Bn, rows, GRID_W, W).transpose(0, 2, 1, 3).reshape(Bn, L, W)


def _from_colmajor(t):
    Bn, L, W = t.shape
    rows = L // GRID_W
    return t.reshape(Bn, GRID_W, rows, W).transpose(0, 2, 1, 3).reshape(Bn, L, W)


def _dwconv_centred(t, w, b):
    y = lax.conv_general_dilated(t, w[:, None, :].astype(t.dtype), window_strides=(1,),
                                 padding=[(CONV_LEFT, CONV_RIGHT)],
                                 dimension_numbers=('NWC', 'WIO', 'NWC'),
                                 feature_group_count=t.shape[-1])
    return y + b.astype(t.dtype)


def _blockdiag(t, w):
    Bn, L, W = t.shape
    y = jnp.einsum('blhi,hij->blhj', t.reshape(Bn, L, B_HEADS, B_HEAD_DIM), w.astype(jnp.float32))
    return y.reshape(Bn, L, W)


def _lin_combine(left, right):
    a_l, b_l = left
    a_r, b_r = right
    return a_l * a_r, a_r * b_l + b_r


def _linear_scan(a, b, h0):
    a_cum, h = lax.associative_scan(_lin_combine, (a, b), axis=1)
    return a_cum * h0[:, None, :] + h


def _rglru_direction(xc, xl, wa, ba, wx, bx, lam, reverse):
    flip = (lambda t: jnp.flip(t, axis=1)) if reverse else (lambda t: t)
    lam = lam.astype(jnp.float32)

    def coeffs(t):
        r = jax.nn.sigmoid(_blockdiag(t, wa) + ba.astype(jnp.float32))
        i = jax.nn.sigmoid(_blockdiag(t, wx) + bx.astype(jnp.float32))
        log_a = -LRU_C * jax.nn.softplus(-lam) * r
        return jnp.exp(log_a), jnp.sqrt(-jnp.expm1(2.0 * log_a)) * (i * t)

    a_c, b_c = coeffs(flip(xc))
    h_c = _linear_scan(a_c, b_c, jnp.zeros((xc.shape[0], B_WIDTH), jnp.float32))
    a_l, b_l = coeffs(flip(xl))
    h_l = _linear_scan(a_l, b_l, h_c[:, -1])
    return flip(h_c), flip(h_l)


def _fourier(u):
    Bn, L, _ = u.shape
    uf = u.astype(jnp.float32).reshape(Bn, L, C_GROUPS, C_GROUP_DIM)
    y = jnp.fft.fft2(uf, axes=(1, 3), norm='ortho').real
    return y.reshape(Bn, L, C_WIDTH)


def _token_mixers(h, hc, w_in, lb, hg_norm, conv_w, conv_b, wa, ba, wx, bx, lam, w_out, with_ctx):
    seg = jnp.split(h @ w_in, IN_SPLITS, axis=-1)
    segc = jnp.split(hc @ w_in, IN_SPLITS, axis=-1)

    def heads(t):
        return t.astype(jnp.float32).reshape(t.shape[0], t.shape[1], A_HEADS, -1)

    lb_h = lb.astype(jnp.float32).reshape(A_HEADS, A_DK)
    qa = (heads(segc[0]), heads(seg[0]))
    va = (heads(segc[3]), heads(seg[3]))
    oa_c = 0.0
    oa_l = 0.0
    for z_idx, rev in ((1, False), (2, True)):
        kc, lfc = _hgrn2_gates(heads(segc[z_idx]), lb_h)
        kl, lfl = _hgrn2_gates(heads(seg[z_idx]), lb_h)
        o_c, o_l = _hgrn2_direction(qa, va, (kc, kl), (lfc, lfl), rev)
        oa_c = oa_c + o_c
        oa_l = oa_l + o_l
    a_l = _head_norm_gate(oa_l, seg[4], hg_norm)

    xbc = _dwconv_centred(segc[5], conv_w, conv_b).astype(jnp.float32)
    xbl = _dwconv_centred(_to_colmajor(seg[5]), conv_w, conv_b).astype(jnp.float32)
    hb_c = 0.0
    hb_l = 0.0
    for d, rev in ((0, False), (1, True)):
        h_c, h_l = _rglru_direction(xbc, xbl, wa[d], ba[d], wx[d], bx[d], lam[d], rev)
        hb_c = hb_c + h_c
        hb_l = hb_l + h_l
    b_l = _from_colmajor(hb_l) * jax.nn.gelu(seg[6].astype(jnp.float32))

    c_l = _fourier(seg[7])

    out_l = jnp.concatenate([a_l, b_l, c_l], axis=-1).astype(h.dtype) @ w_out
    if not with_ctx:
        return out_l, None
    a_c = _head_norm_gate(oa_c, segc[4], hg_norm)
    b_c = hb_c * jax.nn.gelu(segc[6].astype(jnp.float32))
    c_c = _fourier(segc[7])
    out_c = jnp.concatenate([a_c, b_c, c_c], axis=-1).astype(hc.dtype) @ w_out
    return out_l, out_c


def _swiglu(x, wg, wu, wd):
    return (jax.nn.silu(x @ wg) * (x @ wu)) @ wd


def _moe(h, w_router, b_router, w_gate, w_up, w_down, ws_gate, ws_up, ws_down):
    T, D = h.shape
    scores = jax.nn.sigmoid(h.astype(jnp.float32) @ w_router.astype(jnp.float32))
    biased = scores + b_router.astype(jnp.float32)
    grp_score = lax.top_k(biased.reshape(T, N_GROUPS, EXPERTS_PER_GROUP), 2)[0].sum(-1)
    _, grp_idx = lax.top_k(grp_score, TOPK_GROUPS)
    grp_mask = jnp.any(grp_idx[:, :, None] == jnp.arange(N_GROUPS)[None, None, :], axis=1)
    allowed = jnp.repeat(grp_mask, EXPERTS_PER_GROUP, axis=1)
    _, idx = lax.top_k(jnp.where(allowed, biased, -jnp.inf), TOP_K)
    wts = jnp.take_along_axis(scores, idx, axis=1)
    wts = ROUTE_SCALE * wts / jnp.sum(wts, axis=-1, keepdims=True)

    tk = T * TOP_K
    e_flat = idx.reshape(-1).astype(jnp.int32)
    tok_flat = jnp.repeat(jnp.arange(T, dtype=jnp.int32), TOP_K)
    order = jnp.argsort(e_flat)
    e_sorted = e_flat[order]
    tok_sorted = tok_flat[order]
    w_sorted = wts.reshape(-1)[order]
    counts = jnp.bincount(e_flat, length=N_EXPERTS).astype(jnp.int32)
    starts = jnp.cumsum(counts) - counts
    padded = (counts + MOE_BLOCK - 1) // MOE_BLOCK * MOE_BLOCK
    pend = jnp.cumsum(padded)
    pstart = pend - padded
    dest = pstart[e_sorted] + jnp.arange(tk, dtype=jnp.int32) - starts[e_sorted]
    n_blocks = -(-tk // MOE_BLOCK) + N_EXPERTS
    buf_tok = jnp.full((n_blocks * MOE_BLOCK,), T, jnp.int32).at[dest].set(tok_sorted)
    buf_w = jnp.zeros((n_blocks * MOE_BLOCK,), jnp.float32).at[dest].set(w_sorted)
    blk_expert = jnp.minimum(jnp.searchsorted(pend, jnp.arange(n_blocks, dtype=jnp.int32) * MOE_BLOCK, side='right'),
                             N_EXPERTS - 1)
    h_pad = jnp.concatenate([h, jnp.zeros((1, D), h.dtype)], axis=0)

    def block(acc, inp):
        tok, wt, e = inp
        y = _swiglu(h_pad[tok], w_gate[e], w_up[e], w_down[e])
        return acc.at[tok].add(y.astype(jnp.float32) * wt[:, None]), None

    acc, _ = lax.scan(block, jnp.zeros((T + 1, D), jnp.float32),
                      (buf_tok.reshape(n_blocks, MOE_BLOCK), buf_w.reshape(n_blocks, MOE_BLOCK), blk_expert))
    shared = _swiglu(h, ws_gate, ws_up, ws_down)
    return (acc[:T] + shared.astype(jnp.float32)).astype(h.dtype)


def setup_inputs(seed: int = 0) -> dict:
    key = jax.random.key(seed)
    ks = iter(jax.random.split(key, 40))

    def nrm(shape, scale):
        return jax.random.normal(next(ks), shape, jnp.float32) * scale

    D = D_MODEL
    L = DEPTH
    a0 = jax.random.uniform(next(ks), (L, 2, B_WIDTH), jnp.float32, 0.9, 0.999)
    s = a0 ** (1.0 / LRU_C)
    lam = jnp.log(s) - jnp.log1p(-s)
    return {
        'x': nrm((BATCH, SEQ, D), 1.0),
        'c': nrm((BATCH, D), 1.0),
        'ctx': nrm((BATCH, CTX_LEN, D), 1.0),
        'c_ctx': nrm((D,), 1.0),
        'w_mod': nrm((L, D, 6 * D), 0.5 * D ** -0.5),
        'b_mod': nrm((L, 6 * D), 0.02),
        'norm_mix': 1.0 + nrm((L, D), 0.02),
        'norm_ffn': 1.0 + nrm((L, D), 0.02),
        'w_in': nrm((L, D, IN_WIDTH), D ** -0.5),
        'hg_lb': nrm((L, A_QK), 0.5),
        'hg_norm': 1.0 + nrm((L, A_DV), 0.02),
        'lru_conv_w': nrm((L, B_CONV, B_WIDTH), B_CONV ** -0.5),
        'lru_conv_b': nrm((L, B_WIDTH), 0.02),
        'lru_wa': nrm((L, 2, B_HEADS, B_HEAD_DIM, B_HEAD_DIM), B_HEAD_DIM ** -0.5),
        'lru_ba': nrm((L, 2, B_WIDTH), 0.02),
        'lru_wx': nrm((L, 2, B_HEADS, B_HEAD_DIM, B_HEAD_DIM), B_HEAD_DIM ** -0.5),
        'lru_bx': nrm((L, 2, B_WIDTH), 0.02),
        'lru_lam': lam,
        'w_out': nrm((L, MIX_WIDTH, D), MIX_WIDTH ** -0.5),
        'w_router': nrm((L, D, N_EXPERTS), D ** -0.5),
        'b_router': nrm((L, N_EXPERTS), 0.01),
        'w_exp_gate': nrm((L, N_EXPERTS, D, EXPERT_HIDDEN), D ** -0.5),
        'w_exp_up': nrm((L, N_EXPERTS, D, EXPERT_HIDDEN), D ** -0.5),
        'w_exp_down': nrm((L, N_EXPERTS, EXPERT_HIDDEN, D), EXPERT_HIDDEN ** -0.5),
        'w_sh_gate': nrm((L, D, SHARED_HIDDEN), D ** -0.5),
        'w_sh_up': nrm((L, D, SHARED_HIDDEN), D ** -0.5),
        'w_sh_down': nrm((L, SHARED_HIDDEN, D), SHARED_HIDDEN ** -0.5),
        'norm_final': 1.0 + nrm((D,), 0.02),
    }


def reference(x, c, ctx, c_ctx, w_mod, b_mod, norm_mix, norm_ffn, w_in, hg_lb, hg_norm,
              lru_conv_w, lru_conv_b, lru_wa, lru_ba, lru_wx, lru_bx, lru_lam, w_out,
              w_router, b_router, w_exp_gate, w_exp_up, w_exp_down, w_sh_gate, w_sh_up, w_sh_down,
              norm_final):
    D = x.shape[-1]
    lb_all = jnp.cumsum(jax.nn.softmax(hg_lb.astype(jnp.float32), axis=0), axis=0)
    lb_all = lb_all - lb_all[0:1]
    xc = ctx
    for l in range(DEPTH):
        last = l == DEPTH - 1
        mod = (jax.nn.silu(c) @ w_mod[l] + b_mod[l])[:, None, :]
        mod_c = (jax.nn.silu(c_ctx) @ w_mod[l] + b_mod[l])[None, None, :]
        sh1, sc1, g1, sh2, sc2, g2 = jnp.split(mod, 6, axis=-1)
        csh1, csc1, cg1, csh2, csc2, cg2 = jnp.split(mod_c, 6, axis=-1)

        h = _rms_norm(x, norm_mix[l]) * (1.0 + sc1) + sh1
        hc = _rms_norm(xc, norm_mix[l]) * (1.0 + csc1) + csh1
        mix, mix_c = _token_mixers(h, hc, w_in[l], lb_all[l], hg_norm[l], lru_conv_w[l], lru_conv_b[l],
                                   lru_wa[l], lru_ba[l], lru_wx[l], lru_bx[l], lru_lam[l], w_out[l],
                                   not last)
        x = x + g1 * mix
        h2 = _rms_norm(x, norm_ffn[l]) * (1.0 + sc2) + sh2
        moe_args = (w_router[l], b_router[l], w_exp_gate[l], w_exp_up[l], w_exp_down[l],
                    w_sh_gate[l], w_sh_up[l], w_sh_down[l])
        if last:
            x = x + g2 * _moe(h2.reshape(-1, D), *moe_args).reshape(x.shape)
        else:
            xc = xc + cg1 * mix_c
            h2c = _rms_norm(xc, norm_ffn[l]) * (1.0 + csc2) + csh2
            n_lat = x.shape[0] * x.shape[1]
            y = _moe(jnp.concatenate([h2.reshape(-1, D), h2c.reshape(-1, D)], axis=0), *moe_args)
            x = x + g2 * y[:n_lat].reshape(x.shape)
            xc = xc + cg2 * y[n_lat:].reshape(xc.shape)
    return _rms_norm(x, norm_final)
```

```cpp
#include <hip/hip_runtime.h>
#include <cstdio>
#include <cstdint>

#ifndef MK_PER_PHASE
#define MK_PER_PHASE 0
#endif

#define LAS __attribute__((address_space(3)))
#define GAS __attribute__((address_space(1)))
typedef unsigned short bf16;
typedef short bf16x8 __attribute__((ext_vector_type(8)));
typedef float f32x4 __attribute__((ext_vector_type(4)));
typedef float f32x2 __attribute__((ext_vector_type(2)));
typedef unsigned u32x4 __attribute__((ext_vector_type(4)));
typedef unsigned u32x2 __attribute__((ext_vector_type(2)));

__device__ __forceinline__ float bf2f(bf16 v) { return __builtin_bit_cast(float, ((unsigned)v) << 16); }
typedef __bf16 bf16x2_t __attribute__((ext_vector_type(2)));
__device__ __forceinline__ unsigned pk2(float lo, float hi) { bf16x2_t v; v.x = (__bf16)lo; v.y = (__bf16)hi; return __builtin_bit_cast(unsigned, v); }
__device__ __forceinline__ bf16 f2bf(float f) { const __bf16 b = (__bf16)f; return __builtin_bit_cast(unsigned short, b); }
__device__ __forceinline__ unsigned f2bfu(float f) { return (unsigned)f2bf(f); }
#define MFMA16(a, b, c) __builtin_amdgcn_mfma_f32_16x16x32_bf16((a), (b), (c), 0, 0, 0)
#define LDS_WAIT() asm volatile("s_waitcnt lgkmcnt(0)" ::: "memory")
#define LDS_BARRIER() do { asm volatile("s_waitcnt lgkmcnt(0)" ::: "memory"); __builtin_amdgcn_s_barrier(); asm volatile("" ::: "memory"); } while (0)

namespace pg8 {
typedef unsigned short bf16_t;
constexpr int BM = 256, BK = 64, HALF = 128, HTB = HALF * BK * 2, STAGE_BYTES = 8 * HTB, NXCD = 8, WGM = 8;

__host__ __device__ __forceinline__ int lds_byte(int r, int c) { const int st = (r >> 4) * 2 + (c >> 5), rr = r & 15, cc = c & 31, ob = rr * 64 + cc * 2; return st * 1024 + (ob ^ (((ob >> 9) & 1) << 5)); }
__host__ __device__ __forceinline__ void stage_rc(int b, int& R, int& C) { const int st = b / 1024, sb = b % 1024, swz = sb ^ (((sb >> 9) & 1) << 5); R = (st >> 1) * 16 + swz / 64; C = (st & 1) * 32 + (swz % 64) / 2; }
__host__ __device__ __forceinline__ int perm32(int rho) { const int n = rho >> 4, i = rho & 15; return 8 * (i >> 2) + 4 * n + (i & 3); }

struct Unit { int pm, pn, pc, half; };
struct Gemm { const bf16_t* A; const bf16_t* Bt; const int* rows; int K; };

struct StaticOrder {
    int nM, nN, nwg, G, c;
    __device__ void init(int M, int N, int G_, int c_) { nM = M / BM; nN = N / BM; nwg = nM * nN; G = G_; c = c_; }
    __device__ bool next(int i, Unit& u) const {
        const long L = (long)i * G + c; if (L >= nwg) return false;
        int wgid = (int)L; { const int q = nwg / NXCD, r = nwg % NXCD, xcd = wgid % NXCD, off = wgid / NXCD; wgid = (xcd < r ? xcd * (q + 1) : r * (q + 1) + (xcd - r) * q) + off; }
        const int nig = WGM * nN, gid = wgid / nig, fm = gid * WGM, gsz = (nM - fm) < WGM ? (nM - fm) : WGM;
        u.pm = fm + ((wgid % nig) % gsz); u.pn = (wgid % nig) / gsz; u.pc = u.pn; u.half = 0; return true;
    }
};
template <int NT> struct MoeOrder {
    const int* tile_expert; int n_tiles, G, c;
    __device__ bool next(int i, Unit& u) const {
        int rt, j;
        if ((G & 7) == 0) { const int x = c & 7, jw = c >> 3, per = G >> 3; const int t0 = (int)(((long)n_tiles * x) >> 3), t1 = (int)(((long)n_tiles * (x + 1)) >> 3);
            const int Lx = i * per + jw; if (Lx >= (t1 - t0) * NT) return false; rt = t0 + Lx / NT; j = Lx % NT; }
        else { const int L = i * G + c; if (L >= n_tiles * NT) return false; rt = L / NT; j = L % NT; }
        const int te = tile_expert[rt], e = te & 0xffff;
        u.pm = rt; u.pn = e * NT + j; u.pc = j; u.half = te >> 16; return true;
    }
};

__device__ __forceinline__ unsigned cvt_pk_bf16(float lo, float hi) { return pk2(lo, hi); }

struct EpiBf16 {
    static constexpr bool PERM = true;
    bf16_t* O; int ldc;
    __device__ __forceinline__ void operator()(const f32x4 (&acc)[2][2][4][2], const Unit& u, int wr, int wc, int fr, int fq) const {
        const int row0 = u.pm * BM + wr * 64 + fr, col0 = u.pc * BM + wc * 32 + 8 * fq;
#pragma unroll
        for (int ai = 0; ai < 2; ++ai)
#pragma unroll
            for (int m = 0; m < 4; ++m) { bf16_t* rowp = O + (size_t)(row0 + ai * HALF + m * 16) * ldc + col0;
#pragma unroll
                for (int bj = 0; bj < 2; ++bj) { const f32x4 v0 = acc[ai][bj][m][0], v1 = acc[ai][bj][m][1];
                    u32x4 w; w.x = cvt_pk_bf16(v0[0], v0[1]); w.y = cvt_pk_bf16(v0[2], v0[3]); w.z = cvt_pk_bf16(v1[0], v1[1]); w.w = cvt_pk_bf16(v1[2], v1[3]);
                    *(u32x4*)(rowp + bj * HALF) = w; } }
    }
};
struct EpiFp8 {
    static constexpr bool PERM = true;
    unsigned char* O; int ldc;
    static __device__ __forceinline__ unsigned pk4(const f32x4 v) {
        const float a = __builtin_amdgcn_fmed3f(v[0], -448.f, 448.f), b = __builtin_amdgcn_fmed3f(v[1], -448.f, 448.f), c = __builtin_amdgcn_fmed3f(v[2], -448.f, 448.f), d = __builtin_amdgcn_fmed3f(v[3], -448.f, 448.f);
        int p = __builtin_amdgcn_cvt_pk_fp8_f32(a, b, 0, false); p = __builtin_amdgcn_cvt_pk_fp8_f32(c, d, p, true); return (unsigned)p; }
    __device__ __forceinline__ void operator()(const f32x4 (&acc)[2][2][4][2], const Unit& u, int wr, int wc, int fr, int fq) const {
        const int row0 = u.pm * BM + wr * 64 + fr, pos0 = u.pc * BM + wc * 64 + 16 * fq;
#pragma unroll
        for (int ai = 0; ai < 2; ++ai) { if (ai == 1 && u.half) break;
#pragma unroll
            for (int m = 0; m < 4; ++m) { u32x4 w; w.x = pk4(acc[ai][0][m][0]); w.y = pk4(acc[ai][0][m][1]); w.z = pk4(acc[ai][1][m][0]); w.w = pk4(acc[ai][1][m][1]);
                *(u32x4*)(O + (size_t)(row0 + ai * HALF + m * 16) * ldc + pos0) = w; } }
    }
};
struct EpiNone {
    static constexpr bool PERM = true;
    bf16_t* O;
    __device__ __forceinline__ void operator()(const f32x4 (&acc)[2][2][4][2], const Unit& u, int wr, int wc, int fr, int fq) const {
        float s = 0.f;
#pragma unroll
        for (int ai = 0; ai < 2; ++ai)
#pragma unroll
            for (int bj = 0; bj < 2; ++bj)
#pragma unroll
                for (int m = 0; m < 4; ++m)
#pragma unroll
                    for (int n = 0; n < 2; ++n) s += acc[ai][bj][m][n][0] + acc[ai][bj][m][n][1] + acc[ai][bj][m][n][2] + acc[ai][bj][m][n][3];
        if (s == 123.4567f) O[u.pm + wr + wc + fr + fq] = 1;
    }
};
struct EpiF32 {
    static constexpr bool PERM = false;
    float* C; int ldc;
    __device__ __forceinline__ void operator()(const f32x4 (&acc)[2][2][4][2], const Unit& u, int wr, int wc, int fr, int fq) const {
        const int row0 = u.pm * BM + wr * 64 + fr, col0 = u.pc * BM + wc * 32 + 4 * fq;
#pragma unroll
        for (int ai = 0; ai < 2; ++ai)
#pragma unroll
            for (int m = 0; m < 4; ++m) { float* rowp = C + (size_t)(row0 + ai * HALF + m * 16) * ldc + col0;
#pragma unroll
                for (int bj = 0; bj < 2; ++bj)
#pragma unroll
                    for (int n = 0; n < 2; ++n) *(f32x4*)(rowp + bj * HALF + n * 16) = acc[ai][bj][m][n]; }
    }
};
struct EpiResid {
    static constexpr bool PERM = false;
    const float* src_lat; float* dst_lat; const float* src_ctx; float* dst_ctx; const float* gate;
    __device__ __forceinline__ void operator()(const f32x4 (&acc)[2][2][4][2], const Unit& u, int wr, int wc, int fr, int fq) const {
        const int col0 = u.pc * BM + wc * 32 + 4 * fq;
        const float* src; float* dst; const float* gv; int row0;
        if (u.pm < 128) { row0 = u.pm * BM + wr * 64 + fr; src = src_lat; dst = dst_lat; gv = gate + (u.pm >> 6) * 6144 + 2048; }
        else { row0 = (u.pm - 128) * BM + wr * 64 + fr; src = src_ctx; dst = dst_ctx; gv = gate + 2 * 6144 + 2048; }
        f32x4 g[2][2];
#pragma unroll
        for (int bj = 0; bj < 2; ++bj)
#pragma unroll
            for (int n = 0; n < 2; ++n) g[bj][n] = *(const f32x4*)(gv + col0 + bj * HALF + n * 16);
#pragma unroll
        for (int ai = 0; ai < 2; ++ai)
#pragma unroll
            for (int m = 0; m < 4; ++m) { const size_t off = (size_t)(row0 + ai * HALF + m * 16) * 1024 + col0;
#pragma unroll
                for (int bj = 0; bj < 2; ++bj)
#pragma unroll
                    for (int n = 0; n < 2; ++n) { const f32x4 xv = *(const f32x4*)(src + off + bj * HALF + n * 16);
                        *(f32x4*)(dst + off + bj * HALF + n * 16) = xv + g[bj][n] * acc[ai][bj][m][n]; } }
    }
};
struct EpiSwiglu {
    static constexpr bool PERM = true;
    bf16_t* H;
    __device__ __forceinline__ void operator()(const f32x4 (&acc)[2][2][4][2], const Unit& u, int wr, int wc, int fr, int fq) const {
        const int row0 = u.pm * BM + wr * 64 + fr, col0 = u.pc * HALF + wc * 32 + 8 * fq;
#pragma unroll
        for (int ai = 0; ai < 2; ++ai) { if (ai == 1 && u.half) break;
#pragma unroll
            for (int m = 0; m < 4; ++m) { float h[8];
#pragma unroll
                for (int n = 0; n < 2; ++n)
#pragma unroll
                    for (int j = 0; j < 4; ++j) { const float g = acc[ai][0][m][n][j], up = acc[ai][1][m][n][j]; h[n * 4 + j] = g * __builtin_amdgcn_rcpf(1.f + __expf(-g)) * up; }
                u32x4 w; w.x = cvt_pk_bf16(h[0], h[1]); w.y = cvt_pk_bf16(h[2], h[3]); w.z = cvt_pk_bf16(h[4], h[5]); w.w = cvt_pk_bf16(h[6], h[7]);
                *(u32x4*)(H + (size_t)(row0 + ai * HALF + m * 16) * 256 + col0) = w; } }
    }
};

template <class Epi, class Sched, bool GATHER>
__device__ __forceinline__ void gemm_phase(LAS unsigned char* lds, const Gemm g, const Sched& S, const Epi& E, const int tid) {
    const int wid = __builtin_amdgcn_readfirstlane(tid >> 6), lane = tid & 63, wr = wid >> 2, wc = wid & 3, fr = lane & 15, fq = lane >> 4;
    const int K = g.K, nt = K / BK;
    int RA[2], CA[2]; unsigned voffB[2];
#pragma unroll
    for (int i = 0; i < 2; ++i) { int R, C; stage_rc(tid * 16 + i * 8192, R, C); const int Rb = Epi::PERM ? ((R & ~31) + perm32(R & 31)) : R;
        RA[i] = R; CA[i] = C; voffB[i] = (unsigned)(Rb * K + C) * 2u; }
    const unsigned kstep = (unsigned)(BK * 2);
    const unsigned hstep = (unsigned)HALF * (unsigned)K * 2u;
    const unsigned tstep = 2u * hstep;
    const unsigned ldsw = (unsigned)wid * 1024u;
    const int aoff = lds_byte(wr * 64 + fr, fq * 8), boff = lds_byte(wc * 32 + fr, fq * 8);
    const __amdgpu_buffer_rsrc_t srdA = __builtin_amdgcn_make_buffer_rsrc((void*)g.A, (short)0, 0x7fffffff, 0x00020000);
    const __amdgpu_buffer_rsrc_t srdB = __builtin_amdgcn_make_buffer_rsrc((void*)g.Bt, (short)0, 0x7fffffff, 0x00020000);
#define PG8_SA(b, h) (((b) * 2 + (h)) * HTB)
#define PG8_SB(b, h) ((4 + (b) * 2 + (h)) * HTB)
#define PG8_STAGE(bufoff, soff, voff) do { _Pragma("unroll") for (int _i = 0; _i < 2; ++_i) \
        __builtin_amdgcn_raw_ptr_buffer_load_lds(srdB, (LAS unsigned*)(lds + (bufoff) + ldsw + _i * 8192), 16, (int)(voff)[_i], (int)(soff), 0, 0); } while (0)
#define PG8_STAGE2(bufoff, soff, v0, v1) do { \
        __builtin_amdgcn_raw_ptr_buffer_load_lds(srdA, (LAS unsigned*)(lds + (bufoff) + ldsw), 16, (int)(v0), (int)(soff), 0, 0); \
        __builtin_amdgcn_raw_ptr_buffer_load_lds(srdA, (LAS unsigned*)(lds + (bufoff) + ldsw + 8192), 16, (int)(v1), (int)(soff), 0, 0); } while (0)
#define PG8_LDA(dst, b, h) do { _Pragma("unroll") for (int m = 0; m < 4; ++m) _Pragma("unroll") for (int k = 0; k < 2; ++k) dst[m][k] = *(const LAS bf16x8*)(lds + PG8_SA(b, h) + aoff + m * 2048 + k * 1024); } while (0)
#define PG8_LDB(dst, b, h) do { _Pragma("unroll") for (int n = 0; n < 2; ++n) _Pragma("unroll") for (int k = 0; k < 2; ++k) dst[n][k] = *(const LAS bf16x8*)(lds + PG8_SB(b, h) + boff + n * 2048 + k * 1024); } while (0)
#define PG8_MMA(ai, bj, At, Bt) do { __builtin_amdgcn_s_setprio(1); _Pragma("unroll") for (int m = 0; m < 4; ++m) _Pragma("unroll") for (int n = 0; n < 2; ++n) _Pragma("unroll") for (int k = 0; k < 2; ++k) \
        acc[ai][bj][m][n] = __builtin_amdgcn_mfma_f32_16x16x32_bf16(Bt[n][k], At[m][k], acc[ai][bj][m][n], 0, 0, 0); __builtin_amdgcn_s_setprio(0); } while (0)
#define PG8_WAIT_V(n) asm volatile("s_waitcnt vmcnt(" #n ")" ::: "memory")
#define PG8_WAIT_L(n) asm volatile("s_waitcnt lgkmcnt(" #n ")" ::: "memory")
#define PG8_BAR __builtin_amdgcn_s_barrier()
#define PG8_SCHED __builtin_amdgcn_sched_barrier(0)
    Unit cur, nxt; int ui = 0;
    if (!S.next(0, cur)) return;
    f32x4 acc[2][2][4][2];
#pragma unroll
    for (int a = 0; a < 2; ++a)
#pragma unroll
        for (int b = 0; b < 2; ++b)
#pragma unroll
            for (int m = 0; m < 4; ++m)
#pragma unroll
                for (int n = 0; n < 2; ++n) acc[a][b][m][n] = (f32x4){0.f, 0.f, 0.f, 0.f};
    bf16x8 At[4][2], B0[2][2], B1[2][2];
    unsigned c00, c01, c10, c11, n00, n01, n10, n11;
    unsigned cA, cB = (unsigned)cur.pn * tstep;
    if constexpr (GATHER) {
        const int* rp = g.rows + (size_t)cur.pm * BM; const unsigned rb = (unsigned)K * 2u;
        c00 = (unsigned)rp[RA[0]] * rb + (unsigned)CA[0] * 2u; c01 = (unsigned)rp[RA[1]] * rb + (unsigned)CA[1] * 2u;
        c10 = (unsigned)rp[HALF + RA[0]] * rb + (unsigned)CA[0] * 2u; c11 = (unsigned)rp[HALF + RA[1]] * rb + (unsigned)CA[1] * 2u;
        cA = 0u;
    } else {
        c00 = (unsigned)(RA[0] * K + CA[0]) * 2u; c01 = (unsigned)(RA[1] * K + CA[1]) * 2u;
        c10 = (unsigned)((HALF + RA[0]) * K + CA[0]) * 2u; c11 = (unsigned)((HALF + RA[1]) * K + CA[1]) * 2u;
        cA = (unsigned)cur.pm * tstep;
    }
    n00 = c00; n01 = c01; n10 = c10; n11 = c11;
    PG8_STAGE(PG8_SB(0, 0), cB, voffB); PG8_STAGE(PG8_SB(0, 1), cB + hstep, voffB); PG8_STAGE2(PG8_SA(0, 0), cA, c00, c01); PG8_STAGE2(PG8_SA(0, 1), cA, c10, c11);
    if (wr == 1) PG8_BAR;
    PG8_WAIT_V(2); PG8_BAR;
    PG8_STAGE(PG8_SB(1, 0), cB + kstep, voffB); PG8_STAGE2(PG8_SA(1, 0), cA + kstep, c00, c01); PG8_STAGE(PG8_SB(1, 1), cB + hstep + kstep, voffB);
    PG8_WAIT_V(6); PG8_BAR;
    for (;;) {
        const bool has_next = S.next(ui + 1, nxt);
        unsigned nA; const unsigned nB = has_next ? (unsigned)nxt.pn * tstep : cB;
        if constexpr (GATHER) {
            nA = 0u;
            if (has_next) { const int* rp = g.rows + (size_t)nxt.pm * BM; const unsigned rb = (unsigned)K * 2u;
                n00 = (unsigned)rp[RA[0]] * rb + (unsigned)CA[0] * 2u; n01 = (unsigned)rp[RA[1]] * rb + (unsigned)CA[1] * 2u;
                n10 = (unsigned)rp[HALF + RA[0]] * rb + (unsigned)CA[0] * 2u; n11 = (unsigned)rp[HALF + RA[1]] * rb + (unsigned)CA[1] * 2u; }
            else { n00 = c00; n01 = c01; n10 = c10; n11 = c11; }
        } else {
            nA = has_next ? (unsigned)nxt.pm * tstep : cA;
        }
        const bool hf = cur.half != 0;
#pragma unroll 1
        for (int t = 0; t < nt; t += 2) {
            const bool last = (t == nt - 2);
            const unsigned a1 = cA + (unsigned)(t + 1) * kstep;
            const unsigned a2 = last ? nA : cA + (unsigned)(t + 2) * kstep, b2 = last ? nB : cB + (unsigned)(t + 2) * kstep;
            const unsigned a3 = a2 + kstep, b3 = b2 + kstep;
            unsigned s00 = c00, s01 = c01, s10 = c10, s11 = c11;
            if constexpr (GATHER) { s00 = last ? n00 : c00; s01 = last ? n01 : c01; s10 = last ? n10 : c10; s11 = last ? n11 : c11; }
            PG8_LDB(B0, 0, 0); PG8_LDB(B1, 0, 1); PG8_SCHED; PG8_LDA(At, 0, 0); PG8_STAGE2(PG8_SA(1, 1), a1, c10, c11);
            PG8_WAIT_V(8); PG8_WAIT_L(0); PG8_BAR; PG8_MMA(0, 0, At, B0); PG8_MMA(0, 1, At, B1); PG8_BAR; PG8_SCHED;
            if (!hf) PG8_LDA(At, 0, 1); PG8_STAGE(PG8_SB(0, 0), b2, voffB); PG8_STAGE(PG8_SB(0, 1), b2 + hstep, voffB); PG8_STAGE2(PG8_SA(0, 0), a2, s00, s01);
            PG8_WAIT_V(8); PG8_WAIT_L(0); PG8_BAR; if (!hf) { PG8_MMA(1, 0, At, B0); PG8_MMA(1, 1, At, B1); } PG8_BAR; PG8_SCHED;
            PG8_LDB(B0, 1, 0); PG8_LDB(B1, 1, 1); PG8_SCHED; PG8_LDA(At, 1, 0); PG8_STAGE2(PG8_SA(0, 1), a2, s10, s11);
            PG8_WAIT_V(8); PG8_WAIT_L(0); PG8_BAR; PG8_MMA(0, 0, At, B0); PG8_MMA(0, 1, At, B1); PG8_BAR; PG8_SCHED;
            if (!hf) PG8_LDA(At, 1, 1); PG8_STAGE(PG8_SB(1, 0), b3, voffB); PG8_STAGE(PG8_SB(1, 1), b3 + hstep, voffB); PG8_STAGE2(PG8_SA(1, 0), a3, s00, s01);
            PG8_WAIT_V(8); PG8_WAIT_L(0); PG8_BAR; if (!hf) { PG8_MMA(1, 0, At, B0); PG8_MMA(1, 1, At, B1); } PG8_BAR; PG8_SCHED;
        }
        if (wr == 0) PG8_BAR;
        E(acc, cur, wr, wc, fr, fq);
        if (!has_next) break;
#pragma unroll
        for (int a = 0; a < 2; ++a)
#pragma unroll
            for (int b = 0; b < 2; ++b)
#pragma unroll
                for (int m = 0; m < 4; ++m)
#pragma unroll
                    for (int n = 0; n < 2; ++n) acc[a][b][m][n] = (f32x4){0.f, 0.f, 0.f, 0.f};
        cur = nxt; cA = nA; cB = nB; ++ui;
        if constexpr (GATHER) { c00 = n00; c01 = n01; c10 = n10; c11 = n11; }
        if (wr == 1) PG8_BAR;
    }
    PG8_WAIT_V(0);
    PG8_BAR;
#undef PG8_SA
#undef PG8_SB
#undef PG8_STAGE
#undef PG8_STAGE2
#undef PG8_LDA
#undef PG8_LDB
#undef PG8_MMA
#undef PG8_WAIT_V
#undef PG8_WAIT_L
#undef PG8_BAR
#undef PG8_SCHED
}
}

#define XB_TMO      128
#define XB_XCNT(j)  (256  + 64 * (j))
#define XB_XSUB(j)  (1280 + 64 * (j))
#define XB_XGEN(j)  (2304 + 64 * (j))
#define XB_TOP      3328
#define XB_TOPGEN   3392
#define XCD_BAR_WORDS 3456
#define XB_SPIN_CAP (1u << 18)

__device__ __forceinline__ unsigned xb_ld(unsigned* p)              { return __hip_atomic_load(p, __ATOMIC_RELAXED, __HIP_MEMORY_SCOPE_AGENT); }
__device__ __forceinline__ unsigned xb_add(unsigned* p, unsigned v) { return __hip_atomic_fetch_add(p, v, __ATOMIC_RELAXED, __HIP_MEMORY_SCOPE_AGENT); }
__device__ __forceinline__ unsigned xb_xcc_id() { return (unsigned)__builtin_amdgcn_s_getreg((3 << 11) | 20) & 0xFu; }
#define XB_SPIN(cond, bar) do { unsigned _sp = 0; while (cond) { __builtin_amdgcn_s_sleep(1); \
    if ((++_sp & 255u) == 0u) { if (xb_ld(&(bar)[XB_TMO])) break; if (_sp > XB_SPIN_CAP) { atomicAdd(&(bar)[XB_TMO], 1u); break; } } } } while (0)

struct XcdBarrier { unsigned* bar; unsigned x; volatile LAS unsigned* st; };

__device__ __forceinline__ XcdBarrier xcd_barrier_post(unsigned* bar, volatile LAS unsigned* st) {
    XcdBarrier b; b.bar = bar; b.x = xb_xcc_id(); b.st = st;
    if (threadIdx.x == 0) (void)xb_add(&bar[XB_XCNT(b.x)], 1u);
    return b;
}
__device__ __forceinline__ void xcd_barrier_complete(unsigned* bar, unsigned x, unsigned& nloc, unsigned& nx) {
    const unsigned G = gridDim.x * gridDim.y * gridDim.z;
    unsigned sum, cnt, mine, sp = 0u;
    for (;;) {
        sum = 0u; cnt = 0u; mine = 0u;
#pragma unroll 1
        for (unsigned j = 0; j < 16; ++j) { const unsigned c = xb_ld(&bar[XB_XCNT(j)]); sum += c; cnt += (c > 0u) ? 1u : 0u; mine = (j == x) ? c : mine; }
        if (sum == G) break;
        __builtin_amdgcn_s_sleep(1);
        if ((++sp & 255u) == 0u) { if (xb_ld(&bar[XB_TMO])) break; if (sp > XB_SPIN_CAP) { atomicAdd(&bar[XB_TMO], 1u); break; } }
    }
    nloc = mine > 0u ? mine : 1u; nx = cnt > 0u ? cnt : 1u;
}
__device__ __forceinline__ void xcd_barrier(const XcdBarrier& b) {
    asm volatile("s_waitcnt vmcnt(0)" ::: "memory");
    __syncthreads();
    if (threadIdx.x == 0) {
        unsigned* bar = b.bar;
        __builtin_amdgcn_s_waitcnt(0);
        unsigned nloc = b.st[0], nx = b.st[1];
        if (nloc == 0u) { xcd_barrier_complete(bar, b.x, nloc, nx); b.st[0] = nloc; b.st[1] = nx; }
        const unsigned old = xb_add(&bar[XB_XSUB(b.x)], 1u);
        const unsigned gen = old / nloc;
        if (old + 1u == (gen + 1u) * nloc) {
            __builtin_amdgcn_fence(__ATOMIC_RELEASE, "agent");
            asm volatile("s_waitcnt vmcnt(0)" ::: "memory");
            const unsigned og = xb_add(&bar[XB_TOP], 1u);
            const unsigned tg = og / nx;
            if (og + 1u == (tg + 1u) * nx) xb_add(&bar[XB_TOPGEN], 1u);
            else XB_SPIN(xb_ld(&bar[XB_TOPGEN]) == tg, bar);
            __builtin_amdgcn_fence(__ATOMIC_ACQUIRE, "agent");
            xb_add(&bar[XB_XGEN(b.x)], 1u);
            asm volatile("s_waitcnt vmcnt(0)" ::: "memory");
        } else {
            XB_SPIN(xb_ld(&bar[XB_XGEN(b.x)]) == gen, bar);
            __builtin_amdgcn_fence(__ATOMIC_ACQUIRE, "agent");
            asm volatile("s_waitcnt vmcnt(0)" ::: "memory");
        }
    }
    __syncthreads();
}

constexpr int D = 1024, NBATCH = 2, SEQ = 16384, CTXL = 256;
constexpr int TL = NBATCH * SEQ, TC = NBATCH * CTXL, TT = TL + TC;
constexpr int INW = 3328;
constexpr int ZQ = 0, ZFF = 512, ZFB = 1024, ZV = 1536, ZG = 2048, ZXB = 2560, ZYB = 2816, ZU = 3072;
constexpr int NEXP = 256, TOPK = 8;
constexpr float EPS = 1e-6f;
constexpr int NWAVES = 8, NTHR = 512;
constexpr int CV_TILES = 257 * 48;
constexpr int CV_OUTP = 248 * 6;
constexpr int CV_ROUT = 126 * 10;
constexpr int HG_SLOTS = 130;
constexpr int LR_SLOTS = 260;
constexpr int MAXROWS = 364800;

constexpr size_t MiB = 1u << 20;
constexpr size_t WS_CTL = 0, CTL_ZERO_BYTES = 1 * MiB;
constexpr size_t WS_MOD = 1 * MiB;
constexpr size_t WS_TAB = 2 * MiB;
constexpr size_t TAB_FC = 0, TAB_FS = 32768, TAB_CS = 65536, TAB_LB = 81920  , TAB_LRUW = 86016  , TAB_LRUCL = 348160  , TAB_C256 = 352256  , TAB_S256 = 483328  ;
constexpr size_t WS_META = 3 * MiB;
constexpr size_t WS_WIN = 4 * MiB;
constexpr size_t WS_WOUT = 18 * MiB;
constexpr size_t WS_WR = 22 * MiB;
constexpr size_t WS_XC = 24 * MiB;
constexpr size_t WS_LRUC = 26 * MiB;
constexpr size_t LRUC_STRIDE = (size_t)2 * 2 * LR_SLOTS * 256 * 4;
constexpr size_t WS_SEL = 30 * MiB;
constexpr size_t SEL_STRIDE = (size_t)TT * 8 * 4;
constexpr size_t WS_ROWTOK = 34 * MiB;
constexpr size_t WS_HD = 36 * MiB;
constexpr size_t WS_LOGIT = 38 * MiB;
constexpr size_t WS_HB = 72 * MiB;
constexpr size_t WS_WEXP = 138 * MiB;
constexpr size_t WEXP_GU_BYTES = (size_t)257 * 512 * 1024 * 2;
constexpr size_t WS_BIG = 524 * MiB;
constexpr size_t WS_Z = WS_BIG;
constexpr size_t WS_MIX = WS_BIG + 212 * MiB;
constexpr size_t WS_HS = WS_BIG + 278 * MiB;
constexpr size_t WS_FA = WS_BIG + 410 * MiB;
constexpr size_t WS_GE = WS_BIG + 442 * MiB;
constexpr size_t WS_GK = WS_BIG + 508 * MiB;
constexpr size_t WS_HV = WS_BIG + 574 * MiB;
constexpr size_t WS_HBUF = WS_BIG;
constexpr size_t WS_Y = WS_BIG + 180 * MiB;
constexpr size_t WS_WEXP1 = 1104 * MiB;
constexpr size_t WS_END = WS_WEXP1 + (size_t)257 * 1536 * 1024;
static_assert(WS_Y + (size_t)MAXROWS * 1024 <= WS_WEXP1 && WS_HV + (size_t)16 * 2 * HG_SLOTS * 256 * 4 <= WS_WEXP1 && WS_GK + (size_t)2 * TT * 512 * 2 <= WS_HV && WS_GE + (size_t)2 * TT * 512 * 2 <= WS_GK && WS_FA + (size_t)2 * 2 * 128 * 128 * 256 * 2 <= WS_GE, "overlay regions end below the second weight buffer");
static_assert(WS_Z + (size_t)TT * INW * 2 <= WS_MIX && WS_MIX + (size_t)TT * 1024 * 2 <= WS_HS && WS_HS + (size_t)16 * HG_SLOTS * 65536 <= WS_FA, "mixer overlay map");
static_assert(WS_HBUF + (size_t)MAXROWS * 256 * 2 <= WS_Y && WS_WEXP + (size_t)257 * 1536 * 1024 <= WS_BIG && WS_HB + (size_t)TT * 2048 <= WS_WEXP, "moe overlay map");
constexpr int CW_BAR = 4096;
constexpr int CW_CVQ = 8192;
constexpr int CW_CNT = 16384;

constexpr int LDS_BYTES = 151552;
constexpr int MISC_OFF = 150528;

struct Args { const float* in[28]; float* out; unsigned char* ws; int ph_lo, ph_hi; };

typedef const float* cfptr;
#define CAS __attribute__((address_space(4)))
struct Frame {
    LAS unsigned char* lds;
    int tid, lane, wave, G;
    const CAS cfptr* in;
    float* out; unsigned char* ws;
};
#define F_X(F)      ((F).in[0])
#define F_C(F)      ((F).in[1])
#define F_CTX(F)    ((F).in[2])
#define F_CCTX(F)   ((F).in[3])

__device__ __forceinline__ float wave_sum(float v) {
#pragma unroll
    for (int o = 1; o < 64; o <<= 1) v += __shfl_xor(v, o);
    return v;
}
__device__ __forceinline__ float sigmoidf_(float z) { return __builtin_amdgcn_rcpf(1.f + __expf(-z)); }

__device__ __forceinline__ void transpose_item(const float* W, int ldw, int k0, int n0, bf16* WT, int ldk, int drow0, LAS float* scr, int lane) {
#pragma unroll 8
    for (int i = 0; i < 32; ++i) { const int kk = 2 * i + (lane >> 5); scr[kk * 33 + (lane & 31)] = W[(size_t)(k0 + kk) * ldw + n0 + (lane & 31)]; }
    LDS_WAIT();
    const int c = lane & 7;
#pragma unroll
    for (int j = 0; j < 4; ++j) { const int n = (lane >> 3) + 8 * j; const LAS float* s = scr + (8 * c) * 33 + n;
        u32x4 o; o.x = pk2(s[0 * 33], s[1 * 33]); o.y = pk2(s[2 * 33], s[3 * 33]); o.z = pk2(s[4 * 33], s[5 * 33]); o.w = pk2(s[6 * 33], s[7 * 33]);
        *(u32x4*)(WT + (size_t)(drow0 + n) * ldk + k0 + 8 * c) = o; }
    LDS_WAIT();
}

__device__ __forceinline__ void norm_row_bf16(const float* xrow, const float* gain, const float* scl, const float* sft, bf16* orow, int lane) {
    f32x4 v[4]; float s = 0.f;
#pragma unroll
    for (int j = 0; j < 4; ++j) { v[j] = *(const f32x4*)(xrow + 4 * lane + 256 * j); s += (v[j].x * v[j].x + v[j].y * v[j].y) + (v[j].z * v[j].z + v[j].w * v[j].w); }
    const float rstd = rsqrtf(wave_sum(s) * (1.f / D) + EPS);
#pragma unroll
    for (int j = 0; j < 4; ++j) { const int c = 4 * lane + 256 * j;
        const f32x4 g = *(const f32x4*)(gain + c), sc = *(const f32x4*)(scl + c), sh = *(const f32x4*)(sft + c);
        const f32x4 y = v[j] * rstd * g * (sc + 1.f) + sh;
        u32x2 o; o.x = pk2(y.x, y.y); o.y = pk2(y.z, y.w); *(u32x2*)(orow + c) = o; }
}

__device__ __forceinline__ void convert_tile(Frame& F, const float* src, int ldw, bf16* dst, int ldk, int k0, int rowA, int rowB) {
    LAS bf16* T = (LAS bf16*)F.lds;
    const int tid = F.tid, w = F.wave, lane = F.lane;
    f32x4 v[8];
#pragma unroll
    for (int j = 0; j < 8; ++j) v[j] = *(const f32x4*)(src + (size_t)(8 * w + j) * ldw + 4 * lane);
#pragma unroll
    for (int j = 0; j < 8; ++j) { u32x2 o; o.x = pk2(v[j].x, v[j].y); o.y = pk2(v[j].z, v[j].w); *(LAS u32x2*)(T + (8 * w + j) * 264 + ((4 * lane) ^ (w << 3))) = o; }
    __syncthreads();
#pragma unroll
    for (int j = 0; j < 4; ++j) { const int p = tid + NTHR * j, kc = p & 7, n = p >> 3; const LAS bf16* t = T + (8 * kc) * 264 + (n ^ (kc << 3));
        u32x4 o; o.x = (unsigned)t[0] | ((unsigned)t[264] << 16); o.y = (unsigned)t[2 * 264] | ((unsigned)t[3 * 264] << 16);
        o.z = (unsigned)t[4 * 264] | ((unsigned)t[5 * 264] << 16); o.w = (unsigned)t[6 * 264] | ((unsigned)t[7 * 264] << 16);
        const int row = n < 128 ? rowA + n : rowB + n - 128;
        *(u32x4*)(dst + (size_t)row * ldk + k0 + 8 * kc) = o; }
    __syncthreads();
}

__device__ __forceinline__ void phase_g0(Frame& F) {
    float* mod = (float*)(F.ws + WS_MOD);
    {
        LAS float* sc = (LAS float*)F.lds; LAS float* red = sc + 3072;
        for (int u = blockIdx.x; u < 192; u += F.G) {
            const int l = u / 96, n0 = (u % 96) * 64;
            for (int i = F.tid; i < 3072; i += NTHR) { const int r = i >> 10, k = i & 1023; const float c = r < 2 ? F_C(F)[r * 1024 + k] : F_CCTX(F)[k]; sc[i] = c / (1.f + __expf(-c)); }
            __syncthreads();
            const int col = F.tid & 63, kg = F.tid >> 6;
            const float* W = F.in[4] + (size_t)l * 1024 * 6144 + n0 + col;
            float a0 = 0.f, a1 = 0.f, a2 = 0.f;
#pragma unroll 8
            for (int k = kg * 128; k < kg * 128 + 128; ++k) { const float w = W[(size_t)k * 6144]; a0 += sc[k] * w; a1 += sc[1024 + k] * w; a2 += sc[2048 + k] * w; }
            red[(kg * 3 + 0) * 64 + col] = a0; red[(kg * 3 + 1) * 64 + col] = a1; red[(kg * 3 + 2) * 64 + col] = a2;
            __syncthreads();
            if (F.tid < 192) { const int r = F.tid >> 6, cc = F.tid & 63; float s = F.in[5][l * 6144 + n0 + cc];
#pragma unroll
                for (int q = 0; q < 8; ++q) s += red[(q * 3 + r) * 64 + cc];
                mod[(l * 3 + r) * 6144 + n0 + cc] = s; }
            __syncthreads();
        }
    }
    {
        constexpr int PER_L = 16 * (13 + 4 + 1);
        for (int it = blockIdx.x; it < 2 * PER_L; it += F.G) {
            const int l = it / PER_L; int r = it % PER_L; const int kb = r / 18; r %= 18;
            if (r < 13) convert_tile(F, F.in[8] + (size_t)l * 1024 * INW + (size_t)(64 * kb) * INW + 256 * r, INW, (bf16*)(F.ws + WS_WIN) + (size_t)l * INW * 1024, 1024, 64 * kb, 256 * r, 256 * r + 128);
            else if (r < 17) convert_tile(F, F.in[18] + (size_t)l * 1024 * 1024 + (size_t)(64 * kb) * 1024 + 256 * (r - 13), 1024, (bf16*)(F.ws + WS_WOUT) + (size_t)l * 1024 * 1024, 1024, 64 * kb, 256 * (r - 13), 256 * (r - 13) + 128);
            else convert_tile(F, F.in[19] + (size_t)l * 1024 * 256 + (size_t)(64 * kb) * 256, 256, (bf16*)(F.ws + WS_WR) + (size_t)l * 256 * 1024, 1024, 64 * kb, 0, 128);
        }
    }
    {
        const int gt = blockIdx.x * NTHR + F.tid, NGT = F.G * NTHR;
        bf16* Fc = (bf16*)(F.ws + WS_TAB + TAB_FC); bf16* Fs = (bf16*)(F.ws + WS_TAB + TAB_FS); bf16* CS = (bf16*)(F.ws + WS_TAB + TAB_CS);
        for (int i = gt; i < 128 * 128; i += NGT) { const int k = i >> 7, n = i & 127; float s, c; sincospif((float)((k * n) & 127) * (1.f / 64.f), &s, &c); Fc[i] = f2bf(c); Fs[i] = f2bf(s); }
        for (int i = gt; i < 64 * 128; i += NGT) { const int m = i >> 7, kap = i & 127; float s, c; sincospif((float)((m * (kap & 63)) & 63) * (1.f / 32.f), &s, &c); CS[i] = f2bf(kap < 64 ? c : s); }
        bf16* C256 = (bf16*)(F.ws + WS_TAB + TAB_C256); bf16* S256 = (bf16*)(F.ws + WS_TAB + TAB_S256);
        for (int i = gt; i < 256 * 256; i += NGT) { const int k = i >> 8, n = i & 255; float sn, cs; sincospif((float)((k * n) & 255) * (1.f / 128.f), &sn, &cs); C256[i] = f2bf(cs); S256[i] = f2bf(-sn); }
        float* lb = (float*)(F.ws + WS_TAB + TAB_LB);
        for (int i = gt; i < 1024; i += NGT) { const int l = i >> 9, ch = i & 511; lb[i] = l == 0 ? 0.f : sigmoidf_(F.in[9][512 + ch] - F.in[9][ch]); }
        bf16* lw = (bf16*)(F.ws + WS_TAB + TAB_LRUW);
        for (int i = gt; i < 2 * 2 * 4 * 128 * 64; i += NGT) {
            const int k = i & 63, n = (i >> 6) & 127, ldh = i >> 13;
            const float v = n < 64 ? F.in[13][(size_t)ldh * 4096 + k * 64 + n] : F.in[15][(size_t)ldh * 4096 + k * 64 + (n - 64)];
            lw[i] = f2bf(v); }
        float* cl = (float*)(F.ws + WS_TAB + TAB_LRUCL);
        for (int i = gt; i < 1024; i += NGT) { const float lam = F.in[17][i]; const float sp = lam > 15.f ? __expf(-lam) : log1pf(__expf(-lam)); cl[i] = 8.f * sp; }
    }
}

__device__ __forceinline__ void hprep_rows(Frame& F, int l, const float* xlat, const float* xctx, int nrows, int voff_sh, int voff_sc, const float* gain) {
    const float* mod = (const float*)(F.ws + WS_MOD) + (size_t)l * 3 * 6144;
    bf16* HB = (bf16*)(F.ws + WS_HB);
    const int gw = blockIdx.x * NWAVES + F.wave, NGW = F.G * NWAVES;
    for (int m = gw; m < nrows; m += NGW) {
        const float* xr = m < TL ? xlat + (size_t)m * D : xctx + (size_t)(m - TL) * D; const int r = m < TL ? (m >> 14) : 2;
        norm_row_bf16(xr, gain, mod + r * 6144 + voff_sc, mod + r * 6144 + voff_sh, HB + (size_t)m * D, F.lane);
    }
}

__device__ __forceinline__ void cv_tile(Frame& F, int it_all) {
    const int l = it_all >= CV_TILES ? 1 : 0, it = it_all - l * CV_TILES;
    unsigned char* wb = F.ws + (l ? WS_WEXP1 : WS_WEXP);
    bf16* WGU = (bf16*)wb; bf16* WD = (bf16*)(wb + WEXP_GU_BYTES);
    const int e = it / 48, t = it % 48;
    if (t < 32) {
        const int mat = t >> 4, kb = t & 15;
        const float* src = (e < 256 ? (mat == 0 ? F.in[21] : F.in[22]) + ((size_t)l * 256 + e) * 1024 * 256 : (mat == 0 ? F.in[24] : F.in[25]) + (size_t)l * 1024 * 256) + (size_t)(64 * kb) * 256;
        convert_tile(F, src, 256, WGU, 1024, 64 * kb, e * 512 + mat * 128, e * 512 + 256 + mat * 128);
    } else {
        const int kb = (t - 32) >> 2, nb = (t - 32) & 3;
        const float* src = (e < 256 ? F.in[23] + ((size_t)l * 256 + e) * 256 * 1024 : F.in[26] + (size_t)l * 256 * 1024) + (size_t)(64 * kb) * 1024 + 256 * nb;
        convert_tile(F, src, 1024, WD, 256, 64 * kb, e * 1024 + 256 * nb, e * 1024 + 256 * nb + 128);
    }
}
__device__ __forceinline__ int cv_pull(Frame& F) {
    volatile LAS int* slot = (volatile LAS int*)(F.lds + MISC_OFF) + 16;
    if (F.tid == 0) { const unsigned t = __hip_atomic_fetch_add((unsigned*)(F.ws + WS_CTL) + CW_CVQ, 1u, __ATOMIC_RELAXED, __HIP_MEMORY_SCOPE_AGENT); slot[0] = t < (unsigned)(2 * CV_TILES) ? (int)t : -1; }
    __syncthreads(); const int t = slot[0]; __syncthreads(); return t;
}
__device__ __forceinline__ void convert_experts(Frame& F, int l) {
    for (;;) { const int t = cv_pull(F); if (t < 0) break; cv_tile(F, t); if (t >= (l + 1) * CV_TILES) break; }
}

__device__ __forceinline__ void xcd_barrier_cv(const XcdBarrier& b, Frame& F) {
    volatile LAS unsigned* st = (volatile LAS unsigned*)(F.lds + MISC_OFF) + 20;
    asm volatile("s_waitcnt vmcnt(0)" ::: "memory");
    __syncthreads();
    if (threadIdx.x == 0) {
        unsigned* bar = b.bar;
        __builtin_amdgcn_s_waitcnt(0);
        unsigned nloc = b.st[0], nx = b.st[1];
        if (nloc == 0u) { xcd_barrier_complete(bar, b.x, nloc, nx); b.st[0] = nloc; b.st[1] = nx; }
        const unsigned old = xb_add(&bar[XB_XSUB(b.x)], 1u);
        const unsigned gen = old / nloc;
        if (old + 1u == (gen + 1u) * nloc) {
            __builtin_amdgcn_fence(__ATOMIC_RELEASE, "agent");
            asm volatile("s_waitcnt vmcnt(0)" ::: "memory");
            const unsigned og = xb_add(&bar[XB_TOP], 1u);
            const unsigned tg = og / nx;
            if (og + 1u == (tg + 1u) * nx) xb_add(&bar[XB_TOPGEN], 1u);
            else XB_SPIN(xb_ld(&bar[XB_TOPGEN]) == tg, bar);
            __builtin_amdgcn_fence(__ATOMIC_ACQUIRE, "agent");
            xb_add(&bar[XB_XGEN(b.x)], 1u);
            asm volatile("s_waitcnt vmcnt(0)" ::: "memory");
            st[0] = 0u;
        } else { st[0] = 1u; st[1] = gen; }
        st[2] = 0u;
    }
    __syncthreads();
    if (st[0]) {
        unsigned spins = 0u;
        for (;;) {
            int tile = -1;
            if (threadIdx.x == 0) {
                unsigned rel = xb_ld(&b.bar[XB_XGEN(b.x)]) != st[1] ? 1u : 0u;
                if (!rel && (++spins & 255u) == 0u) { if (xb_ld(&b.bar[XB_TMO])) rel = 1u; else if (spins > XB_SPIN_CAP) { atomicAdd(&b.bar[XB_TMO], 1u); rel = 1u; } }
                st[2] = rel;
                if (!rel && st[3] == 0u) { const unsigned t = __hip_atomic_fetch_add((unsigned*)(F.ws + WS_CTL) + CW_CVQ, 1u, __ATOMIC_RELAXED, __HIP_MEMORY_SCOPE_AGENT);
                    if (t < (unsigned)(2 * CV_TILES)) tile = (int)t; else st[3] = 1u; }
                st[4] = (unsigned)tile;
            }
            __syncthreads();
            const unsigned rel = st[2]; tile = (int)st[4];
            __syncthreads();
            if (rel) break;
            if (tile >= 0) cv_tile(F, tile); else __builtin_amdgcn_s_sleep(2);
        }
        if (threadIdx.x == 0) {
            st[3] = 0u;
            __builtin_amdgcn_fence(__ATOMIC_ACQUIRE, "agent");
            asm volatile("s_waitcnt vmcnt(0)" ::: "memory");
        }
    }
    __syncthreads();
}

constexpr int QS = 144, TS = 80;
constexpr int HG_QT = 0, HG_KT = 18432, HG_KTT = 36864, HG_VT = 57344, HG_SMT = 77824, HG_PM = 114688, HG_TOT = 124928, HG_BMID = 126976, HG_BEND = 127488, HG_RSS = 128000, HG_VR = 132096;
static_assert(HG_VR + 64 * QS * 2 <= MISC_OFF, "HGRN2 LDS map");

__device__ __forceinline__ float fast_rcp(float x) { return __builtin_amdgcn_rcpf(x); }

template <int VAR>
__device__ __forceinline__ void hg_chunk_c1(Frame& F, const bf16* Zc, bf16* gq, bf16* gk, float* hv, const bf16* nz, const bf16* nq, const bool has_next, u32x4 (&zq)[4], int h, int rev, const float* lbp, f32x4 (&S)[8], float& dtot) {
    LAS bf16* Qt = (LAS bf16*)(F.lds + HG_QT); LAS bf16* Kt = (LAS bf16*)(F.lds + HG_KT); LAS bf16* KtT = (LAS bf16*)(F.lds + HG_KTT);
    LAS bf16* VT = (LAS bf16*)(F.lds + HG_VT); LAS bf16* Vr = (LAS bf16*)(F.lds + HG_VR);
    LAS float* tot = (LAS float*)(F.lds + HG_TOT); LAS float* bmid = (LAS float*)(F.lds + HG_BMID); LAS float* bend = (LAS float*)(F.lds + HG_BEND);
    LAS float* ebuf = (LAS float*)(F.lds + HG_RSS);
    const int tid = F.tid, lane = F.lane, w = F.wave, li = lane & 15, lq = lane >> 4;
    u32x4 vv[2];
#pragma unroll
    for (int j = 0; j < 2; ++j) { const int p = tid + NTHR * j, row = p >> 4, c16 = p & 15;
        vv[j] = *(const u32x4*)(Zc + (size_t)row * INW + ZV + h * 128 + 8 * c16);
        *(LAS u32x4*)(Kt + row * QS + 8 * c16) = zq[j]; *(LAS u32x4*)(Qt + row * QS + 8 * c16) = zq[2 + j]; }
    LDS_BARRIER();
    const int ch = tid & 127, tq = tid >> 7;
    const float lbv = lbp[h * 128 + ch], oml = 1.f - lbv;
    float cb[16];
#pragma unroll
    for (int i = 0; i < 16; ++i) { float z = bf2f(Kt[(16 * tq + i) * QS + ch]); z = fminf(fmaxf(z, -30.f), 30.f);
        if (VAR & 1) cb[i] = z * -0.01f; else { const float e = __expf(-z), sg = fast_rcp(1.f + e); cb[i] = __logf(lbv + oml * sg);
            Kt[(16 * tq + i) * QS + ch] = f2bf(oml * e * sg); } }
    float run = 0.f;
    if (!rev) {
#pragma unroll
        for (int i = 0; i < 16; ++i) { run += cb[i]; cb[i] = run; }
    } else {
#pragma unroll
        for (int i = 15; i >= 0; --i) { run += cb[i]; cb[i] = run; }
    }
    tot[tq * 128 + ch] = run;
#pragma unroll
    for (int j = 0; j < 2; ++j) { const int p = tid + NTHR * j, row = p >> 4, c16 = p & 15; *(LAS u32x4*)(Vr + row * QS + 8 * c16) = vv[j]; }
    LDS_BARRIER();
    {
        const float t0 = tot[ch], t1 = tot[128 + ch], t2 = tot[256 + ch], t3 = tot[384 + ch];
        const float off = !rev ? ((tq > 0 ? t0 : 0.f) + (tq > 1 ? t1 : 0.f) + (tq > 2 ? t2 : 0.f)) : ((tq < 3 ? t3 : 0.f) + (tq < 2 ? t2 : 0.f) + (tq < 1 ? t1 : 0.f));
#pragma unroll
        for (int i = 0; i < 16; ++i) cb[i] += off;
        const float total = (t0 + t1) + (t2 + t3);
        if (tq == 2) bmid[ch] = cb[0];
        if (tq == 0) { bend[ch] = total; dtot += total; }
    }
    LDS_BARRIER();
    if (!(VAR & 2)) {
        const float bm = bmid[ch];
        unsigned kp[8], vp[8];
#pragma unroll
        for (int i = 0; i < 16; ++i) { const float d = fminf(fmaxf(cb[i] - bm, -80.f), 80.f);
            const float ed = __expf(d);
            Qt[(16 * tq + i) * QS + ch] = f2bf(bf2f(Qt[(16 * tq + i) * QS + ch]) * ed);
            const unsigned kb = f2bfu(bf2f(Kt[(16 * tq + i) * QS + ch]) * fast_rcp(ed)); Kt[(16 * tq + i) * QS + ch] = (bf16)kb;
            const unsigned vb = Vr[(16 * tq + i) * QS + ch];
            if (i & 1) { kp[i >> 1] |= kb << 16; vp[i >> 1] |= vb << 16; } else { kp[i >> 1] = kb; vp[i >> 1] = vb; } }
        *(LAS u32x4*)(KtT + ch * TS + 16 * tq) = (u32x4){kp[0], kp[1], kp[2], kp[3]};
        *(LAS u32x4*)(KtT + ch * TS + 16 * tq + 8) = (u32x4){kp[4], kp[5], kp[6], kp[7]};
        *(LAS u32x4*)(VT + ch * TS + 16 * tq) = (u32x4){vp[0], vp[1], vp[2], vp[3]};
        *(LAS u32x4*)(VT + ch * TS + 16 * tq + 8) = (u32x4){vp[4], vp[5], vp[6], vp[7]};
        if (tid < 128) { const float bmv = bmid[tid], e1 = __expf(bmv), e2 = __expf(bend[tid] - bmv); hv[tid] = e1; hv[128 + tid] = e2; ebuf[tid] = e1; ebuf[128 + tid] = e2; }
    }
    if (has_next) {
#pragma unroll
        for (int j = 0; j < 2; ++j) { const int p = tid + NTHR * j, row = p >> 4, c16 = p & 15;
            zq[j] = *(const u32x4*)(nz + (size_t)row * INW + 8 * c16); zq[2 + j] = *(const u32x4*)(nq + (size_t)row * INW + 8 * c16); }
    }
    LDS_BARRIER();
    if (!(VAR & 4))
#pragma unroll
    for (int j = 0; j < 2; ++j) { const int p = tid + NTHR * j, row = p >> 4, c16 = p & 15;
        *(u32x4*)(gq + (size_t)row * 512 + 8 * c16) = *(const LAS u32x4*)(Qt + row * QS + 8 * c16);
        *(u32x4*)(gk + (size_t)row * 512 + 8 * c16) = *(const LAS u32x4*)(Kt + row * QS + 8 * c16); }
    if (!(VAR & 8)) {
#pragma unroll
    for (int i = 0; i < 8; ++i) S[i] = S[i] * *(const LAS f32x4*)(ebuf + 16 * i + 4 * lq);
    bf16x8 bv[2];
#pragma unroll
    for (int ks = 0; ks < 2; ++ks) bv[ks] = *(const LAS bf16x8*)(VT + (16 * w + li) * TS + 32 * ks + 8 * lq);
    bf16x8 ak[2][2];
#pragma unroll
    for (int ks = 0; ks < 2; ++ks) ak[0][ks] = *(const LAS bf16x8*)(KtT + li * TS + 32 * ks + 8 * lq);
#pragma unroll
    for (int i = 0; i < 8; ++i) { const int cb_ = i & 1;
        if (i < 7) {
#pragma unroll
            for (int ks = 0; ks < 2; ++ks) ak[cb_ ^ 1][ks] = *(const LAS bf16x8*)(KtT + (16 * (i + 1) + li) * TS + 32 * ks + 8 * lq); }
        __builtin_amdgcn_sched_barrier(0);
#pragma unroll
        for (int ks = 0; ks < 2; ++ks) S[i] = MFMA16(ak[cb_][ks], bv[ks], S[i]);
        S[i] = S[i] * *(const LAS f32x4*)(ebuf + 128 + 16 * i + 4 * lq); }
    }
    LDS_BARRIER();
}

struct HgPtrs { const bf16* q; const bf16* k; const bf16* v; const float* hv; };
__device__ __forceinline__ void hg_load6(const HgPtrs& P, int tid, u32x4 (&pre)[7]) {
    pre[6] = *(const u32x4*)(P.hv + 4 * (tid & 63));
#pragma unroll
    for (int j = 0; j < 2; ++j) { const int p = tid + NTHR * j, row = p >> 4, c16 = p & 15;
        pre[j] = *(const u32x4*)(P.q + (size_t)row * 512 + 8 * c16); pre[2 + j] = *(const u32x4*)(P.k + (size_t)row * 512 + 8 * c16); pre[4 + j] = *(const u32x4*)(P.v + (size_t)row * INW + 8 * c16); }
}
template <int VAR>
__device__ __forceinline__ void hg_chunk_c3(Frame& F, const u32x4 (&cur)[7], int rev, f32x4 (&S)[8], f32x4 (&O)[4], bool do_state, const float* Snext) {
    LAS bf16* Qt = (LAS bf16*)(F.lds + HG_QT); LAS bf16* Kt = (LAS bf16*)(F.lds + HG_KT); LAS bf16* KtT = (LAS bf16*)(F.lds + HG_KTT);
    LAS bf16* VT = (LAS bf16*)(F.lds + HG_VT); LAS bf16* SmT = (LAS bf16*)(F.lds + HG_SMT); LAS bf16* Pm = (LAS bf16*)(F.lds + HG_PM); LAS bf16* Vr = (LAS bf16*)(F.lds + HG_VR);
    const int tid = F.tid, lane = F.lane, w = F.wave, li = lane & 15, lq = lane >> 4;
#pragma unroll
    for (int j = 0; j < 2; ++j) { const int p = tid + NTHR * j, row = p >> 4, c16 = p & 15;
        *(LAS u32x4*)(Qt + row * QS + 8 * c16) = cur[j]; *(LAS u32x4*)(Kt + row * QS + 8 * c16) = cur[2 + j]; *(LAS u32x4*)(Vr + row * QS + 8 * c16) = cur[4 + j]; }
    LAS float* ebuf = (LAS float*)(F.lds + HG_BMID);
    if (tid < 64) *(LAS u32x4*)(ebuf + 4 * tid) = cur[6];
    LDS_BARRIER();
    if (!(VAR & 2)) {
        const int ch = tid & 127, tq = tid >> 7; unsigned kp[8], vp[8];
#pragma unroll
        for (int i = 0; i < 16; ++i) { const unsigned vb = Vr[(16 * tq + i) * QS + ch], kb = do_state ? (unsigned)Kt[(16 * tq + i) * QS + ch] : 0u;
            if (i & 1) { kp[i >> 1] |= kb << 16; vp[i >> 1] |= vb << 16; } else { kp[i >> 1] = kb; vp[i >> 1] = vb; } }
        *(LAS u32x4*)(VT + ch * TS + 16 * tq) = (u32x4){vp[0], vp[1], vp[2], vp[3]};
        *(LAS u32x4*)(VT + ch * TS + 16 * tq + 8) = (u32x4){vp[4], vp[5], vp[6], vp[7]};
        if (do_state) { *(LAS u32x4*)(KtT + ch * TS + 16 * tq) = (u32x4){kp[0], kp[1], kp[2], kp[3]}; *(LAS u32x4*)(KtT + ch * TS + 16 * tq + 8) = (u32x4){kp[4], kp[5], kp[6], kp[7]}; }
    }
#pragma unroll
    for (int i = 0; i < 8; ++i) { S[i] = S[i] * *(const LAS f32x4*)(ebuf + 16 * i + 4 * lq);
        u32x2 o; o.x = pk2(S[i].x, S[i].y); o.y = pk2(S[i].z, S[i].w); *(LAS u32x2*)(SmT + (16 * w + li) * QS + 16 * i + 4 * lq) = o; }
    if (Snext) {
#pragma unroll
        for (int i = 0; i < 8; ++i) S[i] = *(const f32x4*)(Snext + (16 * w + li) * 128 + 16 * i + 4 * lq);
    }
    if (!(VAR & 4)) {
        const int tt = w >> 1;
        bf16x8 aq[4];
#pragma unroll
        for (int ks = 0; ks < 4; ++ks) aq[ks] = *(const LAS bf16x8*)(Qt + (16 * tt + li) * QS + 32 * ks + 8 * lq);
#pragma unroll
        for (int sj = 0; sj < 2; ++sj) { const int st = 2 * (w & 1) + sj; f32x4 acc = {0.f, 0.f, 0.f, 0.f};
#pragma unroll
            for (int ks = 0; ks < 4; ++ks) acc = MFMA16(aq[ks], *(const LAS bf16x8*)(Kt + (16 * st + li) * QS + 32 * ks + 8 * lq), acc);
#pragma unroll
            for (int r = 0; r < 4; ++r) { const int t = 16 * tt + 4 * lq + r, s = 16 * st + li; const bool keep = rev ? (s >= t) : (s <= t);
                Pm[t * TS + s] = f2bf(keep ? acc[r] : 0.f); } }
    }
    LDS_BARRIER();
    if (!(VAR & 8)) {
    bf16x8 bs[4], bv[2];
#pragma unroll
    for (int ks = 0; ks < 4; ++ks) bs[ks] = *(const LAS bf16x8*)(SmT + (16 * w + li) * QS + 32 * ks + 8 * lq);
#pragma unroll
    for (int ks = 0; ks < 2; ++ks) bv[ks] = *(const LAS bf16x8*)(VT + (16 * w + li) * TS + 32 * ks + 8 * lq);
    {
        bf16x8 aq[2][4], ap[2][2];
#pragma unroll
        for (int ks = 0; ks < 4; ++ks) aq[0][ks] = *(const LAS bf16x8*)(Qt + li * QS + 32 * ks + 8 * lq);
#pragma unroll
        for (int ks = 0; ks < 2; ++ks) ap[0][ks] = *(const LAS bf16x8*)(Pm + li * TS + 32 * ks + 8 * lq);
#pragma unroll
        for (int mt = 0; mt < 4; ++mt) { const int cb_ = mt & 1;
            if (mt < 3) {
#pragma unroll
                for (int ks = 0; ks < 4; ++ks) aq[cb_ ^ 1][ks] = *(const LAS bf16x8*)(Qt + (16 * (mt + 1) + li) * QS + 32 * ks + 8 * lq);
#pragma unroll
                for (int ks = 0; ks < 2; ++ks) ap[cb_ ^ 1][ks] = *(const LAS bf16x8*)(Pm + (16 * (mt + 1) + li) * TS + 32 * ks + 8 * lq); }
            __builtin_amdgcn_sched_barrier(0);
#pragma unroll
            for (int ks = 0; ks < 4; ++ks) O[mt] = MFMA16(aq[cb_][ks], bs[ks], O[mt]);
#pragma unroll
            for (int ks = 0; ks < 2; ++ks) O[mt] = MFMA16(ap[cb_][ks], bv[ks], O[mt]);
        }
    }
    __builtin_amdgcn_sched_barrier(0);
    if (do_state) {
        bf16x8 ak[2][2];
#pragma unroll
        for (int ks = 0; ks < 2; ++ks) ak[0][ks] = *(const LAS bf16x8*)(KtT + li * TS + 32 * ks + 8 * lq);
#pragma unroll
        for (int i = 0; i < 8; ++i) { const int cb_ = i & 1;
            if (i < 7) {
#pragma unroll
                for (int ks = 0; ks < 2; ++ks) ak[cb_ ^ 1][ks] = *(const LAS bf16x8*)(KtT + (16 * (i + 1) + li) * TS + 32 * ks + 8 * lq); }
            __builtin_amdgcn_sched_barrier(0);
#pragma unroll
            for (int ks = 0; ks < 2; ++ks) S[i] = MFMA16(ak[cb_][ks], bv[ks], S[i]);
            S[i] = S[i] * *(const LAS f32x4*)(ebuf + 128 + 16 * i + 4 * lq); }
    }
    }
    LDS_BARRIER();
}

__device__ __forceinline__ int hg_rowbase(int b, int slot) { return slot < 2 ? TL + b * CTXL + slot * 128 : b * SEQ + (slot - 2) * 128; }

template <int VAR>
__device__ __forceinline__ void hgrn2_c1(Frame& F, int l, int u0, int nunits, int G) {
    const bf16* Z = (const bf16*)(F.ws + WS_Z); const float* lbp = (const float*)(F.ws + WS_TAB + TAB_LB) + l * 512;
    bf16* GQ = (bf16*)(F.ws + WS_GE); bf16* GK = (bf16*)(F.ws + WS_GK); float* HV = (float*)(F.ws + WS_HV);
    if (u0 >= nunits) return;
    u32x4 zq[4];
    {   const int chain = u0 / HG_SLOTS, slot = u0 % HG_SLOTS, dir = chain & 1, b = chain >> 3, h = (chain >> 1) & 3;
        const bf16* zp = Z + (size_t)(hg_rowbase(b, slot) + (dir ? 64 : 0)) * INW;
#pragma unroll
        for (int j = 0; j < 2; ++j) { const int p = F.tid + NTHR * j, row = p >> 4, c16 = p & 15;
            zq[j] = *(const u32x4*)(zp + (size_t)row * INW + (dir ? ZFB : ZFF) + h * 128 + 8 * c16); zq[2 + j] = *(const u32x4*)(zp + (size_t)row * INW + ZQ + h * 128 + 8 * c16); } }
#pragma unroll 1
    for (int u = u0; u < nunits; u += G) {
        const int chain = u / HG_SLOTS, slot = u % HG_SLOTS, dir = chain & 1, b = chain >> 3, h = (chain >> 1) & 3;
        const int row0 = hg_rowbase(b, slot), zcol = (dir ? ZFB : ZFF) + h * 128;
        const int un = u + G; const bool has_nu = un < nunits;
        const int nchain = un / HG_SLOTS, nslot = un % HG_SLOTS, ndir = nchain & 1, nb = nchain >> 3, nh = (nchain >> 1) & 3;
        const bf16* nup = Z + (size_t)(hg_rowbase(nb, nslot) + (ndir ? 64 : 0)) * INW;
        f32x4 S[8]; float dtot = 0.f;
#pragma unroll
        for (int i = 0; i < 8; ++i) S[i] = (f32x4){0.f, 0.f, 0.f, 0.f};
#pragma unroll 1
        for (int step = 0; step < 2; ++step) { const int c = dir ? 1 - step : step; const size_t rowc = (size_t)(row0 + 64 * c);
            const bf16* nrow = step == 0 ? Z + (size_t)(row0 + 64 * (1 - c)) * INW : nup;
            const bf16* nz = nrow + (step == 0 ? zcol : (ndir ? ZFB : ZFF) + nh * 128); const bf16* nq = nrow + ZQ + (step == 0 ? h : nh) * 128;
            hg_chunk_c1<VAR>(F, Z + rowc * INW, GQ + ((size_t)dir * TT + rowc) * 512 + h * 128, GK + ((size_t)dir * TT + rowc) * 512 + h * 128,
                        HV + ((size_t)chain * (2 * HG_SLOTS) + slot * 2 + c) * 256, nz, nq, step == 0 || has_nu, zq, h, dir, lbp, S, dtot); }
        float* HS = (float*)(F.ws + WS_HS) + ((size_t)chain * HG_SLOTS + slot) * 16384;
        const int li = F.lane & 15, lq = F.lane >> 4, v = 16 * F.wave + li;
#pragma unroll
        for (int i = 0; i < 8; ++i) *(f32x4*)(HS + v * 128 + 16 * i + 4 * lq) = S[i];
        if (F.tid < 128) ((float*)(F.ws + WS_HD))[((size_t)chain * HG_SLOTS + slot) * 128 + F.tid] = __expf(dtot);
    }
}

__device__ __forceinline__ void hgrn2_c2(Frame& F) {
    float* HS = (float*)(F.ws + WS_HS); const float* HD = (const float*)(F.ws + WS_HD);
    for (int task = blockIdx.x * NTHR + F.tid; task < 16 * 8192; task += F.G * NTHR) {
        const int chain = task >> 13, e2 = task & 8191, dir = chain & 1, ch2 = (e2 & 63) * 2;
        f32x2 run = {0.f, 0.f};
#pragma unroll 5
        for (int k = 0; k < HG_SLOTS; ++k) {
            const int slot = dir ? (k < 2 ? 1 - k : 131 - k) : k;
            f32x2* p = (f32x2*)(HS + ((size_t)chain * HG_SLOTS + slot) * 16384 + e2 * 2);
            const f32x2 tmp = *p, d = *(const f32x2*)(HD + ((size_t)chain * HG_SLOTS + slot) * 128 + ch2);
            *p = run; run = d * run + tmp;
        }
    }
}

template <int VAR>
__device__ __forceinline__ void hgrn2_c3(Frame& F, int l, int bh, int slot) {
    const int b = bh >> 2, h = bh & 3;
    const bf16* Z = (const bf16*)(F.ws + WS_Z);
    const bf16* GQ = (const bf16*)(F.ws + WS_GE); const bf16* GK = (const bf16*)(F.ws + WS_GK); const float* HV = (const float*)(F.ws + WS_HV);
    bf16* MIX = (bf16*)(F.ws + WS_MIX);
    const int row0 = hg_rowbase(b, slot);
    const int tid = F.tid, lane = F.lane, w = F.wave, li = lane & 15, lq = lane >> 4, v = 16 * w + li;
    u32x4 pa[7], pb[7];
    const float* HVf = HV + ((size_t)(bh * 2 + 0) * (2 * HG_SLOTS) + slot * 2) * 256; const float* HVb = HV + ((size_t)(bh * 2 + 1) * (2 * HG_SLOTS) + slot * 2) * 256;
    {   const size_t r0 = (size_t)row0, r1 = (size_t)(row0 + 64);
        HgPtrs P0{GQ + r0 * 512 + h * 128, GK + r0 * 512 + h * 128, Z + r0 * INW + ZV + h * 128, HVf};
        HgPtrs P1{GQ + r1 * 512 + h * 128, GK + r1 * 512 + h * 128, Z + r1 * INW + ZV + h * 128, HVf + 256};
        hg_load6(P0, tid, pa); hg_load6(P1, tid, pb); }
    if (tid < 32) *(LAS f32x4*)((LAS float*)(F.lds + HG_RSS) + 4 * tid) = *(const f32x4*)(F.in[10] + l * 128 + 4 * tid);
    f32x4 S[8];
    const float* HSb = (const float*)(F.ws + WS_HS) + ((size_t)(bh * 2 + 1) * HG_SLOTS + slot) * 16384;
    {   const float* HSf = (const float*)(F.ws + WS_HS) + ((size_t)(bh * 2 + 0) * HG_SLOTS + slot) * 16384;
#pragma unroll
        for (int i = 0; i < 8; ++i) S[i] = *(const f32x4*)(HSf + v * 128 + 16 * i + 4 * lq); }
    f32x4 O[2][4];
#pragma unroll
    for (int c = 0; c < 2; ++c)
#pragma unroll
        for (int mt = 0; mt < 4; ++mt) O[c][mt] = (f32x4){0.f, 0.f, 0.f, 0.f};
#pragma unroll 1
    for (int st = 0; st < 4; ++st) {
        const int dir = st >> 1, c = (st == 1 || st == 2) ? 1 : 0;
        u32x4 cur[7];
#pragma unroll
        for (int j = 0; j < 7; ++j) { cur[j] = pa[j]; pa[j] = pb[j]; }
        if ((VAR & 1)) { } else if (st < 2) {
            const size_t rn = (size_t)(row0 + (st == 0 ? 64 : 0));
            HgPtrs Pn{GQ + ((size_t)TT + rn) * 512 + h * 128, GK + ((size_t)TT + rn) * 512 + h * 128, Z + rn * INW + ZV + h * 128, HVb + (st == 0 ? 256 : 0)};
            hg_load6(Pn, tid, pb);
        } else if (st == 2) {
#pragma unroll
            for (int j = 0; j < 4; ++j) pb[j] = *(const u32x4*)(Z + (size_t)(row0 + (tid >> 2)) * INW + ZG + h * 128 + 32 * (tid & 3) + 8 * j);
        }
        hg_chunk_c3<VAR>(F, cur, dir, S, O[0], (st & 1) == 0, st == 1 ? HSb : nullptr);
        if ((st & 1) == 0) {
#pragma unroll
            for (int mt = 0; mt < 4; ++mt) { const f32x4 t = O[0][mt]; O[0][mt] = O[1][mt]; O[1][mt] = t; }
        }
    }
    if (VAR & 16) { if (O[0][0][0] == 123.456f && O[1][3][2] == 1.f && S[0][0] == 2.f) MIX[0] = 1; return; }
    LAS float* Ot = (LAS float*)F.lds;
#pragma unroll
    for (int c = 0; c < 2; ++c)
#pragma unroll
        for (int mt = 0; mt < 4; ++mt)
#pragma unroll
            for (int r = 0; r < 4; ++r) Ot[(64 * c + 16 * mt + 4 * lq + r) * 132 + v] = O[c][mt][r];
    LDS_BARRIER();
    {   const int t = tid >> 2, v0 = 32 * (tid & 3);
        f32x4 x[8]; float ss = 0.f;
#pragma unroll
        for (int j = 0; j < 8; ++j) { x[j] = *(const LAS f32x4*)(Ot + t * 132 + v0 + 4 * j); ss += (x[j].x * x[j].x + x[j].y * x[j].y) + (x[j].z * x[j].z + x[j].w * x[j].w); }
        ss += __shfl_xor(ss, 1); ss += __shfl_xor(ss, 2);
        const float rs = rsqrtf(ss * (1.f / 128.f) + EPS);
        const LAS float* gain = (const LAS float*)(F.lds + HG_RSS) + v0;
#pragma unroll
        for (int k = 0; k < 4; ++k) { const u32x4 gq = pb[k]; const f32x4 g0 = *(const LAS f32x4*)(gain + 8 * k), g1 = *(const LAS f32x4*)(gain + 8 * k + 4);
            float o[8];
#pragma unroll
            for (int e = 0; e < 4; ++e) { const unsigned gw = e == 0 ? gq.x : e == 1 ? gq.y : e == 2 ? gq.z : gq.w;
                const float ga = __builtin_bit_cast(float, gw << 16), gb = __builtin_bit_cast(float, gw & 0xffff0000u);
                const float xa = e < 2 ? x[2 * k][2 * e] : x[2 * k + 1][2 * e - 4], xb = e < 2 ? x[2 * k][2 * e + 1] : x[2 * k + 1][2 * e - 3];
                const float na = e < 2 ? g0[2 * e] : g1[2 * e - 4], nb = e < 2 ? g0[2 * e + 1] : g1[2 * e - 3];
                o[2 * e] = xa * rs * na * ga * fast_rcp(1.f + __expf(-ga)); o[2 * e + 1] = xb * rs * nb * gb * fast_rcp(1.f + __expf(-gb)); }
            *(u32x4*)(MIX + (size_t)(row0 + t) * 1024 + h * 128 + v0 + 8 * k) = (u32x4){pk2(o[0], o[1]), pk2(o[2], o[3]), pk2(o[4], o[5]), pk2(o[6], o[7])}; }
    }
    LDS_BARRIER();
}

constexpr int LR_XR = 0, LR_XB = 35376, LR_HS = 69632;

__device__ __forceinline__ int lru_row(bool isctx, int b, int p) { return isctx ? TL + b * CTXL + p : b * SEQ + ((p & 255) << 6) + (p >> 8); }

template <bool FINAL>
__device__ __forceinline__ void lru_unit(Frame& F, int l, int b, int slot) {
    const bool isctx = slot < 4; const int p0 = isctx ? slot * 64 : (slot - 4) * 64, L = isctx ? CTXL : SEQ;
    const bf16* Z = (const bf16*)(F.ws + WS_Z);
    LAS bf16* Xr = (LAS bf16*)(F.lds + LR_XR); LAS bf16* XB = (LAS bf16*)(F.lds + LR_XB); LAS float* Hs = (LAS float*)(F.lds + LR_HS);
    const int tid = F.tid, lane = F.lane, w = F.wave, li = lane & 15, lq = lane >> 4;
    {   u32x4 v[5];
#pragma unroll
        for (int j = 0; j < 5; ++j) { const int idx = tid + NTHR * j, rr = idx >> 5, c16 = idx & 31, p = p0 - 2 + rr; v[j] = (u32x4){0u, 0u, 0u, 0u};
            if (idx < 67 * 32 && p >= 0 && p < L) v[j] = *(const u32x4*)(Z + (size_t)lru_row(isctx, b, p) * INW + ZXB + 8 * c16); }
#pragma unroll
        for (int j = 0; j < 5; ++j) { const int idx = tid + NTHR * j, rr = idx >> 5, c16 = idx & 31; if (idx < 67 * 32) *(LAS u32x4*)(Xr + rr * 264 + 8 * c16) = v[j]; } }
    LDS_BARRIER();
    {   const int ch = tid & 255, ph = tid >> 8;
        const float* cw = F.in[11] + (size_t)l * 4 * 256; const float w0 = cw[ch], w1 = cw[256 + ch], w2 = cw[512 + ch], w3 = cw[768 + ch], cb = F.in[12][l * 256 + ch];
        float x0 = bf2f(Xr[(32 * ph + 0) * 264 + ch]), x1 = bf2f(Xr[(32 * ph + 1) * 264 + ch]), x2 = bf2f(Xr[(32 * ph + 2) * 264 + ch]);
#pragma unroll 8
        for (int p = 32 * ph; p < 32 * ph + 32; ++p) { const float x3 = bf2f(Xr[(p + 3) * 264 + ch]);
            XB[p * 264 + ch] = f2bf(cb + w0 * x0 + w1 * x1 + w2 * x2 + w3 * x3); x0 = x1; x1 = x2; x2 = x3; } }
    LDS_BARRIER();
    {
        const int hh = w >> 1;
        float* LA = (float*)(F.ws + WS_LRUC); float* LH = (float*)(F.ws + WS_LRUC + LRUC_STRIDE); const float* LI = (const float*)(F.ws + WS_LRUC + 2 * LRUC_STRIDE);
        float hsum[4][4];
#pragma unroll 1
        for (int it = 0; it < 4; ++it) {
            const int jn = 2 * (w & 1) + (it >> 1), d = it & 1;
            const bf16* Wl = (const bf16*)(F.ws + WS_TAB + TAB_LRUW) + ((size_t)((l * 2 + d) * 4 + hh) * 128) * 64;
            const int ch = hh * 64 + 16 * jn + li;
            const size_t cidx = ((size_t)(b * 2 + d) * LR_SLOTS + slot) * 256;
            bf16x8 br[2], bi[2];
#pragma unroll
            for (int ks = 0; ks < 2; ++ks) { br[ks] = *(const bf16x8*)(Wl + (16 * jn + li) * 64 + 32 * ks + 8 * lq); bi[ks] = *(const bf16x8*)(Wl + (64 + 16 * jn + li) * 64 + 32 * ks + 8 * lq); }
            const float ba = F.in[14][(l * 2 + d) * 256 + ch], bx = F.in[16][(l * 2 + d) * 256 + ch], cl = ((const float*)(F.ws + WS_TAB + TAB_LRUCL))[(l * 2 + d) * 256 + ch];
            float C = FINAL ? LI[cidx + ch] : 0.f;
            f32x4 ar[4], ai[4];
#pragma unroll
            for (int mt = 0; mt < 4; ++mt) { ar[mt] = (f32x4){0.f, 0.f, 0.f, 0.f}; ai[mt] = (f32x4){0.f, 0.f, 0.f, 0.f};
#pragma unroll
                for (int ks = 0; ks < 2; ++ks) { const bf16x8 a = *(const LAS bf16x8*)(XB + (16 * mt + li) * 264 + hh * 64 + 32 * ks + 8 * lq);
                    ar[mt] = MFMA16(a, br[ks], ar[mt]); ai[mt] = MFMA16(a, bi[ks], ai[mt]); } }
            float PA[4][4], PB[4][4];
#pragma unroll
            for (int mt = 0; mt < 4; ++mt)
#pragma unroll
                for (int r = 0; r < 4; ++r) { const int p = 16 * mt + 4 * lq + r;
                    const float rg = sigmoidf_(ar[mt][r] + ba), ig = sigmoidf_(ai[mt][r] + bx), la = -cl * rg;
                    const float x2 = 2.f * la, e2 = __expf(x2);
                    const float om = x2 > -0.03f ? -x2 * (1.f + 0.5f * x2 * (1.f + x2 * (1.f / 3.f))) : 1.f - e2;
                    PA[mt][r] = __expf(la); PB[mt][r] = __builtin_amdgcn_sqrtf(fmaxf(om, 0.f)) * ig * bf2f(XB[p * 264 + ch]); }
            float TA[4], TB[4], EA[4], EB[4];
#pragma unroll
            for (int mt = 0; mt < 4; ++mt) {
                float pa = 1.f, pb = 0.f;
#pragma unroll
                for (int j = 0; j < 4; ++j) { const int r = d ? 3 - j : j; const float a = PA[mt][r], bb = PB[mt][r]; pb = a * pb + bb; pa = a * pa; PA[mt][r] = pa; PB[mt][r] = pb; }
                float ea = 1.f, eb = 0.f, ta = 1.f, tb = 0.f;
#pragma unroll
                for (int j = 0; j < 4; ++j) { const int k = d ? 3 - j : j; const float ga = __shfl(pa, li + 16 * k), gb = __shfl(pb, li + 16 * k);
                    const bool before = d ? (k > lq) : (k < lq);
                    if (before) { eb = ga * eb + gb; ea = ga * ea; }
                    tb = ga * tb + gb; ta = ga * ta; }
                EA[mt] = ea; EB[mt] = eb; TA[mt] = ta; TB[mt] = tb;
            }
            float Atot = 1.f, Cin[4];
#pragma unroll
            for (int j = 0; j < 4; ++j) { const int mt = d ? 3 - j : j; Cin[mt] = C; C = TA[mt] * C + TB[mt]; Atot *= TA[mt]; }
            if (!FINAL) { if (lq == 0) { LA[cidx + ch] = Atot; LH[cidx + ch] = C; } }
            else {
#pragma unroll
                for (int mt = 0; mt < 4; ++mt) { const float base = EA[mt] * Cin[mt] + EB[mt];
#pragma unroll
                    for (int r = 0; r < 4; ++r) { const float hv = PA[mt][r] * base + PB[mt][r];
                        if (d == 0) hsum[mt][r] = hv; else Hs[(16 * mt + 4 * lq + r) * 256 + ch] = hsum[mt][r] + hv; } }
            }
        }
    }
    if (FINAL) {
        LDS_BARRIER();
        bf16* MIX = (bf16*)(F.ws + WS_MIX);
        u32x4 yq[4];
#pragma unroll
        for (int j = 0; j < 4; ++j) { const int task = tid + NTHR * j, p = task >> 5, c8 = task & 31; yq[j] = *(const u32x4*)(Z + (size_t)lru_row(isctx, b, p0 + p) * INW + ZYB + 8 * c8); }
#pragma unroll
        for (int j = 0; j < 4; ++j) { const int task = tid + NTHR * j, p = task >> 5, c8 = task & 31;
            const f32x4 h0 = *(const LAS f32x4*)(Hs + p * 256 + 8 * c8), h1 = *(const LAS f32x4*)(Hs + p * 256 + 8 * c8 + 4);
            float o[8];
#pragma unroll
            for (int e = 0; e < 4; ++e) { const unsigned yw = yq[j][e];
                const float ya = __builtin_bit_cast(float, yw << 16), yb = __builtin_bit_cast(float, yw & 0xffff0000u);
                const float ua = 0.7978845608f * (ya + 0.044715f * ya * ya * ya), ub = 0.7978845608f * (yb + 0.044715f * yb * yb * yb);
                const float ta = 1.f - 2.f * fast_rcp(1.f + __expf(2.f * ua)), tb = 1.f - 2.f * fast_rcp(1.f + __expf(2.f * ub));
                const float ha = e < 2 ? h0[2 * e] : h1[2 * e - 4], hb = e < 2 ? h0[2 * e + 1] : h1[2 * e - 3];
                o[2 * e] = ha * 0.5f * ya * (1.f + ta); o[2 * e + 1] = hb * 0.5f * yb * (1.f + tb); }
            *(u32x4*)(MIX + (size_t)lru_row(isctx, b, p0 + p) * 1024 + 512 + 8 * c8) = (u32x4){pk2(o[0], o[1]), pk2(o[2], o[3]), pk2(o[4], o[5]), pk2(o[6], o[7])}; }
    }
    LDS_BARRIER();
}

__device__ __forceinline__ void lru_carry(Frame& F) {
    if (blockIdx.x >= 16 || F.wave != 0) return;
    const int chain = blockIdx.x * 64 + F.lane, bd = chain >> 8, ch = chain & 255, d = bd & 1;
    const float* LA = (const float*)(F.ws + WS_LRUC); const float* LH = (const float*)(F.ws + WS_LRUC + LRUC_STRIDE); float* LI = (float*)(F.ws + WS_LRUC + 2 * LRUC_STRIDE);
    float h = 0.f;
    for (int k0 = 0; k0 < LR_SLOTS; k0 += 20) {
        float a[20], hh[20];
#pragma unroll
        for (int j = 0; j < 20; ++j) { const int k = k0 + j, slot = d ? (k < 4 ? 3 - k : 263 - k) : k; const size_t idx = ((size_t)bd * LR_SLOTS + slot) * 256 + ch; a[j] = LA[idx]; hh[j] = LH[idx]; }
#pragma unroll
        for (int j = 0; j < 20; ++j) { const int k = k0 + j, slot = d ? (k < 4 ? 3 - k : 263 - k) : k; const size_t idx = ((size_t)bd * LR_SLOTS + slot) * 256 + ch; LI[idx] = h; h = a[j] * h + hh[j]; }
    }
}

__device__ __forceinline__ void fft_f1(Frame& F, int b, int n2) {
    const bf16* Z = (const bf16*)(F.ws + WS_Z);
    const bf16* Fc = (const bf16*)(F.ws + WS_TAB + TAB_FC); const bf16* Fs = (const bf16*)(F.ws + WS_TAB + TAB_FS);
    bf16* FAr = (bf16*)(F.ws + WS_FA); bf16* FAi = FAr + (size_t)2 * 128 * 128 * 256;
    LAS bf16* DT = (LAS bf16*)F.lds;
    const int tid = F.tid, lane = F.lane, w = F.wave, li = lane & 15, lq = lane >> 4;
    {   const int c = tid & 255, nh = tid >> 8;
        const bf16* src = Z + ((size_t)(b * SEQ + 128 * (64 * nh) + n2)) * INW + ZU + c;
#pragma unroll 2
        for (int j = 0; j < 8; ++j) { unsigned pk[4];
#pragma unroll
            for (int i = 0; i < 4; ++i) pk[i] = (unsigned)src[(size_t)(128 * (8 * j + 2 * i)) * INW] | ((unsigned)src[(size_t)(128 * (8 * j + 2 * i + 1)) * INW] << 16);
            *(LAS u32x4*)(DT + c * 136 + 64 * nh + 8 * j) = (u32x4){pk[0], pk[1], pk[2], pk[3]}; } }
    LDS_BARRIER();
    bf16x8 fc[4], fs[4];
#pragma unroll
    for (int ks = 0; ks < 4; ++ks) { fc[ks] = *(const bf16x8*)(Fc + (16 * w + li) * 128 + 32 * ks + 8 * lq); fs[ks] = *(const bf16x8*)(Fs + (16 * w + li) * 128 + 32 * ks + 8 * lq); }
    float ct[4], st[4];
#pragma unroll
    for (int r = 0; r < 4; ++r) { const int k1 = 16 * w + 4 * lq + r; sincospif((float)((n2 * k1) & 16383) * (1.f / 8192.f), &st[r], &ct[r]); }
#pragma unroll 2
    for (int nt = 0; nt < 16; ++nt) {
        f32x4 re = {0.f, 0.f, 0.f, 0.f}, im = {0.f, 0.f, 0.f, 0.f};
#pragma unroll
        for (int ks = 0; ks < 4; ++ks) { const bf16x8 bb = *(const LAS bf16x8*)(DT + (16 * nt + li) * 136 + 32 * ks + 8 * lq); re = MFMA16(fc[ks], bb, re); im = MFMA16(fs[ks], bb, im); }
#pragma unroll
        for (int r = 0; r < 4; ++r) { const int k1 = 16 * w + 4 * lq + r, c = 16 * nt + li;
            const float R = re[r], I = -im[r];
            const size_t o = ((size_t)(b * 128 + k1) * 128 + n2) * 256 + c;
            FAr[o] = f2bf(R * ct[r] + I * st[r]); FAi[o] = f2bf(I * ct[r] - R * st[r]); }
    }
    LDS_BARRIER();
}

__device__ __forceinline__ void fft_f2(Frame& F, int b, int k1, int chalf) {
    const bf16* Fc = (const bf16*)(F.ws + WS_TAB + TAB_FC); const bf16* Fs = (const bf16*)(F.ws + WS_TAB + TAB_FS); const bf16* CS = (const bf16*)(F.ws + WS_TAB + TAB_CS);
    const bf16* FAr = (const bf16*)(F.ws + WS_FA); const bf16* FAi = FAr + (size_t)2 * 128 * 128 * 256;
    bf16* MIX = (bf16*)(F.ws + WS_MIX);
    LAS bf16* DTr = (LAS bf16*)F.lds; LAS bf16* DTi = DTr + 128 * 136;
    const int tid = F.tid, lane = F.lane, w = F.wave, li = lane & 15, lq = lane >> 4;
    LAS bf16* Wv = (LAS bf16*)(F.lds + 69632) + w * (16 * 2 * 136);
    {   const int c = tid & 127, nq = tid >> 7;
        const size_t o = ((size_t)(b * 128 + k1) * 128 + 32 * nq) * 256 + chalf * 128 + c;
#pragma unroll 2
        for (int j = 0; j < 4; ++j) { unsigned pr[4], pi[4];
#pragma unroll
            for (int i = 0; i < 4; ++i) { const size_t o0 = o + (size_t)(8 * j + 2 * i) * 256, o1 = o0 + 256;
                pr[i] = (unsigned)FAr[o0] | ((unsigned)FAr[o1] << 16); pi[i] = (unsigned)FAi[o0] | ((unsigned)FAi[o1] << 16); }
            *(LAS u32x4*)(DTr + c * 136 + 32 * nq + 8 * j) = (u32x4){pr[0], pr[1], pr[2], pr[3]};
            *(LAS u32x4*)(DTi + c * 136 + 32 * nq + 8 * j) = (u32x4){pi[0], pi[1], pi[2], pi[3]}; } }
    LDS_BARRIER();
    bf16x8 fc[4], fs[4];
#pragma unroll
    for (int ks = 0; ks < 4; ++ks) { fc[ks] = *(const bf16x8*)(Fc + (16 * w + li) * 128 + 32 * ks + 8 * lq); fs[ks] = *(const bf16x8*)(Fs + (16 * w + li) * 128 + 32 * ks + 8 * lq); }
#pragma unroll 2
    for (int nt = 0; nt < 8; ++nt) {
        f32x4 ur = {0.f, 0.f, 0.f, 0.f}, u1 = {0.f, 0.f, 0.f, 0.f}, u2 = {0.f, 0.f, 0.f, 0.f};
#pragma unroll
        for (int ks = 0; ks < 4; ++ks) { const bf16x8 br = *(const LAS bf16x8*)(DTr + (16 * nt + li) * 136 + 32 * ks + 8 * lq), bi = *(const LAS bf16x8*)(DTi + (16 * nt + li) * 136 + 32 * ks + 8 * lq);
            ur = MFMA16(fc[ks], br, ur); ur = MFMA16(fs[ks], bi, ur); u1 = MFMA16(fc[ks], bi, u1); u2 = MFMA16(fs[ks], br, u2); }
        const int gl = nt >> 2, cl = 16 * (nt & 3) + li;
#pragma unroll
        for (int r = 0; r < 4; ++r) { const int k2l = 4 * lq + r; Wv[(k2l * 2 + gl) * 136 + cl] = f2bf(ur[r]); Wv[(k2l * 2 + gl) * 136 + 64 + cl] = f2bf(u1[r] - u2[r]); }
    }
    LDS_WAIT();
#pragma unroll
    for (int gl = 0; gl < 2; ++gl)
#pragma unroll
        for (int mt = 0; mt < 4; ++mt) { f32x4 acc = {0.f, 0.f, 0.f, 0.f};
#pragma unroll
            for (int ks = 0; ks < 4; ++ks) acc = MFMA16(*(const LAS bf16x8*)(Wv + (li * 2 + gl) * 136 + 32 * ks + 8 * lq), *(const bf16x8*)(CS + (16 * mt + li) * 128 + 32 * ks + 8 * lq), acc);
#pragma unroll
            for (int r = 0; r < 4; ++r) { const int k2 = 16 * w + 4 * lq + r; const size_t tok = (size_t)b * SEQ + k1 + 128 * k2;
                MIX[tok * 1024 + 768 + (chalf * 2 + gl) * 64 + 16 * mt + li] = f2bf(acc[r] * (1.f / 1024.f)); } }
    LDS_BARRIER();
}

__device__ __forceinline__ void ctx_fourier(Frame& F, int b, int g) {
    const bf16* Z = (const bf16*)(F.ws + WS_Z); bf16* MIX = (bf16*)(F.ws + WS_MIX);
    const bf16* CS = (const bf16*)(F.ws + WS_TAB + TAB_CS); const bf16* C256 = (const bf16*)(F.ws + WS_TAB + TAB_C256); const bf16* S256 = (const bf16*)(F.ws + WS_TAB + TAB_S256);
    LAS bf16* PT = (LAS bf16*)F.lds; LAS bf16* QT = PT + 64 * 264;
    const int lane = F.lane, w = F.wave, li = lane & 15, lq = lane >> 4;
#pragma unroll 1
    for (int nj = 0; nj < 2; ++nj) { const int nt = 2 * w + nj;
        bf16x8 a[2];
#pragma unroll
        for (int ks = 0; ks < 2; ++ks) a[ks] = *(const bf16x8*)(Z + (size_t)(TL + b * CTXL + 16 * nt + li) * INW + ZU + g * 64 + 32 * ks + 8 * lq);
#pragma unroll
        for (int mt = 0; mt < 4; ++mt) { f32x4 p = {0.f, 0.f, 0.f, 0.f}, q = {0.f, 0.f, 0.f, 0.f};
#pragma unroll
            for (int ks = 0; ks < 2; ++ks) { p = MFMA16(a[ks], *(const bf16x8*)(CS + (16 * mt + li) * 128 + 32 * ks + 8 * lq), p); q = MFMA16(a[ks], *(const bf16x8*)(CS + (16 * mt + li) * 128 + 64 + 32 * ks + 8 * lq), q); }
            u32x2 o; o.x = pk2(p[0], p[1]); o.y = pk2(p[2], p[3]); *(LAS u32x2*)(PT + (16 * mt + li) * 264 + 16 * nt + 4 * lq) = o;
            o.x = pk2(q[0], q[1]); o.y = pk2(q[2], q[3]); *(LAS u32x2*)(QT + (16 * mt + li) * 264 + 16 * nt + 4 * lq) = o; } }
    LDS_BARRIER();
#pragma unroll 1
    for (int kj = 0; kj < 2; ++kj) { const int kt = 2 * w + kj;
        f32x4 acc[4];
#pragma unroll
        for (int mt = 0; mt < 4; ++mt) acc[mt] = (f32x4){0.f, 0.f, 0.f, 0.f};
#pragma unroll 2
        for (int ks = 0; ks < 8; ++ks) { const bf16x8 ac = *(const bf16x8*)(C256 + (16 * kt + li) * 256 + 32 * ks + 8 * lq), as = *(const bf16x8*)(S256 + (16 * kt + li) * 256 + 32 * ks + 8 * lq);
#pragma unroll
            for (int mt = 0; mt < 4; ++mt) { acc[mt] = MFMA16(ac, *(const LAS bf16x8*)(PT + (16 * mt + li) * 264 + 32 * ks + 8 * lq), acc[mt]); acc[mt] = MFMA16(as, *(const LAS bf16x8*)(QT + (16 * mt + li) * 264 + 32 * ks + 8 * lq), acc[mt]); } }
#pragma unroll
        for (int mt = 0; mt < 4; ++mt)
#pragma unroll
            for (int r = 0; r < 4; ++r) MIX[(size_t)(TL + b * CTXL + 16 * kt + 4 * lq + r) * 1024 + 768 + g * 64 + 16 * mt + li] = f2bf(acc[mt][r] * (1.f / 128.f)); }
    LDS_BARRIER();
}

__device__ __forceinline__ void route_phase(Frame& F, int l, int Tl) {
    LAS unsigned* hist = (LAS unsigned*)F.lds;
    for (int i = F.tid; i < 256; i += NTHR) hist[i] = 0u;
    __syncthreads();
    const float* logits = (const float*)(F.ws + WS_LOGIT); const float* br = F.in[20] + l * 256;
    int* sel_e = (int*)(F.ws + WS_SEL); float* sel_w = (float*)(F.ws + WS_SEL + SEL_STRIDE);
    const int lane = F.lane, gw = blockIdx.x * NWAVES + F.wave, NGW = F.G * NWAVES;
    const float NEG = -__builtin_inff();
    for (int t = gw; t < Tl; t += NGW) {
        const f32x4 lg = *(const f32x4*)(logits + (size_t)t * 256 + 4 * lane); const f32x4 bb = *(const f32x4*)(br + 4 * lane);
        float sc[4], cand[4];
#pragma unroll
        for (int i = 0; i < 4; ++i) { sc[i] = sigmoidf_(lg[i]); cand[i] = sc[i] + bb[i]; }
        float m1 = NEG, m2 = NEG;
#pragma unroll
        for (int i = 0; i < 4; ++i) { const float v = cand[i]; if (v > m1) { m2 = m1; m1 = v; } else if (v > m2) m2 = v; }
#pragma unroll
        for (int off = 1; off < 8; off <<= 1) { const float o1 = __shfl_xor(m1, off), o2 = __shfl_xor(m2, off); const float n1 = fmaxf(m1, o1), n2 = fmaxf(fminf(m1, o1), fmaxf(m2, o2)); m1 = n1; m2 = n2; }
        const float gs = m1 + m2; const int g = lane >> 3; int rank = 0;
#pragma unroll
        for (int q = 0; q < 8; ++q) { const float v = __shfl(gs, 8 * q); rank += (v > gs || (v == gs && q < g)) ? 1 : 0; }
        if (rank >= 4) {
#pragma unroll
            for (int i = 0; i < 4; ++i) cand[i] = NEG; }
        float wsum = 0.f, myw = 0.f; int mye = 0;
#pragma unroll 1
        for (int k = 0; k < TOPK; ++k) {
            float bv = cand[0]; int bidx = 4 * lane;
#pragma unroll
            for (int i = 1; i < 4; ++i) if (cand[i] > bv) { bv = cand[i]; bidx = 4 * lane + i; }
#pragma unroll
            for (int off = 1; off < 64; off <<= 1) { const float ov = __shfl_xor(bv, off); const int oi = __shfl_xor(bidx, off); if (ov > bv || (ov == bv && oi < bidx)) { bv = ov; bidx = oi; } }
            const int owner = bidx >> 2, which = bidx & 3;
            const float s = which == 0 ? sc[0] : which == 1 ? sc[1] : which == 2 ? sc[2] : sc[3];
            const float sw = __shfl(s, owner);
#pragma unroll
            for (int i = 0; i < 4; ++i) if (lane == owner && which == i) cand[i] = NEG;
            wsum += sw; if (lane == k) { myw = sw; mye = bidx; }
        }
        if (lane < TOPK) { sel_e[(size_t)t * 8 + lane] = mye; sel_w[(size_t)t * 8 + lane] = 2.5f * myw / wsum; (void)__hip_atomic_fetch_add(&hist[mye], 1u, __ATOMIC_RELAXED, __HIP_MEMORY_SCOPE_WORKGROUP); }
    }
    __syncthreads();
    unsigned* cnt = (unsigned*)(F.ws + WS_CTL) + CW_CNT + 1024 * l;
    for (int e = F.tid; e < 256; e += NTHR) if (hist[e]) atomicAdd(cnt + e, hist[e]);
    __syncthreads();
}

__device__ __forceinline__ void assign_phase(Frame& F, int l, int Tl) {
    LAS int* cntL = (LAS int*)F.lds; LAS int* pstart = cntL + 256; LAS unsigned* hist = (LAS unsigned*)(pstart + 260); LAS unsigned* base = hist + 256; LAS unsigned* hist2 = base + 256;
    unsigned* cnt = (unsigned*)(F.ws + WS_CTL) + CW_CNT + 1024 * l; unsigned* fill = cnt + 512;
    const int tid = F.tid, lane = F.lane;
    if (tid < 256) { cntL[tid] = (int)cnt[tid]; hist[tid] = 0u; hist2[tid] = 0u; }
    __syncthreads();
    if (F.wave == 0) {
        int p[4]; int s = 0;
#pragma unroll
        for (int i = 0; i < 4; ++i) { p[i] = (cntL[4 * lane + i] + 255) & ~255; s += p[i]; }
        int inc = s;
#pragma unroll
        for (int off = 1; off < 64; off <<= 1) { const int v = __shfl_up(inc, off); if (lane >= off) inc += v; }
        int ex = inc - s;
#pragma unroll
        for (int i = 0; i < 4; ++i) { pstart[4 * lane + i] = ex; ex += p[i]; }
        if (lane == 63) pstart[256] = inc;
    }
    __syncthreads();
    const int total_rows = pstart[256], ntile_r = total_rows >> 8, ntiles = ntile_r + (Tl >> 8);
    int* meta = (int*)(F.ws + WS_META); int* tile_expert = meta + 64;
    int* row_tok = (int*)(F.ws + WS_ROWTOK); const int* sel_e = (const int*)(F.ws + WS_SEL); int* tokpos = (int*)(F.ws + WS_SEL + 2 * SEL_STRIDE);
    if (blockIdx.x == 0) {
        if (tid == 0) { meta[0] = ntiles; meta[1] = total_rows; }
        if (tid < 256) { const int rt0 = pstart[tid] >> 8; for (int rt = rt0; rt < (pstart[tid + 1] >> 8); ++rt) tile_expert[rt] = tid | ((cntL[tid] - 256 * (rt - rt0) <= 128) ? 0x10000 : 0); }
        for (int rt = ntile_r + tid; rt < ntiles; rt += NTHR) tile_expert[rt] = 256;
    }
    for (int e = blockIdx.x; e < 256; e += F.G) for (int r = pstart[e] + cntL[e] + tid; r < pstart[e + 1]; r += NTHR) row_tok[r] = 0;
    const int TPW = (Tl + F.G - 1) / F.G, t0 = blockIdx.x * TPW, t1 = (t0 + TPW < Tl) ? t0 + TPW : Tl;
    for (int t = t0 + tid; t < t1; t += NTHR) row_tok[total_rows + t] = t;
    const int npairs = t1 > t0 ? (t1 - t0) * 8 : 0;
    for (int i = tid; i < npairs; i += NTHR) (void)__hip_atomic_fetch_add(&hist[sel_e[(size_t)t0 * 8 + i]], 1u, __ATOMIC_RELAXED, __HIP_MEMORY_SCOPE_WORKGROUP);
    __syncthreads();
    if (tid < 256) base[tid] = hist[tid] ? atomicAdd(fill + tid, hist[tid]) : 0u;
    __syncthreads();
    for (int i = tid; i < npairs; i += NTHR) { const int e = sel_e[(size_t)t0 * 8 + i]; const unsigned off = __hip_atomic_fetch_add(&hist2[e], 1u, __ATOMIC_RELAXED, __HIP_MEMORY_SCOPE_WORKGROUP);
        const int pos = pstart[e] + (int)base[e] + (int)off; row_tok[pos] = t0 + (i >> 3); tokpos[(size_t)t0 * 8 + i] = pos; }
    __syncthreads();
}

__device__ __forceinline__ void combine_phase(Frame& F, int l, int Tl) {
    const int* meta = (const int*)(F.ws + WS_META); const int total_rows = meta[1];
    const unsigned char* Y = (const unsigned char*)(F.ws + WS_Y); const int* tokpos = (const int*)(F.ws + WS_SEL + 2 * SEL_STRIDE); const float* sel_w = (const float*)(F.ws + WS_SEL + SEL_STRIDE);
    const float* mod = (const float*)(F.ws + WS_MOD);
    float* XC = (float*)(F.ws + WS_XC); bf16* HB = (bf16*)(F.ws + WS_HB);
    const int lane = F.lane, gw = blockIdx.x * NWAVES + F.wave, NGW = F.G * NWAVES;
    const int c0 = 16 * lane;
    const int ca = (lane >> 4) * 256 + ((lane >> 2) & 3) * 32 + (lane & 3) * 8, cb2 = ca + 128;
    for (int t = gw; t < Tl; t += NGW) {
        const int myp = lane < 8 ? tokpos[(size_t)t * 8 + lane] : 0; const float myw = lane < 8 ? sel_w[(size_t)t * 8 + lane] : 0.f;
        float* xr = t < TL ? F.out + (size_t)t * D : XC + (size_t)(t - TL) * D; const int r = t < TL ? (t >> 14) : 2;
        u32x4 yv[9];
        yv[8] = *(const u32x4*)(Y + (size_t)(total_rows + t) * 1024 + c0);
#pragma unroll
        for (int k = 0; k < TOPK; ++k) yv[k] = *(const u32x4*)(Y + (size_t)__shfl(myp, k) * 1024 + c0);
        f32x4 xv[4];
        xv[0] = *(const f32x4*)(xr + ca); xv[1] = *(const f32x4*)(xr + ca + 4); xv[2] = *(const f32x4*)(xr + cb2); xv[3] = *(const f32x4*)(xr + cb2 + 4);
        float y[16];
#pragma unroll
        for (int d = 0; d < 4; ++d) { const f32x2 a = __builtin_amdgcn_cvt_pk_f32_fp8((int)yv[8][d], false), bq = __builtin_amdgcn_cvt_pk_f32_fp8((int)yv[8][d], true);
            y[4 * d] = a.x; y[4 * d + 1] = a.y; y[4 * d + 2] = bq.x; y[4 * d + 3] = bq.y; }
#pragma unroll
        for (int k = 0; k < TOPK; ++k) { const float wk = __shfl(myw, k);
#pragma unroll
            for (int d = 0; d < 4; ++d) { const f32x2 a = __builtin_amdgcn_cvt_pk_f32_fp8((int)yv[k][d], false), bq = __builtin_amdgcn_cvt_pk_f32_fp8((int)yv[k][d], true);
                y[4 * d] += wk * a.x; y[4 * d + 1] += wk * a.y; y[4 * d + 2] += wk * bq.x; y[4 * d + 3] += wk * bq.y; } }
        const float* g2 = mod + (size_t)(l * 3 + r) * 6144 + 5120;
        f32x4 xn[4]; float s = 0.f;
#pragma unroll
        for (int j = 0; j < 4; ++j) { const int cj = (j < 2 ? ca : cb2) + 4 * (j & 1);
            xn[j] = xv[j] + *(const f32x4*)(g2 + cj) * (f32x4){y[4 * j], y[4 * j + 1], y[4 * j + 2], y[4 * j + 3]};
            s += (xn[j].x * xn[j].x + xn[j].y * xn[j].y) + (xn[j].z * xn[j].z + xn[j].w * xn[j].w); }
        const float rstd = rsqrtf(wave_sum(s) * (1.f / D) + EPS);
        if (l == 0) {
            const float* m1 = mod + (size_t)(3 + r) * 6144; const float* gain = F.in[6] + 1024;
            unsigned o[8];
#pragma unroll
            for (int j = 0; j < 4; ++j) { const int cj = (j < 2 ? ca : cb2) + 4 * (j & 1); *(f32x4*)(xr + cj) = xn[j];
                const f32x4 yv2 = xn[j] * rstd * *(const f32x4*)(gain + cj) * (*(const f32x4*)(m1 + 1024 + cj) + 1.f) + *(const f32x4*)(m1 + cj);
                o[2 * j] = pk2(yv2.x, yv2.y); o[2 * j + 1] = pk2(yv2.z, yv2.w); }
            *(u32x4*)(HB + (size_t)t * D + ca) = (u32x4){o[0], o[1], o[2], o[3]}; *(u32x4*)(HB + (size_t)t * D + cb2) = (u32x4){o[4], o[5], o[6], o[7]};
        } else {
            const float* gain = F.in[27];
#pragma unroll
            for (int j = 0; j < 4; ++j) { const int cj = (j < 2 ? ca : cb2) + 4 * (j & 1); *(f32x4*)(F.out + (size_t)t * D + cj) = xn[j] * rstd * *(const f32x4*)(gain + cj); }
        }
    }
}


#ifndef PH_EN
#define PH_EN 0xFFFFFFFFu
#endif
#define EN(j) ((PH_EN >> (j)) & 1u)
#ifndef U_EN
#define U_EN 0xFFu
#endif
#define UEN(j) ((U_EN >> (j)) & 1u)
#ifndef DUPMASK
#define DUPMASK 0u
#endif
#define REP(j) for (int rep_ = 0; rep_ < 1 + (int)((DUPMASK >> (j)) & 1u); ++rep_)
#ifndef DUPU
#define DUPU 0u
#endif
#define REPU(j) for (int repu_ = 0; repu_ < 1 + (int)((DUPU >> (j)) & 1u); ++repu_)
#define IN(k) (lo <= (k) && (k) < hi)
#define FRESH() do { asm volatile("" : "+v"(F.tid)); F.lane = F.tid & 63; } while (0)
#define SEAM(k) do { if (lo <= (k) && (k) + 1 < hi) xcd_barrier(bar); } while (0)
#define SEAMCV(k, lcv) do { if (lo <= (k) && (k) + 1 < hi) xcd_barrier_cv(bar, F); } while (0)
template <int l>
__device__ __forceinline__ void layer_phases(Frame& F, const XcdBarrier& bar, const int lo, const int hi) {
    const int bid = blockIdx.x, G = F.G;

        const int pb = 2 + 12 * l;
        const int Tl = l == 0 ? TT : TL;
        bf16* HB = (bf16*)(F.ws + WS_HB); bf16* Zb = (bf16*)(F.ws + WS_Z); bf16* MIX = (bf16*)(F.ws + WS_MIX);
        if (EN(2) && IN(pb + 0)) REP(2) { FRESH();
            pg8::Gemm g{HB, (const bf16*)(F.ws + WS_WIN) + (size_t)l * INW * 1024, nullptr, 1024}; pg8::StaticOrder S; S.init(TT, INW, G, bid);
            pg8::EpiBf16 E{Zb, INW};
            pg8::gemm_phase<pg8::EpiBf16, pg8::StaticOrder, false>(F.lds, g, S, E, F.tid);
            SEAMCV(pb + 0, l);
        }
        if (EN(3) && IN(pb + 1)) REP(3) { FRESH();
            REPU(0) if (UEN(0)) hgrn2_c1<0>(F, l, bid, 16 * HG_SLOTS, G);
            FRESH(); REPU(1) if (UEN(1)) for (int u = (bid + G - 32) % G; u < 2 * LR_SLOTS; u += G) lru_unit<false>(F, l, u / LR_SLOTS, u % LR_SLOTS);
            FRESH(); REPU(2) if (UEN(2)) for (int u = bid; u < 256; u += G) fft_f1(F, u >> 7, u & 127);
            FRESH(); REPU(3) if (UEN(3) && l == 0) for (int u = (bid + G - 64) % G; u < 8; u += G) ctx_fourier(F, u >> 2, u & 3);
            SEAMCV(pb + 1, l);
        }
        if (EN(4) && IN(pb + 2)) REP(4) { FRESH(); hgrn2_c2(F); lru_carry(F); SEAMCV(pb + 2, l); }
        if (EN(5) && IN(pb + 3)) REP(5) { FRESH();
            const int nslot = l == 0 ? HG_SLOTS : HG_SLOTS - 2, slot0 = l == 0 ? 0 : 2;
            FRESH(); REPU(4) if (UEN(4)) for (int u = bid; u < 8 * nslot; u += G) hgrn2_c3<0>(F, l, u / nslot, slot0 + u % nslot);
            const int nls = l == 0 ? LR_SLOTS : LR_SLOTS - 4, ls0 = l == 0 ? 0 : 4;
            FRESH(); REPU(5) if (UEN(5)) for (int u = (bid + G - 32) % G; u < 2 * nls; u += G) lru_unit<true>(F, l, u / nls, ls0 + u % nls);
            FRESH(); REPU(6) if (UEN(6)) for (int u = bid; u < 512; u += G) fft_f2(F, u >> 8, (u >> 1) & 127, u & 1);
            SEAMCV(pb + 3, l);
        }
        if (EN(6) && IN(pb + 4)) REP(6) { FRESH();
            pg8::Gemm g{MIX, (const bf16*)(F.ws + WS_WOUT) + (size_t)l * 1024 * 1024, nullptr, 1024}; pg8::StaticOrder S; S.init(Tl, 1024, G, bid);
            pg8::EpiResid E{l == 0 ? F_X(F) : (const float*)F.out, F.out, F_CTX(F), (float*)(F.ws + WS_XC), (const float*)(F.ws + WS_MOD) + (size_t)l * 3 * 6144};
            pg8::gemm_phase<pg8::EpiResid, pg8::StaticOrder, false>(F.lds, g, S, E, F.tid);
            SEAMCV(pb + 4, l);
        }
        if (EN(7) && IN(pb + 5)) REP(7) { FRESH();
            hprep_rows(F, l, F.out, (const float*)(F.ws + WS_XC), Tl, 3072, 4096, F.in[7] + l * 1024);
            FRESH(); convert_experts(F, l);
            SEAMCV(pb + 5, l);
        }
        if (EN(8) && IN(pb + 6)) REP(8) { FRESH();
            pg8::Gemm g{HB, (const bf16*)(F.ws + WS_WR) + (size_t)l * 256 * 1024, nullptr, 1024}; pg8::StaticOrder S; S.init(Tl, 256, G, bid);
            pg8::EpiF32 E{(float*)(F.ws + WS_LOGIT), 256};
            pg8::gemm_phase<pg8::EpiF32, pg8::StaticOrder, false>(F.lds, g, S, E, F.tid);
            SEAMCV(pb + 6, l);
        }
        if (EN(9) && IN(pb + 7)) REP(9) { FRESH(); route_phase(F, l, Tl); SEAMCV(pb + 7, l); }
        if (EN(10) && IN(pb + 8)) REP(10) { FRESH(); assign_phase(F, l, Tl); SEAMCV(pb + 8, l); }
        if (EN(11) && IN(pb + 9)) REP(11) { FRESH();
            const int* meta = (const int*)(F.ws + WS_META);
            pg8::Gemm g{HB, (const bf16*)(F.ws + (l ? WS_WEXP1 : WS_WEXP)), (const int*)(F.ws + WS_ROWTOK), 1024}; pg8::MoeOrder<2> S{meta + 64, meta[0], G, bid};
            pg8::EpiSwiglu E{(bf16*)(F.ws + WS_HBUF)};
            pg8::gemm_phase<pg8::EpiSwiglu, pg8::MoeOrder<2>, true>(F.lds, g, S, E, F.tid);
            SEAMCV(pb + 9, l);
        }
        if (EN(12) && IN(pb + 10)) REP(12) { FRESH();
            const int* meta = (const int*)(F.ws + WS_META);
            pg8::Gemm g{(const bf16*)(F.ws + WS_HBUF), (const bf16*)(F.ws + (l ? WS_WEXP1 : WS_WEXP) + WEXP_GU_BYTES), nullptr, 256}; pg8::MoeOrder<4> S{meta + 64, meta[0], G, bid};
            pg8::EpiFp8 E{(unsigned char*)(F.ws + WS_Y), 1024};
            pg8::gemm_phase<pg8::EpiFp8, pg8::MoeOrder<4>, false>(F.lds, g, S, E, F.tid);
            SEAMCV(pb + 10, l);
        }
        if (EN(13) && IN(pb + 11)) REP(13) { FRESH(); combine_phase(F, l, Tl); SEAMCV(pb + 11, l); }
    }

constexpr int NPH = 26;
#ifndef BENCH_REPS
#define BENCH_REPS 2
#endif
__global__ void __launch_bounds__(NTHR, 2) fwd_kernel(Args args) {
    extern __shared__ __attribute__((aligned(16))) unsigned char lds_raw[];
    Frame F;
    F.lds = (LAS unsigned char*)lds_raw;
    F.tid = threadIdx.x; F.lane = F.tid & 63; F.wave = __builtin_amdgcn_readfirstlane(F.tid >> 6); F.G = gridDim.x;
    F.in = (const CAS cfptr*)__builtin_amdgcn_kernarg_segment_ptr();
    F.out = args.out; F.ws = args.ws;
    volatile LAS unsigned* MISC = (volatile LAS unsigned*)(F.lds + MISC_OFF);
    if (F.tid < 64) MISC[F.tid] = 0u;
    __syncthreads();
    XcdBarrier bar = xcd_barrier_post((unsigned*)(F.ws + WS_CTL) + CW_BAR, MISC + 8);
    const int lo = args.ph_lo, hi = args.ph_hi;
    const int bid = blockIdx.x, G = F.G;

    if (EN(0) && IN(0)) { FRESH(); phase_g0(F); SEAMCV(0, 0); }
    if (EN(1) && IN(1)) { FRESH(); hprep_rows(F, 0, F_X(F), F_CTX(F), TT, 0, 1024, F.in[6]); SEAMCV(1, 0); }

    layer_phases<0>(F, bar, lo, hi);
    layer_phases<1>(F, bar, lo, hi);
#ifdef BENCH_GEMM
    if (hi == NPH) { xcd_barrier(bar); FRESH();
        _Pragma("unroll 1") for (int rep = 0; rep < BENCH_REPS; ++rep) {
            const int* meta = (const int*)(F.ws + WS_META);
            pg8::Gemm g{(const bf16*)(F.ws + WS_HBUF), (const bf16*)(F.ws + WS_WEXP + WEXP_GU_BYTES), nullptr, 256}; pg8::MoeOrder<4> S{meta + 64, meta[0], F.G, (int)blockIdx.x};
#if BENCH_GEMM == 1
            pg8::EpiFp8 E{(unsigned char*)(F.ws + WS_Y), 1024}; pg8::gemm_phase<pg8::EpiFp8, pg8::MoeOrder<4>, false>(F.lds, g, S, E, F.tid);
#else
            pg8::EpiNone E{(bf16*)(F.ws + WS_Y)}; pg8::gemm_phase<pg8::EpiNone, pg8::MoeOrder<4>, false>(F.lds, g, S, E, F.tid);
#endif
            xcd_barrier(bar); } }
#endif
#ifdef BENCH_INPROJ
    if (hi == NPH) { xcd_barrier(bar); FRESH();
        _Pragma("unroll 1") for (int rep = 0; rep < BENCH_REPS; ++rep) {
            pg8::Gemm g{(const bf16*)(F.ws + WS_HB), (const bf16*)(F.ws + WS_WIN), nullptr, 1024}; pg8::StaticOrder S; S.init(TT, INW, F.G, (int)blockIdx.x);
#if BENCH_INPROJ == 1
            pg8::EpiBf16 E{(bf16*)(F.ws + WS_Z), INW}; pg8::gemm_phase<pg8::EpiBf16, pg8::StaticOrder, false>(F.lds, g, S, E, F.tid);
#else
            pg8::EpiNone E{(bf16*)(F.ws + WS_Z)}; pg8::gemm_phase<pg8::EpiNone, pg8::StaticOrder, false>(F.lds, g, S, E, F.tid);
#endif
            xcd_barrier(bar); } }
#endif
#ifdef BENCH_MOE1
    if (hi == NPH) { xcd_barrier(bar); FRESH();
        _Pragma("unroll 1") for (int rep = 0; rep < BENCH_REPS; ++rep) {
            const int* meta = (const int*)(F.ws + WS_META);
            pg8::MoeOrder<2> S{meta + 64, meta[0], F.G, (int)blockIdx.x};
#if BENCH_MOE1 == 1
            pg8::Gemm g{(const bf16*)(F.ws + WS_HB), (const bf16*)(F.ws + WS_WEXP1), (const int*)(F.ws + WS_ROWTOK), 1024};
            pg8::EpiSwiglu E{(bf16*)(F.ws + WS_HBUF)}; pg8::gemm_phase<pg8::EpiSwiglu, pg8::MoeOrder<2>, true>(F.lds, g, S, E, F.tid);
#elif BENCH_MOE1 == 2
            pg8::Gemm g{(const bf16*)(F.ws + WS_HB), (const bf16*)(F.ws + WS_WEXP1), (const int*)(F.ws + WS_ROWTOK), 1024};
            pg8::EpiNone E{(bf16*)(F.ws + WS_HBUF)}; pg8::gemm_phase<pg8::EpiNone, pg8::MoeOrder<2>, true>(F.lds, g, S, E, F.tid);
#else
            pg8::Gemm g{(const bf16*)(F.ws + WS_HB), (const bf16*)(F.ws + WS_WEXP1), nullptr, 1024};
            pg8::EpiNone E{(bf16*)(F.ws + WS_HBUF)}; pg8::gemm_phase<pg8::EpiNone, pg8::MoeOrder<2>, false>(F.lds, g, S, E, F.tid);
#endif
            xcd_barrier(bar); } }
#endif
#ifdef BENCH_X2
    if (hi == NPH) { xcd_barrier(bar); FRESH();
        _Pragma("unroll 1") for (int rep = 0; rep < BENCH_REPS; ++rep) { if (BENCH_X2 & 1) hgrn2_c2(F); if (BENCH_X2 & 2) lru_carry(F); xcd_barrier(bar); } }
#endif
#ifdef BENCH_C1
    if (hi == NPH) { xcd_barrier(bar); FRESH();
        _Pragma("unroll 1") for (int rep = 0; rep < BENCH_REPS; ++rep) hgrn2_c1<BENCH_C1>(F, 1, (int)blockIdx.x, 16 * HG_SLOTS, F.G); }
#endif
#ifdef BENCH_VAR
    if (hi == NPH) { xcd_barrier(bar); FRESH();
        _Pragma("unroll 1") for (int rep = 0; rep < BENCH_REPS; ++rep) for (int u = blockIdx.x; u < 8 * 128; u += F.G) hgrn2_c3<BENCH_VAR>(F, 1, u >> 7, 2 + (u & 127)); }
#endif
#undef IN
#undef SEAM
}

extern "C" void kernel_launch(void* const* d_in, const int* in_sizes, int n_in, void* d_out, int out_size, void* d_ws, size_t ws_size, hipStream_t stream) {
    static int grid = 0;
    if (grid == 0) {
        if (n_in != 28 || out_size != TL * D || ws_size < WS_END) { fprintf(stderr, "kernel_launch: unexpected problem (n_in %d, out %d, ws %zu < %zu)\n", n_in, out_size, ws_size, (size_t)WS_END); grid = -1; return; }
        int dev = 0, cus = 0, per_cu = 0;
        if (hipGetDevice(&dev) != hipSuccess || hipDeviceGetAttribute(&cus, hipDeviceAttributeMultiprocessorCount, dev) != hipSuccess) { grid = -1; return; }
        if (hipFuncSetAttribute((const void*)fwd_kernel, hipFuncAttributeMaxDynamicSharedMemorySize, LDS_BYTES) != hipSuccess) { fprintf(stderr, "kernel_launch: hipFuncSetAttribute failed\n"); grid = -1; return; }
        if (hipOccupancyMaxActiveBlocksPerMultiprocessor(&per_cu, (const void*)fwd_kernel, NTHR, LDS_BYTES) != hipSuccess || per_cu < 1) { fprintf(stderr, "kernel_launch: occupancy query says %d\n", per_cu); (void)hipGetLastError(); }
        grid = cus;
    }
    if (grid < 0) return;
    (void)hipMemsetAsync((char*)d_ws + WS_CTL, 0, CTL_ZERO_BYTES, stream);
    Args a{};
    for (int i = 0; i < 28; ++i) a.in[i] = (const float*)d_in[i];
    a.out = (float*)d_out; a.ws = (unsigned char*)d_ws;
#if MK_PER_PHASE
    for (int p = 0; p < NPH; ++p) { a.ph_lo = p; a.ph_hi = p + 1; hipLaunchKernelGGL(fwd_kernel, dim3(grid), dim3(NTHR), LDS_BYTES, stream, a); }
#else
    a.ph_lo = 0; a.ph_hi = NPH; hipLaunchKernelGGL(fwd_kernel, dim3(grid), dim3(NTHR), LDS_BYTES, stream, a);
#endif
}
```

```cpp
#include <hip/hip_runtime.h>
#include <cstdio>
#include <cstdint>

#ifndef MK_PER_PHASE
#define MK_PER_PHASE 0
#endif

#define LAS __attribute__((address_space(3)))
#define GAS __attribute__((address_space(1)))
typedef unsigned short bf16;
typedef short bf16x8 __attribute__((ext_vector_type(8)));
typedef float f32x4 __attribute__((ext_vector_type(4)));
typedef float f32x2 __attribute__((ext_vector_type(2)));
typedef unsigned u32x4 __attribute__((ext_vector_type(4)));
typedef unsigned u32x2 __attribute__((ext_vector_type(2)));

__device__ __forceinline__ float bf2f(bf16 v) { return __builtin_bit_cast(float, ((unsigned)v) << 16); }
typedef __bf16 bf16x2_t __attribute__((ext_vector_type(2)));
__device__ __forceinline__ unsigned pk2(float lo, float hi) { bf16x2_t v; v.x = (__bf16)lo; v.y = (__bf16)hi; return __builtin_bit_cast(unsigned, v); }
__device__ __forceinline__ bf16 f2bf(float f) { const __bf16 b = (__bf16)f; return __builtin_bit_cast(unsigned short, b); }
__device__ __forceinline__ unsigned f2bfu(float f) { return (unsigned)f2bf(f); }
#define MFMA16(a, b, c) __builtin_amdgcn_mfma_f32_16x16x32_bf16((a), (b), (c), 0, 0, 0)
#define LDS_WAIT() asm volatile("s_waitcnt lgkmcnt(0)" ::: "memory")
#define LDS_BARRIER() do { asm volatile("s_waitcnt lgkmcnt(0)" ::: "memory"); __builtin_amdgcn_s_barrier(); asm volatile("" ::: "memory"); } while (0)

namespace pg8 {
typedef unsigned short bf16_t;
constexpr int BM = 256, BK = 64, HALF = 128, HTB = HALF * BK * 2, STAGE_BYTES = 8 * HTB, NXCD = 8, WGM = 8;

__host__ __device__ __forceinline__ int lds_byte(int r, int c) { const int st = (r >> 4) * 2 + (c >> 5), rr = r & 15, cc = c & 31, ob = rr * 64 + cc * 2; return st * 1024 + (ob ^ (((ob >> 9) & 1) << 5)); }
__host__ __device__ __forceinline__ void stage_rc(int b, int& R, int& C) { const int st = b / 1024, sb = b % 1024, swz = sb ^ (((sb >> 9) & 1) << 5); R = (st >> 1) * 16 + swz / 64; C = (st & 1) * 32 + (swz % 64) / 2; }
__host__ __device__ __forceinline__ int perm32(int rho) { const int n = rho >> 4, i = rho & 15; return 8 * (i >> 2) + 4 * n + (i & 3); }

struct Unit { int pm, pn, pc, half; };
struct Gemm { const bf16_t* A; const bf16_t* Bt; const int* rows; int K; };

struct StaticOrder {
    int nM, nN, nwg, G, c;
    __device__ void init(int M, int N, int G_, int c_) { nM = M / BM; nN = N / BM; nwg = nM * nN; G = G_; c = c_; }
    __device__ bool next(int i, Unit& u) const {
        const long L = (long)i * G + c; if (L >= nwg) return false;
        int wgid = (int)L; { const int q = nwg / NXCD, r = nwg % NXCD, xcd = wgid % NXCD, off = wgid / NXCD; wgid = (xcd < r ? xcd * (q + 1) : r * (q + 1) + (xcd - r) * q) + off; }
        const int nig = WGM * nN, gid = wgid / nig, fm = gid * WGM, gsz = (nM - fm) < WGM ? (nM - fm) : WGM;
        u.pm = fm + ((wgid % nig) % gsz); u.pn = (wgid % nig) / gsz; u.pc = u.pn; u.half = 0; return true;
    }
};
template <int NT> struct MoeOrder {
    const int* tile_expert; int n_tiles, G, c;
    __device__ bool next(int i, Unit& u) const {
        int rt, j;
        if ((G & 7) == 0) { const int x = c & 7, jw = c >> 3, per = G >> 3; const int t0 = (int)(((long)n_tiles * x) >> 3), t1 = (int)(((long)n_tiles * (x + 1)) >> 3);
            const int Lx = i * per + jw; if (Lx >= (t1 - t0) * NT) return false; rt = t0 + Lx / NT; j = Lx % NT; }
        else { const int L = i * G + c; if (L >= n_tiles * NT) return false; rt = L / NT; j = L % NT; }
        const int te = tile_expert[rt], e = te & 0xffff;
        u.pm = rt; u.pn = e * NT + j; u.pc = j; u.half = te >> 16; return true;
    }
};

__device__ __forceinline__ unsigned cvt_pk_bf16(float lo, float hi) { return pk2(lo, hi); }

struct EpiBf16 {
    static constexpr bool PERM = true;
    bf16_t* O; int ldc;
    __device__ __forceinline__ void operator()(const f32x4 (&acc)[2][2][4][2], const Unit& u, int wr, int wc, int fr, int fq) const {
        const int row0 = u.pm * BM + wr * 64 + fr, col0 = u.pc * BM + wc * 32 + 8 * fq;
#pragma unroll
        for (int ai = 0; ai < 2; ++ai)
#pragma unroll
            for (int m = 0; m < 4; ++m) { bf16_t* rowp = O + (size_t)(row0 + ai * HALF + m * 16) * ldc + col0;
#pragma unroll
                for (int bj = 0; bj < 2; ++bj) { const f32x4 v0 = acc[ai][bj][m][0], v1 = acc[ai][bj][m][1];
                    u32x4 w; w.x = cvt_pk_bf16(v0[0], v0[1]); w.y = cvt_pk_bf16(v0[2], v0[3]); w.z = cvt_pk_bf16(v1[0], v1[1]); w.w = cvt_pk_bf16(v1[2], v1[3]);
                    *(u32x4*)(rowp + bj * HALF) = w; } }
    }
};
struct EpiFp8 {
    static constexpr bool PERM = true;
    unsigned char* O; int ldc;
    static __device__ __forceinline__ unsigned pk4(const f32x4 v) {
        const float a = __builtin_amdgcn_fmed3f(v[0], -448.f, 448.f), b = __builtin_amdgcn_fmed3f(v[1], -448.f, 448.f), c = __builtin_amdgcn_fmed3f(v[2], -448.f, 448.f), d = __builtin_amdgcn_fmed3f(v[3], -448.f, 448.f);
        int p = __builtin_amdgcn_cvt_pk_fp8_f32(a, b, 0, false); p = __builtin_amdgcn_cvt_pk_fp8_f32(c, d, p, true); return (unsigned)p; }
    __device__ __forceinline__ void operator()(const f32x4 (&acc)[2][2][4][2], const Unit& u, int wr, int wc, int fr, int fq) const {
        const int row0 = u.pm * BM + wr * 64 + fr, pos0 = u.pc * BM + wc * 64 + 16 * fq;
#pragma unroll
        for (int ai = 0; ai < 2; ++ai) { if (ai == 1 && u.half) break;
#pragma unroll
            for (int m = 0; m < 4; ++m) { u32x4 w; w.x = pk4(acc[ai][0][m][0]); w.y = pk4(acc[ai][0][m][1]); w.z = pk4(acc[ai][1][m][0]); w.w = pk4(acc[ai][1][m][1]);
                *(u32x4*)(O + (size_t)(row0 + ai * HALF + m * 16) * ldc + pos0) = w; } }
    }
};
struct EpiNone {
    static constexpr bool PERM = true;
    bf16_t* O;
    __device__ __forceinline__ void operator()(const f32x4 (&acc)[2][2][4][2], const Unit& u, int wr, int wc, int fr, int fq) const {
        float s = 0.f;
#pragma unroll
        for (int ai = 0; ai < 2; ++ai)
#pragma unroll
            for (int bj = 0; bj < 2; ++bj)
#pragma unroll
                for (int m = 0; m < 4; ++m)
#pragma unroll
                    for (int n = 0; n < 2; ++n) s += acc[ai][bj][m][n][0] + acc[ai][bj][m][n][1] + acc[ai][bj][m][n][2] + acc[ai][bj][m][n][3];
        if (s == 123.4567f) O[u.pm + wr + wc + fr + fq] = 1;
    }
};
struct EpiF32 {
    static constexpr bool PERM = false;
    float* C; int ldc;
    __device__ __forceinline__ void operator()(const f32x4 (&acc)[2][2][4][2], const Unit& u, int wr, int wc, int fr, int fq) const {
        const int row0 = u.pm * BM + wr * 64 + fr, col0 = u.pc * BM + wc * 32 + 4 * fq;
#pragma unroll
        for (int ai = 0; ai < 2; ++ai)
#pragma unroll
            for (int m = 0; m < 4; ++m) { float* rowp = C + (size_t)(row0 + ai * HALF + m * 16) * ldc + col0;
#pragma unroll
                for (int bj = 0; bj < 2; ++bj)
#pragma unroll
                    for (int n = 0; n < 2; ++n) *(f32x4*)(rowp + bj * HALF + n * 16) = acc[ai][bj][m][n]; }
    }
};
struct EpiResid {
    static constexpr bool PERM = false;
    const float* src_lat; float* dst_lat; const float* src_ctx; float* dst_ctx; const float* gate;
    __device__ __forceinline__ void operator()(const f32x4 (&acc)[2][2][4][2], const Unit& u, int wr, int wc, int fr, int fq) const {
        const int col0 = u.pc * BM + wc * 32 + 4 * fq;
        const float* src; float* dst; const float* gv; int row0;
        if (u.pm < 128) { row0 = u.pm * BM + wr * 64 + fr; src = src_lat; dst = dst_lat; gv = gate + (u.pm >> 6) * 6144 + 2048; }
        else { row0 = (u.pm - 128) * BM + wr * 64 + fr; src = src_ctx; dst = dst_ctx; gv = gate + 2 * 6144 + 2048; }
        f32x4 g[2][2];
#pragma unroll
        for (int bj = 0; bj < 2; ++bj)
#pragma unroll
            for (int n = 0; n < 2; ++n) g[bj][n] = *(const f32x4*)(gv + col0 + bj * HALF + n * 16);
#pragma unroll
        for (int ai = 0; ai < 2; ++ai)
#pragma unroll
            for (int m = 0; m < 4; ++m) { const size_t off = (size_t)(row0 + ai * HALF + m * 16) * 1024 + col0;
#pragma unroll
                for (int bj = 0; bj < 2; ++bj)
#pragma unroll
                    for (int n = 0; n < 2; ++n) { const f32x4 xv = *(const f32x4*)(src + off + bj * HALF + n * 16);
                        *(f32x4*)(dst + off + bj * HALF + n * 16) = xv + g[bj][n] * acc[ai][bj][m][n]; } }
    }
};
struct EpiSwiglu {
    static constexpr bool PERM = true;
    bf16_t* H;
    __device__ __forceinline__ void operator()(const f32x4 (&acc)[2][2][4][2], const Unit& u, int wr, int wc, int fr, int fq) const {
        const int row0 = u.pm * BM + wr * 64 + fr, col0 = u.pc * HALF + wc * 32 + 8 * fq;
#pragma unroll
        for (int ai = 0; ai < 2; ++ai) { if (ai == 1 && u.half) break;
#pragma unroll
            for (int m = 0; m < 4; ++m) { float h[8];
#pragma unroll
                for (int n = 0; n < 2; ++n)
#pragma unroll
                    for (int j = 0; j < 4; ++j) { const float g = acc[ai][0][m][n][j], up = acc[ai][1][m][n][j]; h[n * 4 + j] = g * __builtin_amdgcn_rcpf(1.f + __expf(-g)) * up; }
                u32x4 w; w.x = cvt_pk_bf16(h[0], h[1]); w.y = cvt_pk_bf16(h[2], h[3]); w.z = cvt_pk_bf16(h[4], h[5]); w.w = cvt_pk_bf16(h[6], h[7]);
                *(u32x4*)(H + (size_t)(row0 + ai * HALF + m * 16) * 256 + col0) = w; } }
    }
};

template <class Epi, class Sched, bool GATHER>
__device__ __forceinline__ void gemm_phase(LAS unsigned char* lds, const Gemm g, const Sched& S, const Epi& E, const int tid) {
    const int wid = __builtin_amdgcn_readfirstlane(tid >> 6), lane = tid & 63, wr = wid >> 2, wc = wid & 3, fr = lane & 15, fq = lane >> 4;
    const int K = g.K, nt = K / BK;
    int RA[2], CA[2]; unsigned voffB[2];
#pragma unroll
    for (int i = 0; i < 2; ++i) { int R, C; stage_rc(tid * 16 + i * 8192, R, C); const int Rb = Epi::PERM ? ((R & ~31) + perm32(R & 31)) : R;
        RA[i] = R; CA[i] = C; voffB[i] = (unsigned)(Rb * K + C) * 2u; }
    const unsigned kstep = (unsigned)(BK * 2);
    const unsigned hstep = (unsigned)HALF * (unsigned)K * 2u;
    const unsigned tstep = 2u * hstep;
    const unsigned ldsw = (unsigned)wid * 1024u;
    const int aoff = lds_byte(wr * 64 + fr, fq * 8), boff = lds_byte(wc * 32 + fr, fq * 8);
    const __amdgpu_buffer_rsrc_t srdA = __builtin_amdgcn_make_buffer_rsrc((void*)g.A, (short)0, 0x7fffffff, 0x00020000);
    const __amdgpu_buffer_rsrc_t srdB = __builtin_amdgcn_make_buffer_rsrc((void*)g.Bt, (short)0, 0x7fffffff, 0x00020000);
#define PG8_SA(b, h) (((b) * 2 + (h)) * HTB)
#define PG8_SB(b, h) ((4 + (b) * 2 + (h)) * HTB)
#define PG8_STAGE(bufoff, soff, voff) do { _Pragma("unroll") for (int _i = 0; _i < 2; ++_i) \
        __builtin_amdgcn_raw_ptr_buffer_load_lds(srdB, (LAS unsigned*)(lds + (bufoff) + ldsw + _i * 8192), 16, (int)(voff)[_i], (int)(soff), 0, 0); } while (0)
#define PG8_STAGE2(bufoff, soff, v0, v1) do { \
        __builtin_amdgcn_raw_ptr_buffer_load_lds(srdA, (LAS unsigned*)(lds + (bufoff) + ldsw), 16, (int)(v0), (int)(soff), 0, 0); \
        __builtin_amdgcn_raw_ptr_buffer_load_lds(srdA, (LAS unsigned*)(lds + (bufoff) + ldsw + 8192), 16, (int)(v1), (int)(soff), 0, 0); } while (0)
#define PG8_LDA(dst, b, h) do { _Pragma("unroll") for (int m = 0; m < 4; ++m) _Pragma("unroll") for (int k = 0; k < 2; ++k) dst[m][k] = *(const LAS bf16x8*)(lds + PG8_SA(b, h) + aoff + m * 2048 + k * 1024); } while (0)
#define PG8_LDB(dst, b, h) do { _Pragma("unroll") for (int n = 0; n < 2; ++n) _Pragma("unroll") for (int k = 0; k < 2; ++k) dst[n][k] = *(const LAS bf16x8*)(lds + PG8_SB(b, h) + boff + n * 2048 + k * 1024); } while (0)
#define PG8_MMA(ai, bj, At, Bt) do { __builtin_amdgcn_s_setprio(1); _Pragma("unroll") for (int m = 0; m < 4; ++m) _Pragma("unroll") for (int n = 0; n < 2; ++n) _Pragma("unroll") for (int k = 0; k < 2; ++k) \
        acc[ai][bj][m][n] = __builtin_amdgcn_mfma_f32_16x16x32_bf16(Bt[n][k], At[m][k], acc[ai][bj][m][n], 0, 0, 0); __builtin_amdgcn_s_setprio(0); } while (0)
#define PG8_WAIT_V(n) asm volatile("s_waitcnt vmcnt(" #n ")" ::: "memory")
#define PG8_WAIT_L(n) asm volatile("s_waitcnt lgkmcnt(" #n ")" ::: "memory")
#define PG8_BAR __builtin_amdgcn_s_barrier()
#define PG8_SCHED __builtin_amdgcn_sched_barrier(0)
    Unit cur, nxt; int ui = 0;
    if (!S.next(0, cur)) return;
    f32x4 acc[2][2][4][2];
#pragma unroll
    for (int a = 0; a < 2; ++a)
#pragma unroll
        for (int b = 0; b < 2; ++b)
#pragma unroll
            for (int m = 0; m < 4; ++m)
#pragma unroll
                for (int n = 0; n < 2; ++n) acc[a][b][m][n] = (f32x4){0.f, 0.f, 0.f, 0.f};
    bf16x8 At[4][2], B0[2][2], B1[2][2];
    unsigned c00, c01, c10, c11, n00, n01, n10, n11;
    unsigned cA, cB = (unsigned)cur.pn * tstep;
    if constexpr (GATHER) {
        const int* rp = g.rows + (size_t)cur.pm * BM; const unsigned rb = (unsigned)K * 2u;
        c00 = (unsigned)rp[RA[0]] * rb + (unsigned)CA[0] * 2u; c01 = (unsigned)rp[RA[1]] * rb + (unsigned)CA[1] * 2u;
        c10 = (unsigned)rp[HALF + RA[0]] * rb + (unsigned)CA[0] * 2u; c11 = (unsigned)rp[HALF + RA[1]] * rb + (unsigned)CA[1] * 2u;
        cA = 0u;
    } else {
        c00 = (unsigned)(RA[0] * K + CA[0]) * 2u; c01 = (unsigned)(RA[1] * K + CA[1]) * 2u;
        c10 = (unsigned)((HALF + RA[0]) * K + CA[0]) * 2u; c11 = (unsigned)((HALF + RA[1]) * K + CA[1]) * 2u;
        cA = (unsigned)cur.pm * tstep;
    }
    n00 = c00; n01 = c01; n10 = c10; n11 = c11;
    PG8_STAGE(PG8_SB(0, 0), cB, voffB); PG8_STAGE(PG8_SB(0, 1), cB + hstep, voffB); PG8_STAGE2(PG8_SA(0, 0), cA, c00, c01); PG8_STAGE2(PG8_SA(0, 1), cA, c10, c11);
    if (wr == 1) PG8_BAR;
    PG8_WAIT_V(2); PG8_BAR;
    PG8_STAGE(PG8_SB(1, 0), cB + kstep, voffB); PG8_STAGE2(PG8_SA(1, 0), cA + kstep, c00, c01); PG8_STAGE(PG8_SB(1, 1), cB + hstep + kstep, voffB);
    PG8_WAIT_V(6); PG8_BAR;
    for (;;) {
        const bool has_next = S.next(ui + 1, nxt);
        unsigned nA; const unsigned nB = has_next ? (unsigned)nxt.pn * tstep : cB;
        if constexpr (GATHER) {
            nA = 0u;
            if (has_next) { const int* rp = g.rows + (size_t)nxt.pm * BM; const unsigned rb = (unsigned)K * 2u;
                n00 = (unsigned)rp[RA[0]] * rb + (unsigned)CA[0] * 2u; n01 = (unsigned)rp[RA[1]] * rb + (unsigned)CA[1] * 2u;
                n10 = (unsigned)rp[HALF + RA[0]] * rb + (unsigned)CA[0] * 2u; n11 = (unsigned)rp[HALF + RA[1]] * rb + (unsigned)CA[1] * 2u; }
            else { n00 = c00; n01 = c01; n10 = c10; n11 = c11; }
        } else {
            nA = has_next ? (unsigned)nxt.pm * tstep : cA;
        }
        const bool hf = cur.half != 0;
#pragma unroll 1
        for (int t = 0; t < nt; t += 2) {
            const bool last = (t == nt - 2);
            const unsigned a1 = cA + (unsigned)(t + 1) * kstep;
            const unsigned a2 = last ? nA : cA + (unsigned)(t + 2) * kstep, b2 = last ? nB : cB + (unsigned)(t + 2) * kstep;
            const unsigned a3 = a2 + kstep, b3 = b2 + kstep;
            unsigned s00 = c00, s01 = c01, s10 = c10, s11 = c11;
            if constexpr (GATHER) { s00 = last ? n00 : c00; s01 = last ? n01 : c01; s10 = last ? n10 : c10; s11 = last ? n11 : c11; }
            PG8_LDB(B0, 0, 0); PG8_LDB(B1, 0, 1); PG8_SCHED; PG8_LDA(At, 0, 0); PG8_STAGE2(PG8_SA(1, 1), a1, c10, c11);
            PG8_WAIT_V(8); PG8_WAIT_L(0); PG8_BAR; PG8_MMA(0, 0, At, B0); PG8_MMA(0, 1, At, B1); PG8_BAR; PG8_SCHED;
            if (!hf) PG8_LDA(At, 0, 1); PG8_STAGE(PG8_SB(0, 0), b2, voffB); PG8_STAGE(PG8_SB(0, 1), b2 + hstep, voffB); PG8_STAGE2(PG8_SA(0, 0), a2, s00, s01);
            PG8_WAIT_V(8); PG8_WAIT_L(0); PG8_BAR; if (!hf) { PG8_MMA(1, 0, At, B0); PG8_MMA(1, 1, At, B1); } PG8_BAR; PG8_SCHED;
            PG8_LDB(B0, 1, 0); PG8_LDB(B1, 1, 1); PG8_SCHED; PG8_LDA(At, 1, 0); PG8_STAGE2(PG8_SA(0, 1), a2, s10, s11);
            PG8_WAIT_V(8); PG8_WAIT_L(0); PG8_BAR; PG8_MMA(0, 0, At, B0); PG8_MMA(0, 1, At, B1); PG8_BAR; PG8_SCHED;
            if (!hf) PG8_LDA(At, 1, 1); PG8_STAGE(PG8_SB(1, 0), b3, voffB); PG8_STAGE(PG8_SB(1, 1), b3 + hstep, voffB); PG8_STAGE2(PG8_SA(1, 0), a3, s00, s01);
            PG8_WAIT_V(8); PG8_WAIT_L(0); PG8_BAR; if (!hf) { PG8_MMA(1, 0, At, B0); PG8_MMA(1, 1, At, B1); } PG8_BAR; PG8_SCHED;
        }
        if (wr == 0) PG8_BAR;
        E(acc, cur, wr, wc, fr, fq);
        if (!has_next) break;
#pragma unroll
        for (int a = 0; a < 2; ++a)
#pragma unroll
            for (int b = 0; b < 2; ++b)
#pragma unroll
                for (int m = 0; m < 4; ++m)
#pragma unroll
                    for (int n = 0; n < 2; ++n) acc[a][b][m][n] = (f32x4){0.f, 0.f, 0.f, 0.f};
        cur = nxt; cA = nA; cB = nB; ++ui;
        if constexpr (GATHER) { c00 = n00; c01 = n01; c10 = n10; c11 = n11; }
        if (wr == 1) PG8_BAR;
    }
    PG8_WAIT_V(0);
    PG8_BAR;
#undef PG8_SA
#undef PG8_SB
#undef PG8_STAGE
#undef PG8_STAGE2
#undef PG8_LDA
#undef PG8_LDB
#undef PG8_MMA
#undef PG8_WAIT_V
#undef PG8_WAIT_L
#undef PG8_BAR
#undef PG8_SCHED
}
}

#define XB_TMO      128
#define XB_XCNT(j)  (256  + 64 * (j))
#define XB_XSUB(j)  (1280 + 64 * (j))
#define XB_XGEN(j)  (2304 + 64 * (j))
#define XB_TOP      3328
#define XB_TOPGEN   3392
#define XCD_BAR_WORDS 3456
#define XB_SPIN_CAP (1u << 18)

__device__ __forceinline__ unsigned xb_ld(unsigned* p)              { return __hip_atomic_load(p, __ATOMIC_RELAXED, __HIP_MEMORY_SCOPE_AGENT); }
__device__ __forceinline__ unsigned xb_add(unsigned* p, unsigned v) { return __hip_atomic_fetch_add(p, v, __ATOMIC_RELAXED, __HIP_MEMORY_SCOPE_AGENT); }
__device__ __forceinline__ unsigned xb_xcc_id() { return (unsigned)__builtin_amdgcn_s_getreg((3 << 11) | 20) & 0xFu; }
#define XB_SPIN(cond, bar) do { unsigned _sp = 0; while (cond) { __builtin_amdgcn_s_sleep(1); \
    if ((++_sp & 255u) == 0u) { if (xb_ld(&(bar)[XB_TMO])) break; if (_sp > XB_SPIN_CAP) { atomicAdd(&(bar)[XB_TMO], 1u); break; } } } } while (0)

struct XcdBarrier { unsigned* bar; unsigned x; volatile LAS unsigned* st; };

__device__ __forceinline__ XcdBarrier xcd_barrier_post(unsigned* bar, volatile LAS unsigned* st) {
    XcdBarrier b; b.bar = bar; b.x = xb_xcc_id(); b.st = st;
    if (threadIdx.x == 0) (void)xb_add(&bar[XB_XCNT(b.x)], 1u);
    return b;
}
__device__ __forceinline__ void xcd_barrier_complete(unsigned* bar, unsigned x, unsigned& nloc, unsigned& nx) {
    const unsigned G = gridDim.x * gridDim.y * gridDim.z;
    unsigned sum, cnt, mine, sp = 0u;
    for (;;) {
        sum = 0u; cnt = 0u; mine = 0u;
#pragma unroll 1
        for (unsigned j = 0; j < 16; ++j) { const unsigned c = xb_ld(&bar[XB_XCNT(j)]); sum += c; cnt += (c > 0u) ? 1u : 0u; mine = (j == x) ? c : mine; }
        if (sum == G) break;
        __builtin_amdgcn_s_sleep(1);
        if ((++sp & 255u) == 0u) { if (xb_ld(&bar[XB_TMO])) break; if (sp > XB_SPIN_CAP) { atomicAdd(&bar[XB_TMO], 1u); break; } }
    }
    nloc = mine > 0u ? mine : 1u; nx = cnt > 0u ? cnt : 1u;
}
__device__ __forceinline__ void xcd_barrier(const XcdBarrier& b) {
    asm volatile("s_waitcnt vmcnt(0)" ::: "memory");
    __syncthreads();
    if (threadIdx.x == 0) {
        unsigned* bar = b.bar;
        __builtin_amdgcn_s_waitcnt(0);
        unsigned nloc = b.st[0], nx = b.st[1];
        if (nloc == 0u) { xcd_barrier_complete(bar, b.x, nloc, nx); b.st[0] = nloc; b.st[1] = nx; }
        const unsigned old = xb_add(&bar[XB_XSUB(b.x)], 1u);
        const unsigned gen = old / nloc;
        if (old + 1u == (gen + 1u) * nloc) {
            __builtin_amdgcn_fence(__ATOMIC_RELEASE, "agent");
            asm volatile("s_waitcnt vmcnt(0)" ::: "memory");
            const unsigned og = xb_add(&bar[XB_TOP], 1u);
            const unsigned tg = og / nx;
            if (og + 1u == (tg + 1u) * nx) xb_add(&bar[XB_TOPGEN], 1u);
            else XB_SPIN(xb_ld(&bar[XB_TOPGEN]) == tg, bar);
            __builtin_amdgcn_fence(__ATOMIC_ACQUIRE, "agent");
            xb_add(&bar[XB_XGEN(b.x)], 1u);
            asm volatile("s_waitcnt vmcnt(0)" ::: "memory");
        } else {
            XB_SPIN(xb_ld(&bar[XB_XGEN(b.x)]) == gen, bar);
            __builtin_amdgcn_fence(__ATOMIC_ACQUIRE, "agent");
            asm volatile("s_waitcnt vmcnt(0)" ::: "memory");
        }
    }
    __syncthreads();
}

constexpr int D = 1024, NBATCH = 2, SEQ = 16384, CTXL = 256;
constexpr int TL = NBATCH * SEQ, TC = NBATCH * CTXL, TT = TL + TC;
constexpr int INW = 3328;
constexpr int ZQ = 0, ZFF = 512, ZFB = 1024, ZV = 1536, ZG = 2048, ZXB = 2560, ZYB = 2816, ZU = 3072;
constexpr int NEXP = 256, TOPK = 8;
constexpr float EPS = 1e-6f;
constexpr int NWAVES = 8, NTHR = 512;
constexpr int CV_TILES = 257 * 48;
constexpr int CV_OUTP = 248 * 6;
constexpr int CV_ROUT = 126 * 10;
constexpr int HG_SLOTS = 130;
constexpr int LR_SLOTS = 260;
constexpr int MAXROWS = 364800;

constexpr size_t MiB = 1u << 20;
constexpr size_t WS_CTL = 0, CTL_ZERO_BYTES = 1 * MiB;
constexpr size_t WS_MOD = 1 * MiB;
constexpr size_t WS_TAB = 2 * MiB;
constexpr size_t TAB_FC = 0, TAB_FS = 32768, TAB_CS = 65536, TAB_LB = 81920  , TAB_LRUW = 86016  , TAB_LRUCL = 348160  , TAB_C256 = 352256  , TAB_S256 = 483328  ;
constexpr size_t WS_META = 3 * MiB;
constexpr size_t WS_WIN = 4 * MiB;
constexpr size_t WS_WOUT = 18 * MiB;
constexpr size_t WS_WR = 22 * MiB;
constexpr size_t WS_XC = 24 * MiB;
constexpr size_t WS_LRUC = 26 * MiB;
constexpr size_t LRUC_STRIDE = (size_t)2 * 2 * LR_SLOTS * 256 * 4;
constexpr size_t WS_SEL = 30 * MiB;
constexpr size_t SEL_STRIDE = (size_t)TT * 8 * 4;
constexpr size_t WS_ROWTOK = 34 * MiB;
constexpr size_t WS_HD = 36 * MiB;
constexpr size_t WS_LOGIT = 38 * MiB;
constexpr size_t WS_HB = 72 * MiB;
constexpr size_t WS_WEXP = 138 * MiB;
constexpr size_t WEXP_GU_BYTES = (size_t)257 * 512 * 1024 * 2;
constexpr size_t WS_BIG = 524 * MiB;
constexpr size_t WS_Z = WS_BIG;
constexpr size_t WS_MIX = WS_BIG + 212 * MiB;
constexpr size_t WS_HS = WS_BIG + 278 * MiB;
constexpr size_t WS_FA = WS_BIG + 410 * MiB;
constexpr size_t WS_GE = WS_BIG + 442 * MiB;
constexpr size_t WS_GK = WS_BIG + 508 * MiB;
constexpr size_t WS_HV = WS_BIG + 574 * MiB;
constexpr size_t WS_HBUF = WS_BIG;
constexpr size_t WS_Y = WS_BIG + 180 * MiB;
constexpr size_t WS_WEXP1 = 1104 * MiB;
constexpr size_t WS_END = WS_WEXP1 + (size_t)257 * 1536 * 1024;
static_assert(WS_Y + (size_t)MAXROWS * 1024 <= WS_WEXP1 && WS_HV + (size_t)16 * 2 * HG_SLOTS * 256 * 4 <= WS_WEXP1 && WS_GK + (size_t)2 * TT * 512 * 2 <= WS_HV && WS_GE + (size_t)2 * TT * 512 * 2 <= WS_GK && WS_FA + (size_t)2 * 2 * 128 * 128 * 256 * 2 <= WS_GE, "overlay regions end below the second weight buffer");
static_assert(WS_Z + (size_t)TT * INW * 2 <= WS_MIX && WS_MIX + (size_t)TT * 1024 * 2 <= WS_HS && WS_HS + (size_t)16 * HG_SLOTS * 65536 <= WS_FA, "mixer overlay map");
static_assert(WS_HBUF + (size_t)MAXROWS * 256 * 2 <= WS_Y && WS_WEXP + (size_t)257 * 1536 * 1024 <= WS_BIG && WS_HB + (size_t)TT * 2048 <= WS_WEXP, "moe overlay map");
constexpr int CW_BAR = 4096;
constexpr int CW_CVQ = 8192;
constexpr int CW_CNT = 16384;

constexpr int LDS_BYTES = 151552;
constexpr int MISC_OFF = 150528;

struct Args { const float* in[28]; float* out; unsigned char* ws; int ph_lo, ph_hi; };

typedef const float* cfptr;
#define CAS __attribute__((address_space(4)))
struct Frame {
    LAS unsigned char* lds;
    int tid, lane, wave, G;
    const CAS cfptr* in;
    float* out; unsigned char* ws;
};
#define F_X(F)      ((F).in[0])
#define F_C(F)      ((F).in[1])
#define F_CTX(F)    ((F).in[2])
#define F_CCTX(F)   ((F).in[3])

__device__ __forceinline__ float wave_sum(float v) {
#pragma unroll
    for (int o = 1; o < 64; o <<= 1) v += __shfl_xor(v, o);
    return v;
}
__device__ __forceinline__ float sigmoidf_(float z) { return __builtin_amdgcn_rcpf(1.f + __expf(-z)); }

__device__ __forceinline__ void transpose_item(const float* W, int ldw, int k0, int n0, bf16* WT, int ldk, int drow0, LAS float* scr, int lane) {
#pragma unroll 8
    for (int i = 0; i < 32; ++i) { const int kk = 2 * i + (lane >> 5); scr[kk * 33 + (lane & 31)] = W[(size_t)(k0 + kk) * ldw + n0 + (lane & 31)]; }
    LDS_WAIT();
    const int c = lane & 7;
#pragma unroll
    for (int j = 0; j < 4; ++j) { const int n = (lane >> 3) + 8 * j; const LAS float* s = scr + (8 * c) * 33 + n;
        u32x4 o; o.x = pk2(s[0 * 33], s[1 * 33]); o.y = pk2(s[2 * 33], s[3 * 33]); o.z = pk2(s[4 * 33], s[5 * 33]); o.w = pk2(s[6 * 33], s[7 * 33]);
        *(u32x4*)(WT + (size_t)(drow0 + n) * ldk + k0 + 8 * c) = o; }
    LDS_WAIT();
}

__device__ __forceinline__ void norm_row_bf16(const float* xrow, const float* gain, const float* scl, const float* sft, bf16* orow, int lane) {
    f32x4 v[4]; float s = 0.f;
#pragma unroll
    for (int j = 0; j < 4; ++j) { v[j] = *(const f32x4*)(xrow + 4 * lane + 256 * j); s += (v[j].x * v[j].x + v[j].y * v[j].y) + (v[j].z * v[j].z + v[j].w * v[j].w); }
    const float rstd = rsqrtf(wave_sum(s) * (1.f / D) + EPS);
#pragma unroll
    for (int j = 0; j < 4; ++j) { const int c = 4 * lane + 256 * j;
        const f32x4 g = *(const f32x4*)(gain + c), sc = *(const f32x4*)(scl + c), sh = *(const f32x4*)(sft + c);
        const f32x4 y = v[j] * rstd * g * (sc + 1.f) + sh;
        u32x2 o; o.x = pk2(y.x, y.y); o.y = pk2(y.z, y.w); *(u32x2*)(orow + c) = o; }
}

__device__ __forceinline__ void convert_tile(Frame& F, const float* src, int ldw, bf16* dst, int ldk, int k0, int rowA, int rowB) {
    LAS bf16* T = (LAS bf16*)F.lds;
    const int tid = F.tid, w = F.wave, lane = F.lane;
    f32x4 v[8];
#pragma unroll
    for (int j = 0; j < 8; ++j) v[j] = *(const f32x4*)(src + (size_t)(8 * w + j) * ldw + 4 * lane);
#pragma unroll
    for (int j = 0; j < 8; ++j) { u32x2 o; o.x = pk2(v[j].x, v[j].y); o.y = pk2(v[j].z, v[j].w); *(LAS u32x2*)(T + (8 * w + j) * 264 + ((4 * lane) ^ (w << 3))) = o; }
    __syncthreads();
#pragma unroll
    for (int j = 0; j < 4; ++j) { const int p = tid + NTHR * j, kc = p & 7, n = p >> 3; const LAS bf16* t = T + (8 * kc) * 264 + (n ^ (kc << 3));
        u32x4 o; o.x = (unsigned)t[0] | ((unsigned)t[264] << 16); o.y = (unsigned)t[2 * 264] | ((unsigned)t[3 * 264] << 16);
        o.z = (unsigned)t[4 * 264] | ((unsigned)t[5 * 264] << 16); o.w = (unsigned)t[6 * 264] | ((unsigned)t[7 * 264] << 16);
        const int row = n < 128 ? rowA + n : rowB + n - 128;
        *(u32x4*)(dst + (size_t)row * ldk + k0 + 8 * kc) = o; }
    __syncthreads();
}

__device__ __forceinline__ void phase_g0(Frame& F) {
    float* mod = (float*)(F.ws + WS_MOD);
    {
        LAS float* sc = (LAS float*)F.lds; LAS float* red = sc + 3072;
        for (int u = blockIdx.x; u < 192; u += F.G) {
            const int l = u / 96, n0 = (u % 96) * 64;
            for (int i = F.tid; i < 3072; i += NTHR) { const int r = i >> 10, k = i & 1023; const float c = r < 2 ? F_C(F)[r * 1024 + k] : F_CCTX(F)[k]; sc[i] = c / (1.f + __expf(-c)); }
            __syncthreads();
            const int col = F.tid & 63, kg = F.tid >> 6;
            const float* W = F.in[4] + (size_t)l * 1024 * 6144 + n0 + col;
            float a0 = 0.f, a1 = 0.f, a2 = 0.f;
#pragma unroll 8
            for (int k = kg * 128; k < kg * 128 + 128; ++k) { const float w = W[(size_t)k * 6144]; a0 += sc[k] * w; a1 += sc[1024 + k] * w; a2 += sc[2048 + k] * w; }
            red[(kg * 3 + 0) * 64 + col] = a0; red[(kg * 3 + 1) * 64 + col] = a1; red[(kg * 3 + 2) * 64 + col] = a2;
            __syncthreads();
            if (F.tid < 192) { const int r = F.tid >> 6, cc = F.tid & 63; float s = F.in[5][l * 6144 + n0 + cc];
#pragma unroll
                for (int q = 0; q < 8; ++q) s += red[(q * 3 + r) * 64 + cc];
                mod[(l * 3 + r) * 6144 + n0 + cc] = s; }
            __syncthreads();
        }
    }
    {
        constexpr int PER_L = 16 * (13 + 4 + 1);
        for (int it = blockIdx.x; it < 2 * PER_L; it += F.G) {
            const int l = it / PER_L; int r = it % PER_L; const int kb = r / 18; r %= 18;
            if (r < 13) convert_tile(F, F.in[8] + (size_t)l * 1024 * INW + (size_t)(64 * kb) * INW + 256 * r, INW, (bf16*)(F.ws + WS_WIN) + (size_t)l * INW * 1024, 1024, 64 * kb, 256 * r, 256 * r + 128);
            else if (r < 17) convert_tile(F, F.in[18] + (size_t)l * 1024 * 1024 + (size_t)(64 * kb) * 1024 + 256 * (r - 13), 1024, (bf16*)(F.ws + WS_WOUT) + (size_t)l * 1024 * 1024, 1024, 64 * kb, 256 * (r - 13), 256 * (r - 13) + 128);
            else convert_tile(F, F.in[19] + (size_t)l * 1024 * 256 + (size_t)(64 * kb) * 256, 256, (bf16*)(F.ws + WS_WR) + (size_t)l * 256 * 1024, 1024, 64 * kb, 0, 128);
        }
    }
    {
        const int gt = blockIdx.x * NTHR + F.tid, NGT = F.G * NTHR;
        bf16* Fc = (bf16*)(F.ws + WS_TAB + TAB_FC); bf16* Fs = (bf16*)(F.ws + WS_TAB + TAB_FS); bf16* CS = (bf16*)(F.ws + WS_TAB + TAB_CS);
        for (int i = gt; i < 128 * 128; i += NGT) { const int k = i >> 7, n = i & 127; float s, c; sincospif((float)((k * n) & 127) * (1.f / 64.f), &s, &c); Fc[i] = f2bf(c); Fs[i] = f2bf(s); }
        for (int i = gt; i < 64 * 128; i += NGT) { const int m = i >> 7, kap = i & 127; float s, c; sincospif((float)((m * (kap & 63)) & 63) * (1.f / 32.f), &s, &c); CS[i] = f2bf(kap < 64 ? c : s); }
        bf16* C256 = (bf16*)(F.ws + WS_TAB + TAB_C256); bf16* S256 = (bf16*)(F.ws + WS_TAB + TAB_S256);
        for (int i = gt; i < 256 * 256; i += NGT) { const int k = i >> 8, n = i & 255; float sn, cs; sincospif((float)((k * n) & 255) * (1.f / 128.f), &sn, &cs); C256[i] = f2bf(cs); S256[i] = f2bf(-sn); }
        float* lb = (float*)(F.ws + WS_TAB + TAB_LB);
        for (int i = gt; i < 1024; i += NGT) { const int l = i >> 9, ch = i & 511; lb[i] = l == 0 ? 0.f : sigmoidf_(F.in[9][512 + ch] - F.in[9][ch]); }
        bf16* lw = (bf16*)(F.ws + WS_TAB + TAB_LRUW);
        for (int i = gt; i < 2 * 2 * 4 * 128 * 64; i += NGT) {
            const int k = i & 63, n = (i >> 6) & 127, ldh = i >> 13;
            const float v = n < 64 ? F.in[13][(size_t)ldh * 4096 + k * 64 + n] : F.in[15][(size_t)ldh * 4096 + k * 64 + (n - 64)];
            lw[i] = f2bf(v); }
        float* cl = (float*)(F.ws + WS_TAB + TAB_LRUCL);
        for (int i = gt; i < 1024; i += NGT) { const float lam = F.in[17][i]; const float sp = lam > 15.f ? __expf(-lam) : log1pf(__expf(-lam)); cl[i] = 8.f * sp; }
    }
}

__device__ __forceinline__ void hprep_rows(Frame& F, int l, const float* xlat, const float* xctx, int nrows, int voff_sh, int voff_sc, const float* gain) {
    const float* mod = (const float*)(F.ws + WS_MOD) + (size_t)l * 3 * 6144;
    bf16* HB = (bf16*)(F.ws + WS_HB);
    const int gw = blockIdx.x * NWAVES + F.wave, NGW = F.G * NWAVES;
    for (int m = gw; m < nrows; m += NGW) {
        const float* xr = m < TL ? xlat + (size_t)m * D : xctx + (size_t)(m - TL) * D; const int r = m < TL ? (m >> 14) : 2;
        norm_row_bf16(xr, gain, mod + r * 6144 + voff_sc, mod + r * 6144 + voff_sh, HB + (size_t)m * D, F.lane);
    }
}

__device__ __forceinline__ void cv_tile(Frame& F, int it_all) {
    const int l = it_all >= CV_TILES ? 1 : 0, it = it_all - l * CV_TILES;
    unsigned char* wb = F.ws + (l ? WS_WEXP1 : WS_WEXP);
    bf16* WGU = (bf16*)wb; bf16* WD = (bf16*)(wb + WEXP_GU_BYTES);
    const int e = it / 48, t = it % 48;
    if (t < 32) {
        const int mat = t >> 4, kb = t & 15;
        const float* src = (e < 256 ? (mat == 0 ? F.in[21] : F.in[22]) + ((size_t)l * 256 + e) * 1024 * 256 : (mat == 0 ? F.in[24] : F.in[25]) + (size_t)l * 1024 * 256) + (size_t)(64 * kb) * 256;
        convert_tile(F, src, 256, WGU, 1024, 64 * kb, e * 512 + mat * 128, e * 512 + 256 + mat * 128);
    } else {
        const int kb = (t - 32) >> 2, nb = (t - 32) & 3;
        const float* src = (e < 256 ? F.in[23] + ((size_t)l * 256 + e) * 256 * 1024 : F.in[26] + (size_t)l * 256 * 1024) + (size_t)(64 * kb) * 1024 + 256 * nb;
        convert_tile(F, src, 1024, WD, 256, 64 * kb, e * 1024 + 256 * nb, e * 1024 + 256 * nb + 128);
    }
}
__device__ __forceinline__ int cv_pull(Frame& F) {
    volatile LAS int* slot = (volatile LAS int*)(F.lds + MISC_OFF) + 16;
    if (F.tid == 0) { const unsigned t = __hip_atomic_fetch_add((unsigned*)(F.ws + WS_CTL) + CW_CVQ, 1u, __ATOMIC_RELAXED, __HIP_MEMORY_SCOPE_AGENT); slot[0] = t < (unsigned)(2 * CV_TILES) ? (int)t : -1; }
    __syncthreads(); const int t = slot[0]; __syncthreads(); return t;
}
__device__ __forceinline__ void convert_experts(Frame& F, int l) {
    for (;;) { const int t = cv_pull(F); if (t < 0) break; cv_tile(F, t); if (t >= (l + 1) * CV_TILES) break; }
}

__device__ __forceinline__ void xcd_barrier_cv(const XcdBarrier& b, Frame& F) {
    volatile LAS unsigned* st = (volatile LAS unsigned*)(F.lds + MISC_OFF) + 20;
    asm volatile("s_waitcnt vmcnt(0)" ::: "memory");
    __syncthreads();
    if (threadIdx.x == 0) {
        unsigned* bar = b.bar;
        __builtin_amdgcn_s_waitcnt(0);
        unsigned nloc = b.st[0], nx = b.st[1];
        if (nloc == 0u) { xcd_barrier_complete(bar, b.x, nloc, nx); b.st[0] = nloc; b.st[1] = nx; }
        const unsigned old = xb_add(&bar[XB_XSUB(b.x)], 1u);
        const unsigned gen = old / nloc;
        if (old + 1u == (gen + 1u) * nloc) {
            __builtin_amdgcn_fence(__ATOMIC_RELEASE, "agent");
            asm volatile("s_waitcnt vmcnt(0)" ::: "memory");
            const unsigned og = xb_add(&bar[XB_TOP], 1u);
            const unsigned tg = og / nx;
            if (og + 1u == (tg + 1u) * nx) xb_add(&bar[XB_TOPGEN], 1u);
            else XB_SPIN(xb_ld(&bar[XB_TOPGEN]) == tg, bar);
            __builtin_amdgcn_fence(__ATOMIC_ACQUIRE, "agent");
            xb_add(&bar[XB_XGEN(b.x)], 1u);
            asm volatile("s_waitcnt vmcnt(0)" ::: "memory");
            st[0] = 0u;
        } else { st[0] = 1u; st[1] = gen; }
        st[2] = 0u;
    }
    __syncthreads();
    if (st[0]) {
        unsigned spins = 0u;
        for (;;) {
            int tile = -1;
            if (threadIdx.x == 0) {
                unsigned rel = xb_ld(&b.bar[XB_XGEN(b.x)]) != st[1] ? 1u : 0u;
                if (!rel && (++spins & 255u) == 0u) { if (xb_ld(&b.bar[XB_TMO])) rel = 1u; else if (spins > XB_SPIN_CAP) { atomicAdd(&b.bar[XB_TMO], 1u); rel = 1u; } }
                st[2] = rel;
                if (!rel && st[3] == 0u) { const unsigned t = __hip_atomic_fetch_add((unsigned*)(F.ws + WS_CTL) + CW_CVQ, 1u, __ATOMIC_RELAXED, __HIP_MEMORY_SCOPE_AGENT);
                    if (t < (unsigned)(2 * CV_TILES)) tile = (int)t; else st[3] = 1u; }
                st[4] = (unsigned)tile;
            }
            __syncthreads();
            const unsigned rel = st[2]; tile = (int)st[4];
            __syncthreads();
            if (rel) break;
            if (tile >= 0) cv_tile(F, tile); else __builtin_amdgcn_s_sleep(2);
        }
        if (threadIdx.x == 0) {
            st[3] = 0u;
            __builtin_amdgcn_fence(__ATOMIC_ACQUIRE, "agent");
            asm volatile("s_waitcnt vmcnt(0)" ::: "memory");
        }
    }
    __syncthreads();
}

constexpr int QS = 144, TS = 80;
constexpr int HG_QT = 0, HG_KT = 18432, HG_KTT = 36864, HG_VT = 57344, HG_SMT = 77824, HG_PM = 114688, HG_TOT = 124928, HG_BMID = 126976, HG_BEND = 127488, HG_RSS = 128000, HG_VR = 132096;
static_assert(HG_VR + 64 * QS * 2 <= MISC_OFF, "HGRN2 LDS map");

__device__ __forceinline__ float fast_rcp(float x) { return __builtin_amdgcn_rcpf(x); }
__device__ __forceinline__ f32x4 hg_ld4(const bf16* p) { const u32x2 v = *(const u32x2*)p;
    return (f32x4){__builtin_bit_cast(float, v.x << 16), __builtin_bit_cast(float, v.x & 0xffff0000u), __builtin_bit_cast(float, v.y << 16), __builtin_bit_cast(float, v.y & 0xffff0000u)}; }


template <int VAR>
__device__ __forceinline__ void hg_chunk_c1(Frame& F, const bf16* Zc, bf16* gq, bf16* gk, float* hv, const bf16* nz, const bf16* nq, const bool has_next, u32x4 (&zq)[4], int h, int rev, const float* lbp, f32x4 (&S)[8], float& dtot) {
    LAS bf16* Qt = (LAS bf16*)(F.lds + HG_QT); LAS bf16* Kt = (LAS bf16*)(F.lds + HG_KT); LAS bf16* KtT = (LAS bf16*)(F.lds + HG_KTT);
    LAS bf16* VT = (LAS bf16*)(F.lds + HG_VT); LAS bf16* Vr = (LAS bf16*)(F.lds + HG_VR);
    LAS float* tot = (LAS float*)(F.lds + HG_TOT); LAS float* bmid = (LAS float*)(F.lds + HG_BMID); LAS float* bend = (LAS float*)(F.lds + HG_BEND);
    LAS float* ebuf = (LAS float*)(F.lds + HG_RSS);
    const int tid = F.tid, lane = F.lane, w = F.wave, li = lane & 15, lq = lane >> 4;
    u32x4 vv[2];
#pragma unroll
    for (int j = 0; j < 2; ++j) { const int p = tid + NTHR * j, row = p >> 4, c16 = p & 15;
        vv[j] = *(const u32x4*)(Zc + (size_t)row * INW + ZV + h * 128 + 8 * c16);
        *(LAS u32x4*)(Kt + row * QS + 8 * c16) = zq[j]; *(LAS u32x4*)(Qt + row * QS + 8 * c16) = zq[2 + j]; }
    LDS_BARRIER();
    const int ch = tid & 127, tq = tid >> 7;
    const float lbv = lbp[h * 128 + ch], oml = 1.f - lbv;
    float cb[16];
#pragma unroll
    for (int i = 0; i < 16; ++i) { float z = bf2f(Kt[(16 * tq + i) * QS + ch]); z = fminf(fmaxf(z, -30.f), 30.f);
        if (VAR & 1) cb[i] = z * -0.01f; else { const float e = __expf(-z), sg = fast_rcp(1.f + e); cb[i] = __logf(lbv + oml * sg);
            Kt[(16 * tq + i) * QS + ch] = f2bf(oml * e * sg); } }
    float run = 0.f;
    if (!rev) {
#pragma unroll
        for (int i = 0; i < 16; ++i) { run += cb[i]; cb[i] = run; }
    } else {
#pragma unroll
        for (int i = 15; i >= 0; --i) { run += cb[i]; cb[i] = run; }
    }
    tot[tq * 128 + ch] = run;
#pragma unroll
    for (int j = 0; j < 2; ++j) { const int p = tid + NTHR * j, row = p >> 4, c16 = p & 15; *(LAS u32x4*)(Vr + row * QS + 8 * c16) = vv[j]; }
    LDS_BARRIER();
    {
        const float t0 = tot[ch], t1 = tot[128 + ch], t2 = tot[256 + ch], t3 = tot[384 + ch];
        const float off = !rev ? ((tq > 0 ? t0 : 0.f) + (tq > 1 ? t1 : 0.f) + (tq > 2 ? t2 : 0.f)) : ((tq < 3 ? t3 : 0.f) + (tq < 2 ? t2 : 0.f) + (tq < 1 ? t1 : 0.f));
#pragma unroll
        for (int i = 0; i < 16; ++i) cb[i] += off;
        const float total = (t0 + t1) + (t2 + t3);
        if (tq == 2) bmid[ch] = cb[0];
        if (tq == 0) { bend[ch] = total; dtot += total; }
    }
    LDS_BARRIER();
    if (!(VAR & 2)) {
        const float bm = bmid[ch];
        unsigned kp[8], vp[8];
#pragma unroll
        for (int i = 0; i < 16; ++i) { const float d = fminf(fmaxf(cb[i] - bm, -80.f), 80.f);
            const float ed = __expf(d);
            Qt[(16 * tq + i) * QS + ch] = f2bf(bf2f(Qt[(16 * tq + i) * QS + ch]) * ed);
            const unsigned kb = f2bfu(bf2f(Kt[(16 * tq + i) * QS + ch]) * fast_rcp(ed)); Kt[(16 * tq + i) * QS + ch] = (bf16)kb;
            const unsigned vb = Vr[(16 * tq + i) * QS + ch];
            if (i & 1) { kp[i >> 1] |= kb << 16; vp[i >> 1] |= vb << 16; } else { kp[i >> 1] = kb; vp[i >> 1] = vb; } }
        *(LAS u32x4*)(KtT + ch * TS + 16 * tq) = (u32x4){kp[0], kp[1], kp[2], kp[3]};
        *(LAS u32x4*)(KtT + ch * TS + 16 * tq + 8) = (u32x4){kp[4], kp[5], kp[6], kp[7]};
        *(LAS u32x4*)(VT + ch * TS + 16 * tq) = (u32x4){vp[0], vp[1], vp[2], vp[3]};
        *(LAS u32x4*)(VT + ch * TS + 16 * tq + 8) = (u32x4){vp[4], vp[5], vp[6], vp[7]};
        if (tid < 128) { const float bmv = bmid[tid], e1 = __expf(bmv), e2 = __expf(bend[tid] - bmv); hv[tid] = e1; hv[128 + tid] = e2; ebuf[tid] = e1; ebuf[128 + tid] = e2; }
    }
    if (has_next) {
#pragma unroll
        for (int j = 0; j < 2; ++j) { const int p = tid + NTHR * j, row = p >> 4, c16 = p & 15;
            zq[j] = *(const u32x4*)(nz + (size_t)row * INW + 8 * c16); zq[2 + j] = *(const u32x4*)(nq + (size_t)row * INW + 8 * c16); }
    }
    LDS_BARRIER();
    if (!(VAR & 4))
#pragma unroll
    for (int j = 0; j < 2; ++j) { const int p = tid + NTHR * j, row = p >> 4, c16 = p & 15;
        *(u32x4*)(gq + (size_t)row * 512 + 8 * c16) = *(const LAS u32x4*)(Qt + row * QS + 8 * c16);
        *(u32x4*)(gk + (size_t)row * 512 + 8 * c16) = *(const LAS u32x4*)(Kt + row * QS + 8 * c16); }
    if (!(VAR & 8)) {
#pragma unroll
    for (int i = 0; i < 8; ++i) S[i] = S[i] * *(const LAS f32x4*)(ebuf + 16 * i + 4 * lq);
    bf16x8 bv[2];
#pragma unroll
    for (int ks = 0; ks < 2; ++ks) bv[ks] = *(const LAS bf16x8*)(VT + (16 * w + li) * TS + 32 * ks + 8 * lq);
    bf16x8 ak[2][2];
#pragma unroll
    for (int ks = 0; ks < 2; ++ks) ak[0][ks] = *(const LAS bf16x8*)(KtT + li * TS + 32 * ks + 8 * lq);
#pragma unroll
    for (int i = 0; i < 8; ++i) { const int cb_ = i & 1;
        if (i < 7) {
#pragma unroll
            for (int ks = 0; ks < 2; ++ks) ak[cb_ ^ 1][ks] = *(const LAS bf16x8*)(KtT + (16 * (i + 1) + li) * TS + 32 * ks + 8 * lq); }
        __builtin_amdgcn_sched_barrier(0);
#pragma unroll
        for (int ks = 0; ks < 2; ++ks) S[i] = MFMA16(ak[cb_][ks], bv[ks], S[i]);
        S[i] = S[i] * *(const LAS f32x4*)(ebuf + 128 + 16 * i + 4 * lq); }
    }
    LDS_BARRIER();
}

struct HgPtrs { const bf16* q; const bf16* k; const bf16* v; const float* hv; };
__device__ __forceinline__ void hg_load6(const HgPtrs& P, int tid, u32x4 (&pre)[7]) {
    pre[6] = *(const u32x4*)(P.hv + 4 * (tid & 63));
#pragma unroll
    for (int j = 0; j < 2; ++j) { const int p = tid + NTHR * j, row = p >> 4, c16 = p & 15;
        pre[j] = *(const u32x4*)(P.q + (size_t)row * 512 + 8 * c16); pre[2 + j] = *(const u32x4*)(P.k + (size_t)row * 512 + 8 * c16); pre[4 + j] = *(const u32x4*)(P.v + (size_t)row * INW + 8 * c16); }
}
template <int VAR>
__device__ __forceinline__ void hg_chunk_c3(Frame& F, const u32x4 (&cur)[7], int rev, f32x4 (&S)[8], f32x4 (&O)[4], bool do_state, const bf16* Snext) {
    LAS bf16* Qt = (LAS bf16*)(F.lds + HG_QT); LAS bf16* Kt = (LAS bf16*)(F.lds + HG_KT); LAS bf16* KtT = (LAS bf16*)(F.lds + HG_KTT);
    LAS bf16* VT = (LAS bf16*)(F.lds + HG_VT); LAS bf16* SmT = (LAS bf16*)(F.lds + HG_SMT); LAS bf16* Pm = (LAS bf16*)(F.lds + HG_PM); LAS bf16* Vr = (LAS bf16*)(F.lds + HG_VR);
    const int tid = F.tid, lane = F.lane, w = F.wave, li = lane & 15, lq = lane >> 4;
#pragma unroll
    for (int j = 0; j < 2; ++j) { const int p = tid + NTHR * j, row = p >> 4, c16 = p & 15;
        *(LAS u32x4*)(Qt + row * QS + 8 * c16) = cur[j]; *(LAS u32x4*)(Kt + row * QS + 8 * c16) = cur[2 + j]; *(LAS u32x4*)(Vr + row * QS + 8 * c16) = cur[4 + j]; }
    LAS float* ebuf = (LAS float*)(F.lds + HG_BMID);
    if (tid < 64) *(LAS u32x4*)(ebuf + 4 * tid) = cur[6];
    LDS_BARRIER();
    if (!(VAR & 2)) {
        const int ch = tid & 127, tq = tid >> 7; unsigned kp[8], vp[8];
#pragma unroll
        for (int i = 0; i < 16; ++i) { const unsigned vb = Vr[(16 * tq + i) * QS + ch], kb = do_state ? (unsigned)Kt[(16 * tq + i) * QS + ch] : 0u;
            if (i & 1) { kp[i >> 1] |= kb << 16; vp[i >> 1] |= vb << 16; } else { kp[i >> 1] = kb; vp[i >> 1] = vb; } }
        *(LAS u32x4*)(VT + ch * TS + 16 * tq) = (u32x4){vp[0], vp[1], vp[2], vp[3]};
        *(LAS u32x4*)(VT + ch * TS + 16 * tq + 8) = (u32x4){vp[4], vp[5], vp[6], vp[7]};
        if (do_state) { *(LAS u32x4*)(KtT + ch * TS + 16 * tq) = (u32x4){kp[0], kp[1], kp[2], kp[3]}; *(LAS u32x4*)(KtT + ch * TS + 16 * tq + 8) = (u32x4){kp[4], kp[5], kp[6], kp[7]}; }
    }
#pragma unroll
    for (int i = 0; i < 8; ++i) { S[i] = S[i] * *(const LAS f32x4*)(ebuf + 16 * i + 4 * lq);
        u32x2 o; o.x = pk2(S[i].x, S[i].y); o.y = pk2(S[i].z, S[i].w); *(LAS u32x2*)(SmT + (16 * w + li) * QS + 16 * i + 4 * lq) = o; }
    if (Snext) {
#pragma unroll
        for (int i = 0; i < 8; ++i) S[i] = hg_ld4(Snext + (16 * w + li) * 128 + 16 * i + 4 * lq);
    }
    if (!(VAR & 4)) {
        const int tt = w >> 1;
        bf16x8 aq[4];
#pragma unroll
        for (int ks = 0; ks < 4; ++ks) aq[ks] = *(const LAS bf16x8*)(Qt + (16 * tt + li) * QS + 32 * ks + 8 * lq);
#pragma unroll
        for (int sj = 0; sj < 2; ++sj) { const int st = 2 * (w & 1) + sj; f32x4 acc = {0.f, 0.f, 0.f, 0.f};
#pragma unroll
            for (int ks = 0; ks < 4; ++ks) acc = MFMA16(aq[ks], *(const LAS bf16x8*)(Kt + (16 * st + li) * QS + 32 * ks + 8 * lq), acc);
#pragma unroll
            for (int r = 0; r < 4; ++r) { const int t = 16 * tt + 4 * lq + r, s = 16 * st + li; const bool keep = rev ? (s >= t) : (s <= t);
                Pm[t * TS + s] = f2bf(keep ? acc[r] : 0.f); } }
    }
    LDS_BARRIER();
    if (!(VAR & 8)) {
    bf16x8 bs[4], bv[2];
#pragma unroll
    for (int ks = 0; ks < 4; ++ks) bs[ks] = *(const LAS bf16x8*)(SmT + (16 * w + li) * QS + 32 * ks + 8 * lq);
#pragma unroll
    for (int ks = 0; ks < 2; ++ks) bv[ks] = *(const LAS bf16x8*)(VT + (16 * w + li) * TS + 32 * ks + 8 * lq);
    {
        bf16x8 aq[2][4], ap[2][2];
#pragma unroll
        for (int ks = 0; ks < 4; ++ks) aq[0][ks] = *(const LAS bf16x8*)(Qt + li * QS + 32 * ks + 8 * lq);
#pragma unroll
        for (int ks = 0; ks < 2; ++ks) ap[0][ks] = *(const LAS bf16x8*)(Pm + li * TS + 32 * ks + 8 * lq);
#pragma unroll
        for (int mt = 0; mt < 4; ++mt) { const int cb_ = mt & 1;
            if (mt < 3) {
#pragma unroll
                for (int ks = 0; ks < 4; ++ks) aq[cb_ ^ 1][ks] = *(const LAS bf16x8*)(Qt + (16 * (mt + 1) + li) * QS + 32 * ks + 8 * lq);
#pragma unroll
                for (int ks = 0; ks < 2; ++ks) ap[cb_ ^ 1][ks] = *(const LAS bf16x8*)(Pm + (16 * (mt + 1) + li) * TS + 32 * ks + 8 * lq); }
            __builtin_amdgcn_sched_barrier(0);
#pragma unroll
            for (int ks = 0; ks < 4; ++ks) O[mt] = MFMA16(aq[cb_][ks], bs[ks], O[mt]);
#pragma unroll
            for (int ks = 0; ks < 2; ++ks) O[mt] = MFMA16(ap[cb_][ks], bv[ks], O[mt]);
        }
    }
    __builtin_amdgcn_sched_barrier(0);
    if (do_state) {
        bf16x8 ak[2][2];
#pragma unroll
        for (int ks = 0; ks < 2; ++ks) ak[0][ks] = *(const LAS bf16x8*)(KtT + li * TS + 32 * ks + 8 * lq);
#pragma unroll
        for (int i = 0; i < 8; ++i) { const int cb_ = i & 1;
            if (i < 7) {
#pragma unroll
                for (int ks = 0; ks < 2; ++ks) ak[cb_ ^ 1][ks] = *(const LAS bf16x8*)(KtT + (16 * (i + 1) + li) * TS + 32 * ks + 8 * lq); }
            __builtin_amdgcn_sched_barrier(0);
#pragma unroll
            for (int ks = 0; ks < 2; ++ks) S[i] = MFMA16(ak[cb_][ks], bv[ks], S[i]);
            S[i] = S[i] * *(const LAS f32x4*)(ebuf + 128 + 16 * i + 4 * lq); }
    }
    }
    LDS_BARRIER();
}

__device__ __forceinline__ int hg_rowbase(int b, int slot) { return slot < 2 ? TL + b * CTXL + slot * 128 : b * SEQ + (slot - 2) * 128; }

template <int VAR>
__device__ __forceinline__ void hgrn2_c1(Frame& F, int l, int u0, int nunits, int G) {
    const bf16* Z = (const bf16*)(F.ws + WS_Z); const float* lbp = (const float*)(F.ws + WS_TAB + TAB_LB) + l * 512;
    bf16* GQ = (bf16*)(F.ws + WS_GE); bf16* GK = (bf16*)(F.ws + WS_GK); float* HV = (float*)(F.ws + WS_HV);
    if (u0 >= nunits) return;
    u32x4 zq[4];
    {   const int chain = u0 / HG_SLOTS, slot = u0 % HG_SLOTS, dir = chain & 1, b = chain >> 3, h = (chain >> 1) & 3;
        const bf16* zp = Z + (size_t)(hg_rowbase(b, slot) + (dir ? 64 : 0)) * INW;
#pragma unroll
        for (int j = 0; j < 2; ++j) { const int p = F.tid + NTHR * j, row = p >> 4, c16 = p & 15;
            zq[j] = *(const u32x4*)(zp + (size_t)row * INW + (dir ? ZFB : ZFF) + h * 128 + 8 * c16); zq[2 + j] = *(const u32x4*)(zp + (size_t)row * INW + ZQ + h * 128 + 8 * c16); } }
#pragma unroll 1
    for (int u = u0; u < nunits; u += G) {
        const int chain = u / HG_SLOTS, slot = u % HG_SLOTS, dir = chain & 1, b = chain >> 3, h = (chain >> 1) & 3;
        const int row0 = hg_rowbase(b, slot), zcol = (dir ? ZFB : ZFF) + h * 128;
        const int un = u + G; const bool has_nu = un < nunits;
        const int nchain = un / HG_SLOTS, nslot = un % HG_SLOTS, ndir = nchain & 1, nb = nchain >> 3, nh = (nchain >> 1) & 3;
        const bf16* nup = Z + (size_t)(hg_rowbase(nb, nslot) + (ndir ? 64 : 0)) * INW;
        f32x4 S[8]; float dtot = 0.f;
#pragma unroll
        for (int i = 0; i < 8; ++i) S[i] = (f32x4){0.f, 0.f, 0.f, 0.f};
#pragma unroll 1
        for (int step = 0; step < 2; ++step) { const int c = dir ? 1 - step : step; const size_t rowc = (size_t)(row0 + 64 * c);
            const bf16* nrow = step == 0 ? Z + (size_t)(row0 + 64 * (1 - c)) * INW : nup;
            const bf16* nz = nrow + (step == 0 ? zcol : (ndir ? ZFB : ZFF) + nh * 128); const bf16* nq = nrow + ZQ + (step == 0 ? h : nh) * 128;
            hg_chunk_c1<VAR>(F, Z + rowc * INW, GQ + ((size_t)dir * TT + rowc) * 512 + h * 128, GK + ((size_t)dir * TT + rowc) * 512 + h * 128,
                        HV + ((size_t)chain * (2 * HG_SLOTS) + slot * 2 + c) * 256, nz, nq, step == 0 || has_nu, zq, h, dir, lbp, S, dtot); }
        bf16* HS = (bf16*)(F.ws + WS_HS) + ((size_t)chain * HG_SLOTS + slot) * 16384;
        const int li = F.lane & 15, lq = F.lane >> 4, v = 16 * F.wave + li;
#pragma unroll
        for (int i = 0; i < 8; ++i) { u32x2 o; o.x = pk2(S[i].x, S[i].y); o.y = pk2(S[i].z, S[i].w); *(u32x2*)(HS + v * 128 + 16 * i + 4 * lq) = o; }
        if (F.tid < 128) ((float*)(F.ws + WS_HD))[((size_t)chain * HG_SLOTS + slot) * 128 + F.tid] = __expf(dtot);
    }
}

__device__ __forceinline__ void hgrn2_c2(Frame& F) {
    bf16* HS = (bf16*)(F.ws + WS_HS); const float* HD = (const float*)(F.ws + WS_HD);
    for (int task = blockIdx.x * NTHR + F.tid; task < 16 * 8192; task += F.G * NTHR) {
        const int chain = task >> 13, e2 = task & 8191, dir = chain & 1, ch2 = (e2 & 63) * 2;
        f32x2 run = {0.f, 0.f};
#pragma unroll 5
        for (int k = 0; k < HG_SLOTS; ++k) {
            const int slot = dir ? (k < 2 ? 1 - k : 131 - k) : k;
            unsigned* p = (unsigned*)(HS + ((size_t)chain * HG_SLOTS + slot) * 16384 + e2 * 2);
            const unsigned t2 = *p; const f32x2 tmp = {__builtin_bit_cast(float, t2 << 16), __builtin_bit_cast(float, t2 & 0xffff0000u)}, d = *(const f32x2*)(HD + ((size_t)chain * HG_SLOTS + slot) * 128 + ch2);
            *p = pk2(run.x, run.y); run = d * run + tmp;
        }
    }
}

template <int VAR>
__device__ __forceinline__ void hgrn2_c3(Frame& F, int l, int bh, int slot) {
    const int b = bh >> 2, h = bh & 3;
    const bf16* Z = (const bf16*)(F.ws + WS_Z);
    const bf16* GQ = (const bf16*)(F.ws + WS_GE); const bf16* GK = (const bf16*)(F.ws + WS_GK); const float* HV = (const float*)(F.ws + WS_HV);
    bf16* MIX = (bf16*)(F.ws + WS_MIX);
    const int row0 = hg_rowbase(b, slot);
    const int tid = F.tid, lane = F.lane, w = F.wave, li = lane & 15, lq = lane >> 4, v = 16 * w + li;
    u32x4 pa[7], pb[7];
    const float* HVf = HV + ((size_t)(bh * 2 + 0) * (2 * HG_SLOTS) + slot * 2) * 256; const float* HVb = HV + ((size_t)(bh * 2 + 1) * (2 * HG_SLOTS) + slot * 2) * 256;
    {   const size_t r0 = (size_t)row0, r1 = (size_t)(row0 + 64);
        HgPtrs P0{GQ + r0 * 512 + h * 128, GK + r0 * 512 + h * 128, Z + r0 * INW + ZV + h * 128, HVf};
        HgPtrs P1{GQ + r1 * 512 + h * 128, GK + r1 * 512 + h * 128, Z + r1 * INW + ZV + h * 128, HVf + 256};
        hg_load6(P0, tid, pa); hg_load6(P1, tid, pb); }
    if (tid < 32) *(LAS f32x4*)((LAS float*)(F.lds + HG_RSS) + 4 * tid) = *(const f32x4*)(F.in[10] + l * 128 + 4 * tid);
    f32x4 S[8];
    const bf16* HSb = (const bf16*)(F.ws + WS_HS) + ((size_t)(bh * 2 + 1) * HG_SLOTS + slot) * 16384;
    {   const bf16* HSf = (const bf16*)(F.ws + WS_HS) + ((size_t)(bh * 2 + 0) * HG_SLOTS + slot) * 16384;
#pragma unroll
        for (int i = 0; i < 8; ++i) S[i] = hg_ld4(HSf + v * 128 + 16 * i + 4 * lq); }
    f32x4 O[2][4];
#pragma unroll
    for (int c = 0; c < 2; ++c)
#pragma unroll
        for (int mt = 0; mt < 4; ++mt) O[c][mt] = (f32x4){0.f, 0.f, 0.f, 0.f};
#pragma unroll 1
    for (int st = 0; st < 4; ++st) {
        const int dir = st >> 1, c = (st == 1 || st == 2) ? 1 : 0;
        u32x4 cur[7];
#pragma unroll
        for (int j = 0; j < 7; ++j) { cur[j] = pa[j]; pa[j] = pb[j]; }
        if ((VAR & 1)) { } else if (st < 2) {
            const size_t rn = (size_t)(row0 + (st == 0 ? 64 : 0));
            HgPtrs Pn{GQ + ((size_t)TT + rn) * 512 + h * 128, GK + ((size_t)TT + rn) * 512 + h * 128, Z + rn * INW + ZV + h * 128, HVb + (st == 0 ? 256 : 0)};
            hg_load6(Pn, tid, pb);
        } else if (st == 2) {
#pragma unroll
            for (int j = 0; j < 4; ++j) pb[j] = *(const u32x4*)(Z + (size_t)(row0 + (tid >> 2)) * INW + ZG + h * 128 + 32 * (tid & 3) + 8 * j);
        }
        hg_chunk_c3<VAR>(F, cur, dir, S, O[0], (st & 1) == 0, st == 1 ? HSb : nullptr);
        if ((st & 1) == 0) {
#pragma unroll
            for (int mt = 0; mt < 4; ++mt) { const f32x4 t = O[0][mt]; O[0][mt] = O[1][mt]; O[1][mt] = t; }
        }
    }
    if (VAR & 16) { if (O[0][0][0] == 123.456f && O[1][3][2] == 1.f && S[0][0] == 2.f) MIX[0] = 1; return; }
    LAS float* Ot = (LAS float*)F.lds;
#pragma unroll
    for (int c = 0; c < 2; ++c)
#pragma unroll
        for (int mt = 0; mt < 4; ++mt)
#pragma unroll
            for (int r = 0; r < 4; ++r) Ot[(64 * c + 16 * mt + 4 * lq + r) * 132 + v] = O[c][mt][r];
    LDS_BARRIER();
    {   const int t = tid >> 2, v0 = 32 * (tid & 3);
        f32x4 x[8]; float ss = 0.f;
#pragma unroll
        for (int j = 0; j < 8; ++j) { x[j] = *(const LAS f32x4*)(Ot + t * 132 + v0 + 4 * j); ss += (x[j].x * x[j].x + x[j].y * x[j].y) + (x[j].z * x[j].z + x[j].w * x[j].w); }
        ss += __shfl_xor(ss, 1); ss += __shfl_xor(ss, 2);
        const float rs = rsqrtf(ss * (1.f / 128.f) + EPS);
        const LAS float* gain = (const LAS float*)(F.lds + HG_RSS) + v0;
#pragma unroll
        for (int k = 0; k < 4; ++k) { const u32x4 gq = pb[k]; const f32x4 g0 = *(const LAS f32x4*)(gain + 8 * k), g1 = *(const LAS f32x4*)(gain + 8 * k + 4);
            float o[8];
#pragma unroll
            for (int e = 0; e < 4; ++e) { const unsigned gw = e == 0 ? gq.x : e == 1 ? gq.y : e == 2 ? gq.z : gq.w;
                const float ga = __builtin_bit_cast(float, gw << 16), gb = __builtin_bit_cast(float, gw & 0xffff0000u);
                const float xa = e < 2 ? x[2 * k][2 * e] : x[2 * k + 1][2 * e - 4], xb = e < 2 ? x[2 * k][2 * e + 1] : x[2 * k + 1][2 * e - 3];
                const float na = e < 2 ? g0[2 * e] : g1[2 * e - 4], nb = e < 2 ? g0[2 * e + 1] : g1[2 * e - 3];
                o[2 * e] = xa * rs * na * ga * fast_rcp(1.f + __expf(-ga)); o[2 * e + 1] = xb * rs * nb * gb * fast_rcp(1.f + __expf(-gb)); }
            *(u32x4*)(MIX + (size_t)(row0 + t) * 1024 + h * 128 + v0 + 8 * k) = (u32x4){pk2(o[0], o[1]), pk2(o[2], o[3]), pk2(o[4], o[5]), pk2(o[6], o[7])}; }
    }
    LDS_BARRIER();
}

constexpr int LR_XR = 0, LR_XB = 35376, LR_HS = 69632;

__device__ __forceinline__ int lru_row(bool isctx, int b, int p) { return isctx ? TL + b * CTXL + p : b * SEQ + ((p & 255) << 6) + (p >> 8); }

template <bool FINAL>
__device__ __forceinline__ void lru_unit(Frame& F, int l, int b, int slot) {
    const bool isctx = slot < 4; const int p0 = isctx ? slot * 64 : (slot - 4) * 64, L = isctx ? CTXL : SEQ;
    const bf16* Z = (const bf16*)(F.ws + WS_Z);
    LAS bf16* Xr = (LAS bf16*)(F.lds + LR_XR); LAS bf16* XB = (LAS bf16*)(F.lds + LR_XB); LAS float* Hs = (LAS float*)(F.lds + LR_HS);
    const int tid = F.tid, lane = F.lane, w = F.wave, li = lane & 15, lq = lane >> 4;
    {   u32x4 v[5];
#pragma unroll
        for (int j = 0; j < 5; ++j) { const int idx = tid + NTHR * j, rr = idx >> 5, c16 = idx & 31, p = p0 - 2 + rr; v[j] = (u32x4){0u, 0u, 0u, 0u};
            if (idx < 67 * 32 && p >= 0 && p < L) v[j] = *(const u32x4*)(Z + (size_t)lru_row(isctx, b, p) * INW + ZXB + 8 * c16); }
#pragma unroll
        for (int j = 0; j < 5; ++j) { const int idx = tid + NTHR * j, rr = idx >> 5, c16 = idx & 31; if (idx < 67 * 32) *(LAS u32x4*)(Xr + rr * 264 + 8 * c16) = v[j]; } }
    LDS_BARRIER();
    {   const int ch = tid & 255, ph = tid >> 8;
        const float* cw = F.in[11] + (size_t)l * 4 * 256; const float w0 = cw[ch], w1 = cw[256 + ch], w2 = cw[512 + ch], w3 = cw[768 + ch], cb = F.in[12][l * 256 + ch];
        float x0 = bf2f(Xr[(32 * ph + 0) * 264 + ch]), x1 = bf2f(Xr[(32 * ph + 1) * 264 + ch]), x2 = bf2f(Xr[(32 * ph + 2) * 264 + ch]);
#pragma unroll 8
        for (int p = 32 * ph; p < 32 * ph + 32; ++p) { const float x3 = bf2f(Xr[(p + 3) * 264 + ch]);
            XB[p * 264 + ch] = f2bf(cb + w0 * x0 + w1 * x1 + w2 * x2 + w3 * x3); x0 = x1; x1 = x2; x2 = x3; } }
    LDS_BARRIER();
    {
        const int hh = w >> 1;
        float* LA = (float*)(F.ws + WS_LRUC); float* LH = (float*)(F.ws + WS_LRUC + LRUC_STRIDE); const float* LI = (const float*)(F.ws + WS_LRUC + 2 * LRUC_STRIDE);
        float hsum[4][4];
#pragma unroll 1
        for (int it = 0; it < 4; ++it) {
            const int jn = 2 * (w & 1) + (it >> 1), d = it & 1;
            const bf16* Wl = (const bf16*)(F.ws + WS_TAB + TAB_LRUW) + ((size_t)((l * 2 + d) * 4 + hh) * 128) * 64;
            const int ch = hh * 64 + 16 * jn + li;
            const size_t cidx = ((size_t)(b * 2 + d) * LR_SLOTS + slot) * 256;
            bf16x8 br[2], bi[2];
#pragma unroll
            for (int ks = 0; ks < 2; ++ks) { br[ks] = *(const bf16x8*)(Wl + (16 * jn + li) * 64 + 32 * ks + 8 * lq); bi[ks] = *(const bf16x8*)(Wl + (64 + 16 * jn + li) * 64 + 32 * ks + 8 * lq); }
            const float ba = F.in[14][(l * 2 + d) * 256 + ch], bx = F.in[16][(l * 2 + d) * 256 + ch], cl = ((const float*)(F.ws + WS_TAB + TAB_LRUCL))[(l * 2 + d) * 256 + ch];
            float C = FINAL ? LI[cidx + ch] : 0.f;
            f32x4 ar[4], ai[4];
#pragma unroll
            for (int mt = 0; mt < 4; ++mt) { ar[mt] = (f32x4){0.f, 0.f, 0.f, 0.f}; ai[mt] = (f32x4){0.f, 0.f, 0.f, 0.f};
#pragma unroll
                for (int ks = 0; ks < 2; ++ks) { const bf16x8 a = *(const LAS bf16x8*)(XB + (16 * mt + li) * 264 + hh * 64 + 32 * ks + 8 * lq);
                    ar[mt] = MFMA16(a, br[ks], ar[mt]); ai[mt] = MFMA16(a, bi[ks], ai[mt]); } }
            float PA[4][4], PB[4][4];
#pragma unroll
            for (int mt = 0; mt < 4; ++mt)
#pragma unroll
                for (int r = 0; r < 4; ++r) { const int p = 16 * mt + 4 * lq + r;
                    const float rg = sigmoidf_(ar[mt][r] + ba), ig = sigmoidf_(ai[mt][r] + bx), la = -cl * rg;
                    const float x2 = 2.f * la, e2 = __expf(x2);
                    const float om = x2 > -0.03f ? -x2 * (1.f + 0.5f * x2 * (1.f + x2 * (1.f / 3.f))) : 1.f - e2;
                    PA[mt][r] = __expf(la); PB[mt][r] = __builtin_amdgcn_sqrtf(fmaxf(om, 0.f)) * ig * bf2f(XB[p * 264 + ch]); }
            float TA[4], TB[4], EA[4], EB[4];
#pragma unroll
            for (int mt = 0; mt < 4; ++mt) {
                float pa = 1.f, pb = 0.f;
#pragma unroll
                for (int j = 0; j < 4; ++j) { const int r = d ? 3 - j : j; const float a = PA[mt][r], bb = PB[mt][r]; pb = a * pb + bb; pa = a * pa; PA[mt][r] = pa; PB[mt][r] = pb; }
                float ea = 1.f, eb = 0.f, ta = 1.f, tb = 0.f;
#pragma unroll
                for (int j = 0; j < 4; ++j) { const int k = d ? 3 - j : j; const float ga = __shfl(pa, li + 16 * k), gb = __shfl(pb, li + 16 * k);
                    const bool before = d ? (k > lq) : (k < lq);
                    if (before) { eb = ga * eb + gb; ea = ga * ea; }
                    tb = ga * tb + gb; ta = ga * ta; }
                EA[mt] = ea; EB[mt] = eb; TA[mt] = ta; TB[mt] = tb;
            }
            float Atot = 1.f, Cin[4];
#pragma unroll
            for (int j = 0; j < 4; ++j) { const int mt = d ? 3 - j : j; Cin[mt] = C; C = TA[mt] * C + TB[mt]; Atot *= TA[mt]; }
            if (!FINAL) { if (lq == 0) { LA[cidx + ch] = Atot; LH[cidx + ch] = C; } }
            else {
#pragma unroll
                for (int mt = 0; mt < 4; ++mt) { const float base = EA[mt] * Cin[mt] + EB[mt];
#pragma unroll
                    for (int r = 0; r < 4; ++r) { const float hv = PA[mt][r] * base + PB[mt][r];
                        if (d == 0) hsum[mt][r] = hv; else Hs[(16 * mt + 4 * lq + r) * 256 + ch] = hsum[mt][r] + hv; } }
            }
        }
    }
    if (FINAL) {
        LDS_BARRIER();
        bf16* MIX = (bf16*)(F.ws + WS_MIX);
        u32x4 yq[4];
#pragma unroll
        for (int j = 0; j < 4; ++j) { const int task = tid + NTHR * j, p = task >> 5, c8 = task & 31; yq[j] = *(const u32x4*)(Z + (size_t)lru_row(isctx, b, p0 + p) * INW + ZYB + 8 * c8); }
#pragma unroll
        for (int j = 0; j < 4; ++j) { const int task = tid + NTHR * j, p = task >> 5, c8 = task & 31;
            const f32x4 h0 = *(const LAS f32x4*)(Hs + p * 256 + 8 * c8), h1 = *(const LAS f32x4*)(Hs + p * 256 + 8 * c8 + 4);
            float o[8];
#pragma unroll
            for (int e = 0; e < 4; ++e) { const unsigned yw = yq[j][e];
                const float ya = __builtin_bit_cast(float, yw << 16), yb = __builtin_bit_cast(float, yw & 0xffff0000u);
                const float ua = 0.7978845608f * (ya + 0.044715f * ya * ya * ya), ub = 0.7978845608f * (yb + 0.044715f * yb * yb * yb);
                const float ta = 1.f - 2.f * fast_rcp(1.f + __expf(2.f * ua)), tb = 1.f - 2.f * fast_rcp(1.f + __expf(2.f * ub));
                const float ha = e < 2 ? h0[2 * e] : h1[2 * e - 4], hb = e < 2 ? h0[2 * e + 1] : h1[2 * e - 3];
                o[2 * e] = ha * 0.5f * ya * (1.f + ta); o[2 * e + 1] = hb * 0.5f * yb * (1.f + tb); }
            *(u32x4*)(MIX + (size_t)lru_row(isctx, b, p0 + p) * 1024 + 512 + 8 * c8) = (u32x4){pk2(o[0], o[1]), pk2(o[2], o[3]), pk2(o[4], o[5]), pk2(o[6], o[7])}; }
    }
    LDS_BARRIER();
}

__device__ __forceinline__ void lru_carry(Frame& F) {
    if (blockIdx.x >= 16 || F.wave != 0) return;
    const int chain = blockIdx.x * 64 + F.lane, bd = chain >> 8, ch = chain & 255, d = bd & 1;
    const float* LA = (const float*)(F.ws + WS_LRUC); const float* LH = (const float*)(F.ws + WS_LRUC + LRUC_STRIDE); float* LI = (float*)(F.ws + WS_LRUC + 2 * LRUC_STRIDE);
    float h = 0.f;
    for (int k0 = 0; k0 < LR_SLOTS; k0 += 20) {
        float a[20], hh[20];
#pragma unroll
        for (int j = 0; j < 20; ++j) { const int k = k0 + j, slot = d ? (k < 4 ? 3 - k : 263 - k) : k; const size_t idx = ((size_t)bd * LR_SLOTS + slot) * 256 + ch; a[j] = LA[idx]; hh[j] = LH[idx]; }
#pragma unroll
        for (int j = 0; j < 20; ++j) { const int k = k0 + j, slot = d ? (k < 4 ? 3 - k : 263 - k) : k; const size_t idx = ((size_t)bd * LR_SLOTS + slot) * 256 + ch; LI[idx] = h; h = a[j] * h + hh[j]; }
    }
}

__device__ __forceinline__ void fft_f1(Frame& F, int b, int n2) {
    const bf16* Z = (const bf16*)(F.ws + WS_Z);
    const bf16* Fc = (const bf16*)(F.ws + WS_TAB + TAB_FC); const bf16* Fs = (const bf16*)(F.ws + WS_TAB + TAB_FS);
    bf16* FAr = (bf16*)(F.ws + WS_FA); bf16* FAi = FAr + (size_t)2 * 128 * 128 * 256;
    LAS bf16* DT = (LAS bf16*)F.lds;
    const int tid = F.tid, lane = F.lane, w = F.wave, li = lane & 15, lq = lane >> 4;
    {   const int c = tid & 255, nh = tid >> 8;
        const bf16* src = Z + ((size_t)(b * SEQ + 128 * (64 * nh) + n2)) * INW + ZU + c;
#pragma unroll 2
        for (int j = 0; j < 8; ++j) { unsigned pk[4];
#pragma unroll
            for (int i = 0; i < 4; ++i) pk[i] = (unsigned)src[(size_t)(128 * (8 * j + 2 * i)) * INW] | ((unsigned)src[(size_t)(128 * (8 * j + 2 * i + 1)) * INW] << 16);
            *(LAS u32x4*)(DT + c * 136 + 64 * nh + 8 * j) = (u32x4){pk[0], pk[1], pk[2], pk[3]}; } }
    LDS_BARRIER();
    bf16x8 fc[4], fs[4];
#pragma unroll
    for (int ks = 0; ks < 4; ++ks) { fc[ks] = *(const bf16x8*)(Fc + (16 * w + li) * 128 + 32 * ks + 8 * lq); fs[ks] = *(const bf16x8*)(Fs + (16 * w + li) * 128 + 32 * ks + 8 * lq); }
    float ct[4], st[4];
#pragma unroll
    for (int r = 0; r < 4; ++r) { const int k1 = 16 * w + 4 * lq + r; sincospif((float)((n2 * k1) & 16383) * (1.f / 8192.f), &st[r], &ct[r]); }
#pragma unroll 2
    for (int nt = 0; nt < 16; ++nt) {
        f32x4 re = {0.f, 0.f, 0.f, 0.f}, im = {0.f, 0.f, 0.f, 0.f};
#pragma unroll
        for (int ks = 0; ks < 4; ++ks) { const bf16x8 bb = *(const LAS bf16x8*)(DT + (16 * nt + li) * 136 + 32 * ks + 8 * lq); re = MFMA16(fc[ks], bb, re); im = MFMA16(fs[ks], bb, im); }
#pragma unroll
        for (int r = 0; r < 4; ++r) { const int k1 = 16 * w + 4 * lq + r, c = 16 * nt + li;
            const float R = re[r], I = -im[r];
            const size_t o = ((size_t)(b * 128 + k1) * 128 + n2) * 256 + c;
            FAr[o] = f2bf(R * ct[r] + I * st[r]); FAi[o] = f2bf(I * ct[r] - R * st[r]); }
    }
    LDS_BARRIER();
}

__device__ __forceinline__ void fft_f2(Frame& F, int b, int k1, int chalf) {
    const bf16* Fc = (const bf16*)(F.ws + WS_TAB + TAB_FC); const bf16* Fs = (const bf16*)(F.ws + WS_TAB + TAB_FS); const bf16* CS = (const bf16*)(F.ws + WS_TAB + TAB_CS);
    const bf16* FAr = (const bf16*)(F.ws + WS_FA); const bf16* FAi = FAr + (size_t)2 * 128 * 128 * 256;
    bf16* MIX = (bf16*)(F.ws + WS_MIX);
    LAS bf16* DTr = (LAS bf16*)F.lds; LAS bf16* DTi = DTr + 128 * 136;
    const int tid = F.tid, lane = F.lane, w = F.wave, li = lane & 15, lq = lane >> 4;
    LAS bf16* Wv = (LAS bf16*)(F.lds + 69632) + w * (16 * 2 * 136);
    {   const int c = tid & 127, nq = tid >> 7;
        const size_t o = ((size_t)(b * 128 + k1) * 128 + 32 * nq) * 256 + chalf * 128 + c;
#pragma unroll 2
        for (int j = 0; j < 4; ++j) { unsigned pr[4], pi[4];
#pragma unroll
            for (int i = 0; i < 4; ++i) { const size_t o0 = o + (size_t)(8 * j + 2 * i) * 256, o1 = o0 + 256;
                pr[i] = (unsigned)FAr[o0] | ((unsigned)FAr[o1] << 16); pi[i] = (unsigned)FAi[o0] | ((unsigned)FAi[o1] << 16); }
            *(LAS u32x4*)(DTr + c * 136 + 32 * nq + 8 * j) = (u32x4){pr[0], pr[1], pr[2], pr[3]};
            *(LAS u32x4*)(DTi + c * 136 + 32 * nq + 8 * j) = (u32x4){pi[0], pi[1], pi[2], pi[3]}; } }
    LDS_BARRIER();
    bf16x8 fc[4], fs[4];
#pragma unroll
    for (int ks = 0; ks < 4; ++ks) { fc[ks] = *(const bf16x8*)(Fc + (16 * w + li) * 128 + 32 * ks + 8 * lq); fs[ks] = *(const bf16x8*)(Fs + (16 * w + li) * 128 + 32 * ks + 8 * lq); }
#pragma unroll 2
    for (int nt = 0; nt < 8; ++nt) {
        f32x4 ur = {0.f, 0.f, 0.f, 0.f}, u1 = {0.f, 0.f, 0.f, 0.f}, u2 = {0.f, 0.f, 0.f, 0.f};
#pragma unroll
        for (int ks = 0; ks < 4; ++ks) { const bf16x8 br = *(const LAS bf16x8*)(DTr + (16 * nt + li) * 136 + 32 * ks + 8 * lq), bi = *(const LAS bf16x8*)(DTi + (16 * nt + li) * 136 + 32 * ks + 8 * lq);
            ur = MFMA16(fc[ks], br, ur); ur = MFMA16(fs[ks], bi, ur); u1 = MFMA16(fc[ks], bi, u1); u2 = MFMA16(fs[ks], br, u2); }
        const int gl = nt >> 2, cl = 16 * (nt & 3) + li;
#pragma unroll
        for (int r = 0; r < 4; ++r) { const int k2l = 4 * lq + r; Wv[(k2l * 2 + gl) * 136 + cl] = f2bf(ur[r]); Wv[(k2l * 2 + gl) * 136 + 64 + cl] = f2bf(u1[r] - u2[r]); }
    }
    LDS_WAIT();
#pragma unroll
    for (int gl = 0; gl < 2; ++gl)
#pragma unroll
        for (int mt = 0; mt < 4; ++mt) { f32x4 acc = {0.f, 0.f, 0.f, 0.f};
#pragma unroll
            for (int ks = 0; ks < 4; ++ks) acc = MFMA16(*(const LAS bf16x8*)(Wv + (li * 2 + gl) * 136 + 32 * ks + 8 * lq), *(const bf16x8*)(CS + (16 * mt + li) * 128 + 32 * ks + 8 * lq), acc);
#pragma unroll
            for (int r = 0; r < 4; ++r) { const int k2 = 16 * w + 4 * lq + r; const size_t tok = (size_t)b * SEQ + k1 + 128 * k2;
                MIX[tok * 1024 + 768 + (chalf * 2 + gl) * 64 + 16 * mt + li] = f2bf(acc[r] * (1.f / 1024.f)); } }
    LDS_BARRIER();
}

__device__ __forceinline__ void ctx_fourier(Frame& F, int b, int g) {
    const bf16* Z = (const bf16*)(F.ws + WS_Z); bf16* MIX = (bf16*)(F.ws + WS_MIX);
    const bf16* CS = (const bf16*)(F.ws + WS_TAB + TAB_CS); const bf16* C256 = (const bf16*)(F.ws + WS_TAB + TAB_C256); const bf16* S256 = (const bf16*)(F.ws + WS_TAB + TAB_S256);
    LAS bf16* PT = (LAS bf16*)F.lds; LAS bf16* QT = PT + 64 * 264;
    const int lane = F.lane, w = F.wave, li = lane & 15, lq = lane >> 4;
#pragma unroll 1
    for (int nj = 0; nj < 2; ++nj) { const int nt = 2 * w + nj;
        bf16x8 a[2];
#pragma unroll
        for (int ks = 0; ks < 2; ++ks) a[ks] = *(const bf16x8*)(Z + (size_t)(TL + b * CTXL + 16 * nt + li) * INW + ZU + g * 64 + 32 * ks + 8 * lq);
#pragma unroll
        for (int mt = 0; mt < 4; ++mt) { f32x4 p = {0.f, 0.f, 0.f, 0.f}, q = {0.f, 0.f, 0.f, 0.f};
#pragma unroll
            for (int ks = 0; ks < 2; ++ks) { p = MFMA16(a[ks], *(const bf16x8*)(CS + (16 * mt + li) * 128 + 32 * ks + 8 * lq), p); q = MFMA16(a[ks], *(const bf16x8*)(CS + (16 * mt + li) * 128 + 64 + 32 * ks + 8 * lq), q); }
            u32x2 o; o.x = pk2(p[0], p[1]); o.y = pk2(p[2], p[3]); *(LAS u32x2*)(PT + (16 * mt + li) * 264 + 16 * nt + 4 * lq) = o;
            o.x = pk2(q[0], q[1]); o.y = pk2(q[2], q[3]); *(LAS u32x2*)(QT + (16 * mt + li) * 264 + 16 * nt + 4 * lq) = o; } }
    LDS_BARRIER();
#pragma unroll 1
    for (int kj = 0; kj < 2; ++kj) { const int kt = 2 * w + kj;
        f32x4 acc[4];
#pragma unroll
        for (int mt = 0; mt < 4; ++mt) acc[mt] = (f32x4){0.f, 0.f, 0.f, 0.f};
#pragma unroll 2
        for (int ks = 0; ks < 8; ++ks) { const bf16x8 ac = *(const bf16x8*)(C256 + (16 * kt + li) * 256 + 32 * ks + 8 * lq), as = *(const bf16x8*)(S256 + (16 * kt + li) * 256 + 32 * ks + 8 * lq);
#pragma unroll
            for (int mt = 0; mt < 4; ++mt) { acc[mt] = MFMA16(ac, *(const LAS bf16x8*)(PT + (16 * mt + li) * 264 + 32 * ks + 8 * lq), acc[mt]); acc[mt] = MFMA16(as, *(const LAS bf16x8*)(QT + (16 * mt + li) * 264 + 32 * ks + 8 * lq), acc[mt]); } }
#pragma unroll
        for (int mt = 0; mt < 4; ++mt)
#pragma unroll
            for (int r = 0; r < 4; ++r) MIX[(size_t)(TL + b * CTXL + 16 * kt + 4 * lq + r) * 1024 + 768 + g * 64 + 16 * mt + li] = f2bf(acc[mt][r] * (1.f / 128.f)); }
    LDS_BARRIER();
}

__device__ __forceinline__ void route_phase(Frame& F, int l, int Tl) {
    LAS unsigned* hist = (LAS unsigned*)F.lds;
    for (int i = F.tid; i < 256; i += NTHR) hist[i] = 0u;
    __syncthreads();
    const float* logits = (const float*)(F.ws + WS_LOGIT); const float* br = F.in[20] + l * 256;
    int* sel_e = (int*)(F.ws + WS_SEL); float* sel_w = (float*)(F.ws + WS_SEL + SEL_STRIDE);
    const int lane = F.lane, gw = blockIdx.x * NWAVES + F.wave, NGW = F.G * NWAVES;
    const float NEG = -__builtin_inff();
    for (int t = gw; t < Tl; t += NGW) {
        const f32x4 lg = *(const f32x4*)(logits + (size_t)t * 256 + 4 * lane); const f32x4 bb = *(const f32x4*)(br + 4 * lane);
        float sc[4], cand[4];
#pragma unroll
        for (int i = 0; i < 4; ++i) { sc[i] = sigmoidf_(lg[i]); cand[i] = sc[i] + bb[i]; }
        float m1 = NEG, m2 = NEG;
#pragma unroll
        for (int i = 0; i < 4; ++i) { const float v = cand[i]; if (v > m1) { m2 = m1; m1 = v; } else if (v > m2) m2 = v; }
#pragma unroll
        for (int off = 1; off < 8; off <<= 1) { const float o1 = __shfl_xor(m1, off), o2 = __shfl_xor(m2, off); const float n1 = fmaxf(m1, o1), n2 = fmaxf(fminf(m1, o1), fmaxf(m2, o2)); m1 = n1; m2 = n2; }
        const float gs = m1 + m2; const int g = lane >> 3; int rank = 0;
#pragma unroll
        for (int q = 0; q < 8; ++q) { const float v = __shfl(gs, 8 * q); rank += (v > gs || (v == gs && q < g)) ? 1 : 0; }
        if (rank >= 4) {
#pragma unroll
            for (int i = 0; i < 4; ++i) cand[i] = NEG; }
        float wsum = 0.f, myw = 0.f; int mye = 0;
#pragma unroll 1
        for (int k = 0; k < TOPK; ++k) {
            float bv = cand[0]; int bidx = 4 * lane;
#pragma unroll
            for (int i = 1; i < 4; ++i) if (cand[i] > bv) { bv = cand[i]; bidx = 4 * lane + i; }
#pragma unroll
            for (int off = 1; off < 64; off <<= 1) { const float ov = __shfl_xor(bv, off); const int oi = __shfl_xor(bidx, off); if (ov > bv || (ov == bv && oi < bidx)) { bv = ov; bidx = oi; } }
            const int owner = bidx >> 2, which = bidx & 3;
            const float s = which == 0 ? sc[0] : which == 1 ? sc[1] : which == 2 ? sc[2] : sc[3];
            const float sw = __shfl(s, owner);
#pragma unroll
            for (int i = 0; i < 4; ++i) if (lane == owner && which == i) cand[i] = NEG;
            wsum += sw; if (lane == k) { myw = sw; mye = bidx; }
        }
        if (lane < TOPK) { sel_e[(size_t)t * 8 + lane] = mye; sel_w[(size_t)t * 8 + lane] = 2.5f * myw / wsum; (void)__hip_atomic_fetch_add(&hist[mye], 1u, __ATOMIC_RELAXED, __HIP_MEMORY_SCOPE_WORKGROUP); }
    }
    __syncthreads();
    unsigned* cnt = (unsigned*)(F.ws + WS_CTL) + CW_CNT + 1024 * l;
    for (int e = F.tid; e < 256; e += NTHR) if (hist[e]) atomicAdd(cnt + e, hist[e]);
    __syncthreads();
}

__device__ __forceinline__ void assign_phase(Frame& F, int l, int Tl) {
    LAS int* cntL = (LAS int*)F.lds; LAS int* pstart = cntL + 256; LAS unsigned* hist = (LAS unsigned*)(pstart + 260); LAS unsigned* base = hist + 256; LAS unsigned* hist2 = base + 256;
    unsigned* cnt = (unsigned*)(F.ws + WS_CTL) + CW_CNT + 1024 * l; unsigned* fill = cnt + 512;
    const int tid = F.tid, lane = F.lane;
    if (tid < 256) { cntL[tid] = (int)cnt[tid]; hist[tid] = 0u; hist2[tid] = 0u; }
    __syncthreads();
    if (F.wave == 0) {
        int p[4]; int s = 0;
#pragma unroll
        for (int i = 0; i < 4; ++i) { p[i] = (cntL[4 * lane + i] + 255) & ~255; s += p[i]; }
        int inc = s;
#pragma unroll
        for (int off = 1; off < 64; off <<= 1) { const int v = __shfl_up(inc, off); if (lane >= off) inc += v; }
        int ex = inc - s;
#pragma unroll
        for (int i = 0; i < 4; ++i) { pstart[4 * lane + i] = ex; ex += p[i]; }
        if (lane == 63) pstart[256] = inc;
    }
    __syncthreads();
    const int total_rows = pstart[256], ntile_r = total_rows >> 8, ntiles = ntile_r + (Tl >> 8);
    int* meta = (int*)(F.ws + WS_META); int* tile_expert = meta + 64;
    int* row_tok = (int*)(F.ws + WS_ROWTOK); const int* sel_e = (const int*)(F.ws + WS_SEL); int* tokpos = (int*)(F.ws + WS_SEL + 2 * SEL_STRIDE);
    if (blockIdx.x == 0) {
        if (tid == 0) { meta[0] = ntiles; meta[1] = total_rows; }
        if (tid < 256) { const int rt0 = pstart[tid] >> 8; for (int rt = rt0; rt < (pstart[tid + 1] >> 8); ++rt) tile_expert[rt] = tid | ((cntL[tid] - 256 * (rt - rt0) <= 128) ? 0x10000 : 0); }
        for (int rt = ntile_r + tid; rt < ntiles; rt += NTHR) tile_expert[rt] = 256;
    }
    for (int e = blockIdx.x; e < 256; e += F.G) for (int r = pstart[e] + cntL[e] + tid; r < pstart[e + 1]; r += NTHR) row_tok[r] = 0;
    const int TPW = (Tl + F.G - 1) / F.G, t0 = blockIdx.x * TPW, t1 = (t0 + TPW < Tl) ? t0 + TPW : Tl;
    for (int t = t0 + tid; t < t1; t += NTHR) row_tok[total_rows + t] = t;
    const int npairs = t1 > t0 ? (t1 - t0) * 8 : 0;
    for (int i = tid; i < npairs; i += NTHR) (void)__hip_atomic_fetch_add(&hist[sel_e[(size_t)t0 * 8 + i]], 1u, __ATOMIC_RELAXED, __HIP_MEMORY_SCOPE_WORKGROUP);
    __syncthreads();
    if (tid < 256) base[tid] = hist[tid] ? atomicAdd(fill + tid, hist[tid]) : 0u;
    __syncthreads();
    for (int i = tid; i < npairs; i += NTHR) { const int e = sel_e[(size_t)t0 * 8 + i]; const unsigned off = __hip_atomic_fetch_add(&hist2[e], 1u, __ATOMIC_RELAXED, __HIP_MEMORY_SCOPE_WORKGROUP);
        const int pos = pstart[e] + (int)base[e] + (int)off; row_tok[pos] = t0 + (i >> 3); tokpos[(size_t)t0 * 8 + i] = pos; }
    __syncthreads();
}

__device__ __forceinline__ void combine_phase(Frame& F, int l, int Tl) {
    const int* meta = (const int*)(F.ws + WS_META); const int total_rows = meta[1];
    const unsigned char* Y = (const unsigned char*)(F.ws + WS_Y); const int* tokpos = (const int*)(F.ws + WS_SEL + 2 * SEL_STRIDE); const float* sel_w = (const float*)(F.ws + WS_SEL + SEL_STRIDE);
    const float* mod = (const float*)(F.ws + WS_MOD);
    float* XC = (float*)(F.ws + WS_XC); bf16* HB = (bf16*)(F.ws + WS_HB);
    const int lane = F.lane, gw = blockIdx.x * NWAVES + F.wave, NGW = F.G * NWAVES;
    const int c0 = 16 * lane;
    const int ca = (lane >> 4) * 256 + ((lane >> 2) & 3) * 32 + (lane & 3) * 8, cb2 = ca + 128;
    for (int t = gw; t < Tl; t += NGW) {
        const int myp = lane < 8 ? tokpos[(size_t)t * 8 + lane] : 0; const float myw = lane < 8 ? sel_w[(size_t)t * 8 + lane] : 0.f;
        float* xr = t < TL ? F.out + (size_t)t * D : XC + (size_t)(t - TL) * D; const int r = t < TL ? (t >> 14) : 2;
        u32x4 yv[9];
        yv[8] = *(const u32x4*)(Y + (size_t)(total_rows + t) * 1024 + c0);
#pragma unroll
        for (int k = 0; k < TOPK; ++k) yv[k] = *(const u32x4*)(Y + (size_t)__shfl(myp, k) * 1024 + c0);
        f32x4 xv[4];
        xv[0] = *(const f32x4*)(xr + ca); xv[1] = *(const f32x4*)(xr + ca + 4); xv[2] = *(const f32x4*)(xr + cb2); xv[3] = *(const f32x4*)(xr + cb2 + 4);
        float y[16];
#pragma unroll
        for (int d = 0; d < 4; ++d) { const f32x2 a = __builtin_amdgcn_cvt_pk_f32_fp8((int)yv[8][d], false), bq = __builtin_amdgcn_cvt_pk_f32_fp8((int)yv[8][d], true);
            y[4 * d] = a.x; y[4 * d + 1] = a.y; y[4 * d + 2] = bq.x; y[4 * d + 3] = bq.y; }
#pragma unroll
        for (int k = 0; k < TOPK; ++k) { const float wk = __shfl(myw, k);
#pragma unroll
            for (int d = 0; d < 4; ++d) { const f32x2 a = __builtin_amdgcn_cvt_pk_f32_fp8((int)yv[k][d], false), bq = __builtin_amdgcn_cvt_pk_f32_fp8((int)yv[k][d], true);
                y[4 * d] += wk * a.x; y[4 * d + 1] += wk * a.y; y[4 * d + 2] += wk * bq.x; y[4 * d + 3] += wk * bq.y; } }
        const float* g2 = mod + (size_t)(l * 3 + r) * 6144 + 5120;
        f32x4 xn[4]; float s = 0.f;
#pragma unroll
        for (int j = 0; j < 4; ++j) { const int cj = (j < 2 ? ca : cb2) + 4 * (j & 1);
            xn[j] = xv[j] + *(const f32x4*)(g2 + cj) * (f32x4){y[4 * j], y[4 * j + 1], y[4 * j + 2], y[4 * j + 3]};
            s += (xn[j].x * xn[j].x + xn[j].y * xn[j].y) + (xn[j].z * xn[j].z + xn[j].w * xn[j].w); }
        const float rstd = rsqrtf(wave_sum(s) * (1.f / D) + EPS);
        if (l == 0) {
            const float* m1 = mod + (size_t)(3 + r) * 6144; const float* gain = F.in[6] + 1024;
            unsigned o[8];
#pragma unroll
            for (int j = 0; j < 4; ++j) { const int cj = (j < 2 ? ca : cb2) + 4 * (j & 1); *(f32x4*)(xr + cj) = xn[j];
                const f32x4 yv2 = xn[j] * rstd * *(const f32x4*)(gain + cj) * (*(const f32x4*)(m1 + 1024 + cj) + 1.f) + *(const f32x4*)(m1 + cj);
                o[2 * j] = pk2(yv2.x, yv2.y); o[2 * j + 1] = pk2(yv2.z, yv2.w); }
            *(u32x4*)(HB + (size_t)t * D + ca) = (u32x4){o[0], o[1], o[2], o[3]}; *(u32x4*)(HB + (size_t)t * D + cb2) = (u32x4){o[4], o[5], o[6], o[7]};
        } else {
            const float* gain = F.in[27];
#pragma unroll
            for (int j = 0; j < 4; ++j) { const int cj = (j < 2 ? ca : cb2) + 4 * (j & 1); *(f32x4*)(F.out + (size_t)t * D + cj) = xn[j] * rstd * *(const f32x4*)(gain + cj); }
        }
    }
}


#ifndef PH_EN
#define PH_EN 0xFFFFFFFFu
#endif
#define EN(j) ((PH_EN >> (j)) & 1u)
#ifndef U_EN
#define U_EN 0xFFu
#endif
#define UEN(j) ((U_EN >> (j)) & 1u)
#ifndef DUPMASK
#define DUPMASK 0u
#endif
#define REP(j) for (int rep_ = 0; rep_ < 1 + (int)((DUPMASK >> (j)) & 1u); ++rep_)
#ifndef DUPU
#define DUPU 0u
#endif
#define REPU(j) for (int repu_ = 0; repu_ < 1 + (int)((DUPU >> (j)) & 1u); ++repu_)
#define IN(k) (lo <= (k) && (k) < hi)
#define FRESH() do { asm volatile("" : "+v"(F.tid)); F.lane = F.tid & 63; } while (0)
#define SEAM(k) do { if (lo <= (k) && (k) + 1 < hi) xcd_barrier(bar); } while (0)
#define SEAMCV(k, lcv) do { if (lo <= (k) && (k) + 1 < hi) xcd_barrier_cv(bar, F); } while (0)
template <int l>
__device__ __forceinline__ void layer_phases(Frame& F, const XcdBarrier& bar, const int lo, const int hi) {
    const int bid = blockIdx.x, G = F.G;

        const int pb = 2 + 12 * l;
        const int Tl = l == 0 ? TT : TL;
        bf16* HB = (bf16*)(F.ws + WS_HB); bf16* Zb = (bf16*)(F.ws + WS_Z); bf16* MIX = (bf16*)(F.ws + WS_MIX);
        if (EN(2) && IN(pb + 0)) REP(2) { FRESH();
            pg8::Gemm g{HB, (const bf16*)(F.ws + WS_WIN) + (size_t)l * INW * 1024, nullptr, 1024}; pg8::StaticOrder S; S.init(TT, INW, G, bid);
            pg8::EpiBf16 E{Zb, INW};
            pg8::gemm_phase<pg8::EpiBf16, pg8::StaticOrder, false>(F.lds, g, S, E, F.tid);
            SEAMCV(pb + 0, l);
        }
        if (EN(3) && IN(pb + 1)) REP(3) { FRESH();
            REPU(0) if (UEN(0)) hgrn2_c1<0>(F, l, bid, 16 * HG_SLOTS, G);
            FRESH(); REPU(1) if (UEN(1)) for (int u = (bid + G - 32) % G; u < 2 * LR_SLOTS; u += G) lru_unit<false>(F, l, u / LR_SLOTS, u % LR_SLOTS);
            FRESH(); REPU(2) if (UEN(2)) for (int u = bid; u < 256; u += G) fft_f1(F, u >> 7, u & 127);
            FRESH(); REPU(3) if (UEN(3) && l == 0) for (int u = (bid + G - 64) % G; u < 8; u += G) ctx_fourier(F, u >> 2, u & 3);
            SEAMCV(pb + 1, l);
        }
        if (EN(4) && IN(pb + 2)) REP(4) { FRESH(); hgrn2_c2(F); lru_carry(F); SEAMCV(pb + 2, l); }
        if (EN(5) && IN(pb + 3)) REP(5) { FRESH();
            const int nslot = l == 0 ? HG_SLOTS : HG_SLOTS - 2, slot0 = l == 0 ? 0 : 2;
            FRESH(); REPU(4) if (UEN(4)) for (int u = bid; u < 8 * nslot; u += G) hgrn2_c3<0>(F, l, u / nslot, slot0 + u % nslot);
            const int nls = l == 0 ? LR_SLOTS : LR_SLOTS - 4, ls0 = l == 0 ? 0 : 4;
            FRESH(); REPU(5) if (UEN(5)) for (int u = (bid + G - 32) % G; u < 2 * nls; u += G) lru_unit<true>(F, l, u / nls, ls0 + u % nls);
            FRESH(); REPU(6) if (UEN(6)) for (int u = bid; u < 512; u += G) fft_f2(F, u >> 8, (u >> 1) & 127, u & 1);
            SEAMCV(pb + 3, l);
        }
        if (EN(6) && IN(pb + 4)) REP(6) { FRESH();
            pg8::Gemm g{MIX, (const bf16*)(F.ws + WS_WOUT) + (size_t)l * 1024 * 1024, nullptr, 1024}; pg8::StaticOrder S; S.init(Tl, 1024, G, bid);
            pg8::EpiResid E{l == 0 ? F_X(F) : (const float*)F.out, F.out, F_CTX(F), (float*)(F.ws + WS_XC), (const float*)(F.ws + WS_MOD) + (size_t)l * 3 * 6144};
            pg8::gemm_phase<pg8::EpiResid, pg8::StaticOrder, false>(F.lds, g, S, E, F.tid);
            SEAMCV(pb + 4, l);
        }
        if (EN(7) && IN(pb + 5)) REP(7) { FRESH();
            hprep_rows(F, l, F.out, (const float*)(F.ws + WS_XC), Tl, 3072, 4096, F.in[7] + l * 1024);
            SEAMCV(pb + 5, l);
        }
        if (EN(8) && IN(pb + 6)) REP(8) { FRESH();
            pg8::Gemm g{HB, (const bf16*)(F.ws + WS_WR) + (size_t)l * 256 * 1024, nullptr, 1024}; pg8::StaticOrder S; S.init(Tl, 256, G, bid);
            pg8::EpiF32 E{(float*)(F.ws + WS_LOGIT), 256};
            pg8::gemm_phase<pg8::EpiF32, pg8::StaticOrder, false>(F.lds, g, S, E, F.tid);
            SEAMCV(pb + 6, l);
        }
        if (EN(9) && IN(pb + 7)) REP(9) { FRESH(); route_phase(F, l, Tl); SEAMCV(pb + 7, l); }
        if (EN(10) && IN(pb + 8)) REP(10) { FRESH(); assign_phase(F, l, Tl); FRESH(); convert_experts(F, l); SEAMCV(pb + 8, l); }
        if (EN(11) && IN(pb + 9)) REP(11) { FRESH();
            const int* meta = (const int*)(F.ws + WS_META);
            pg8::Gemm g{HB, (const bf16*)(F.ws + (l ? WS_WEXP1 : WS_WEXP)), (const int*)(F.ws + WS_ROWTOK), 1024}; pg8::MoeOrder<2> S{meta + 64, meta[0], G, bid};
            pg8::EpiSwiglu E{(bf16*)(F.ws + WS_HBUF)};
            pg8::gemm_phase<pg8::EpiSwiglu, pg8::MoeOrder<2>, true>(F.lds, g, S, E, F.tid);
            SEAMCV(pb + 9, l);
        }
        if (EN(12) && IN(pb + 10)) REP(12) { FRESH();
            const int* meta = (const int*)(F.ws + WS_META);
            pg8::Gemm g{(const bf16*)(F.ws + WS_HBUF), (const bf16*)(F.ws + (l ? WS_WEXP1 : WS_WEXP) + WEXP_GU_BYTES), nullptr, 256}; pg8::MoeOrder<4> S{meta + 64, meta[0], G, bid};
            pg8::EpiFp8 E{(unsigned char*)(F.ws + WS_Y), 1024};
            pg8::gemm_phase<pg8::EpiFp8, pg8::MoeOrder<4>, false>(F.lds, g, S, E, F.tid);
            SEAMCV(pb + 10, l);
        }
        if (EN(13) && IN(pb + 11)) REP(13) { FRESH(); combine_phase(F, l, Tl); SEAMCV(pb + 11, l); }
    }

constexpr int NPH = 26;
#ifndef BENCH_REPS
#define BENCH_REPS 2
#endif
__global__ void __launch_bounds__(NTHR, 2) fwd_kernel(Args args) {
    extern __shared__ __attribute__((aligned(16))) unsigned char lds_raw[];
    Frame F;
    F.lds = (LAS unsigned char*)lds_raw;
    F.tid = threadIdx.x; F.lane = F.tid & 63; F.wave = __builtin_amdgcn_readfirstlane(F.tid >> 6); F.G = gridDim.x;
    F.in = (const CAS cfptr*)__builtin_amdgcn_kernarg_segment_ptr();
    F.out = args.out; F.ws = args.ws;
    volatile LAS unsigned* MISC = (volatile LAS unsigned*)(F.lds + MISC_OFF);
    if (F.tid < 64) MISC[F.tid] = 0u;
    __syncthreads();
    XcdBarrier bar = xcd_barrier_post((unsigned*)(F.ws + WS_CTL) + CW_BAR, MISC + 8);
    const int lo = args.ph_lo, hi = args.ph_hi;
    const int bid = blockIdx.x, G = F.G;

    if (EN(0) && IN(0)) { FRESH(); phase_g0(F); SEAMCV(0, 0); }
    if (EN(1) && IN(1)) { FRESH(); hprep_rows(F, 0, F_X(F), F_CTX(F), TT, 0, 1024, F.in[6]); SEAMCV(1, 0); }

    layer_phases<0>(F, bar, lo, hi);
    layer_phases<1>(F, bar, lo, hi);
#ifdef BENCH_GEMM
    if (hi == NPH) { xcd_barrier(bar); FRESH();
        _Pragma("unroll 1") for (int rep = 0; rep < BENCH_REPS; ++rep) {
            const int* meta = (const int*)(F.ws + WS_META);
            pg8::Gemm g{(const bf16*)(F.ws + WS_HBUF), (const bf16*)(F.ws + WS_WEXP + WEXP_GU_BYTES), nullptr, 256}; pg8::MoeOrder<4> S{meta + 64, meta[0], F.G, (int)blockIdx.x};
#if BENCH_GEMM == 1
            pg8::EpiFp8 E{(unsigned char*)(F.ws + WS_Y), 1024}; pg8::gemm_phase<pg8::EpiFp8, pg8::MoeOrder<4>, false>(F.lds, g, S, E, F.tid);
#else
            pg8::EpiNone E{(bf16*)(F.ws + WS_Y)}; pg8::gemm_phase<pg8::EpiNone, pg8::MoeOrder<4>, false>(F.lds, g, S, E, F.tid);
#endif
            xcd_barrier(bar); } }
#endif
#ifdef BENCH_INPROJ
    if (hi == NPH) { xcd_barrier(bar); FRESH();
        _Pragma("unroll 1") for (int rep = 0; rep < BENCH_REPS; ++rep) {
            pg8::Gemm g{(const bf16*)(F.ws + WS_HB), (const bf16*)(F.ws + WS_WIN), nullptr, 1024}; pg8::StaticOrder S; S.init(TT, INW, F.G, (int)blockIdx.x);
#if BENCH_INPROJ == 1
            pg8::EpiBf16 E{(bf16*)(F.ws + WS_Z), INW}; pg8::gemm_phase<pg8::EpiBf16, pg8::StaticOrder, false>(F.lds, g, S, E, F.tid);
#else
            pg8::EpiNone E{(bf16*)(F.ws + WS_Z)}; pg8::gemm_phase<pg8::EpiNone, pg8::StaticOrder, false>(F.lds, g, S, E, F.tid);
#endif
            xcd_barrier(bar); } }
#endif
#ifdef BENCH_MOE1
    if (hi == NPH) { xcd_barrier(bar); FRESH();
        _Pragma("unroll 1") for (int rep = 0; rep < BENCH_REPS; ++rep) {
            const int* meta = (const int*)(F.ws + WS_META);
            pg8::MoeOrder<2> S{meta + 64, meta[0], F.G, (int)blockIdx.x};
#if BENCH_MOE1 == 1
            pg8::Gemm g{(const bf16*)(F.ws + WS_HB), (const bf16*)(F.ws + WS_WEXP1), (const int*)(F.ws + WS_ROWTOK), 1024};
            pg8::EpiSwiglu E{(bf16*)(F.ws + WS_HBUF)}; pg8::gemm_phase<pg8::EpiSwiglu, pg8::MoeOrder<2>, true>(F.lds, g, S, E, F.tid);
#elif BENCH_MOE1 == 2
            pg8::Gemm g{(const bf16*)(F.ws + WS_HB), (const bf16*)(F.ws + WS_WEXP1), (const int*)(F.ws + WS_ROWTOK), 1024};
            pg8::EpiNone E{(bf16*)(F.ws + WS_HBUF)}; pg8::gemm_phase<pg8::EpiNone, pg8::MoeOrder<2>, true>(F.lds, g, S, E, F.tid);
#else
            pg8::Gemm g{(const bf16*)(F.ws + WS_HB), (const bf16*)(F.ws + WS_WEXP1), nullptr, 1024};
            pg8::EpiNone E{(bf16*)(F.ws + WS_HBUF)}; pg8::gemm_phase<pg8::EpiNone, pg8::MoeOrder<2>, false>(F.lds, g, S, E, F.tid);
#endif
            xcd_barrier(bar); } }
#endif
#ifdef BENCH_X2
    if (hi == NPH) { xcd_barrier(bar); FRESH();
        _Pragma("unroll 1") for (int rep = 0; rep < BENCH_REPS; ++rep) { if (BENCH_X2 & 1) hgrn2_c2(F); if (BENCH_X2 & 2) lru_carry(F); xcd_barrier(bar); } }
#endif
#ifdef BENCH_C1
    if (hi == NPH) { xcd_barrier(bar); FRESH();
        _Pragma("unroll 1") for (int rep = 0; rep < BENCH_REPS; ++rep) hgrn2_c1<BENCH_C1>(F, 1, (int)blockIdx.x, 16 * HG_SLOTS, F.G); }
#endif
#ifdef BENCH_VAR
    if (hi == NPH) { xcd_barrier(bar); FRESH();
        _Pragma("unroll 1") for (int rep = 0; rep < BENCH_REPS; ++rep) for (int u = blockIdx.x; u < 8 * 128; u += F.G) hgrn2_c3<BENCH_VAR>(F, 1, u >> 7, 2 + (u & 127)); }
#endif
#undef IN
#undef SEAM
}

extern "C" void kernel_launch(void* const* d_in, const int* in_sizes, int n_in, void* d_out, int out_size, void* d_ws, size_t ws_size, hipStream_t stream) {
    static int grid = 0;
    if (grid == 0) {
        if (n_in != 28 || out_size != TL * D || ws_size < WS_END) { fprintf(stderr, "kernel_launch: unexpected problem (n_in %d, out %d, ws %zu < %zu)\n", n_in, out_size, ws_size, (size_t)WS_END); grid = -1; return; }
        int dev = 0, cus = 0, per_cu = 0;
        if (hipGetDevice(&dev) != hipSuccess || hipDeviceGetAttribute(&cus, hipDeviceAttributeMultiprocessorCount, dev) != hipSuccess) { grid = -1; return; }
        if (hipFuncSetAttribute((const void*)fwd_kernel, hipFuncAttributeMaxDynamicSharedMemorySize, LDS_BYTES) != hipSuccess) { fprintf(stderr, "kernel_launch: hipFuncSetAttribute failed\n"); grid = -1; return; }
        if (hipOccupancyMaxActiveBlocksPerMultiprocessor(&per_cu, (const void*)fwd_kernel, NTHR, LDS_BYTES) != hipSuccess || per_cu < 1) { fprintf(stderr, "kernel_launch: occupancy query says %d\n", per_cu); (void)hipGetLastError(); }
        grid = cus;
    }
    if (grid < 0) return;
    (void)hipMemsetAsync((char*)d_ws + WS_CTL, 0, CTL_ZERO_BYTES, stream);
    Args a{};
    for (int i = 0; i < 28; ++i) a.in[i] = (const float*)d_in[i];
    a.out = (float*)d_out; a.ws = (unsigned char*)d_ws;
#if MK_PER_PHASE
    for (int p = 0; p < NPH; ++p) { a.ph_lo = p; a.ph_hi = p + 1; hipLaunchKernelGGL(fwd_kernel, dim3(grid), dim3(NTHR), LDS_BYTES, stream, a); }
#else
    a.ph_lo = 0; a.ph_hi = NPH; hipLaunchKernelGGL(fwd_kernel, dim3(grid), dim3(NTHR), LDS_BYTES, stream, a);
#endif
}
```

```cpp
#include <hip/hip_runtime.h>
#include <cstdio>
#include <cstdint>

#ifndef MK_PER_PHASE
#define MK_PER_PHASE 0
#endif

#define LAS __attribute__((address_space(3)))
#define GAS __attribute__((address_space(1)))
typedef unsigned short bf16;
typedef short bf16x8 __attribute__((ext_vector_type(8)));
typedef float f32x4 __attribute__((ext_vector_type(4)));
typedef float f32x2 __attribute__((ext_vector_type(2)));
typedef unsigned u32x4 __attribute__((ext_vector_type(4)));
typedef unsigned u32x2 __attribute__((ext_vector_type(2)));

__device__ __forceinline__ float bf2f(bf16 v) { return __builtin_bit_cast(float, ((unsigned)v) << 16); }
typedef __bf16 bf16x2_t __attribute__((ext_vector_type(2)));
__device__ __forceinline__ unsigned pk2(float lo, float hi) { bf16x2_t v; v.x = (__bf16)lo; v.y = (__bf16)hi; return __builtin_bit_cast(unsigned, v); }
__device__ __forceinline__ bf16 f2bf(float f) { const __bf16 b = (__bf16)f; return __builtin_bit_cast(unsigned short, b); }
__device__ __forceinline__ unsigned f2bfu(float f) { return (unsigned)f2bf(f); }
#define MFMA16(a, b, c) __builtin_amdgcn_mfma_f32_16x16x32_bf16((a), (b), (c), 0, 0, 0)
#define LDS_WAIT() asm volatile("s_waitcnt lgkmcnt(0)" ::: "memory")
#define LDS_BARRIER() do { asm volatile("s_waitcnt lgkmcnt(0)" ::: "memory"); __builtin_amdgcn_s_barrier(); asm volatile("" ::: "memory"); } while (0)

namespace pg8 {
typedef unsigned short bf16_t;
constexpr int BM = 256, BK = 64, HALF = 128, HTB = HALF * BK * 2, STAGE_BYTES = 8 * HTB, NXCD = 8, WGM = 8;

__host__ __device__ __forceinline__ int lds_byte(int r, int c) { const int st = (r >> 4) * 2 + (c >> 5), rr = r & 15, cc = c & 31, ob = rr * 64 + cc * 2; return st * 1024 + (ob ^ (((ob >> 9) & 1) << 5)); }
__host__ __device__ __forceinline__ void stage_rc(int b, int& R, int& C) { const int st = b / 1024, sb = b % 1024, swz = sb ^ (((sb >> 9) & 1) << 5); R = (st >> 1) * 16 + swz / 64; C = (st & 1) * 32 + (swz % 64) / 2; }
__host__ __device__ __forceinline__ int perm32(int rho) { const int n = rho >> 4, i = rho & 15; return 8 * (i >> 2) + 4 * n + (i & 3); }

struct Unit { int pm, pn, pc, half; };
struct Gemm { const bf16_t* A; const bf16_t* Bt; const int* rows; int K; };

struct StaticOrder {
    int nM, nN, nwg, G, c;
    __device__ void init(int M, int N, int G_, int c_) { nM = M / BM; nN = N / BM; nwg = nM * nN; G = G_; c = c_; }
    __device__ bool next(int i, Unit& u) const {
        const long L = (long)i * G + c; if (L >= nwg) return false;
        int wgid = (int)L; { const int q = nwg / NXCD, r = nwg % NXCD, xcd = wgid % NXCD, off = wgid / NXCD; wgid = (xcd < r ? xcd * (q + 1) : r * (q + 1) + (xcd - r) * q) + off; }
        const int nig = WGM * nN, gid = wgid / nig, fm = gid * WGM, gsz = (nM - fm) < WGM ? (nM - fm) : WGM;
        u.pm = fm + ((wgid % nig) % gsz); u.pn = (wgid % nig) / gsz; u.pc = u.pn; u.half = 0; return true;
    }
};
template <int NT> struct MoeOrder {
    const int* tile_expert; int n_tiles, G, c;
    __device__ bool next(int i, Unit& u) const {
        int rt, j;
        if ((G & 7) == 0) { const int x = c & 7, jw = c >> 3, per = G >> 3; const int t0 = (int)(((long)n_tiles * x) >> 3), t1 = (int)(((long)n_tiles * (x + 1)) >> 3);
            const int Lx = i * per + jw; if (Lx >= (t1 - t0) * NT) return false; rt = t0 + Lx / NT; j = Lx % NT; }
        else { const int L = i * G + c; if (L >= n_tiles * NT) return false; rt = L / NT; j = L % NT; }
        const int te = tile_expert[rt], e = te & 0xffff;
        u.pm = rt; u.pn = e * NT + j; u.pc = j; u.half = te >> 16; return true;
    }
};

__device__ __forceinline__ unsigned cvt_pk_bf16(float lo, float hi) { return pk2(lo, hi); }

struct EpiBf16 {
    static constexpr bool PERM = true;
    bf16_t* O; int ldc;
    __device__ __forceinline__ void operator()(const f32x4 (&acc)[2][2][4][2], const Unit& u, int wr, int wc, int fr, int fq) const {
        const int row0 = u.pm * BM + wr * 64 + fr, col0 = u.pc * BM + wc * 32 + 8 * fq;
#pragma unroll
        for (int ai = 0; ai < 2; ++ai)
#pragma unroll
            for (int m = 0; m < 4; ++m) { bf16_t* rowp = O + (size_t)(row0 + ai * HALF + m * 16) * ldc + col0;
#pragma unroll
                for (int bj = 0; bj < 2; ++bj) { const f32x4 v0 = acc[ai][bj][m][0], v1 = acc[ai][bj][m][1];
                    u32x4 w; w.x = cvt_pk_bf16(v0[0], v0[1]); w.y = cvt_pk_bf16(v0[2], v0[3]); w.z = cvt_pk_bf16(v1[0], v1[1]); w.w = cvt_pk_bf16(v1[2], v1[3]);
                    *(u32x4*)(rowp + bj * HALF) = w; } }
    }
};
struct EpiFp8 {
    static constexpr bool PERM = true;
    unsigned char* O; int ldc;
    static __device__ __forceinline__ unsigned pk4(const f32x4 v) {
        const float a = __builtin_amdgcn_fmed3f(v[0], -448.f, 448.f), b = __builtin_amdgcn_fmed3f(v[1], -448.f, 448.f), c = __builtin_amdgcn_fmed3f(v[2], -448.f, 448.f), d = __builtin_amdgcn_fmed3f(v[3], -448.f, 448.f);
        int p = __builtin_amdgcn_cvt_pk_fp8_f32(a, b, 0, false); p = __builtin_amdgcn_cvt_pk_fp8_f32(c, d, p, true); return (unsigned)p; }
    __device__ __forceinline__ void operator()(const f32x4 (&acc)[2][2][4][2], const Unit& u, int wr, int wc, int fr, int fq) const {
        const int row0 = u.pm * BM + wr * 64 + fr, pos0 = u.pc * BM + wc * 64 + 16 * fq;
#pragma unroll
        for (int ai = 0; ai < 2; ++ai) { if (ai == 1 && u.half) break;
#pragma unroll
            for (int m = 0; m < 4; ++m) { u32x4 w; w.x = pk4(acc[ai][0][m][0]); w.y = pk4(acc[ai][0][m][1]); w.z = pk4(acc[ai][1][m][0]); w.w = pk4(acc[ai][1][m][1]);
                *(u32x4*)(O + (size_t)(row0 + ai * HALF + m * 16) * ldc + pos0) = w; } }
    }
};
struct EpiNone {
    static constexpr bool PERM = true;
    bf16_t* O;
    __device__ __forceinline__ void operator()(const f32x4 (&acc)[2][2][4][2], const Unit& u, int wr, int wc, int fr, int fq) const {
        float s = 0.f;
#pragma unroll
        for (int ai = 0; ai < 2; ++ai)
#pragma unroll
            for (int bj = 0; bj < 2; ++bj)
#pragma unroll
                for (int m = 0; m < 4; ++m)
#pragma unroll
                    for (int n = 0; n < 2; ++n) s += acc[ai][bj][m][n][0] + acc[ai][bj][m][n][1] + acc[ai][bj][m][n][2] + acc[ai][bj][m][n][3];
        if (s == 123.4567f) O[u.pm + wr + wc + fr + fq] = 1;
    }
};
struct EpiF32 {
    static constexpr bool PERM = false;
    float* C; int ldc;
    __device__ __forceinline__ void operator()(const f32x4 (&acc)[2][2][4][2], const Unit& u, int wr, int wc, int fr, int fq) const {
        const int row0 = u.pm * BM + wr * 64 + fr, col0 = u.pc * BM + wc * 32 + 4 * fq;
#pragma unroll
        for (int ai = 0; ai < 2; ++ai)
#pragma unroll
            for (int m = 0; m < 4; ++m) { float* rowp = C + (size_t)(row0 + ai * HALF + m * 16) * ldc + col0;
#pragma unroll
                for (int bj = 0; bj < 2; ++bj)
#pragma unroll
                    for (int n = 0; n < 2; ++n) *(f32x4*)(rowp + bj * HALF + n * 16) = acc[ai][bj][m][n]; }
    }
};
struct EpiResid {
    static constexpr bool PERM = false;
    const float* src_lat; float* dst_lat; const float* src_ctx; float* dst_ctx; const float* gate;
    __device__ __forceinline__ void operator()(const f32x4 (&acc)[2][2][4][2], const Unit& u, int wr, int wc, int fr, int fq) const {
        const int col0 = u.pc * BM + wc * 32 + 4 * fq;
        const float* src; float* dst; const float* gv; int row0;
        if (u.pm < 128) { row0 = u.pm * BM + wr * 64 + fr; src = src_lat; dst = dst_lat; gv = gate + (u.pm >> 6) * 6144 + 2048; }
        else { row0 = (u.pm - 128) * BM + wr * 64 + fr; src = src_ctx; dst = dst_ctx; gv = gate + 2 * 6144 + 2048; }
        f32x4 g[2][2];
#pragma unroll
        for (int bj = 0; bj < 2; ++bj)
#pragma unroll
            for (int n = 0; n < 2; ++n) g[bj][n] = *(const f32x4*)(gv + col0 + bj * HALF + n * 16);
#pragma unroll
        for (int ai = 0; ai < 2; ++ai)
#pragma unroll
            for (int m = 0; m < 4; ++m) { const size_t off = (size_t)(row0 + ai * HALF + m * 16) * 1024 + col0;
#pragma unroll
                for (int bj = 0; bj < 2; ++bj)
#pragma unroll
                    for (int n = 0; n < 2; ++n) { const f32x4 xv = *(const f32x4*)(src + off + bj * HALF + n * 16);
                        *(f32x4*)(dst + off + bj * HALF + n * 16) = xv + g[bj][n] * acc[ai][bj][m][n]; } }
    }
};
struct EpiSwiglu {
    static constexpr bool PERM = true;
    bf16_t* H;
    __device__ __forceinline__ void operator()(const f32x4 (&acc)[2][2][4][2], const Unit& u, int wr, int wc, int fr, int fq) const {
        const int row0 = u.pm * BM + wr * 64 + fr, col0 = u.pc * HALF + wc * 32 + 8 * fq;
#pragma unroll
        for (int ai = 0; ai < 2; ++ai) { if (ai == 1 && u.half) break;
#pragma unroll
            for (int m = 0; m < 4; ++m) { float h[8];
#pragma unroll
                for (int n = 0; n < 2; ++n)
#pragma unroll
                    for (int j = 0; j < 4; ++j) { const float g = acc[ai][0][m][n][j], up = acc[ai][1][m][n][j]; h[n * 4 + j] = g * __builtin_amdgcn_rcpf(1.f + __expf(-g)) * up; }
                u32x4 w; w.x = cvt_pk_bf16(h[0], h[1]); w.y = cvt_pk_bf16(h[2], h[3]); w.z = cvt_pk_bf16(h[4], h[5]); w.w = cvt_pk_bf16(h[6], h[7]);
                *(u32x4*)(H + (size_t)(row0 + ai * HALF + m * 16) * 256 + col0) = w; } }
    }
};

template <class Epi, class Sched, bool GATHER>
__device__ __forceinline__ void gemm_phase(LAS unsigned char* lds, const Gemm g, const Sched& S, const Epi& E, const int tid) {
    const int wid = __builtin_amdgcn_readfirstlane(tid >> 6), lane = tid & 63, wr = wid >> 2, wc = wid & 3, fr = lane & 15, fq = lane >> 4;
    const int K = g.K, nt = K / BK;
    int RA[2], CA[2]; unsigned voffB[2];
#pragma unroll
    for (int i = 0; i < 2; ++i) { int R, C; stage_rc(tid * 16 + i * 8192, R, C); const int Rb = Epi::PERM ? ((R & ~31) + perm32(R & 31)) : R;
        RA[i] = R; CA[i] = C; voffB[i] = (unsigned)(Rb * K + C) * 2u; }
    const unsigned kstep = (unsigned)(BK * 2);
    const unsigned hstep = (unsigned)HALF * (unsigned)K * 2u;
    const unsigned tstep = 2u * hstep;
    const unsigned ldsw = (unsigned)wid * 1024u;
    const int aoff = lds_byte(wr * 64 + fr, fq * 8), boff = lds_byte(wc * 32 + fr, fq * 8);
    const __amdgpu_buffer_rsrc_t srdA = __builtin_amdgcn_make_buffer_rsrc((void*)g.A, (short)0, 0x7fffffff, 0x00020000);
    const __amdgpu_buffer_rsrc_t srdB = __builtin_amdgcn_make_buffer_rsrc((void*)g.Bt, (short)0, 0x7fffffff, 0x00020000);
#define PG8_SA(b, h) (((b) * 2 + (h)) * HTB)
#define PG8_SB(b, h) ((4 + (b) * 2 + (h)) * HTB)
#define PG8_STAGE(bufoff, soff, voff) do { _Pragma("unroll") for (int _i = 0; _i < 2; ++_i) \
        __builtin_amdgcn_raw_ptr_buffer_load_lds(srdB, (LAS unsigned*)(lds + (bufoff) + ldsw + _i * 8192), 16, (int)(voff)[_i], (int)(soff), 0, 0); } while (0)
#define PG8_STAGE2(bufoff, soff, v0, v1) do { \
        __builtin_amdgcn_raw_ptr_buffer_load_lds(srdA, (LAS unsigned*)(lds + (bufoff) + ldsw), 16, (int)(v0), (int)(soff), 0, 0); \
        __builtin_amdgcn_raw_ptr_buffer_load_lds(srdA, (LAS unsigned*)(lds + (bufoff) + ldsw + 8192), 16, (int)(v1), (int)(soff), 0, 0); } while (0)
#define PG8_LDA(dst, b, h) do { _Pragma("unroll") for (int m = 0; m < 4; ++m) _Pragma("unroll") for (int k = 0; k < 2; ++k) dst[m][k] = *(const LAS bf16x8*)(lds + PG8_SA(b, h) + aoff + m * 2048 + k * 1024); } while (0)
#define PG8_LDB(dst, b, h) do { _Pragma("unroll") for (int n = 0; n < 2; ++n) _Pragma("unroll") for (int k = 0; k < 2; ++k) dst[n][k] = *(const LAS bf16x8*)(lds + PG8_SB(b, h) + boff + n * 2048 + k * 1024); } while (0)
#define PG8_MMA(ai, bj, At, Bt) do { __builtin_amdgcn_s_setprio(1); _Pragma("unroll") for (int m = 0; m < 4; ++m) _Pragma("unroll") for (int n = 0; n < 2; ++n) _Pragma("unroll") for (int k = 0; k < 2; ++k) \
        acc[ai][bj][m][n] = __builtin_amdgcn_mfma_f32_16x16x32_bf16(Bt[n][k], At[m][k], acc[ai][bj][m][n], 0, 0, 0); __builtin_amdgcn_s_setprio(0); } while (0)
#define PG8_WAIT_V(n) asm volatile("s_waitcnt vmcnt(" #n ")" ::: "memory")
#define PG8_WAIT_L(n) asm volatile("s_waitcnt lgkmcnt(" #n ")" ::: "memory")
#define PG8_BAR __builtin_amdgcn_s_barrier()
#define PG8_SCHED __builtin_amdgcn_sched_barrier(0)
    Unit cur, nxt; int ui = 0;
    if (!S.next(0, cur)) return;
    f32x4 acc[2][2][4][2];
#pragma unroll
    for (int a = 0; a < 2; ++a)
#pragma unroll
        for (int b = 0; b < 2; ++b)
#pragma unroll
            for (int m = 0; m < 4; ++m)
#pragma unroll
                for (int n = 0; n < 2; ++n) acc[a][b][m][n] = (f32x4){0.f, 0.f, 0.f, 0.f};
    bf16x8 At[4][2], B0[2][2], B1[2][2];
    unsigned c00, c01, c10, c11, n00, n01, n10, n11;
    unsigned cA, cB = (unsigned)cur.pn * tstep;
    if constexpr (GATHER) {
        const int* rp = g.rows + (size_t)cur.pm * BM; const unsigned rb = (unsigned)K * 2u;
        c00 = (unsigned)rp[RA[0]] * rb + (unsigned)CA[0] * 2u; c01 = (unsigned)rp[RA[1]] * rb + (unsigned)CA[1] * 2u;
        c10 = (unsigned)rp[HALF + RA[0]] * rb + (unsigned)CA[0] * 2u; c11 = (unsigned)rp[HALF + RA[1]] * rb + (unsigned)CA[1] * 2u;
        cA = 0u;
    } else {
        c00 = (unsigned)(RA[0] * K + CA[0]) * 2u; c01 = (unsigned)(RA[1] * K + CA[1]) * 2u;
        c10 = (unsigned)((HALF + RA[0]) * K + CA[0]) * 2u; c11 = (unsigned)((HALF + RA[1]) * K + CA[1]) * 2u;
        cA = (unsigned)cur.pm * tstep;
    }
    n00 = c00; n01 = c01; n10 = c10; n11 = c11;
    PG8_STAGE(PG8_SB(0, 0), cB, voffB); PG8_STAGE(PG8_SB(0, 1), cB + hstep, voffB); PG8_STAGE2(PG8_SA(0, 0), cA, c00, c01); PG8_STAGE2(PG8_SA(0, 1), cA, c10, c11);
    if (wr == 1) PG8_BAR;
    PG8_WAIT_V(2); PG8_BAR;
    PG8_STAGE(PG8_SB(1, 0), cB + kstep, voffB); PG8_STAGE2(PG8_SA(1, 0), cA + kstep, c00, c01); PG8_STAGE(PG8_SB(1, 1), cB + hstep + kstep, voffB);
    PG8_WAIT_V(6); PG8_BAR;
    for (;;) {
        const bool has_next = S.next(ui + 1, nxt);
        unsigned nA; const unsigned nB = has_next ? (unsigned)nxt.pn * tstep : cB;
        if constexpr (GATHER) {
            nA = 0u;
            if (has_next) { const int* rp = g.rows + (size_t)nxt.pm * BM; const unsigned rb = (unsigned)K * 2u;
                n00 = (unsigned)rp[RA[0]] * rb + (unsigned)CA[0] * 2u; n01 = (unsigned)rp[RA[1]] * rb + (unsigned)CA[1] * 2u;
                n10 = (unsigned)rp[HALF + RA[0]] * rb + (unsigned)CA[0] * 2u; n11 = (unsigned)rp[HALF + RA[1]] * rb + (unsigned)CA[1] * 2u; }
            else { n00 = c00; n01 = c01; n10 = c10; n11 = c11; }
        } else {
            nA = has_next ? (unsigned)nxt.pm * tstep : cA;
        }
        const bool hf = cur.half != 0;
#pragma unroll 1
        for (int t = 0; t < nt; t += 2) {
            const bool last = (t == nt - 2);
            const unsigned a1 = cA + (unsigned)(t + 1) * kstep;
            const unsigned a2 = last ? nA : cA + (unsigned)(t + 2) * kstep, b2 = last ? nB : cB + (unsigned)(t + 2) * kstep;
            const unsigned a3 = a2 + kstep, b3 = b2 + kstep;
            unsigned s00 = c00, s01 = c01, s10 = c10, s11 = c11;
            if constexpr (GATHER) { s00 = last ? n00 : c00; s01 = last ? n01 : c01; s10 = last ? n10 : c10; s11 = last ? n11 : c11; }
            PG8_LDB(B0, 0, 0); PG8_LDB(B1, 0, 1); PG8_SCHED; PG8_LDA(At, 0, 0); PG8_STAGE2(PG8_SA(1, 1), a1, c10, c11);
            PG8_WAIT_V(8); PG8_WAIT_L(0); PG8_BAR; PG8_MMA(0, 0, At, B0); PG8_MMA(0, 1, At, B1); PG8_BAR; PG8_SCHED;
            if (!hf) PG8_LDA(At, 0, 1); PG8_STAGE(PG8_SB(0, 0), b2, voffB); PG8_STAGE(PG8_SB(0, 1), b2 + hstep, voffB); PG8_STAGE2(PG8_SA(0, 0), a2, s00, s01);
            PG8_WAIT_V(8); PG8_WAIT_L(0); PG8_BAR; if (!hf) { PG8_MMA(1, 0, At, B0); PG8_MMA(1, 1, At, B1); } PG8_BAR; PG8_SCHED;
            PG8_LDB(B0, 1, 0); PG8_LDB(B1, 1, 1); PG8_SCHED; PG8_LDA(At, 1, 0); PG8_STAGE2(PG8_SA(0, 1), a2, s10, s11);
            PG8_WAIT_V(8); PG8_WAIT_L(0); PG8_BAR; PG8_MMA(0, 0, At, B0); PG8_MMA(0, 1, At, B1); PG8_BAR; PG8_SCHED;
            if (!hf) PG8_LDA(At, 1, 1); PG8_STAGE(PG8_SB(1, 0), b3, voffB); PG8_STAGE(PG8_SB(1, 1), b3 + hstep, voffB); PG8_STAGE2(PG8_SA(1, 0), a3, s00, s01);
            PG8_WAIT_V(8); PG8_WAIT_L(0); PG8_BAR; if (!hf) { PG8_MMA(1, 0, At, B0); PG8_MMA(1, 1, At, B1); } PG8_BAR; PG8_SCHED;
        }
        if (wr == 0) PG8_BAR;
        E(acc, cur, wr, wc, fr, fq);
        if (!has_next) break;
#pragma unroll
        for (int a = 0; a < 2; ++a)
#pragma unroll
            for (int b = 0; b < 2; ++b)
#pragma unroll
                for (int m = 0; m < 4; ++m)
#pragma unroll
                    for (int n = 0; n < 2; ++n) acc[a][b][m][n] = (f32x4){0.f, 0.f, 0.f, 0.f};
        cur = nxt; cA = nA; cB = nB; ++ui;
        if constexpr (GATHER) { c00 = n00; c01 = n01; c10 = n10; c11 = n11; }
        if (wr == 1) PG8_BAR;
    }
    PG8_WAIT_V(0);
    PG8_BAR;
#undef PG8_SA
#undef PG8_SB
#undef PG8_STAGE
#undef PG8_STAGE2
#undef PG8_LDA
#undef PG8_LDB
#undef PG8_MMA
#undef PG8_WAIT_V
#undef PG8_WAIT_L
#undef PG8_BAR
#undef PG8_SCHED
}
}

#define XB_TMO      128
#define XB_XCNT(j)  (256  + 64 * (j))
#define XB_XSUB(j)  (1280 + 64 * (j))
#define XB_XGEN(j)  (2304 + 64 * (j))
#define XB_TOP      3328
#define XB_TOPGEN   3392
#define XCD_BAR_WORDS 3456
#define XB_SPIN_CAP (1u << 18)

__device__ __forceinline__ unsigned xb_ld(unsigned* p)              { return __hip_atomic_load(p, __ATOMIC_RELAXED, __HIP_MEMORY_SCOPE_AGENT); }
__device__ __forceinline__ unsigned xb_add(unsigned* p, unsigned v) { return __hip_atomic_fetch_add(p, v, __ATOMIC_RELAXED, __HIP_MEMORY_SCOPE_AGENT); }
__device__ __forceinline__ unsigned xb_xcc_id() { return (unsigned)__builtin_amdgcn_s_getreg((3 << 11) | 20) & 0xFu; }
#define XB_SPIN(cond, bar) do { unsigned _sp = 0; while (cond) { __builtin_amdgcn_s_sleep(1); \
    if ((++_sp & 255u) == 0u) { if (xb_ld(&(bar)[XB_TMO])) break; if (_sp > XB_SPIN_CAP) { atomicAdd(&(bar)[XB_TMO], 1u); break; } } } } while (0)

struct XcdBarrier { unsigned* bar; unsigned x; volatile LAS unsigned* st; };

__device__ __forceinline__ XcdBarrier xcd_barrier_post(unsigned* bar, volatile LAS unsigned* st) {
    XcdBarrier b; b.bar = bar; b.x = xb_xcc_id(); b.st = st;
    if (threadIdx.x == 0) (void)xb_add(&bar[XB_XCNT(b.x)], 1u);
    return b;
}
__device__ __forceinline__ void xcd_barrier_complete(unsigned* bar, unsigned x, unsigned& nloc, unsigned& nx) {
    const unsigned G = gridDim.x * gridDim.y * gridDim.z;
    unsigned sum, cnt, mine, sp = 0u;
    for (;;) {
        sum = 0u; cnt = 0u; mine = 0u;
#pragma unroll 1
        for (unsigned j = 0; j < 16; ++j) { const unsigned c = xb_ld(&bar[XB_XCNT(j)]); sum += c; cnt += (c > 0u) ? 1u : 0u; mine = (j == x) ? c : mine; }
        if (sum == G) break;
        __builtin_amdgcn_s_sleep(1);
        if ((++sp & 255u) == 0u) { if (xb_ld(&bar[XB_TMO])) break; if (sp > XB_SPIN_CAP) { atomicAdd(&bar[XB_TMO], 1u); break; } }
    }
    nloc = mine > 0u ? mine : 1u; nx = cnt > 0u ? cnt : 1u;
}
__device__ __forceinline__ void xcd_barrier(const XcdBarrier& b) {
    asm volatile("s_waitcnt vmcnt(0)" ::: "memory");
    __syncthreads();
    if (threadIdx.x == 0) {
        unsigned* bar = b.bar;
        __builtin_amdgcn_s_waitcnt(0);
        unsigned nloc = b.st[0], nx = b.st[1];
        if (nloc == 0u) { xcd_barrier_complete(bar, b.x, nloc, nx); b.st[0] = nloc; b.st[1] = nx; }
        const unsigned old = xb_add(&bar[XB_XSUB(b.x)], 1u);
        const unsigned gen = old / nloc;
        if (old + 1u == (gen + 1u) * nloc) {
            __builtin_amdgcn_fence(__ATOMIC_RELEASE, "agent");
            asm volatile("s_waitcnt vmcnt(0)" ::: "memory");
            const unsigned og = xb_add(&bar[XB_TOP], 1u);
            const unsigned tg = og / nx;
            if (og + 1u == (tg + 1u) * nx) xb_add(&bar[XB_TOPGEN], 1u);
            else XB_SPIN(xb_ld(&bar[XB_TOPGEN]) == tg, bar);
            __builtin_amdgcn_fence(__ATOMIC_ACQUIRE, "agent");
            xb_add(&bar[XB_XGEN(b.x)], 1u);
            asm volatile("s_waitcnt vmcnt(0)" ::: "memory");
        } else {
            XB_SPIN(xb_ld(&bar[XB_XGEN(b.x)]) == gen, bar);
            __builtin_amdgcn_fence(__ATOMIC_ACQUIRE, "agent");
            asm volatile("s_waitcnt vmcnt(0)" ::: "memory");
        }
    }
    __syncthreads();
}

constexpr int D = 1024, NBATCH = 2, SEQ = 16384, CTXL = 256;
constexpr int TL = NBATCH * SEQ, TC = NBATCH * CTXL, TT = TL + TC;
constexpr int INW = 3328;
constexpr int ZQ = 0, ZFF = 512, ZFB = 1024, ZV = 1536, ZG = 2048, ZXB = 2560, ZYB = 2816, ZU = 3072;
constexpr int NEXP = 256, TOPK = 8;
constexpr float EPS = 1e-6f;
constexpr int NWAVES = 8, NTHR = 512;
constexpr int CV_TILES = 257 * 48;
constexpr int CV_OUTP = 248 * 6;
constexpr int CV_ROUT = 126 * 10;
constexpr int HG_SLOTS = 130;
constexpr int LR_SLOTS = 260;
constexpr int MAXROWS = 364800;

constexpr size_t MiB = 1u << 20;
constexpr size_t WS_CTL = 0, CTL_ZERO_BYTES = 1 * MiB;
constexpr size_t WS_MOD = 1 * MiB;
constexpr size_t WS_TAB = 2 * MiB;
constexpr size_t TAB_FC = 0, TAB_FS = 32768, TAB_CS = 65536, TAB_LB = 81920  , TAB_LRUW = 86016  , TAB_LRUCL = 348160  , TAB_C256 = 352256  , TAB_S256 = 483328  ;
constexpr size_t WS_META = 3 * MiB;
constexpr size_t WS_WIN = 4 * MiB;
constexpr size_t WS_WOUT = 18 * MiB;
constexpr size_t WS_WR = 22 * MiB;
constexpr size_t WS_XC = 24 * MiB;
constexpr size_t WS_LRUC = 26 * MiB;
constexpr size_t LRUC_STRIDE = (size_t)2 * 2 * LR_SLOTS * 256 * 4;
constexpr size_t WS_SEL = 30 * MiB;
constexpr size_t SEL_STRIDE = (size_t)TT * 8 * 4;
constexpr size_t WS_ROWTOK = 34 * MiB;
constexpr size_t WS_HD = 36 * MiB;
constexpr size_t WS_LOGIT = 38 * MiB;
constexpr size_t WS_HB = 72 * MiB;
constexpr size_t WS_WEXP = 138 * MiB;
constexpr size_t WEXP_GU_BYTES = (size_t)257 * 512 * 1024 * 2;
constexpr size_t WS_BIG = 524 * MiB;
constexpr size_t WS_Z = WS_BIG;
constexpr size_t WS_MIX = WS_BIG + 212 * MiB;
constexpr size_t WS_HS = WS_BIG + 278 * MiB;
constexpr size_t WS_FA = WS_BIG + 410 * MiB;
constexpr size_t WS_GE = WS_BIG + 442 * MiB;
constexpr size_t WS_GK = WS_BIG + 508 * MiB;
constexpr size_t WS_HV = WS_BIG + 574 * MiB;
constexpr size_t WS_HBUF = WS_BIG;
constexpr size_t WS_Y = WS_BIG + 180 * MiB;
constexpr size_t WS_WEXP1 = 1104 * MiB;
constexpr size_t WS_END = WS_WEXP1 + (size_t)257 * 1536 * 1024;
static_assert(WS_Y + (size_t)MAXROWS * 1024 <= WS_WEXP1 && WS_HV + (size_t)16 * 2 * HG_SLOTS * 256 * 4 <= WS_WEXP1 && WS_GK + (size_t)2 * TT * 512 * 2 <= WS_HV && WS_GE + (size_t)2 * TT * 512 * 2 <= WS_GK && WS_FA + (size_t)2 * 2 * 128 * 128 * 256 * 2 <= WS_GE, "overlay regions end below the second weight buffer");
static_assert(WS_Z + (size_t)TT * INW * 2 <= WS_MIX && WS_MIX + (size_t)TT * 1024 * 2 <= WS_HS && WS_HS + (size_t)16 * HG_SLOTS * 65536 <= WS_FA, "mixer overlay map");
static_assert(WS_HBUF + (size_t)MAXROWS * 256 * 2 <= WS_Y && WS_WEXP + (size_t)257 * 1536 * 1024 <= WS_BIG && WS_HB + (size_t)TT * 2048 <= WS_WEXP, "moe overlay map");
constexpr int CW_BAR = 4096;
constexpr int CW_CVQ = 8192;
constexpr int CW_CNT = 16384;

constexpr int LDS_BYTES = 151552;
constexpr int MISC_OFF = 150528;

struct Args { const float* in[28]; float* out; unsigned char* ws; int ph_lo, ph_hi; };

typedef const float* cfptr;
#define CAS __attribute__((address_space(4)))
struct Frame {
    LAS unsigned char* lds;
    int tid, lane, wave, G;
    const CAS cfptr* in;
    float* out; unsigned char* ws;
};
#define F_X(F)      ((F).in[0])
#define F_C(F)      ((F).in[1])
#define F_CTX(F)    ((F).in[2])
#define F_CCTX(F)   ((F).in[3])

__device__ __forceinline__ float wave_sum(float v) {
#pragma unroll
    for (int o = 1; o < 64; o <<= 1) v += __shfl_xor(v, o);
    return v;
}
__device__ __forceinline__ float sigmoidf_(float z) { return __builtin_amdgcn_rcpf(1.f + __expf(-z)); }

__device__ __forceinline__ void transpose_item(const float* W, int ldw, int k0, int n0, bf16* WT, int ldk, int drow0, LAS float* scr, int lane) {
#pragma unroll 8
    for (int i = 0; i < 32; ++i) { const int kk = 2 * i + (lane >> 5); scr[kk * 33 + (lane & 31)] = W[(size_t)(k0 + kk) * ldw + n0 + (lane & 31)]; }
    LDS_WAIT();
    const int c = lane & 7;
#pragma unroll
    for (int j = 0; j < 4; ++j) { const int n = (lane >> 3) + 8 * j; const LAS float* s = scr + (8 * c) * 33 + n;
        u32x4 o; o.x = pk2(s[0 * 33], s[1 * 33]); o.y = pk2(s[2 * 33], s[3 * 33]); o.z = pk2(s[4 * 33], s[5 * 33]); o.w = pk2(s[6 * 33], s[7 * 33]);
        *(u32x4*)(WT + (size_t)(drow0 + n) * ldk + k0 + 8 * c) = o; }
    LDS_WAIT();
}

__device__ __forceinline__ void norm_row_bf16(const float* xrow, const float* gain, const float* scl, const float* sft, bf16* orow, int lane) {
    f32x4 v[4]; float s = 0.f;
#pragma unroll
    for (int j = 0; j < 4; ++j) { v[j] = *(const f32x4*)(xrow + 4 * lane + 256 * j); s += (v[j].x * v[j].x + v[j].y * v[j].y) + (v[j].z * v[j].z + v[j].w * v[j].w); }
    const float rstd = rsqrtf(wave_sum(s) * (1.f / D) + EPS);
#pragma unroll
    for (int j = 0; j < 4; ++j) { const int c = 4 * lane + 256 * j;
        const f32x4 g = *(const f32x4*)(gain + c), sc = *(const f32x4*)(scl + c), sh = *(const f32x4*)(sft + c);
        const f32x4 y = v[j] * rstd * g * (sc + 1.f) + sh;
        u32x2 o; o.x = pk2(y.x, y.y); o.y = pk2(y.z, y.w); *(u32x2*)(orow + c) = o; }
}

__device__ __forceinline__ void convert_tile(Frame& F, const float* src, int ldw, bf16* dst, int ldk, int k0, int rowA, int rowB) {
    LAS bf16* T = (LAS bf16*)F.lds;
    const int tid = F.tid, w = F.wave, lane = F.lane;
    f32x4 v[8];
#pragma unroll
    for (int j = 0; j < 8; ++j) v[j] = *(const f32x4*)(src + (size_t)(8 * w + j) * ldw + 4 * lane);
#pragma unroll
    for (int j = 0; j < 8; ++j) { u32x2 o; o.x = pk2(v[j].x, v[j].y); o.y = pk2(v[j].z, v[j].w); *(LAS u32x2*)(T + (8 * w + j) * 264 + ((4 * lane) ^ (w << 3))) = o; }
    __syncthreads();
#pragma unroll
    for (int j = 0; j < 4; ++j) { const int p = tid + NTHR * j, kc = p & 7, n = p >> 3; const LAS bf16* t = T + (8 * kc) * 264 + (n ^ (kc << 3));
        u32x4 o; o.x = (unsigned)t[0] | ((unsigned)t[264] << 16); o.y = (unsigned)t[2 * 264] | ((unsigned)t[3 * 264] << 16);
        o.z = (unsigned)t[4 * 264] | ((unsigned)t[5 * 264] << 16); o.w = (unsigned)t[6 * 264] | ((unsigned)t[7 * 264] << 16);
        const int row = n < 128 ? rowA + n : rowB + n - 128;
        *(u32x4*)(dst + (size_t)row * ldk + k0 + 8 * kc) = o; }
    __syncthreads();
}

__device__ __forceinline__ void phase_g0(Frame& F) {
    float* mod = (float*)(F.ws + WS_MOD);
    {
        LAS float* sc = (LAS float*)F.lds; LAS float* red = sc + 3072;
        for (int u = blockIdx.x; u < 192; u += F.G) {
            const int l = u / 96, n0 = (u % 96) * 64;
            for (int i = F.tid; i < 3072; i += NTHR) { const int r = i >> 10, k = i & 1023; const float c = r < 2 ? F_C(F)[r * 1024 + k] : F_CCTX(F)[k]; sc[i] = c / (1.f + __expf(-c)); }
            __syncthreads();
            const int col = F.tid & 63, kg = F.tid >> 6;
            const float* W = F.in[4] + (size_t)l * 1024 * 6144 + n0 + col;
            float a0 = 0.f, a1 = 0.f, a2 = 0.f;
#pragma unroll 8
            for (int k = kg * 128; k < kg * 128 + 128; ++k) { const float w = W[(size_t)k * 6144]; a0 += sc[k] * w; a1 += sc[1024 + k] * w; a2 += sc[2048 + k] * w; }
            red[(kg * 3 + 0) * 64 + col] = a0; red[(kg * 3 + 1) * 64 + col] = a1; red[(kg * 3 + 2) * 64 + col] = a2;
            __syncthreads();
            if (F.tid < 192) { const int r = F.tid >> 6, cc = F.tid & 63; float s = F.in[5][l * 6144 + n0 + cc];
#pragma unroll
                for (int q = 0; q < 8; ++q) s += red[(q * 3 + r) * 64 + cc];
                mod[(l * 3 + r) * 6144 + n0 + cc] = s; }
            __syncthreads();
        }
    }
    {
        constexpr int PER_L = 16 * (13 + 4 + 1);
        for (int it = blockIdx.x; it < 2 * PER_L; it += F.G) {
            const int l = it / PER_L; int r = it % PER_L; const int kb = r / 18; r %= 18;
            if (r < 13) convert_tile(F, F.in[8] + (size_t)l * 1024 * INW + (size_t)(64 * kb) * INW + 256 * r, INW, (bf16*)(F.ws + WS_WIN) + (size_t)l * INW * 1024, 1024, 64 * kb, 256 * r, 256 * r + 128);
            else if (r < 17) convert_tile(F, F.in[18] + (size_t)l * 1024 * 1024 + (size_t)(64 * kb) * 1024 + 256 * (r - 13), 1024, (bf16*)(F.ws + WS_WOUT) + (size_t)l * 1024 * 1024, 1024, 64 * kb, 256 * (r - 13), 256 * (r - 13) + 128);
            else convert_tile(F, F.in[19] + (size_t)l * 1024 * 256 + (size_t)(64 * kb) * 256, 256, (bf16*)(F.ws + WS_WR) + (size_t)l * 256 * 1024, 1024, 64 * kb, 0, 128);
        }
    }
    {
        const int gt = blockIdx.x * NTHR + F.tid, NGT = F.G * NTHR;
        bf16* Fc = (bf16*)(F.ws + WS_TAB + TAB_FC); bf16* Fs = (bf16*)(F.ws + WS_TAB + TAB_FS); bf16* CS = (bf16*)(F.ws + WS_TAB + TAB_CS);
        for (int i = gt; i < 128 * 128; i += NGT) { const int k = i >> 7, n = i & 127; float s, c; sincospif((float)((k * n) & 127) * (1.f / 64.f), &s, &c); Fc[i] = f2bf(c); Fs[i] = f2bf(s); }
        for (int i = gt; i < 64 * 128; i += NGT) { const int m = i >> 7, kap = i & 127; float s, c; sincospif((float)((m * (kap & 63)) & 63) * (1.f / 32.f), &s, &c); CS[i] = f2bf(kap < 64 ? c : s); }
        bf16* C256 = (bf16*)(F.ws + WS_TAB + TAB_C256); bf16* S256 = (bf16*)(F.ws + WS_TAB + TAB_S256);
        for (int i = gt; i < 256 * 256; i += NGT) { const int k = i >> 8, n = i & 255; float sn, cs; sincospif((float)((k * n) & 255) * (1.f / 128.f), &sn, &cs); C256[i] = f2bf(cs); S256[i] = f2bf(-sn); }
        float* lb = (float*)(F.ws + WS_TAB + TAB_LB);
        for (int i = gt; i < 1024; i += NGT) { const int l = i >> 9, ch = i & 511; lb[i] = l == 0 ? 0.f : sigmoidf_(F.in[9][512 + ch] - F.in[9][ch]); }
        bf16* lw = (bf16*)(F.ws + WS_TAB + TAB_LRUW);
        for (int i = gt; i < 2 * 2 * 4 * 128 * 64; i += NGT) {
            const int k = i & 63, n = (i >> 6) & 127, ldh = i >> 13;
            const float v = n < 64 ? F.in[13][(size_t)ldh * 4096 + k * 64 + n] : F.in[15][(size_t)ldh * 4096 + k * 64 + (n - 64)];
            lw[i] = f2bf(v); }
        float* cl = (float*)(F.ws + WS_TAB + TAB_LRUCL);
        for (int i = gt; i < 1024; i += NGT) { const float lam = F.in[17][i]; const float sp = lam > 15.f ? __expf(-lam) : log1pf(__expf(-lam)); cl[i] = 8.f * sp; }
    }
}

__device__ __forceinline__ void hprep_rows(Frame& F, int l, const float* xlat, const float* xctx, int nrows, int voff_sh, int voff_sc, const float* gain) {
    const float* mod = (const float*)(F.ws + WS_MOD) + (size_t)l * 3 * 6144;
    bf16* HB = (bf16*)(F.ws + WS_HB);
    const int gw = blockIdx.x * NWAVES + F.wave, NGW = F.G * NWAVES;
    for (int m = gw; m < nrows; m += NGW) {
        const float* xr = m < TL ? xlat + (size_t)m * D : xctx + (size_t)(m - TL) * D; const int r = m < TL ? (m >> 14) : 2;
        norm_row_bf16(xr, gain, mod + r * 6144 + voff_sc, mod + r * 6144 + voff_sh, HB + (size_t)m * D, F.lane);
    }
}

__device__ __forceinline__ void cv_tile(Frame& F, int it_all) {
    const int l = it_all >= CV_TILES ? 1 : 0, it = it_all - l * CV_TILES;
    unsigned char* wb = F.ws + (l ? WS_WEXP1 : WS_WEXP);
    bf16* WGU = (bf16*)wb; bf16* WD = (bf16*)(wb + WEXP_GU_BYTES);
    const int e = it / 48, t = it % 48;
    if (t < 32) {
        const int mat = t >> 4, kb = t & 15;
        const float* src = (e < 256 ? (mat == 0 ? F.in[21] : F.in[22]) + ((size_t)l * 256 + e) * 1024 * 256 : (mat == 0 ? F.in[24] : F.in[25]) + (size_t)l * 1024 * 256) + (size_t)(64 * kb) * 256;
        convert_tile(F, src, 256, WGU, 1024, 64 * kb, e * 512 + mat * 128, e * 512 + 256 + mat * 128);
    } else {
        const int kb = (t - 32) >> 2, nb = (t - 32) & 3;
        const float* src = (e < 256 ? F.in[23] + ((size_t)l * 256 + e) * 256 * 1024 : F.in[26] + (size_t)l * 256 * 1024) + (size_t)(64 * kb) * 1024 + 256 * nb;
        convert_tile(F, src, 1024, WD, 256, 64 * kb, e * 1024 + 256 * nb, e * 1024 + 256 * nb + 128);
    }
}
__device__ __forceinline__ int cv_pull(Frame& F) {
    volatile LAS int* slot = (volatile LAS int*)(F.lds + MISC_OFF) + 16;
    if (F.tid == 0) { const unsigned t = __hip_atomic_fetch_add((unsigned*)(F.ws + WS_CTL) + CW_CVQ, 1u, __ATOMIC_RELAXED, __HIP_MEMORY_SCOPE_AGENT); slot[0] = t < (unsigned)(2 * CV_TILES) ? (int)t : -1; }
    __syncthreads(); const int t = slot[0]; __syncthreads(); return t;
}
__device__ __forceinline__ void convert_experts(Frame& F, int l) {
    for (;;) { const int t = cv_pull(F); if (t < 0) break; cv_tile(F, t); if (t >= (l + 1) * CV_TILES) break; }
}

__device__ __forceinline__ void xcd_barrier_cv(const XcdBarrier& b, Frame& F) {
    volatile LAS unsigned* st = (volatile LAS unsigned*)(F.lds + MISC_OFF) + 20;
    asm volatile("s_waitcnt vmcnt(0)" ::: "memory");
    __syncthreads();
    if (threadIdx.x == 0) {
        unsigned* bar = b.bar;
        __builtin_amdgcn_s_waitcnt(0);
        unsigned nloc = b.st[0], nx = b.st[1];
        if (nloc == 0u) { xcd_barrier_complete(bar, b.x, nloc, nx); b.st[0] = nloc; b.st[1] = nx; }
        const unsigned old = xb_add(&bar[XB_XSUB(b.x)], 1u);
        const unsigned gen = old / nloc;
        if (old + 1u == (gen + 1u) * nloc) {
            __builtin_amdgcn_fence(__ATOMIC_RELEASE, "agent");
            asm volatile("s_waitcnt vmcnt(0)" ::: "memory");
            const unsigned og = xb_add(&bar[XB_TOP], 1u);
            const unsigned tg = og / nx;
            if (og + 1u == (tg + 1u) * nx) xb_add(&bar[XB_TOPGEN], 1u);
            else XB_SPIN(xb_ld(&bar[XB_TOPGEN]) == tg, bar);
            __builtin_amdgcn_fence(__ATOMIC_ACQUIRE, "agent");
            xb_add(&bar[XB_XGEN(b.x)], 1u);
            asm volatile("s_waitcnt vmcnt(0)" ::: "memory");
            st[0] = 0u;
        } else { st[0] = 1u; st[1] = gen; }
        st[2] = 0u;
    }
    __syncthreads();
    if (st[0]) {
        unsigned spins = 0u;
        for (;;) {
            int tile = -1;
            if (threadIdx.x == 0) {
                unsigned rel = xb_ld(&b.bar[XB_XGEN(b.x)]) != st[1] ? 1u : 0u;
                if (!rel && (++spins & 255u) == 0u) { if (xb_ld(&b.bar[XB_TMO])) rel = 1u; else if (spins > XB_SPIN_CAP) { atomicAdd(&b.bar[XB_TMO], 1u); rel = 1u; } }
                st[2] = rel;
                if (!rel && st[3] == 0u) { const unsigned t = __hip_atomic_fetch_add((unsigned*)(F.ws + WS_CTL) + CW_CVQ, 1u, __ATOMIC_RELAXED, __HIP_MEMORY_SCOPE_AGENT);
                    if (t < (unsigned)(2 * CV_TILES)) tile = (int)t; else st[3] = 1u; }
                st[4] = (unsigned)tile;
            }
            __syncthreads();
            const unsigned rel = st[2]; tile = (int)st[4];
            __syncthreads();
            if (rel) break;
            if (tile >= 0) cv_tile(F, tile); else __builtin_amdgcn_s_sleep(2);
        }
        if (threadIdx.x == 0) {
            st[3] = 0u;
            __builtin_amdgcn_fence(__ATOMIC_ACQUIRE, "agent");
            asm volatile("s_waitcnt vmcnt(0)" ::: "memory");
        }
    }
    __syncthreads();
}

constexpr int QS = 144, TS = 80;
constexpr int HG_QT = 0, HG_KT = 18432, HG_KTT = 36864, HG_VT = 57344, HG_SMT = 77824, HG_PM = 114688, HG_TOT = 124928, HG_BMID = 126976, HG_BEND = 127488, HG_RSS = 128000, HG_VR = 132096;
static_assert(HG_VR + 64 * QS * 2 <= MISC_OFF, "HGRN2 LDS map");

__device__ __forceinline__ float fast_rcp(float x) { return __builtin_amdgcn_rcpf(x); }
__device__ __forceinline__ f32x4 hg_ld4(const bf16* p) { const u32x2 v = *(const u32x2*)p;
    return (f32x4){__builtin_bit_cast(float, v.x << 16), __builtin_bit_cast(float, v.x & 0xffff0000u), __builtin_bit_cast(float, v.y << 16), __builtin_bit_cast(float, v.y & 0xffff0000u)}; }


template <int VAR>
__device__ __forceinline__ void hg_chunk_c1(Frame& F, const bf16* Zc, bf16* gq, bf16* gk, float* hv, const bf16* nz, const bf16* nq, const bool has_next, u32x4 (&zq)[4], int h, int rev, const float* lbp, f32x4 (&S)[8], float& dtot) {
    LAS bf16* Qt = (LAS bf16*)(F.lds + HG_QT); LAS bf16* Kt = (LAS bf16*)(F.lds + HG_KT); LAS bf16* KtT = (LAS bf16*)(F.lds + HG_KTT);
    LAS bf16* VT = (LAS bf16*)(F.lds + HG_VT); LAS bf16* Vr = (LAS bf16*)(F.lds + HG_VR);
    LAS float* tot = (LAS float*)(F.lds + HG_TOT); LAS float* bmid = (LAS float*)(F.lds + HG_BMID); LAS float* bend = (LAS float*)(F.lds + HG_BEND);
    LAS float* ebuf = (LAS float*)(F.lds + HG_RSS);
    const int tid = F.tid, lane = F.lane, w = F.wave, li = lane & 15, lq = lane >> 4;
    u32x4 vv[2];
#pragma unroll
    for (int j = 0; j < 2; ++j) { const int p = tid + NTHR * j, row = p >> 4, c16 = p & 15;
        vv[j] = *(const u32x4*)(Zc + (size_t)row * INW + ZV + h * 128 + 8 * c16);
        *(LAS u32x4*)(Kt + row * QS + 8 * c16) = zq[j]; *(LAS u32x4*)(Qt + row * QS + 8 * c16) = zq[2 + j]; }
    LDS_BARRIER();
    const int ch = tid & 127, tq = tid >> 7;
    const float lbv = lbp[h * 128 + ch], oml = 1.f - lbv;
    float cb[16];
#pragma unroll
    for (int i = 0; i < 16; ++i) { float z = bf2f(Kt[(16 * tq + i) * QS + ch]); z = fminf(fmaxf(z, -30.f), 30.f);
        if (VAR & 1) cb[i] = z * -0.01f; else { const float e = __expf(-z), sg = fast_rcp(1.f + e); cb[i] = __logf(lbv + oml * sg);
            Kt[(16 * tq + i) * QS + ch] = f2bf(oml * e * sg); } }
    if (tq == 2) bmid[ch] = cb[0];
    float run = 0.f;
    if (!rev) {
#pragma unroll
        for (int i = 0; i < 16; ++i) { run += cb[i]; cb[i] = run; }
    } else {
#pragma unroll
        for (int i = 15; i >= 0; --i) { run += cb[i]; cb[i] = run; }
    }
    tot[tq * 128 + ch] = run;
#pragma unroll
    for (int j = 0; j < 2; ++j) { const int p = tid + NTHR * j, row = p >> 4, c16 = p & 15; *(LAS u32x4*)(Vr + row * QS + 8 * c16) = vv[j]; }
    LDS_BARRIER();
    float bm, total;
    {
        const float t0 = tot[ch], t1 = tot[128 + ch], t2 = tot[256 + ch], t3 = tot[384 + ch];
        const float off = !rev ? ((tq > 0 ? t0 : 0.f) + (tq > 1 ? t1 : 0.f) + (tq > 2 ? t2 : 0.f)) : ((tq < 3 ? t3 : 0.f) + (tq < 2 ? t2 : 0.f) + (tq < 1 ? t1 : 0.f));
#pragma unroll
        for (int i = 0; i < 16; ++i) cb[i] += off;
        total = (t0 + t1) + (t2 + t3);
        bm = !rev ? (t0 + t1) + bmid[ch] : (t2 + t3);
        if (tq == 0) dtot += total;
    }
    if (!(VAR & 2)) {
        unsigned kp[8], vp[8];
#pragma unroll
        for (int i = 0; i < 16; ++i) { const float d = fminf(fmaxf(cb[i] - bm, -80.f), 80.f);
            const float ed = __expf(d);
            Qt[(16 * tq + i) * QS + ch] = f2bf(bf2f(Qt[(16 * tq + i) * QS + ch]) * ed);
            const unsigned kb = f2bfu(bf2f(Kt[(16 * tq + i) * QS + ch]) * fast_rcp(ed)); Kt[(16 * tq + i) * QS + ch] = (bf16)kb;
            const unsigned vb = Vr[(16 * tq + i) * QS + ch];
            if (i & 1) { kp[i >> 1] |= kb << 16; vp[i >> 1] |= vb << 16; } else { kp[i >> 1] = kb; vp[i >> 1] = vb; } }
        *(LAS u32x4*)(KtT + ch * TS + 16 * tq) = (u32x4){kp[0], kp[1], kp[2], kp[3]};
        *(LAS u32x4*)(KtT + ch * TS + 16 * tq + 8) = (u32x4){kp[4], kp[5], kp[6], kp[7]};
        *(LAS u32x4*)(VT + ch * TS + 16 * tq) = (u32x4){vp[0], vp[1], vp[2], vp[3]};
        *(LAS u32x4*)(VT + ch * TS + 16 * tq + 8) = (u32x4){vp[4], vp[5], vp[6], vp[7]};
        if (tid < 128) { const float e1 = __expf(bm), e2 = __expf(total - bm); hv[tid] = e1; hv[128 + tid] = e2; ebuf[tid] = e1; ebuf[128 + tid] = e2; }
    }
    if (has_next) {
#pragma unroll
        for (int j = 0; j < 2; ++j) { const int p = tid + NTHR * j, row = p >> 4, c16 = p & 15;
            zq[j] = *(const u32x4*)(nz + (size_t)row * INW + 8 * c16); zq[2 + j] = *(const u32x4*)(nq + (size_t)row * INW + 8 * c16); }
    }
    LDS_BARRIER();
    if (!(VAR & 4))
#pragma unroll
    for (int j = 0; j < 2; ++j) { const int p = tid + NTHR * j, row = p >> 4, c16 = p & 15;
        *(u32x4*)(gq + (size_t)row * 512 + 8 * c16) = *(const LAS u32x4*)(Qt + row * QS + 8 * c16);
        *(u32x4*)(gk + (size_t)row * 512 + 8 * c16) = *(const LAS u32x4*)(Kt + row * QS + 8 * c16); }
    if (!(VAR & 8)) {
#pragma unroll
    for (int i = 0; i < 8; ++i) S[i] = S[i] * *(const LAS f32x4*)(ebuf + 16 * i + 4 * lq);
    bf16x8 bv[2];
#pragma unroll
    for (int ks = 0; ks < 2; ++ks) bv[ks] = *(const LAS bf16x8*)(VT + (16 * w + li) * TS + 32 * ks + 8 * lq);
    bf16x8 ak[2][2];
#pragma unroll
    for (int ks = 0; ks < 2; ++ks) ak[0][ks] = *(const LAS bf16x8*)(KtT + li * TS + 32 * ks + 8 * lq);
#pragma unroll
    for (int i = 0; i < 8; ++i) { const int cb_ = i & 1;
        if (i < 7) {
#pragma unroll
            for (int ks = 0; ks < 2; ++ks) ak[cb_ ^ 1][ks] = *(const LAS bf16x8*)(KtT + (16 * (i + 1) + li) * TS + 32 * ks + 8 * lq); }
        __builtin_amdgcn_sched_barrier(0);
#pragma unroll
        for (int ks = 0; ks < 2; ++ks) S[i] = MFMA16(ak[cb_][ks], bv[ks], S[i]);
        S[i] = S[i] * *(const LAS f32x4*)(ebuf + 128 + 16 * i + 4 * lq); }
    }
    LDS_BARRIER();
}

struct HgPtrs { const bf16* q; const bf16* k; const bf16* v; const float* hv; };
__device__ __forceinline__ void hg_load6(const HgPtrs& P, int tid, u32x4 (&pre)[7]) {
    pre[6] = *(const u32x4*)(P.hv + 4 * (tid & 63));
#pragma unroll
    for (int j = 0; j < 2; ++j) { const int p = tid + NTHR * j, row = p >> 4, c16 = p & 15;
        pre[j] = *(const u32x4*)(P.q + (size_t)row * 512 + 8 * c16); pre[2 + j] = *(const u32x4*)(P.k + (size_t)row * 512 + 8 * c16); pre[4 + j] = *(const u32x4*)(P.v + (size_t)row * INW + 8 * c16); }
}
template <int VAR>
__device__ __forceinline__ void hg_chunk_c3(Frame& F, const u32x4 (&cur)[7], int rev, f32x4 (&S)[8], f32x4 (&O)[4], bool do_state, const bf16* Snext) {
    LAS bf16* Qt = (LAS bf16*)(F.lds + HG_QT); LAS bf16* Kt = (LAS bf16*)(F.lds + HG_KT); LAS bf16* KtT = (LAS bf16*)(F.lds + HG_KTT);
    LAS bf16* VT = (LAS bf16*)(F.lds + HG_VT); LAS bf16* SmT = (LAS bf16*)(F.lds + HG_SMT); LAS bf16* Pm = (LAS bf16*)(F.lds + HG_PM); LAS bf16* Vr = (LAS bf16*)(F.lds + HG_VR);
    const int tid = F.tid, lane = F.lane, w = F.wave, li = lane & 15, lq = lane >> 4;
#pragma unroll
    for (int j = 0; j < 2; ++j) { const int p = tid + NTHR * j, row = p >> 4, c16 = p & 15;
        *(LAS u32x4*)(Qt + row * QS + 8 * c16) = cur[j]; *(LAS u32x4*)(Kt + row * QS + 8 * c16) = cur[2 + j]; *(LAS u32x4*)(Vr + row * QS + 8 * c16) = cur[4 + j]; }
    LAS float* ebuf = (LAS float*)(F.lds + HG_BMID);
    if (tid < 64) *(LAS u32x4*)(ebuf + 4 * tid) = cur[6];
    LDS_BARRIER();
    if (!(VAR & 2)) {
        const int ch = tid & 127, tq = tid >> 7; unsigned kp[8], vp[8];
#pragma unroll
        for (int i = 0; i < 16; ++i) { const unsigned vb = Vr[(16 * tq + i) * QS + ch], kb = do_state ? (unsigned)Kt[(16 * tq + i) * QS + ch] : 0u;
            if (i & 1) { kp[i >> 1] |= kb << 16; vp[i >> 1] |= vb << 16; } else { kp[i >> 1] = kb; vp[i >> 1] = vb; } }
        *(LAS u32x4*)(VT + ch * TS + 16 * tq) = (u32x4){vp[0], vp[1], vp[2], vp[3]};
        *(LAS u32x4*)(VT + ch * TS + 16 * tq + 8) = (u32x4){vp[4], vp[5], vp[6], vp[7]};
        if (do_state) { *(LAS u32x4*)(KtT + ch * TS + 16 * tq) = (u32x4){kp[0], kp[1], kp[2], kp[3]}; *(LAS u32x4*)(KtT + ch * TS + 16 * tq + 8) = (u32x4){kp[4], kp[5], kp[6], kp[7]}; }
    }
#pragma unroll
    for (int i = 0; i < 8; ++i) { S[i] = S[i] * *(const LAS f32x4*)(ebuf + 16 * i + 4 * lq);
        u32x2 o; o.x = pk2(S[i].x, S[i].y); o.y = pk2(S[i].z, S[i].w); *(LAS u32x2*)(SmT + (16 * w + li) * QS + 16 * i + 4 * lq) = o; }
    if (Snext) {
#pragma unroll
        for (int i = 0; i < 8; ++i) S[i] = hg_ld4(Snext + (16 * w + li) * 128 + 16 * i + 4 * lq);
    }
    if (!(VAR & 4)) {
        const int tt = w >> 1;
        bf16x8 aq[4];
#pragma unroll
        for (int ks = 0; ks < 4; ++ks) aq[ks] = *(const LAS bf16x8*)(Qt + (16 * tt + li) * QS + 32 * ks + 8 * lq);
#pragma unroll
        for (int sj = 0; sj < 2; ++sj) { const int st = 2 * (w & 1) + sj; f32x4 acc = {0.f, 0.f, 0.f, 0.f};
#pragma unroll
            for (int ks = 0; ks < 4; ++ks) acc = MFMA16(aq[ks], *(const LAS bf16x8*)(Kt + (16 * st + li) * QS + 32 * ks + 8 * lq), acc);
#pragma unroll
            for (int r = 0; r < 4; ++r) { const int t = 16 * tt + 4 * lq + r, s = 16 * st + li; const bool keep = rev ? (s >= t) : (s <= t);
                Pm[t * TS + s] = f2bf(keep ? acc[r] : 0.f); } }
    }
    LDS_BARRIER();
    if (!(VAR & 8)) {
    bf16x8 bs[4], bv[2];
#pragma unroll
    for (int ks = 0; ks < 4; ++ks) bs[ks] = *(const LAS bf16x8*)(SmT + (16 * w + li) * QS + 32 * ks + 8 * lq);
#pragma unroll
    for (int ks = 0; ks < 2; ++ks) bv[ks] = *(const LAS bf16x8*)(VT + (16 * w + li) * TS + 32 * ks + 8 * lq);
    {
        bf16x8 aq[2][4], ap[2][2];
#pragma unroll
        for (int ks = 0; ks < 4; ++ks) aq[0][ks] = *(const LAS bf16x8*)(Qt + li * QS + 32 * ks + 8 * lq);
#pragma unroll
        for (int ks = 0; ks < 2; ++ks) ap[0][ks] = *(const LAS bf16x8*)(Pm + li * TS + 32 * ks + 8 * lq);
#pragma unroll
        for (int mt = 0; mt < 4; ++mt) { const int cb_ = mt & 1;
            if (mt < 3) {
#pragma unroll
                for (int ks = 0; ks < 4; ++ks) aq[cb_ ^ 1][ks] = *(const LAS bf16x8*)(Qt + (16 * (mt + 1) + li) * QS + 32 * ks + 8 * lq);
#pragma unroll
                for (int ks = 0; ks < 2; ++ks) ap[cb_ ^ 1][ks] = *(const LAS bf16x8*)(Pm + (16 * (mt + 1) + li) * TS + 32 * ks + 8 * lq); }
            __builtin_amdgcn_sched_barrier(0);
#pragma unroll
            for (int ks = 0; ks < 4; ++ks) O[mt] = MFMA16(aq[cb_][ks], bs[ks], O[mt]);
#pragma unroll
            for (int ks = 0; ks < 2; ++ks) O[mt] = MFMA16(ap[cb_][ks], bv[ks], O[mt]);
        }
    }
    __builtin_amdgcn_sched_barrier(0);
    if (do_state) {
        bf16x8 ak[2][2];
#pragma unroll
        for (int ks = 0; ks < 2; ++ks) ak[0][ks] = *(const LAS bf16x8*)(KtT + li * TS + 32 * ks + 8 * lq);
#pragma unroll
        for (int i = 0; i < 8; ++i) { const int cb_ = i & 1;
            if (i < 7) {
#pragma unroll
                for (int ks = 0; ks < 2; ++ks) ak[cb_ ^ 1][ks] = *(const LAS bf16x8*)(KtT + (16 * (i + 1) + li) * TS + 32 * ks + 8 * lq); }
            __builtin_amdgcn_sched_barrier(0);
#pragma unroll
            for (int ks = 0; ks < 2; ++ks) S[i] = MFMA16(ak[cb_][ks], bv[ks], S[i]);
            S[i] = S[i] * *(const LAS f32x4*)(ebuf + 128 + 16 * i + 4 * lq); }
    }
    }
    LDS_BARRIER();
}

__device__ __forceinline__ int hg_rowbase(int b, int slot) { return slot < 2 ? TL + b * CTXL + slot * 128 : b * SEQ + (slot - 2) * 128; }

template <int VAR>
__device__ __forceinline__ void hgrn2_c1(Frame& F, int l, int u0, int nunits, int G) {
    const bf16* Z = (const bf16*)(F.ws + WS_Z); const float* lbp = (const float*)(F.ws + WS_TAB + TAB_LB) + l * 512;
    bf16* GQ = (bf16*)(F.ws + WS_GE); bf16* GK = (bf16*)(F.ws + WS_GK); float* HV = (float*)(F.ws + WS_HV);
    if (u0 >= nunits) return;
    u32x4 zq[4];
    {   const int chain = u0 / HG_SLOTS, slot = u0 % HG_SLOTS, dir = chain & 1, b = chain >> 3, h = (chain >> 1) & 3;
        const bf16* zp = Z + (size_t)(hg_rowbase(b, slot) + (dir ? 64 : 0)) * INW;
#pragma unroll
        for (int j = 0; j < 2; ++j) { const int p = F.tid + NTHR * j, row = p >> 4, c16 = p & 15;
            zq[j] = *(const u32x4*)(zp + (size_t)row * INW + (dir ? ZFB : ZFF) + h * 128 + 8 * c16); zq[2 + j] = *(const u32x4*)(zp + (size_t)row * INW + ZQ + h * 128 + 8 * c16); } }
#pragma unroll 1
    for (int u = u0; u < nunits; u += G) {
        const int chain = u / HG_SLOTS, slot = u % HG_SLOTS, dir = chain & 1, b = chain >> 3, h = (chain >> 1) & 3;
        const int row0 = hg_rowbase(b, slot), zcol = (dir ? ZFB : ZFF) + h * 128;
        const int un = u + G; const bool has_nu = un < nunits;
        const int nchain = un / HG_SLOTS, nslot = un % HG_SLOTS, ndir = nchain & 1, nb = nchain >> 3, nh = (nchain >> 1) & 3;
        const bf16* nup = Z + (size_t)(hg_rowbase(nb, nslot) + (ndir ? 64 : 0)) * INW;
        f32x4 S[8]; float dtot = 0.f;
#pragma unroll
        for (int i = 0; i < 8; ++i) S[i] = (f32x4){0.f, 0.f, 0.f, 0.f};
#pragma unroll 1
        for (int step = 0; step < 2; ++step) { const int c = dir ? 1 - step : step; const size_t rowc = (size_t)(row0 + 64 * c);
            const bf16* nrow = step == 0 ? Z + (size_t)(row0 + 64 * (1 - c)) * INW : nup;
            const bf16* nz = nrow + (step == 0 ? zcol : (ndir ? ZFB : ZFF) + nh * 128); const bf16* nq = nrow + ZQ + (step == 0 ? h : nh) * 128;
            hg_chunk_c1<VAR>(F, Z + rowc * INW, GQ + ((size_t)dir * TT + rowc) * 512 + h * 128, GK + ((size_t)dir * TT + rowc) * 512 + h * 128,
                        HV + ((size_t)chain * (2 * HG_SLOTS) + slot * 2 + c) * 256, nz, nq, step == 0 || has_nu, zq, h, dir, lbp, S, dtot); }
        bf16* HS = (bf16*)(F.ws + WS_HS) + ((size_t)chain * HG_SLOTS + slot) * 16384;
        const int li = F.lane & 15, lq = F.lane >> 4, v = 16 * F.wave + li;
#pragma unroll
        for (int i = 0; i < 8; ++i) { u32x2 o; o.x = pk2(S[i].x, S[i].y); o.y = pk2(S[i].z, S[i].w); *(u32x2*)(HS + v * 128 + 16 * i + 4 * lq) = o; }
        if (F.tid < 128) ((float*)(F.ws + WS_HD))[((size_t)chain * HG_SLOTS + slot) * 128 + F.tid] = __expf(dtot);
    }
}

__device__ __forceinline__ void hgrn2_c2(Frame& F) {
    bf16* HS = (bf16*)(F.ws + WS_HS); const float* HD = (const float*)(F.ws + WS_HD);
    for (int task = blockIdx.x * NTHR + F.tid; task < 16 * 8192; task += F.G * NTHR) {
        const int chain = task >> 13, e2 = task & 8191, dir = chain & 1, ch2 = (e2 & 63) * 2;
        f32x2 run = {0.f, 0.f};
#pragma unroll 5
        for (int k = 0; k < HG_SLOTS; ++k) {
            const int slot = dir ? (k < 2 ? 1 - k : 131 - k) : k;
            unsigned* p = (unsigned*)(HS + ((size_t)chain * HG_SLOTS + slot) * 16384 + e2 * 2);
            const unsigned t2 = *p; const f32x2 tmp = {__builtin_bit_cast(float, t2 << 16), __builtin_bit_cast(float, t2 & 0xffff0000u)}, d = *(const f32x2*)(HD + ((size_t)chain * HG_SLOTS + slot) * 128 + ch2);
            *p = pk2(run.x, run.y); run = d * run + tmp;
        }
    }
}

template <int VAR>
__device__ __forceinline__ void hgrn2_c3(Frame& F, int l, int bh, int slot) {
    const int b = bh >> 2, h = bh & 3;
    const bf16* Z = (const bf16*)(F.ws + WS_Z);
    const bf16* GQ = (const bf16*)(F.ws + WS_GE); const bf16* GK = (const bf16*)(F.ws + WS_GK); const float* HV = (const float*)(F.ws + WS_HV);
    bf16* MIX = (bf16*)(F.ws + WS_MIX);
    const int row0 = hg_rowbase(b, slot);
    const int tid = F.tid, lane = F.lane, w = F.wave, li = lane & 15, lq = lane >> 4, v = 16 * w + li;
    u32x4 pa[7], pb[7];
    const float* HVf = HV + ((size_t)(bh * 2 + 0) * (2 * HG_SLOTS) + slot * 2) * 256; const float* HVb = HV + ((size_t)(bh * 2 + 1) * (2 * HG_SLOTS) + slot * 2) * 256;
    {   const size_t r0 = (size_t)row0, r1 = (size_t)(row0 + 64);
        HgPtrs P0{GQ + r0 * 512 + h * 128, GK + r0 * 512 + h * 128, Z + r0 * INW + ZV + h * 128, HVf};
        HgPtrs P1{GQ + r1 * 512 + h * 128, GK + r1 * 512 + h * 128, Z + r1 * INW + ZV + h * 128, HVf + 256};
        hg_load6(P0, tid, pa); hg_load6(P1, tid, pb); }
    if (tid < 32) *(LAS f32x4*)((LAS float*)(F.lds + HG_RSS) + 4 * tid) = *(const f32x4*)(F.in[10] + l * 128 + 4 * tid);
    f32x4 S[8];
    const bf16* HSb = (const bf16*)(F.ws + WS_HS) + ((size_t)(bh * 2 + 1) * HG_SLOTS + slot) * 16384;
    {   const bf16* HSf = (const bf16*)(F.ws + WS_HS) + ((size_t)(bh * 2 + 0) * HG_SLOTS + slot) * 16384;
#pragma unroll
        for (int i = 0; i < 8; ++i) S[i] = hg_ld4(HSf + v * 128 + 16 * i + 4 * lq); }
    f32x4 O[2][4];
#pragma unroll
    for (int c = 0; c < 2; ++c)
#pragma unroll
        for (int mt = 0; mt < 4; ++mt) O[c][mt] = (f32x4){0.f, 0.f, 0.f, 0.f};
#pragma unroll 1
    for (int st = 0; st < 4; ++st) {
        const int dir = st >> 1, c = (st == 1 || st == 2) ? 1 : 0;
        u32x4 cur[7];
#pragma unroll
        for (int j = 0; j < 7; ++j) { cur[j] = pa[j]; pa[j] = pb[j]; }
        if ((VAR & 1)) { } else if (st < 2) {
            const size_t rn = (size_t)(row0 + (st == 0 ? 64 : 0));
            HgPtrs Pn{GQ + ((size_t)TT + rn) * 512 + h * 128, GK + ((size_t)TT + rn) * 512 + h * 128, Z + rn * INW + ZV + h * 128, HVb + (st == 0 ? 256 : 0)};
            hg_load6(Pn, tid, pb);
        } else if (st == 2) {
#pragma unroll
            for (int j = 0; j < 4; ++j) pb[j] = *(const u32x4*)(Z + (size_t)(row0 + (tid >> 2)) * INW + ZG + h * 128 + 32 * (tid & 3) + 8 * j);
        }
        hg_chunk_c3<VAR>(F, cur, dir, S, O[0], (st & 1) == 0, st == 1 ? HSb : nullptr);
        if ((st & 1) == 0) {
#pragma unroll
            for (int mt = 0; mt < 4; ++mt) { const f32x4 t = O[0][mt]; O[0][mt] = O[1][mt]; O[1][mt] = t; }
        }
    }
    if (VAR & 16) { if (O[0][0][0] == 123.456f && O[1][3][2] == 1.f && S[0][0] == 2.f) MIX[0] = 1; return; }
    LAS float* Ot = (LAS float*)F.lds;
#pragma unroll
    for (int c = 0; c < 2; ++c)
#pragma unroll
        for (int mt = 0; mt < 4; ++mt)
#pragma unroll
            for (int r = 0; r < 4; ++r) Ot[(64 * c + 16 * mt + 4 * lq + r) * 132 + v] = O[c][mt][r];
    LDS_BARRIER();
    {   const int t = tid >> 2, v0 = 32 * (tid & 3);
        f32x4 x[8]; float ss = 0.f;
#pragma unroll
        for (int j = 0; j < 8; ++j) { x[j] = *(const LAS f32x4*)(Ot + t * 132 + v0 + 4 * j); ss += (x[j].x * x[j].x + x[j].y * x[j].y) + (x[j].z * x[j].z + x[j].w * x[j].w); }
        ss += __shfl_xor(ss, 1); ss += __shfl_xor(ss, 2);
        const float rs = rsqrtf(ss * (1.f / 128.f) + EPS);
        const LAS float* gain = (const LAS float*)(F.lds + HG_RSS) + v0;
#pragma unroll
        for (int k = 0; k < 4; ++k) { const u32x4 gq = pb[k]; const f32x4 g0 = *(const LAS f32x4*)(gain + 8 * k), g1 = *(const LAS f32x4*)(gain + 8 * k + 4);
            float o[8];
#pragma unroll
            for (int e = 0; e < 4; ++e) { const unsigned gw = e == 0 ? gq.x : e == 1 ? gq.y : e == 2 ? gq.z : gq.w;
                const float ga = __builtin_bit_cast(float, gw << 16), gb = __builtin_bit_cast(float, gw & 0xffff0000u);
                const float xa = e < 2 ? x[2 * k][2 * e] : x[2 * k + 1][2 * e - 4], xb = e < 2 ? x[2 * k][2 * e + 1] : x[2 * k + 1][2 * e - 3];
                const float na = e < 2 ? g0[2 * e] : g1[2 * e - 4], nb = e < 2 ? g0[2 * e + 1] : g1[2 * e - 3];
                o[2 * e] = xa * rs * na * ga * fast_rcp(1.f + __expf(-ga)); o[2 * e + 1] = xb * rs * nb * gb * fast_rcp(1.f + __expf(-gb)); }
            *(u32x4*)(MIX + (size_t)(row0 + t) * 1024 + h * 128 + v0 + 8 * k) = (u32x4){pk2(o[0], o[1]), pk2(o[2], o[3]), pk2(o[4], o[5]), pk2(o[6], o[7])}; }
    }
    LDS_BARRIER();
}

constexpr int LR_XR = 0, LR_XB = 35376, LR_HS = 69632;

__device__ __forceinline__ int lru_row(bool isctx, int b, int p) { return isctx ? TL + b * CTXL + p : b * SEQ + ((p & 255) << 6) + (p >> 8); }

template <bool FINAL>
__device__ __forceinline__ void lru_unit(Frame& F, int l, int b, int slot) {
    const bool isctx = slot < 4; const int p0 = isctx ? slot * 64 : (slot - 4) * 64, L = isctx ? CTXL : SEQ;
    const bf16* Z = (const bf16*)(F.ws + WS_Z);
    LAS bf16* Xr = (LAS bf16*)(F.lds + LR_XR); LAS bf16* XB = (LAS bf16*)(F.lds + LR_XB); LAS float* Hs = (LAS float*)(F.lds + LR_HS);
    const int tid = F.tid, lane = F.lane, w = F.wave, li = lane & 15, lq = lane >> 4;
    {   u32x4 v[5];
#pragma unroll
        for (int j = 0; j < 5; ++j) { const int idx = tid + NTHR * j, rr = idx >> 5, c16 = idx & 31, p = p0 - 2 + rr; v[j] = (u32x4){0u, 0u, 0u, 0u};
            if (idx < 67 * 32 && p >= 0 && p < L) v[j] = *(const u32x4*)(Z + (size_t)lru_row(isctx, b, p) * INW + ZXB + 8 * c16); }
#pragma unroll
        for (int j = 0; j < 5; ++j) { const int idx = tid + NTHR * j, rr = idx >> 5, c16 = idx & 31; if (idx < 67 * 32) *(LAS u32x4*)(Xr + rr * 264 + 8 * c16) = v[j]; } }
    LDS_BARRIER();
    {   const int ch = tid & 255, ph = tid >> 8;
        const float* cw = F.in[11] + (size_t)l * 4 * 256; const float w0 = cw[ch], w1 = cw[256 + ch], w2 = cw[512 + ch], w3 = cw[768 + ch], cb = F.in[12][l * 256 + ch];
        float x0 = bf2f(Xr[(32 * ph + 0) * 264 + ch]), x1 = bf2f(Xr[(32 * ph + 1) * 264 + ch]), x2 = bf2f(Xr[(32 * ph + 2) * 264 + ch]);
#pragma unroll 8
        for (int p = 32 * ph; p < 32 * ph + 32; ++p) { const float x3 = bf2f(Xr[(p + 3) * 264 + ch]);
            XB[p * 264 + ch] = f2bf(cb + w0 * x0 + w1 * x1 + w2 * x2 + w3 * x3); x0 = x1; x1 = x2; x2 = x3; } }
    LDS_BARRIER();
    {
        const int hh = w >> 1;
        float* LA = (float*)(F.ws + WS_LRUC); float* LH = (float*)(F.ws + WS_LRUC + LRUC_STRIDE); const float* LI = (const float*)(F.ws + WS_LRUC + 2 * LRUC_STRIDE);
        float hsum[4][4];
        bf16x8 nbr[2], nbi[2]; float nba, nbx, ncl, nC;
#define LRU_FETCH(itn) do { const int jn_ = 2 * (w & 1) + ((itn) >> 1), d_ = (itn) & 1, ch_ = hh * 64 + 16 * jn_ + li; \
            const bf16* Wl_ = (const bf16*)(F.ws + WS_TAB + TAB_LRUW) + ((size_t)((l * 2 + d_) * 4 + hh) * 128) * 64; \
            _Pragma("unroll") for (int ks = 0; ks < 2; ++ks) { nbr[ks] = *(const bf16x8*)(Wl_ + (16 * jn_ + li) * 64 + 32 * ks + 8 * lq); nbi[ks] = *(const bf16x8*)(Wl_ + (64 + 16 * jn_ + li) * 64 + 32 * ks + 8 * lq); } \
            nba = F.in[14][(l * 2 + d_) * 256 + ch_]; nbx = F.in[16][(l * 2 + d_) * 256 + ch_]; ncl = ((const float*)(F.ws + WS_TAB + TAB_LRUCL))[(l * 2 + d_) * 256 + ch_]; \
            nC = FINAL ? LI[((size_t)(b * 2 + d_) * LR_SLOTS + slot) * 256 + ch_] : 0.f; } while (0)
        LRU_FETCH(0);
#pragma unroll 1
        for (int it = 0; it < 4; ++it) {
            const int jn = 2 * (w & 1) + (it >> 1), d = it & 1;
            const int ch = hh * 64 + 16 * jn + li;
            const size_t cidx = ((size_t)(b * 2 + d) * LR_SLOTS + slot) * 256;
            bf16x8 br[2], bi[2];
#pragma unroll
            for (int ks = 0; ks < 2; ++ks) { br[ks] = nbr[ks]; bi[ks] = nbi[ks]; }
            const float ba = nba, bx = nbx, cl = ncl;
            float C = nC;
            if (it < 3) LRU_FETCH(it + 1);
            f32x4 ar[4], ai[4];
#pragma unroll
            for (int mt = 0; mt < 4; ++mt) { ar[mt] = (f32x4){0.f, 0.f, 0.f, 0.f}; ai[mt] = (f32x4){0.f, 0.f, 0.f, 0.f};
#pragma unroll
                for (int ks = 0; ks < 2; ++ks) { const bf16x8 a = *(const LAS bf16x8*)(XB + (16 * mt + li) * 264 + hh * 64 + 32 * ks + 8 * lq);
                    ar[mt] = MFMA16(a, br[ks], ar[mt]); ai[mt] = MFMA16(a, bi[ks], ai[mt]); } }
            float PA[4][4], PB[4][4];
#pragma unroll
            for (int mt = 0; mt < 4; ++mt)
#pragma unroll
                for (int r = 0; r < 4; ++r) { const int p = 16 * mt + 4 * lq + r;
                    const float rg = sigmoidf_(ar[mt][r] + ba), ig = sigmoidf_(ai[mt][r] + bx), la = -cl * rg;
                    const float x2 = 2.f * la, e2 = __expf(x2);
                    const float om = x2 > -0.03f ? -x2 * (1.f + 0.5f * x2 * (1.f + x2 * (1.f / 3.f))) : 1.f - e2;
                    PA[mt][r] = __expf(la); PB[mt][r] = __builtin_amdgcn_sqrtf(fmaxf(om, 0.f)) * ig * bf2f(XB[p * 264 + ch]); }
            float TA[4], TB[4], EA[4], EB[4];
#pragma unroll
            for (int mt = 0; mt < 4; ++mt) {
                float pa = 1.f, pb = 0.f;
#pragma unroll
                for (int j = 0; j < 4; ++j) { const int r = d ? 3 - j : j; const float a = PA[mt][r], bb = PB[mt][r]; pb = a * pb + bb; pa = a * pa; PA[mt][r] = pa; PB[mt][r] = pb; }
                float ea = 1.f, eb = 0.f, ta = 1.f, tb = 0.f;
#pragma unroll
                for (int j = 0; j < 4; ++j) { const int k = d ? 3 - j : j; const float ga = __shfl(pa, li + 16 * k), gb = __shfl(pb, li + 16 * k);
                    const bool before = d ? (k > lq) : (k < lq);
                    if (before) { eb = ga * eb + gb; ea = ga * ea; }
                    tb = ga * tb + gb; ta = ga * ta; }
                EA[mt] = ea; EB[mt] = eb; TA[mt] = ta; TB[mt] = tb;
            }
            float Atot = 1.f, Cin[4];
#pragma unroll
            for (int j = 0; j < 4; ++j) { const int mt = d ? 3 - j : j; Cin[mt] = C; C = TA[mt] * C + TB[mt]; Atot *= TA[mt]; }
            if (!FINAL) { if (lq == 0) { LA[cidx + ch] = Atot; LH[cidx + ch] = C; } }
            else {
#pragma unroll
                for (int mt = 0; mt < 4; ++mt) { const float base = EA[mt] * Cin[mt] + EB[mt];
#pragma unroll
                    for (int r = 0; r < 4; ++r) { const float hv = PA[mt][r] * base + PB[mt][r];
                        if (d == 0) hsum[mt][r] = hv; else Hs[(16 * mt + 4 * lq + r) * 256 + ch] = hsum[mt][r] + hv; } }
            }
        }
    }
#undef LRU_FETCH
    if (FINAL) {
        LDS_BARRIER();
        bf16* MIX = (bf16*)(F.ws + WS_MIX);
        u32x4 yq[4];
#pragma unroll
        for (int j = 0; j < 4; ++j) { const int task = tid + NTHR * j, p = task >> 5, c8 = task & 31; yq[j] = *(const u32x4*)(Z + (size_t)lru_row(isctx, b, p0 + p) * INW + ZYB + 8 * c8); }
#pragma unroll
        for (int j = 0; j < 4; ++j) { const int task = tid + NTHR * j, p = task >> 5, c8 = task & 31;
            const f32x4 h0 = *(const LAS f32x4*)(Hs + p * 256 + 8 * c8), h1 = *(const LAS f32x4*)(Hs + p * 256 + 8 * c8 + 4);
            float o[8];
#pragma unroll
            for (int e = 0; e < 4; ++e) { const unsigned yw = yq[j][e];
                const float ya = __builtin_bit_cast(float, yw << 16), yb = __builtin_bit_cast(float, yw & 0xffff0000u);
                const float ua = 0.7978845608f * (ya + 0.044715f * ya * ya * ya), ub = 0.7978845608f * (yb + 0.044715f * yb * yb * yb);
                const float ta = 1.f - 2.f * fast_rcp(1.f + __expf(2.f * ua)), tb = 1.f - 2.f * fast_rcp(1.f + __expf(2.f * ub));
                const float ha = e < 2 ? h0[2 * e] : h1[2 * e - 4], hb = e < 2 ? h0[2 * e + 1] : h1[2 * e - 3];
                o[2 * e] = ha * 0.5f * ya * (1.f + ta); o[2 * e + 1] = hb * 0.5f * yb * (1.f + tb); }
            *(u32x4*)(MIX + (size_t)lru_row(isctx, b, p0 + p) * 1024 + 512 + 8 * c8) = (u32x4){pk2(o[0], o[1]), pk2(o[2], o[3]), pk2(o[4], o[5]), pk2(o[6], o[7])}; }
    }
    LDS_BARRIER();
}

__device__ __forceinline__ void lru_carry(Frame& F) {
    if (blockIdx.x >= 16 || F.wave != 0) return;
    const int chain = blockIdx.x * 64 + F.lane, bd = chain >> 8, ch = chain & 255, d = bd & 1;
    const float* LA = (const float*)(F.ws + WS_LRUC); const float* LH = (const float*)(F.ws + WS_LRUC + LRUC_STRIDE); float* LI = (float*)(F.ws + WS_LRUC + 2 * LRUC_STRIDE);
    float h = 0.f;
    for (int k0 = 0; k0 < LR_SLOTS; k0 += 20) {
        float a[20], hh[20];
#pragma unroll
        for (int j = 0; j < 20; ++j) { const int k = k0 + j, slot = d ? (k < 4 ? 3 - k : 263 - k) : k; const size_t idx = ((size_t)bd * LR_SLOTS + slot) * 256 + ch; a[j] = LA[idx]; hh[j] = LH[idx]; }
#pragma unroll
        for (int j = 0; j < 20; ++j) { const int k = k0 + j, slot = d ? (k < 4 ? 3 - k : 263 - k) : k; const size_t idx = ((size_t)bd * LR_SLOTS + slot) * 256 + ch; LI[idx] = h; h = a[j] * h + hh[j]; }
    }
}

__device__ __forceinline__ void fft_f1(Frame& F, int b, int n2) {
    const bf16* Z = (const bf16*)(F.ws + WS_Z);
    const bf16* Fc = (const bf16*)(F.ws + WS_TAB + TAB_FC); const bf16* Fs = (const bf16*)(F.ws + WS_TAB + TAB_FS);
    bf16* FAr = (bf16*)(F.ws + WS_FA); bf16* FAi = FAr + (size_t)2 * 128 * 128 * 256;
    LAS bf16* DT = (LAS bf16*)F.lds;
    const int tid = F.tid, lane = F.lane, w = F.wave, li = lane & 15, lq = lane >> 4;
    {   const int c = tid & 255, nh = tid >> 8;
        const bf16* src = Z + ((size_t)(b * SEQ + 128 * (64 * nh) + n2)) * INW + ZU + c;
#pragma unroll 2
        for (int j = 0; j < 8; ++j) { unsigned pk[4];
#pragma unroll
            for (int i = 0; i < 4; ++i) pk[i] = (unsigned)src[(size_t)(128 * (8 * j + 2 * i)) * INW] | ((unsigned)src[(size_t)(128 * (8 * j + 2 * i + 1)) * INW] << 16);
            *(LAS u32x4*)(DT + c * 136 + 64 * nh + 8 * j) = (u32x4){pk[0], pk[1], pk[2], pk[3]}; } }
    LDS_BARRIER();
    bf16x8 fc[4], fs[4];
#pragma unroll
    for (int ks = 0; ks < 4; ++ks) { fc[ks] = *(const bf16x8*)(Fc + (16 * w + li) * 128 + 32 * ks + 8 * lq); fs[ks] = *(const bf16x8*)(Fs + (16 * w + li) * 128 + 32 * ks + 8 * lq); }
    float ct[4], st[4];
#pragma unroll
    for (int r = 0; r < 4; ++r) { const int k1 = 16 * w + 4 * lq + r; sincospif((float)((n2 * k1) & 16383) * (1.f / 8192.f), &st[r], &ct[r]); }
#pragma unroll 2
    for (int nt = 0; nt < 16; ++nt) {
        f32x4 re = {0.f, 0.f, 0.f, 0.f}, im = {0.f, 0.f, 0.f, 0.f};
#pragma unroll
        for (int ks = 0; ks < 4; ++ks) { const bf16x8 bb = *(const LAS bf16x8*)(DT + (16 * nt + li) * 136 + 32 * ks + 8 * lq); re = MFMA16(fc[ks], bb, re); im = MFMA16(fs[ks], bb, im); }
#pragma unroll
        for (int r = 0; r < 4; ++r) { const int k1 = 16 * w + 4 * lq + r, c = 16 * nt + li;
            const float R = re[r], I = -im[r];
            const size_t o = ((size_t)(b * 128 + k1) * 128 + n2) * 256 + c;
            FAr[o] = f2bf(R * ct[r] + I * st[r]); FAi[o] = f2bf(I * ct[r] - R * st[r]); }
    }
    LDS_BARRIER();
}

__device__ __forceinline__ void fft_f2(Frame& F, int b, int k1, int chalf) {
    const bf16* Fc = (const bf16*)(F.ws + WS_TAB + TAB_FC); const bf16* Fs = (const bf16*)(F.ws + WS_TAB + TAB_FS); const bf16* CS = (const bf16*)(F.ws + WS_TAB + TAB_CS);
    const bf16* FAr = (const bf16*)(F.ws + WS_FA); const bf16* FAi = FAr + (size_t)2 * 128 * 128 * 256;
    bf16* MIX = (bf16*)(F.ws + WS_MIX);
    LAS bf16* DTr = (LAS bf16*)F.lds; LAS bf16* DTi = DTr + 128 * 136;
    const int tid = F.tid, lane = F.lane, w = F.wave, li = lane & 15, lq = lane >> 4;
    LAS bf16* Wv = (LAS bf16*)(F.lds + 69632) + w * (16 * 2 * 136);
    {   u32x4 pr[4], pi[4];
#pragma unroll
        for (int j = 0; j < 4; ++j) { const int p = tid + NTHR * j, n2 = p >> 4, c8 = p & 15; const size_t o = ((size_t)(b * 128 + k1) * 128 + n2) * 256 + chalf * 128 + 8 * c8;
            pr[j] = *(const u32x4*)(FAr + o); pi[j] = *(const u32x4*)(FAi + o); }
#pragma unroll
        for (int j = 0; j < 4; ++j) { const int p = tid + NTHR * j, n2 = p >> 4, c8 = p & 15, col = n2 ^ (8 * c8);
#pragma unroll
            for (int i = 0; i < 8; ++i) { const unsigned wr_ = pr[j][i >> 1], wi_ = pi[j][i >> 1];
                DTr[(8 * c8 + i) * 136 + col] = (bf16)((i & 1) ? (wr_ >> 16) : (wr_ & 0xffffu)); DTi[(8 * c8 + i) * 136 + col] = (bf16)((i & 1) ? (wi_ >> 16) : (wi_ & 0xffffu)); } } }
    LDS_BARRIER();
    bf16x8 fc[4], fs[4];
#pragma unroll
    for (int ks = 0; ks < 4; ++ks) { fc[ks] = *(const bf16x8*)(Fc + (16 * w + li) * 128 + 32 * ks + 8 * lq); fs[ks] = *(const bf16x8*)(Fs + (16 * w + li) * 128 + 32 * ks + 8 * lq); }
#pragma unroll 2
    for (int nt = 0; nt < 8; ++nt) {
        f32x4 ur = {0.f, 0.f, 0.f, 0.f}, u1 = {0.f, 0.f, 0.f, 0.f}, u2 = {0.f, 0.f, 0.f, 0.f};
        const int sw = 2 * nt + (li >> 3);
#pragma unroll
        for (int ks = 0; ks < 4; ++ks) { const int off = (16 * nt + li) * 136 + 8 * ((4 * ks + lq) ^ sw);
            const bf16x8 br = *(const LAS bf16x8*)(DTr + off), bi = *(const LAS bf16x8*)(DTi + off);
            ur = MFMA16(fc[ks], br, ur); ur = MFMA16(fs[ks], bi, ur); u1 = MFMA16(fc[ks], bi, u1); u2 = MFMA16(fs[ks], br, u2); }
        const int gl = nt >> 2, cl = 16 * (nt & 3) + li;
#pragma unroll
        for (int r = 0; r < 4; ++r) { const int k2l = 4 * lq + r; Wv[(k2l * 2 + gl) * 136 + cl] = f2bf(ur[r]); Wv[(k2l * 2 + gl) * 136 + 64 + cl] = f2bf(u1[r] - u2[r]); }
    }
    LDS_BARRIER();
    LAS bf16* Yt = (LAS bf16*)F.lds;
#pragma unroll
    for (int gl = 0; gl < 2; ++gl)
#pragma unroll
        for (int mt = 0; mt < 4; ++mt) { f32x4 acc = {0.f, 0.f, 0.f, 0.f};
#pragma unroll
            for (int ks = 0; ks < 4; ++ks) acc = MFMA16(*(const LAS bf16x8*)(Wv + (li * 2 + gl) * 136 + 32 * ks + 8 * lq), *(const bf16x8*)(CS + (16 * mt + li) * 128 + 32 * ks + 8 * lq), acc);
#pragma unroll
            for (int r = 0; r < 4; ++r) Yt[(16 * w + 4 * lq + r) * 136 + gl * 64 + 16 * mt + li] = f2bf(acc[r] * (1.f / 1024.f)); }
    LDS_BARRIER();
#pragma unroll
    for (int j = 0; j < 4; ++j) { const int p = tid + NTHR * j, k2 = p >> 4, c8 = p & 15;
        *(u32x4*)(MIX + ((size_t)b * SEQ + k1 + 128 * k2) * 1024 + 768 + chalf * 128 + 8 * c8) = *(const LAS u32x4*)(Yt + k2 * 136 + 8 * c8); }
    LDS_BARRIER();
}

__device__ __forceinline__ void ctx_fourier(Frame& F, int b, int g) {
    const bf16* Z = (const bf16*)(F.ws + WS_Z); bf16* MIX = (bf16*)(F.ws + WS_MIX);
    const bf16* CS = (const bf16*)(F.ws + WS_TAB + TAB_CS); const bf16* C256 = (const bf16*)(F.ws + WS_TAB + TAB_C256); const bf16* S256 = (const bf16*)(F.ws + WS_TAB + TAB_S256);
    LAS bf16* PT = (LAS bf16*)F.lds; LAS bf16* QT = PT + 64 * 264;
    const int lane = F.lane, w = F.wave, li = lane & 15, lq = lane >> 4;
#pragma unroll 1
    for (int nj = 0; nj < 2; ++nj) { const int nt = 2 * w + nj;
        bf16x8 a[2];
#pragma unroll
        for (int ks = 0; ks < 2; ++ks) a[ks] = *(const bf16x8*)(Z + (size_t)(TL + b * CTXL + 16 * nt + li) * INW + ZU + g * 64 + 32 * ks + 8 * lq);
#pragma unroll
        for (int mt = 0; mt < 4; ++mt) { f32x4 p = {0.f, 0.f, 0.f, 0.f}, q = {0.f, 0.f, 0.f, 0.f};
#pragma unroll
            for (int ks = 0; ks < 2; ++ks) { p = MFMA16(a[ks], *(const bf16x8*)(CS + (16 * mt + li) * 128 + 32 * ks + 8 * lq), p); q = MFMA16(a[ks], *(const bf16x8*)(CS + (16 * mt + li) * 128 + 64 + 32 * ks + 8 * lq), q); }
            u32x2 o; o.x = pk2(p[0], p[1]); o.y = pk2(p[2], p[3]); *(LAS u32x2*)(PT + (16 * mt + li) * 264 + 16 * nt + 4 * lq) = o;
            o.x = pk2(q[0], q[1]); o.y = pk2(q[2], q[3]); *(LAS u32x2*)(QT + (16 * mt + li) * 264 + 16 * nt + 4 * lq) = o; } }
    LDS_BARRIER();
#pragma unroll 1
    for (int kj = 0; kj < 2; ++kj) { const int kt = 2 * w + kj;
        f32x4 acc[4];
#pragma unroll
        for (int mt = 0; mt < 4; ++mt) acc[mt] = (f32x4){0.f, 0.f, 0.f, 0.f};
#pragma unroll 2
        for (int ks = 0; ks < 8; ++ks) { const bf16x8 ac = *(const bf16x8*)(C256 + (16 * kt + li) * 256 + 32 * ks + 8 * lq), as = *(const bf16x8*)(S256 + (16 * kt + li) * 256 + 32 * ks + 8 * lq);
#pragma unroll
            for (int mt = 0; mt < 4; ++mt) { acc[mt] = MFMA16(ac, *(const LAS bf16x8*)(PT + (16 * mt + li) * 264 + 32 * ks + 8 * lq), acc[mt]); acc[mt] = MFMA16(as, *(const LAS bf16x8*)(QT + (16 * mt + li) * 264 + 32 * ks + 8 * lq), acc[mt]); } }
#pragma unroll
        for (int mt = 0; mt < 4; ++mt)
#pragma unroll
            for (int r = 0; r < 4; ++r) MIX[(size_t)(TL + b * CTXL + 16 * kt + 4 * lq + r) * 1024 + 768 + g * 64 + 16 * mt + li] = f2bf(acc[mt][r] * (1.f / 128.f)); }
    LDS_BARRIER();
}

__device__ __forceinline__ void route_phase(Frame& F, int l, int Tl) {
    LAS unsigned* hist = (LAS unsigned*)F.lds;
    for (int i = F.tid; i < 256; i += NTHR) hist[i] = 0u;
    __syncthreads();
    const float* logits = (const float*)(F.ws + WS_LOGIT); const float* br = F.in[20] + l * 256;
    int* sel_e = (int*)(F.ws + WS_SEL); float* sel_w = (float*)(F.ws + WS_SEL + SEL_STRIDE);
    const int lane = F.lane, gw = blockIdx.x * NWAVES + F.wave, NGW = F.G * NWAVES;
    const float NEG = -__builtin_inff();
    for (int t = gw; t < Tl; t += NGW) {
        const f32x4 lg = *(const f32x4*)(logits + (size_t)t * 256 + 4 * lane); const f32x4 bb = *(const f32x4*)(br + 4 * lane);
        float sc[4], cand[4];
#pragma unroll
        for (int i = 0; i < 4; ++i) { sc[i] = sigmoidf_(lg[i]); cand[i] = sc[i] + bb[i]; }
        float m1 = NEG, m2 = NEG;
#pragma unroll
        for (int i = 0; i < 4; ++i) { const float v = cand[i]; if (v > m1) { m2 = m1; m1 = v; } else if (v > m2) m2 = v; }
#pragma unroll
        for (int off = 1; off < 8; off <<= 1) { const float o1 = __shfl_xor(m1, off), o2 = __shfl_xor(m2, off); const float n1 = fmaxf(m1, o1), n2 = fmaxf(fminf(m1, o1), fmaxf(m2, o2)); m1 = n1; m2 = n2; }
        const float gs = m1 + m2; const int g = lane >> 3; int rank = 0;
#pragma unroll
        for (int q = 0; q < 8; ++q) { const float v = __shfl(gs, 8 * q); rank += (v > gs || (v == gs && q < g)) ? 1 : 0; }
        if (rank >= 4) {
#pragma unroll
            for (int i = 0; i < 4; ++i) cand[i] = NEG; }
        float wsum = 0.f, myw = 0.f; int mye = 0;
#pragma unroll 1
        for (int k = 0; k < TOPK; ++k) {
            float bv = cand[0]; int bidx = 4 * lane;
#pragma unroll
            for (int i = 1; i < 4; ++i) if (cand[i] > bv) { bv = cand[i]; bidx = 4 * lane + i; }
#pragma unroll
            for (int off = 1; off < 64; off <<= 1) { const float ov = __shfl_xor(bv, off); const int oi = __shfl_xor(bidx, off); if (ov > bv || (ov == bv && oi < bidx)) { bv = ov; bidx = oi; } }
            const int owner = bidx >> 2, which = bidx & 3;
            const float s = which == 0 ? sc[0] : which == 1 ? sc[1] : which == 2 ? sc[2] : sc[3];
            const float sw = __shfl(s, owner);
#pragma unroll
            for (int i = 0; i < 4; ++i) if (lane == owner && which == i) cand[i] = NEG;
            wsum += sw; if (lane == k) { myw = sw; mye = bidx; }
        }
        if (lane < TOPK) { sel_e[(size_t)t * 8 + lane] = mye; sel_w[(size_t)t * 8 + lane] = 2.5f * myw / wsum; (void)__hip_atomic_fetch_add(&hist[mye], 1u, __ATOMIC_RELAXED, __HIP_MEMORY_SCOPE_WORKGROUP); }
    }
    __syncthreads();
    unsigned* cnt = (unsigned*)(F.ws + WS_CTL) + CW_CNT + 1024 * l;
    for (int e = F.tid; e < 256; e += NTHR) if (hist[e]) atomicAdd(cnt + e, hist[e]);
    __syncthreads();
}

__device__ __forceinline__ void assign_phase(Frame& F, int l, int Tl) {
    LAS int* cntL = (LAS int*)F.lds; LAS int* pstart = cntL + 256; LAS unsigned* hist = (LAS unsigned*)(pstart + 260); LAS unsigned* base = hist + 256; LAS unsigned* hist2 = base + 256;
    unsigned* cnt = (unsigned*)(F.ws + WS_CTL) + CW_CNT + 1024 * l; unsigned* fill = cnt + 512;
    const int tid = F.tid, lane = F.lane;
    if (tid < 256) { cntL[tid] = (int)cnt[tid]; hist[tid] = 0u; hist2[tid] = 0u; }
    __syncthreads();
    if (F.wave == 0) {
        int p[4]; int s = 0;
#pragma unroll
        for (int i = 0; i < 4; ++i) { p[i] = (cntL[4 * lane + i] + 255) & ~255; s += p[i]; }
        int inc = s;
#pragma unroll
        for (int off = 1; off < 64; off <<= 1) { const int v = __shfl_up(inc, off); if (lane >= off) inc += v; }
        int ex = inc - s;
#pragma unroll
        for (int i = 0; i < 4; ++i) { pstart[4 * lane + i] = ex; ex += p[i]; }
        if (lane == 63) pstart[256] = inc;
    }
    __syncthreads();
    const int total_rows = pstart[256], ntile_r = total_rows >> 8, ntiles = ntile_r + (Tl >> 8);
    int* meta = (int*)(F.ws + WS_META); int* tile_expert = meta + 64;
    int* row_tok = (int*)(F.ws + WS_ROWTOK); const int* sel_e = (const int*)(F.ws + WS_SEL); int* tokpos = (int*)(F.ws + WS_SEL + 2 * SEL_STRIDE);
    if (blockIdx.x == 0) {
        if (tid == 0) { meta[0] = ntiles; meta[1] = total_rows; }
        if (tid < 256) { const int rt0 = pstart[tid] >> 8; for (int rt = rt0; rt < (pstart[tid + 1] >> 8); ++rt) tile_expert[rt] = tid | ((cntL[tid] - 256 * (rt - rt0) <= 128) ? 0x10000 : 0); }
        for (int rt = ntile_r + tid; rt < ntiles; rt += NTHR) tile_expert[rt] = 256;
    }
    for (int e = blockIdx.x; e < 256; e += F.G) for (int r = pstart[e] + cntL[e] + tid; r < pstart[e + 1]; r += NTHR) row_tok[r] = 0;
    const int TPW = (Tl + F.G - 1) / F.G, t0 = blockIdx.x * TPW, t1 = (t0 + TPW < Tl) ? t0 + TPW : Tl;
    for (int t = t0 + tid; t < t1; t += NTHR) row_tok[total_rows + t] = t;
    const int npairs = t1 > t0 ? (t1 - t0) * 8 : 0;
    for (int i = tid; i < npairs; i += NTHR) (void)__hip_atomic_fetch_add(&hist[sel_e[(size_t)t0 * 8 + i]], 1u, __ATOMIC_RELAXED, __HIP_MEMORY_SCOPE_WORKGROUP);
    __syncthreads();
    if (tid < 256) base[tid] = hist[tid] ? atomicAdd(fill + tid, hist[tid]) : 0u;
    __syncthreads();
    for (int i = tid; i < npairs; i += NTHR) { const int e = sel_e[(size_t)t0 * 8 + i]; const unsigned off = __hip_atomic_fetch_add(&hist2[e], 1u, __ATOMIC_RELAXED, __HIP_MEMORY_SCOPE_WORKGROUP);
        const int pos = pstart[e] + (int)base[e] + (int)off; row_tok[pos] = t0 + (i >> 3); tokpos[(size_t)t0 * 8 + i] = pos; }
    __syncthreads();
}

__device__ __forceinline__ void combine_phase(Frame& F, int l, int Tl) {
    const int* meta = (const int*)(F.ws + WS_META); const int total_rows = meta[1];
    const unsigned char* Y = (const unsigned char*)(F.ws + WS_Y); const int* tokpos = (const int*)(F.ws + WS_SEL + 2 * SEL_STRIDE); const float* sel_w = (const float*)(F.ws + WS_SEL + SEL_STRIDE);
    const float* mod = (const float*)(F.ws + WS_MOD);
    float* XC = (float*)(F.ws + WS_XC); bf16* HB = (bf16*)(F.ws + WS_HB);
    const int lane = F.lane, gw = blockIdx.x * NWAVES + F.wave, NGW = F.G * NWAVES;
    const int c0 = 16 * lane;
    const int ca = (lane >> 4) * 256 + ((lane >> 2) & 3) * 32 + (lane & 3) * 8, cb2 = ca + 128;
    for (int t = gw; t < Tl; t += NGW) {
        const int myp = lane < 8 ? tokpos[(size_t)t * 8 + lane] : 0; const float myw = lane < 8 ? sel_w[(size_t)t * 8 + lane] : 0.f;
        float* xr = t < TL ? F.out + (size_t)t * D : XC + (size_t)(t - TL) * D; const int r = t < TL ? (t >> 14) : 2;
        u32x4 yv[9];
        yv[8] = *(const u32x4*)(Y + (size_t)(total_rows + t) * 1024 + c0);
#pragma unroll
        for (int k = 0; k < TOPK; ++k) yv[k] = *(const u32x4*)(Y + (size_t)__shfl(myp, k) * 1024 + c0);
        f32x4 xv[4];
        xv[0] = *(const f32x4*)(xr + ca); xv[1] = *(const f32x4*)(xr + ca + 4); xv[2] = *(const f32x4*)(xr + cb2); xv[3] = *(const f32x4*)(xr + cb2 + 4);
        float y[16];
#pragma unroll
        for (int d = 0; d < 4; ++d) { const f32x2 a = __builtin_amdgcn_cvt_pk_f32_fp8((int)yv[8][d], false), bq = __builtin_amdgcn_cvt_pk_f32_fp8((int)yv[8][d], true);
            y[4 * d] = a.x; y[4 * d + 1] = a.y; y[4 * d + 2] = bq.x; y[4 * d + 3] = bq.y; }
#pragma unroll
        for (int k = 0; k < TOPK; ++k) { const float wk = __shfl(myw, k);
#pragma unroll
            for (int d = 0; d < 4; ++d) { const f32x2 a = __builtin_amdgcn_cvt_pk_f32_fp8((int)yv[k][d], false), bq = __builtin_amdgcn_cvt_pk_f32_fp8((int)yv[k][d], true);
                y[4 * d] += wk * a.x; y[4 * d + 1] += wk * a.y; y[4 * d + 2] += wk * bq.x; y[4 * d + 3] += wk * bq.y; } }
        const float* g2 = mod + (size_t)(l * 3 + r) * 6144 + 5120;
        f32x4 xn[4]; float s = 0.f;
#pragma unroll
        for (int j = 0; j < 4; ++j) { const int cj = (j < 2 ? ca : cb2) + 4 * (j & 1);
            xn[j] = xv[j] + *(const f32x4*)(g2 + cj) * (f32x4){y[4 * j], y[4 * j + 1], y[4 * j + 2], y[4 * j + 3]};
            s += (xn[j].x * xn[j].x + xn[j].y * xn[j].y) + (xn[j].z * xn[j].z + xn[j].w * xn[j].w); }
        const float rstd = rsqrtf(wave_sum(s) * (1.f / D) + EPS);
        if (l == 0) {
            const float* m1 = mod + (size_t)(3 + r) * 6144; const float* gain = F.in[6] + 1024;
            unsigned o[8];
#pragma unroll
            for (int j = 0; j < 4; ++j) { const int cj = (j < 2 ? ca : cb2) + 4 * (j & 1); *(f32x4*)(xr + cj) = xn[j];
                const f32x4 yv2 = xn[j] * rstd * *(const f32x4*)(gain + cj) * (*(const f32x4*)(m1 + 1024 + cj) + 1.f) + *(const f32x4*)(m1 + cj);
                o[2 * j] = pk2(yv2.x, yv2.y); o[2 * j + 1] = pk2(yv2.z, yv2.w); }
            *(u32x4*)(HB + (size_t)t * D + ca) = (u32x4){o[0], o[1], o[2], o[3]}; *(u32x4*)(HB + (size_t)t * D + cb2) = (u32x4){o[4], o[5], o[6], o[7]};
        } else {
            const float* gain = F.in[27];
#pragma unroll
            for (int j = 0; j < 4; ++j) { const int cj = (j < 2 ? ca : cb2) + 4 * (j & 1); *(f32x4*)(F.out + (size_t)t * D + cj) = xn[j] * rstd * *(const f32x4*)(gain + cj); }
        }
    }
}


#ifndef PH_EN
#define PH_EN 0xFFFFFFFFu
#endif
#define EN(j) ((PH_EN >> (j)) & 1u)
#ifndef U_EN
#define U_EN 0xFFu
#endif
#define UEN(j) ((U_EN >> (j)) & 1u)
#ifndef DUPMASK
#define DUPMASK 0u
#endif
#define REP(j) for (int rep_ = 0; rep_ < 1 + (int)((DUPMASK >> (j)) & 1u); ++rep_)
#ifndef DUPU
#define DUPU 0u
#endif
#define REPU(j) for (int repu_ = 0; repu_ < 1 + (int)((DUPU >> (j)) & 1u); ++repu_)
#define IN(k) (lo <= (k) && (k) < hi)
#define FRESH() do { asm volatile("" : "+v"(F.tid)); F.lane = F.tid & 63; } while (0)
#define SEAM(k) do { if (lo <= (k) && (k) + 1 < hi) xcd_barrier(bar); } while (0)
#define SEAMCV(k, lcv) do { if (lo <= (k) && (k) + 1 < hi) xcd_barrier_cv(bar, F); } while (0)
template <int l>
__device__ __forceinline__ void layer_phases(Frame& F, const XcdBarrier& bar, const int lo, const int hi) {
    const int bid = blockIdx.x, G = F.G;

        const int pb = 2 + 12 * l;
        const int Tl = l == 0 ? TT : TL;
        bf16* HB = (bf16*)(F.ws + WS_HB); bf16* Zb = (bf16*)(F.ws + WS_Z); bf16* MIX = (bf16*)(F.ws + WS_MIX);
        if (EN(2) && IN(pb + 0)) REP(2) { FRESH();
            pg8::Gemm g{HB, (const bf16*)(F.ws + WS_WIN) + (size_t)l * INW * 1024, nullptr, 1024}; pg8::StaticOrder S; S.init(TT, INW, G, bid);
            pg8::EpiBf16 E{Zb, INW};
            pg8::gemm_phase<pg8::EpiBf16, pg8::StaticOrder, false>(F.lds, g, S, E, F.tid);
            SEAMCV(pb + 0, l);
        }
        if (EN(3) && IN(pb + 1)) REP(3) { FRESH();
            REPU(0) if (UEN(0)) hgrn2_c1<0>(F, l, bid, 16 * HG_SLOTS, G);
            FRESH(); REPU(1) if (UEN(1)) for (int u = (bid + G - 32) % G; u < 2 * LR_SLOTS; u += G) lru_unit<false>(F, l, u / LR_SLOTS, u % LR_SLOTS);
            FRESH(); REPU(2) if (UEN(2)) for (int u = bid; u < 256; u += G) fft_f1(F, u >> 7, u & 127);
            FRESH(); REPU(3) if (UEN(3) && l == 0) for (int u = (bid + G - 64) % G; u < 8; u += G) ctx_fourier(F, u >> 2, u & 3);
            SEAMCV(pb + 1, l);
        }
        if (EN(4) && IN(pb + 2)) REP(4) { FRESH(); hgrn2_c2(F); lru_carry(F); SEAMCV(pb + 2, l); }
        if (EN(5) && IN(pb + 3)) REP(5) { FRESH();
            const int nslot = l == 0 ? HG_SLOTS : HG_SLOTS - 2, slot0 = l == 0 ? 0 : 2;
            FRESH(); REPU(4) if (UEN(4)) for (int u = bid; u < 8 * nslot; u += G) hgrn2_c3<0>(F, l, u / nslot, slot0 + u % nslot);
            const int nls = l == 0 ? LR_SLOTS : LR_SLOTS - 4, ls0 = l == 0 ? 0 : 4;
            FRESH(); REPU(5) if (UEN(5)) for (int u = (bid + G - 32) % G; u < 2 * nls; u += G) lru_unit<true>(F, l, u / nls, ls0 + u % nls);
            FRESH(); REPU(6) if (UEN(6)) for (int u = bid; u < 512; u += G) fft_f2(F, u >> 8, (u >> 1) & 127, u & 1);
            SEAMCV(pb + 3, l);
        }
        if (EN(6) && IN(pb + 4)) REP(6) { FRESH();
            pg8::Gemm g{MIX, (const bf16*)(F.ws + WS_WOUT) + (size_t)l * 1024 * 1024, nullptr, 1024}; pg8::StaticOrder S; S.init(Tl, 1024, G, bid);
            pg8::EpiResid E{l == 0 ? F_X(F) : (const float*)F.out, F.out, F_CTX(F), (float*)(F.ws + WS_XC), (const float*)(F.ws + WS_MOD) + (size_t)l * 3 * 6144};
            pg8::gemm_phase<pg8::EpiResid, pg8::StaticOrder, false>(F.lds, g, S, E, F.tid);
            SEAMCV(pb + 4, l);
        }
        if (EN(7) && IN(pb + 5)) REP(7) { FRESH();
            hprep_rows(F, l, F.out, (const float*)(F.ws + WS_XC), Tl, 3072, 4096, F.in[7] + l * 1024);
            SEAMCV(pb + 5, l);
        }
        if (EN(8) && IN(pb + 6)) REP(8) { FRESH();
            pg8::Gemm g{HB, (const bf16*)(F.ws + WS_WR) + (size_t)l * 256 * 1024, nullptr, 1024}; pg8::StaticOrder S; S.init(Tl, 256, G, bid);
            pg8::EpiF32 E{(float*)(F.ws + WS_LOGIT), 256};
            pg8::gemm_phase<pg8::EpiF32, pg8::StaticOrder, false>(F.lds, g, S, E, F.tid);
            SEAMCV(pb + 6, l);
        }
        if (EN(9) && IN(pb + 7)) REP(9) { FRESH(); route_phase(F, l, Tl); SEAMCV(pb + 7, l); }
        if (EN(10) && IN(pb + 8)) REP(10) { FRESH(); assign_phase(F, l, Tl); FRESH(); convert_experts(F, l); SEAMCV(pb + 8, l); }
        if (EN(11) && IN(pb + 9)) REP(11) { FRESH();
            const int* meta = (const int*)(F.ws + WS_META);
            pg8::Gemm g{HB, (const bf16*)(F.ws + (l ? WS_WEXP1 : WS_WEXP)), (const int*)(F.ws + WS_ROWTOK), 1024}; pg8::MoeOrder<2> S{meta + 64, meta[0], G, bid};
            pg8::EpiSwiglu E{(bf16*)(F.ws + WS_HBUF)};
            pg8::gemm_phase<pg8::EpiSwiglu, pg8::MoeOrder<2>, true>(F.lds, g, S, E, F.tid);
            SEAMCV(pb + 9, l);
        }
        if (EN(12) && IN(pb + 10)) REP(12) { FRESH();
            const int* meta = (const int*)(F.ws + WS_META);
            pg8::Gemm g{(const bf16*)(F.ws + WS_HBUF), (const bf16*)(F.ws + (l ? WS_WEXP1 : WS_WEXP) + WEXP_GU_BYTES), nullptr, 256}; pg8::MoeOrder<4> S{meta + 64, meta[0], G, bid};
            pg8::EpiFp8 E{(unsigned char*)(F.ws + WS_Y), 1024};
            pg8::gemm_phase<pg8::EpiFp8, pg8::MoeOrder<4>, false>(F.lds, g, S, E, F.tid);
            SEAMCV(pb + 10, l);
        }
        if (EN(13) && IN(pb + 11)) REP(13) { FRESH(); combine_phase(F, l, Tl); SEAMCV(pb + 11, l); }
    }

constexpr int NPH = 26;
#ifndef BENCH_REPS
#define BENCH_REPS 2
#endif
__global__ void __launch_bounds__(NTHR, 2) fwd_kernel(Args args) {
    extern __shared__ __attribute__((aligned(16))) unsigned char lds_raw[];
    Frame F;
    F.lds = (LAS unsigned char*)lds_raw;
    F.tid = threadIdx.x; F.lane = F.tid & 63; F.wave = __builtin_amdgcn_readfirstlane(F.tid >> 6); F.G = gridDim.x;
    F.in = (const CAS cfptr*)__builtin_amdgcn_kernarg_segment_ptr();
    F.out = args.out; F.ws = args.ws;
    volatile LAS unsigned* MISC = (volatile LAS unsigned*)(F.lds + MISC_OFF);
    if (F.tid < 64) MISC[F.tid] = 0u;
    __syncthreads();
    XcdBarrier bar = xcd_barrier_post((unsigned*)(F.ws + WS_CTL) + CW_BAR, MISC + 8);
    const int lo = args.ph_lo, hi = args.ph_hi;
    const int bid = blockIdx.x, G = F.G;

    if (EN(0) && IN(0)) { FRESH(); phase_g0(F); SEAMCV(0, 0); }
    if (EN(1) && IN(1)) { FRESH(); hprep_rows(F, 0, F_X(F), F_CTX(F), TT, 0, 1024, F.in[6]); SEAMCV(1, 0); }

    layer_phases<0>(F, bar, lo, hi);
    layer_phases<1>(F, bar, lo, hi);
#ifdef BENCH_GEMM
    if (hi == NPH) { xcd_barrier(bar); FRESH();
        _Pragma("unroll 1") for (int rep = 0; rep < BENCH_REPS; ++rep) {
            const int* meta = (const int*)(F.ws + WS_META);
            pg8::Gemm g{(const bf16*)(F.ws + WS_HBUF), (const bf16*)(F.ws + WS_WEXP + WEXP_GU_BYTES), nullptr, 256}; pg8::MoeOrder<4> S{meta + 64, meta[0], F.G, (int)blockIdx.x};
#if BENCH_GEMM == 1
            pg8::EpiFp8 E{(unsigned char*)(F.ws + WS_Y), 1024}; pg8::gemm_phase<pg8::EpiFp8, pg8::MoeOrder<4>, false>(F.lds, g, S, E, F.tid);
#else
            pg8::EpiNone E{(bf16*)(F.ws + WS_Y)}; pg8::gemm_phase<pg8::EpiNone, pg8::MoeOrder<4>, false>(F.lds, g, S, E, F.tid);
#endif
            xcd_barrier(bar); } }
#endif
#ifdef BENCH_INPROJ
    if (hi == NPH) { xcd_barrier(bar); FRESH();
        _Pragma("unroll 1") for (int rep = 0; rep < BENCH_REPS; ++rep) {
            pg8::Gemm g{(const bf16*)(F.ws + WS_HB), (const bf16*)(F.ws + WS_WIN), nullptr, 1024}; pg8::StaticOrder S; S.init(TT, INW, F.G, (int)blockIdx.x);
#if BENCH_INPROJ == 1
            pg8::EpiBf16 E{(bf16*)(F.ws + WS_Z), INW}; pg8::gemm_phase<pg8::EpiBf16, pg8::StaticOrder, false>(F.lds, g, S, E, F.tid);
#else
            pg8::EpiNone E{(bf16*)(F.ws + WS_Z)}; pg8::gemm_phase<pg8::EpiNone, pg8::StaticOrder, false>(F.lds, g, S, E, F.tid);
#endif
            xcd_barrier(bar); } }
#endif
#ifdef BENCH_MOE1
    if (hi == NPH) { xcd_barrier(bar); FRESH();
        _Pragma("unroll 1") for (int rep = 0; rep < BENCH_REPS; ++rep) {
            const int* meta = (const int*)(F.ws + WS_META);
            pg8::MoeOrder<2> S{meta + 64, meta[0], F.G, (int)blockIdx.x};
#if BENCH_MOE1 == 1
            pg8::Gemm g{(const bf16*)(F.ws + WS_HB), (const bf16*)(F.ws + WS_WEXP1), (const int*)(F.ws + WS_ROWTOK), 1024};
            pg8::EpiSwiglu E{(bf16*)(F.ws + WS_HBUF)}; pg8::gemm_phase<pg8::EpiSwiglu, pg8::MoeOrder<2>, true>(F.lds, g, S, E, F.tid);
#elif BENCH_MOE1 == 2
            pg8::Gemm g{(const bf16*)(F.ws + WS_HB), (const bf16*)(F.ws + WS_WEXP1), (const int*)(F.ws + WS_ROWTOK), 1024};
            pg8::EpiNone E{(bf16*)(F.ws + WS_HBUF)}; pg8::gemm_phase<pg8::EpiNone, pg8::MoeOrder<2>, true>(F.lds, g, S, E, F.tid);
#else
            pg8::Gemm g{(const bf16*)(F.ws + WS_HB), (const bf16*)(F.ws + WS_WEXP1), nullptr, 1024};
            pg8::EpiNone E{(bf16*)(F.ws + WS_HBUF)}; pg8::gemm_phase<pg8::EpiNone, pg8::MoeOrder<2>, false>(F.lds, g, S, E, F.tid);
#endif
            xcd_barrier(bar); } }
#endif
#ifdef BENCH_X2
    if (hi == NPH) { xcd_barrier(bar); FRESH();
        _Pragma("unroll 1") for (int rep = 0; rep < BENCH_REPS; ++rep) { if (BENCH_X2 & 1) hgrn2_c2(F); if (BENCH_X2 & 2) lru_carry(F); xcd_barrier(bar); } }
#endif
#ifdef BENCH_C1
    if (hi == NPH) { xcd_barrier(bar); FRESH();
        _Pragma("unroll 1") for (int rep = 0; rep < BENCH_REPS; ++rep) hgrn2_c1<BENCH_C1>(F, 1, (int)blockIdx.x, 16 * HG_SLOTS, F.G); }
#endif
#ifdef BENCH_VAR
    if (hi == NPH) { xcd_barrier(bar); FRESH();
        _Pragma("unroll 1") for (int rep = 0; rep < BENCH_REPS; ++rep) for (int u = blockIdx.x; u < 8 * 128; u += F.G) hgrn2_c3<BENCH_VAR>(F, 1, u >> 7, 2 + (u & 127)); }
#endif
#undef IN
#undef SEAM
}

extern "C" void kernel_launch(void* const* d_in, const int* in_sizes, int n_in, void* d_out, int out_size, void* d_ws, size_t ws_size, hipStream_t stream) {
    static int grid = 0;
    if (grid == 0) {
        if (n_in != 28 || out_size != TL * D || ws_size < WS_END) { fprintf(stderr, "kernel_launch: unexpected problem (n_in %d, out %d, ws %zu < %zu)\n", n_in, out_size, ws_size, (size_t)WS_END); grid = -1; return; }
        int dev = 0, cus = 0, per_cu = 0;
        if (hipGetDevice(&dev) != hipSuccess || hipDeviceGetAttribute(&cus, hipDeviceAttributeMultiprocessorCount, dev) != hipSuccess) { grid = -1; return; }
        if (hipFuncSetAttribute((const void*)fwd_kernel, hipFuncAttributeMaxDynamicSharedMemorySize, LDS_BYTES) != hipSuccess) { fprintf(stderr, "kernel_launch: hipFuncSetAttribute failed\n"); grid = -1; return; }
        if (hipOccupancyMaxActiveBlocksPerMultiprocessor(&per_cu, (const void*)fwd_kernel, NTHR, LDS_BYTES) != hipSuccess || per_cu < 1) { fprintf(stderr, "kernel_launch: occupancy query says %d\n", per_cu); (void)hipGetLastError(); }
        grid = cus;
    }
    if (grid < 0) return;
    (void)hipMemsetAsync((char*)d_ws + WS_CTL, 0, CTL_ZERO_BYTES, stream);
    Args a{};
    for (int i = 0; i < 28; ++i) a.in[i] = (const float*)d_in[i];
    a.out = (float*)d_out; a.ws = (unsigned char*)d_ws;
#if MK_PER_PHASE
    for (int p = 0; p < NPH; ++p) { a.ph_lo = p; a.ph_hi = p + 1; hipLaunchKernelGGL(fwd_kernel, dim3(grid), dim3(NTHR), LDS_BYTES, stream, a); }
#else
    a.ph_lo = 0; a.ph_hi = NPH; hipLaunchKernelGGL(fwd_kernel, dim3(grid), dim3(NTHR), LDS_BYTES, stream, a);
#endif
}
```

```cpp
#include <hip/hip_runtime.h>
#include <cstdio>
#include <cstdint>

#ifndef MK_PER_PHASE
#define MK_PER_PHASE 0
#endif

#define LAS __attribute__((address_space(3)))
#define GAS __attribute__((address_space(1)))
typedef unsigned short bf16;
typedef short bf16x8 __attribute__((ext_vector_type(8)));
typedef float f32x4 __attribute__((ext_vector_type(4)));
typedef float f32x2 __attribute__((ext_vector_type(2)));
typedef unsigned u32x4 __attribute__((ext_vector_type(4)));
typedef unsigned u32x2 __attribute__((ext_vector_type(2)));
typedef int i32x4 __attribute__((ext_vector_type(4)));
typedef int i32x8 __attribute__((ext_vector_type(8)));

__device__ __forceinline__ float bf2f(bf16 v) { return __builtin_bit_cast(float, ((unsigned)v) << 16); }
typedef __bf16 bf16x2_t __attribute__((ext_vector_type(2)));
__device__ __forceinline__ unsigned pk2(float lo, float hi) { bf16x2_t v; v.x = (__bf16)lo; v.y = (__bf16)hi; return __builtin_bit_cast(unsigned, v); }
__device__ __forceinline__ bf16 f2bf(float f) { const __bf16 b = (__bf16)f; return __builtin_bit_cast(unsigned short, b); }
__device__ __forceinline__ unsigned f2bfu(float f) { return (unsigned)f2bf(f); }
#define MFMA16(a, b, c) __builtin_amdgcn_mfma_f32_16x16x32_bf16((a), (b), (c), 0, 0, 0)
#define LDS_WAIT() asm volatile("s_waitcnt lgkmcnt(0)" ::: "memory")
#define LDS_BARRIER() do { asm volatile("s_waitcnt lgkmcnt(0)" ::: "memory"); __builtin_amdgcn_s_barrier(); asm volatile("" ::: "memory"); } while (0)

namespace pg8 {
typedef unsigned short bf16_t;
constexpr int BM = 256, BK = 64, HALF = 128, HTB = HALF * BK * 2, STAGE_BYTES = 8 * HTB, NXCD = 8, WGM = 8;

__host__ __device__ __forceinline__ int lds_byte(int r, int c) { const int st = (r >> 4) * 2 + (c >> 5), rr = r & 15, cc = c & 31, ob = rr * 64 + cc * 2; return st * 1024 + (ob ^ (((ob >> 9) & 1) << 5)); }
__host__ __device__ __forceinline__ void stage_rc(int b, int& R, int& C) { const int st = b / 1024, sb = b % 1024, swz = sb ^ (((sb >> 9) & 1) << 5); R = (st >> 1) * 16 + swz / 64; C = (st & 1) * 32 + (swz % 64) / 2; }
__host__ __device__ __forceinline__ int perm32(int rho) { const int n = rho >> 4, i = rho & 15; return 8 * (i >> 2) + 4 * n + (i & 3); }

struct Unit { int pm, pn, pc, half; };
struct Gemm { const bf16_t* A; const bf16_t* Bt; const int* rows; int K; int sw = 0x7f7f7f7f, sx = 0x7f7f7f7f; };

struct StaticOrder {
    int nM, nN, nwg, G, c;
    __device__ void init(int M, int N, int G_, int c_) { nM = M / BM; nN = N / BM; nwg = nM * nN; G = G_; c = c_; }
    __device__ bool next(int i, Unit& u) const {
        const long L = (long)i * G + c; if (L >= nwg) return false;
        int wgid = (int)L; { const int q = nwg / NXCD, r = nwg % NXCD, xcd = wgid % NXCD, off = wgid / NXCD; wgid = (xcd < r ? xcd * (q + 1) : r * (q + 1) + (xcd - r) * q) + off; }
        const int nig = WGM * nN, gid = wgid / nig, fm = gid * WGM, gsz = (nM - fm) < WGM ? (nM - fm) : WGM;
        u.pm = fm + ((wgid % nig) % gsz); u.pn = (wgid % nig) / gsz; u.pc = u.pn; u.half = 0; return true;
    }
};
template <int NT> struct MoeOrder {
    const int* tile_expert; int n_tiles, G, c;
    __device__ bool next(int i, Unit& u) const {
        int rt, j;
        if ((G & 7) == 0) { const int x = c & 7, jw = c >> 3, per = G >> 3; const int t0 = (int)(((long)n_tiles * x) >> 3), t1 = (int)(((long)n_tiles * (x + 1)) >> 3);
            const int Lx = i * per + jw; if (Lx >= (t1 - t0) * NT) return false; rt = t0 + Lx / NT; j = Lx % NT; }
        else { const int L = i * G + c; if (L >= n_tiles * NT) return false; rt = L / NT; j = L % NT; }
        const int te = tile_expert[rt], e = te & 0xffff;
        u.pm = rt; u.pn = e * NT + j; u.pc = j; u.half = te >> 16; return true;
    }
};

__device__ __forceinline__ unsigned cvt_pk_bf16(float lo, float hi) { return pk2(lo, hi); }

struct EpiBf16 {
    static constexpr bool PERM = true;
    bf16_t* O; int ldc;
    __device__ __forceinline__ void operator()(const f32x4 (&acc)[2][2][4][2], const Unit& u, int wr, int wc, int fr, int fq) const {
        const int row0 = u.pm * BM + wr * 64 + fr, col0 = u.pc * BM + wc * 32 + 8 * fq;
#pragma unroll
        for (int ai = 0; ai < 2; ++ai)
#pragma unroll
            for (int m = 0; m < 4; ++m) { bf16_t* rowp = O + (size_t)(row0 + ai * HALF + m * 16) * ldc + col0;
#pragma unroll
                for (int bj = 0; bj < 2; ++bj) { const f32x4 v0 = acc[ai][bj][m][0], v1 = acc[ai][bj][m][1];
                    u32x4 w; w.x = cvt_pk_bf16(v0[0], v0[1]); w.y = cvt_pk_bf16(v0[2], v0[3]); w.z = cvt_pk_bf16(v1[0], v1[1]); w.w = cvt_pk_bf16(v1[2], v1[3]);
                    *(u32x4*)(rowp + bj * HALF) = w; } }
    }
};
struct EpiFp8 {
    static constexpr bool PERM = true;
    unsigned char* O; int ldc;
    static __device__ __forceinline__ unsigned pk4(const f32x4 v) {
        const float a = __builtin_amdgcn_fmed3f(v[0], -448.f, 448.f), b = __builtin_amdgcn_fmed3f(v[1], -448.f, 448.f), c = __builtin_amdgcn_fmed3f(v[2], -448.f, 448.f), d = __builtin_amdgcn_fmed3f(v[3], -448.f, 448.f);
        int p = __builtin_amdgcn_cvt_pk_fp8_f32(a, b, 0, false); p = __builtin_amdgcn_cvt_pk_fp8_f32(c, d, p, true); return (unsigned)p; }
    __device__ __forceinline__ void operator()(const f32x4 (&acc)[2][2][4][2], const Unit& u, int wr, int wc, int fr, int fq) const {
        const int row0 = u.pm * BM + wr * 64 + fr, pos0 = u.pc * BM + wc * 64 + 16 * fq;
#pragma unroll
        for (int ai = 0; ai < 2; ++ai) { if (ai == 1 && u.half) break;
#pragma unroll
            for (int m = 0; m < 4; ++m) { u32x4 w; w.x = pk4(acc[ai][0][m][0]); w.y = pk4(acc[ai][0][m][1]); w.z = pk4(acc[ai][1][m][0]); w.w = pk4(acc[ai][1][m][1]);
                *(u32x4*)(O + (size_t)(row0 + ai * HALF + m * 16) * ldc + pos0) = w; } }
    }
};
struct EpiNone {
    static constexpr bool PERM = true;
    bf16_t* O;
    __device__ __forceinline__ void operator()(const f32x4 (&acc)[2][2][4][2], const Unit& u, int wr, int wc, int fr, int fq) const {
        float s = 0.f;
#pragma unroll
        for (int ai = 0; ai < 2; ++ai)
#pragma unroll
            for (int bj = 0; bj < 2; ++bj)
#pragma unroll
                for (int m = 0; m < 4; ++m)
#pragma unroll
                    for (int n = 0; n < 2; ++n) s += acc[ai][bj][m][n][0] + acc[ai][bj][m][n][1] + acc[ai][bj][m][n][2] + acc[ai][bj][m][n][3];
        if (s == 123.4567f) O[u.pm + wr + wc + fr + fq] = 1;
    }
};
struct EpiF32 {
    static constexpr bool PERM = false;
    float* C; int ldc;
    __device__ __forceinline__ void operator()(const f32x4 (&acc)[2][2][4][2], const Unit& u, int wr, int wc, int fr, int fq) const {
        const int row0 = u.pm * BM + wr * 64 + fr, col0 = u.pc * BM + wc * 32 + 4 * fq;
#pragma unroll
        for (int ai = 0; ai < 2; ++ai)
#pragma unroll
            for (int m = 0; m < 4; ++m) { float* rowp = C + (size_t)(row0 + ai * HALF + m * 16) * ldc + col0;
#pragma unroll
                for (int bj = 0; bj < 2; ++bj)
#pragma unroll
                    for (int n = 0; n < 2; ++n) *(f32x4*)(rowp + bj * HALF + n * 16) = acc[ai][bj][m][n]; }
    }
};
struct EpiResid {
    static constexpr bool PERM = false;
    const float* src_lat; float* dst_lat; const float* src_ctx; float* dst_ctx; const float* gate;
    __device__ __forceinline__ void operator()(const f32x4 (&acc)[2][2][4][2], const Unit& u, int wr, int wc, int fr, int fq) const {
        const int col0 = u.pc * BM + wc * 32 + 4 * fq;
        const float* src; float* dst; const float* gv; int row0;
        if (u.pm < 128) { row0 = u.pm * BM + wr * 64 + fr; src = src_lat; dst = dst_lat; gv = gate + (u.pm >> 6) * 6144 + 2048; }
        else { row0 = (u.pm - 128) * BM + wr * 64 + fr; src = src_ctx; dst = dst_ctx; gv = gate + 2 * 6144 + 2048; }
        f32x4 g[2][2];
#pragma unroll
        for (int bj = 0; bj < 2; ++bj)
#pragma unroll
            for (int n = 0; n < 2; ++n) g[bj][n] = *(const f32x4*)(gv + col0 + bj * HALF + n * 16);
#pragma unroll
        for (int ai = 0; ai < 2; ++ai)
#pragma unroll
            for (int m = 0; m < 4; ++m) { const size_t off = (size_t)(row0 + ai * HALF + m * 16) * 1024 + col0;
#pragma unroll
                for (int bj = 0; bj < 2; ++bj)
#pragma unroll
                    for (int n = 0; n < 2; ++n) { const f32x4 xv = *(const f32x4*)(src + off + bj * HALF + n * 16);
                        *(f32x4*)(dst + off + bj * HALF + n * 16) = xv + g[bj][n] * acc[ai][bj][m][n]; } }
    }
};
struct EpiSwiglu {
    static constexpr bool PERM = true;
    bf16_t* H;
    __device__ __forceinline__ void operator()(const f32x4 (&acc)[2][2][4][2], const Unit& u, int wr, int wc, int fr, int fq) const {
        const int row0 = u.pm * BM + wr * 64 + fr, col0 = u.pc * HALF + wc * 32 + 8 * fq;
#pragma unroll
        for (int ai = 0; ai < 2; ++ai) { if (ai == 1 && u.half) break;
#pragma unroll
            for (int m = 0; m < 4; ++m) { float h[8];
#pragma unroll
                for (int n = 0; n < 2; ++n)
#pragma unroll
                    for (int j = 0; j < 4; ++j) { const float g = acc[ai][0][m][n][j], up = acc[ai][1][m][n][j]; h[n * 4 + j] = g * __builtin_amdgcn_rcpf(1.f + __expf(-g)) * up; }
                u32x4 w; w.x = cvt_pk_bf16(h[0], h[1]); w.y = cvt_pk_bf16(h[2], h[3]); w.z = cvt_pk_bf16(h[4], h[5]); w.w = cvt_pk_bf16(h[6], h[7]);
                *(u32x4*)(H + (size_t)(row0 + ai * HALF + m * 16) * 256 + col0) = w; } }
    }
};

struct EpiSwiglu8 {
    static constexpr bool PERM = true;
    unsigned char* H;
    __device__ __forceinline__ void operator()(const f32x4 (&acc)[2][2][4][2], const Unit& u, int wr, int wc, int fr, int fq) const {
        const int row0 = u.pm * BM + wr * 64 + fr, col0 = u.pc * HALF + wc * 32 + 8 * fq;
#pragma unroll
        for (int ai = 0; ai < 2; ++ai) { if (ai == 1 && u.half) break;
#pragma unroll
            for (int m = 0; m < 4; ++m) { float h[8];
#pragma unroll
                for (int n = 0; n < 2; ++n)
#pragma unroll
                    for (int j = 0; j < 4; ++j) { const float g = acc[ai][0][m][n][j], up = acc[ai][1][m][n][j]; h[n * 4 + j] = __builtin_amdgcn_fmed3f(4.f * g * __builtin_amdgcn_rcpf(1.f + __expf(-g)) * up, -448.f, 448.f); }
                int lo = __builtin_amdgcn_cvt_pk_fp8_f32(h[0], h[1], 0, false); lo = __builtin_amdgcn_cvt_pk_fp8_f32(h[2], h[3], lo, true);
                int hi = __builtin_amdgcn_cvt_pk_fp8_f32(h[4], h[5], 0, false); hi = __builtin_amdgcn_cvt_pk_fp8_f32(h[6], h[7], hi, true);
                u32x2 w; w.x = (unsigned)lo; w.y = (unsigned)hi;
                *(u32x2*)(H + (size_t)(row0 + ai * HALF + m * 16) * 256 + col0) = w; } }
    }
};

template <class Epi, class Sched, bool GATHER, bool FP8 = false>
__device__ __forceinline__ void gemm_phase(LAS unsigned char* lds, const Gemm g, const Sched& S, const Epi& E, const int tid) {
    const int wid = __builtin_amdgcn_readfirstlane(tid >> 6), lane = tid & 63, wr = wid >> 2, wc = wid & 3, fr = lane & 15, fq = lane >> 4;
    const int K = g.K, nt = K / BK;
    int RA[2], CA[2]; unsigned voffB[2];
#pragma unroll
    for (int i = 0; i < 2; ++i) { int R, C; stage_rc(tid * 16 + i * 8192, R, C); const int Rb = Epi::PERM ? ((R & ~31) + perm32(R & 31)) : R;
        RA[i] = R; CA[i] = C; voffB[i] = (unsigned)(Rb * K + C) * 2u; }
    const unsigned kstep = (unsigned)(BK * 2);
    const unsigned hstep = (unsigned)HALF * (unsigned)K * 2u;
    const unsigned tstep = 2u * hstep;
    const unsigned ldsw = (unsigned)wid * 1024u;
    const int aoff = lds_byte(wr * 64 + fr, fq * 8), boff = lds_byte(wc * 32 + fr, fq * 8);
    const __amdgpu_buffer_rsrc_t srdA = __builtin_amdgcn_make_buffer_rsrc((void*)g.A, (short)0, 0x7fffffff, 0x00020000);
    const __amdgpu_buffer_rsrc_t srdB = __builtin_amdgcn_make_buffer_rsrc((void*)g.Bt, (short)0, 0x7fffffff, 0x00020000);
#define PG8_SA(b, h) (((b) * 2 + (h)) * HTB)
#define PG8_SB(b, h) ((4 + (b) * 2 + (h)) * HTB)
#define PG8_STAGE(bufoff, soff, voff) do { _Pragma("unroll") for (int _i = 0; _i < 2; ++_i) \
        __builtin_amdgcn_raw_ptr_buffer_load_lds(srdB, (LAS unsigned*)(lds + (bufoff) + ldsw + _i * 8192), 16, (int)(voff)[_i], (int)(soff), 0, 0); } while (0)
#define PG8_STAGE2(bufoff, soff, v0, v1) do { \
        __builtin_amdgcn_raw_ptr_buffer_load_lds(srdA, (LAS unsigned*)(lds + (bufoff) + ldsw), 16, (int)(v0), (int)(soff), 0, 0); \
        __builtin_amdgcn_raw_ptr_buffer_load_lds(srdA, (LAS unsigned*)(lds + (bufoff) + ldsw + 8192), 16, (int)(v1), (int)(soff), 0, 0); } while (0)
#define PG8_LDA(dst, b, h) do { _Pragma("unroll") for (int m = 0; m < 4; ++m) _Pragma("unroll") for (int k = 0; k < 2; ++k) dst[m][k] = *(const LAS bf16x8*)(lds + PG8_SA(b, h) + aoff + m * 2048 + k * 1024); } while (0)
#define PG8_LDB(dst, b, h) do { _Pragma("unroll") for (int n = 0; n < 2; ++n) _Pragma("unroll") for (int k = 0; k < 2; ++k) dst[n][k] = *(const LAS bf16x8*)(lds + PG8_SB(b, h) + boff + n * 2048 + k * 1024); } while (0)
#define PG8_MMA(ai, bj, At, Bt) do { __builtin_amdgcn_s_setprio(1); _Pragma("unroll") for (int m = 0; m < 4; ++m) _Pragma("unroll") for (int n = 0; n < 2; ++n) { \
        if constexpr (FP8) { const i32x4 b0_ = __builtin_bit_cast(i32x4, Bt[n][0]), b1_ = __builtin_bit_cast(i32x4, Bt[n][1]), a0_ = __builtin_bit_cast(i32x4, At[m][0]), a1_ = __builtin_bit_cast(i32x4, At[m][1]); \
            const i32x8 w8_ = __builtin_shufflevector(b0_, b1_, 0, 1, 2, 3, 4, 5, 6, 7), x8_ = __builtin_shufflevector(a0_, a1_, 0, 1, 2, 3, 4, 5, 6, 7); \
            asm volatile("v_mfma_scale_f32_16x16x128_f8f6f4 %0, %1, %2, %0, %3, %4 op_sel_hi:[0,0,0]" : "+v"(acc[ai][bj][m][n]) : "v"(w8_), "v"(x8_), "v"(sw_), "v"(sx_)); } \
        else { _Pragma("unroll") for (int k = 0; k < 2; ++k) acc[ai][bj][m][n] = __builtin_amdgcn_mfma_f32_16x16x32_bf16(Bt[n][k], At[m][k], acc[ai][bj][m][n], 0, 0, 0); } } __builtin_amdgcn_s_setprio(0); } while (0)
#define PG8_WAIT_V(n) asm volatile("s_waitcnt vmcnt(" #n ")" ::: "memory")
#define PG8_WAIT_L(n) asm volatile("s_waitcnt lgkmcnt(" #n ")" ::: "memory")
#define PG8_BAR __builtin_amdgcn_s_barrier()
#define PG8_SCHED __builtin_amdgcn_sched_barrier(0)
    Unit cur, nxt; int ui = 0;
    if (!S.next(0, cur)) return;
    int sw_ = g.sw, sx_ = g.sx;
    if constexpr (FP8) asm volatile("" : "+v"(sw_), "+v"(sx_));
    else { (void)sw_; (void)sx_; }
    f32x4 acc[2][2][4][2];
#pragma unroll
    for (int a = 0; a < 2; ++a)
#pragma unroll
        for (int b = 0; b < 2; ++b)
#pragma unroll
            for (int m = 0; m < 4; ++m)
#pragma unroll
                for (int n = 0; n < 2; ++n) acc[a][b][m][n] = (f32x4){0.f, 0.f, 0.f, 0.f};
    bf16x8 At[4][2], B0[2][2], B1[2][2];
    unsigned c00, c01, c10, c11, n00, n01, n10, n11;
    unsigned cA, cB = (unsigned)cur.pn * tstep;
    if constexpr (GATHER) {
        const int* rp = g.rows + (size_t)cur.pm * BM; const unsigned rb = (unsigned)K * 2u;
        c00 = (unsigned)rp[RA[0]] * rb + (unsigned)CA[0] * 2u; c01 = (unsigned)rp[RA[1]] * rb + (unsigned)CA[1] * 2u;
        c10 = (unsigned)rp[HALF + RA[0]] * rb + (unsigned)CA[0] * 2u; c11 = (unsigned)rp[HALF + RA[1]] * rb + (unsigned)CA[1] * 2u;
        cA = 0u;
    } else {
        c00 = (unsigned)(RA[0] * K + CA[0]) * 2u; c01 = (unsigned)(RA[1] * K + CA[1]) * 2u;
        c10 = (unsigned)((HALF + RA[0]) * K + CA[0]) * 2u; c11 = (unsigned)((HALF + RA[1]) * K + CA[1]) * 2u;
        cA = (unsigned)cur.pm * tstep;
    }
    n00 = c00; n01 = c01; n10 = c10; n11 = c11;
    PG8_STAGE(PG8_SB(0, 0), cB, voffB); PG8_STAGE(PG8_SB(0, 1), cB + hstep, voffB); PG8_STAGE2(PG8_SA(0, 0), cA, c00, c01); PG8_STAGE2(PG8_SA(0, 1), cA, c10, c11);
    if (wr == 1) PG8_BAR;
    PG8_WAIT_V(2); PG8_BAR;
    PG8_STAGE(PG8_SB(1, 0), cB + kstep, voffB); PG8_STAGE2(PG8_SA(1, 0), cA + kstep, c00, c01); PG8_STAGE(PG8_SB(1, 1), cB + hstep + kstep, voffB);
    PG8_WAIT_V(6); PG8_BAR;
    for (;;) {
        const bool has_next = S.next(ui + 1, nxt);
        unsigned nA; const unsigned nB = has_next ? (unsigned)nxt.pn * tstep : cB;
        if constexpr (GATHER) {
            nA = 0u;
            if (has_next) { const int* rp = g.rows + (size_t)nxt.pm * BM; const unsigned rb = (unsigned)K * 2u;
                n00 = (unsigned)rp[RA[0]] * rb + (unsigned)CA[0] * 2u; n01 = (unsigned)rp[RA[1]] * rb + (unsigned)CA[1] * 2u;
                n10 = (unsigned)rp[HALF + RA[0]] * rb + (unsigned)CA[0] * 2u; n11 = (unsigned)rp[HALF + RA[1]] * rb + (unsigned)CA[1] * 2u; }
            else { n00 = c00; n01 = c01; n10 = c10; n11 = c11; }
        } else {
            nA = has_next ? (unsigned)nxt.pm * tstep : cA;
        }
        const bool hf = cur.half != 0;
#pragma unroll 1
        for (int t = 0; t < nt; t += 2) {
            const bool last = (t == nt - 2);
            const unsigned a1 = cA + (unsigned)(t + 1) * kstep;
            const unsigned a2 = last ? nA : cA + (unsigned)(t + 2) * kstep, b2 = last ? nB : cB + (unsigned)(t + 2) * kstep;
            const unsigned a3 = a2 + kstep, b3 = b2 + kstep;
            unsigned s00 = c00, s01 = c01, s10 = c10, s11 = c11;
            if constexpr (GATHER) { s00 = last ? n00 : c00; s01 = last ? n01 : c01; s10 = last ? n10 : c10; s11 = last ? n11 : c11; }
            PG8_LDB(B0, 0, 0); PG8_LDB(B1, 0, 1); PG8_SCHED; PG8_LDA(At, 0, 0); PG8_STAGE2(PG8_SA(1, 1), a1, c10, c11);
            PG8_WAIT_V(8); PG8_WAIT_L(0); PG8_BAR; PG8_MMA(0, 0, At, B0); PG8_MMA(0, 1, At, B1); PG8_BAR; PG8_SCHED;
            if (!hf) PG8_LDA(At, 0, 1); PG8_STAGE(PG8_SB(0, 0), b2, voffB); PG8_STAGE(PG8_SB(0, 1), b2 + hstep, voffB); PG8_STAGE2(PG8_SA(0, 0), a2, s00, s01);
            PG8_WAIT_V(8); PG8_WAIT_L(0); PG8_BAR; if (!hf) { PG8_MMA(1, 0, At, B0); PG8_MMA(1, 1, At, B1); } PG8_BAR; PG8_SCHED;
            PG8_LDB(B0, 1, 0); PG8_LDB(B1, 1, 1); PG8_SCHED; PG8_LDA(At, 1, 0); PG8_STAGE2(PG8_SA(0, 1), a2, s10, s11);
            PG8_WAIT_V(8); PG8_WAIT_L(0); PG8_BAR; PG8_MMA(0, 0, At, B0); PG8_MMA(0, 1, At, B1); PG8_BAR; PG8_SCHED;
            if (!hf) PG8_LDA(At, 1, 1); PG8_STAGE(PG8_SB(1, 0), b3, voffB); PG8_STAGE(PG8_SB(1, 1), b3 + hstep, voffB); PG8_STAGE2(PG8_SA(1, 0), a3, s00, s01);
            PG8_WAIT_V(8); PG8_WAIT_L(0); PG8_BAR; if (!hf) { PG8_MMA(1, 0, At, B0); PG8_MMA(1, 1, At, B1); } PG8_BAR; PG8_SCHED;
        }
        if (wr == 0) PG8_BAR;
        if constexpr (FP8) { asm volatile("s_nop 15\n\ts_nop 7" ::: "memory"); PG8_SCHED; }
        E(acc, cur, wr, wc, fr, fq);
        if (!has_next) break;
#pragma unroll
        for (int a = 0; a < 2; ++a)
#pragma unroll
            for (int b = 0; b < 2; ++b)
#pragma unroll
                for (int m = 0; m < 4; ++m)
#pragma unroll
                    for (int n = 0; n < 2; ++n) acc[a][b][m][n] = (f32x4){0.f, 0.f, 0.f, 0.f};
        cur = nxt; cA = nA; cB = nB; ++ui;
        if constexpr (GATHER) { c00 = n00; c01 = n01; c10 = n10; c11 = n11; }
        if (wr == 1) PG8_BAR;
    }
    PG8_WAIT_V(0);
    PG8_BAR;
#undef PG8_SA
#undef PG8_SB
#undef PG8_STAGE
#undef PG8_STAGE2
#undef PG8_LDA
#undef PG8_LDB
#undef PG8_MMA
#undef PG8_WAIT_V
#undef PG8_WAIT_L
#undef PG8_BAR
#undef PG8_SCHED
}
}

#define XB_TMO      128
#define XB_XCNT(j)  (256  + 64 * (j))
#define XB_XSUB(j)  (1280 + 64 * (j))
#define XB_XGEN(j)  (2304 + 64 * (j))
#define XB_TOP      3328
#define XB_TOPGEN   3392
#define XCD_BAR_WORDS 3456
#define XB_SPIN_CAP (1u << 18)

__device__ __forceinline__ unsigned xb_ld(unsigned* p)              { return __hip_atomic_load(p, __ATOMIC_RELAXED, __HIP_MEMORY_SCOPE_AGENT); }
__device__ __forceinline__ unsigned xb_add(unsigned* p, unsigned v) { return __hip_atomic_fetch_add(p, v, __ATOMIC_RELAXED, __HIP_MEMORY_SCOPE_AGENT); }
__device__ __forceinline__ unsigned xb_xcc_id() { return (unsigned)__builtin_amdgcn_s_getreg((3 << 11) | 20) & 0xFu; }
#define XB_SPIN(cond, bar) do { unsigned _sp = 0; while (cond) { __builtin_amdgcn_s_sleep(1); \
    if ((++_sp & 255u) == 0u) { if (xb_ld(&(bar)[XB_TMO])) break; if (_sp > XB_SPIN_CAP) { atomicAdd(&(bar)[XB_TMO], 1u); break; } } } } while (0)

struct XcdBarrier { unsigned* bar; unsigned x; volatile LAS unsigned* st; };

__device__ __forceinline__ XcdBarrier xcd_barrier_post(unsigned* bar, volatile LAS unsigned* st) {
    XcdBarrier b; b.bar = bar; b.x = xb_xcc_id(); b.st = st;
    if (threadIdx.x == 0) (void)xb_add(&bar[XB_XCNT(b.x)], 1u);
    return b;
}
__device__ __forceinline__ void xcd_barrier_complete(unsigned* bar, unsigned x, unsigned& nloc, unsigned& nx) {
    const unsigned G = gridDim.x * gridDim.y * gridDim.z;
    unsigned sum, cnt, mine, sp = 0u;
    for (;;) {
        sum = 0u; cnt = 0u; mine = 0u;
#pragma unroll 1
        for (unsigned j = 0; j < 16; ++j) { const unsigned c = xb_ld(&bar[XB_XCNT(j)]); sum += c; cnt += (c > 0u) ? 1u : 0u; mine = (j == x) ? c : mine; }
        if (sum == G) break;
        __builtin_amdgcn_s_sleep(1);
        if ((++sp & 255u) == 0u) { if (xb_ld(&bar[XB_TMO])) break; if (sp > XB_SPIN_CAP) { atomicAdd(&bar[XB_TMO], 1u); break; } }
    }
    nloc = mine > 0u ? mine : 1u; nx = cnt > 0u ? cnt : 1u;
}
__device__ __forceinline__ void xcd_barrier(const XcdBarrier& b) {
    asm volatile("s_waitcnt vmcnt(0)" ::: "memory");
    __syncthreads();
    if (threadIdx.x == 0) {
        unsigned* bar = b.bar;
        __builtin_amdgcn_s_waitcnt(0);
        unsigned nloc = b.st[0], nx = b.st[1];
        if (nloc == 0u) { xcd_barrier_complete(bar, b.x, nloc, nx); b.st[0] = nloc; b.st[1] = nx; }
        const unsigned old = xb_add(&bar[XB_XSUB(b.x)], 1u);
        const unsigned gen = old / nloc;
        if (old + 1u == (gen + 1u) * nloc) {
            __builtin_amdgcn_fence(__ATOMIC_RELEASE, "agent");
            asm volatile("s_waitcnt vmcnt(0)" ::: "memory");
            const unsigned og = xb_add(&bar[XB_TOP], 1u);
            const unsigned tg = og / nx;
            if (og + 1u == (tg + 1u) * nx) xb_add(&bar[XB_TOPGEN], 1u);
            else XB_SPIN(xb_ld(&bar[XB_TOPGEN]) == tg, bar);
            __builtin_amdgcn_fence(__ATOMIC_ACQUIRE, "agent");
            xb_add(&bar[XB_XGEN(b.x)], 1u);
            asm volatile("s_waitcnt vmcnt(0)" ::: "memory");
        } else {
            XB_SPIN(xb_ld(&bar[XB_XGEN(b.x)]) == gen, bar);
            __builtin_amdgcn_fence(__ATOMIC_ACQUIRE, "agent");
            asm volatile("s_waitcnt vmcnt(0)" ::: "memory");
        }
    }
    __syncthreads();
}

constexpr int D = 1024, NBATCH = 2, SEQ = 16384, CTXL = 256;
constexpr int TL = NBATCH * SEQ, TC = NBATCH * CTXL, TT = TL + TC;
constexpr int INW = 3328;
constexpr int ZQ = 0, ZFF = 512, ZFB = 1024, ZV = 1536, ZG = 2048, ZXB = 2560, ZYB = 2816, ZU = 3072;
constexpr int NEXP = 256, TOPK = 8;
constexpr float EPS = 1e-6f;
constexpr int NWAVES = 8, NTHR = 512;
constexpr int CV_TILES = 257 * 48;
constexpr int CV_OUTP = 248 * 6;
constexpr int CV_ROUT = 126 * 10;
constexpr int HG_SLOTS = 130;
constexpr int LR_SLOTS = 260;
constexpr int MAXROWS = 364800;

constexpr size_t MiB = 1u << 20;
constexpr size_t WS_CTL = 0, CTL_ZERO_BYTES = 1 * MiB;
constexpr size_t WS_MOD = 1 * MiB;
constexpr size_t WS_TAB = 2 * MiB;
constexpr size_t TAB_FC = 0, TAB_FS = 32768, TAB_CS = 65536, TAB_LB = 81920  , TAB_LRUW = 86016  , TAB_LRUCL = 348160  , TAB_C256 = 352256  , TAB_S256 = 483328  ;
constexpr size_t WS_META = 3 * MiB;
constexpr size_t WS_WIN = 4 * MiB;
constexpr size_t WS_WOUT = 18 * MiB;
constexpr size_t WS_WR = 22 * MiB;
constexpr size_t WS_XC = 24 * MiB;
constexpr size_t WS_LRUC = 26 * MiB;
constexpr size_t LRUC_STRIDE = (size_t)2 * 2 * LR_SLOTS * 256 * 4;
constexpr size_t WS_SEL = 30 * MiB;
constexpr size_t SEL_STRIDE = (size_t)TT * 8 * 4;
constexpr size_t WS_ROWTOK = 34 * MiB;
constexpr size_t WS_HD = 36 * MiB;
constexpr size_t WS_LOGIT = 38 * MiB;
constexpr size_t WS_HB = 72 * MiB;
constexpr size_t WS_WEXP = 138 * MiB;
constexpr size_t WEXP_GU_BYTES = (size_t)257 * 512 * 1024;
constexpr size_t WS_HB8 = 340 * MiB;
constexpr size_t WS_BIG = 524 * MiB;
constexpr size_t WS_Z = WS_BIG;
constexpr size_t WS_MIX = WS_BIG + 212 * MiB;
constexpr size_t WS_HS = WS_BIG + 278 * MiB;
constexpr size_t WS_FA = WS_BIG + 410 * MiB;
constexpr size_t WS_GE = WS_BIG + 442 * MiB;
constexpr size_t WS_GK = WS_BIG + 508 * MiB;
constexpr size_t WS_HV = WS_BIG + 574 * MiB;
constexpr size_t WS_HBUF = WS_BIG;
constexpr size_t WS_Y = WS_BIG + 180 * MiB;
constexpr size_t WS_WEXP1 = 1104 * MiB;
constexpr size_t WS_END = WS_WEXP1 + (size_t)257 * 768 * 1024;
static_assert(WS_Y + (size_t)MAXROWS * 1024 <= WS_WEXP1 && WS_HV + (size_t)16 * 2 * HG_SLOTS * 256 * 4 <= WS_WEXP1 && WS_GK + (size_t)2 * TT * 512 * 2 <= WS_HV && WS_GE + (size_t)2 * TT * 512 * 2 <= WS_GK && WS_FA + (size_t)2 * 2 * 128 * 128 * 256 * 2 <= WS_GE, "overlay regions end below the second weight buffer");
static_assert(WS_Z + (size_t)TT * INW * 2 <= WS_MIX && WS_MIX + (size_t)TT * 1024 * 2 <= WS_HS && WS_HS + (size_t)16 * HG_SLOTS * 65536 <= WS_FA, "mixer overlay map");
static_assert(WS_HBUF + (size_t)MAXROWS * 256 * 2 <= WS_Y && WS_WEXP + (size_t)257 * 768 * 1024 <= WS_HB8 && WS_HB8 + (size_t)TT * 1024 <= WS_BIG && WS_HB + (size_t)TT * 2048 <= WS_WEXP, "moe overlay map");
constexpr int CW_BAR = 4096;
constexpr int CW_CVQ = 8192;
constexpr int CW_CNT = 16384;

constexpr int LDS_BYTES = 151552;
constexpr int MISC_OFF = 150528;

struct Args { const float* in[28]; float* out; unsigned char* ws; int ph_lo, ph_hi; };

typedef const float* cfptr;
#define CAS __attribute__((address_space(4)))
struct Frame {
    LAS unsigned char* lds;
    int tid, lane, wave, G;
    const CAS cfptr* in;
    float* out; unsigned char* ws;
};
#define F_X(F)      ((F).in[0])
#define F_C(F)      ((F).in[1])
#define F_CTX(F)    ((F).in[2])
#define F_CCTX(F)   ((F).in[3])

__device__ __forceinline__ float wave_sum(float v) {
#pragma unroll
    for (int o = 1; o < 64; o <<= 1) v += __shfl_xor(v, o);
    return v;
}
__device__ __forceinline__ float sigmoidf_(float z) { return __builtin_amdgcn_rcpf(1.f + __expf(-z)); }

__device__ __forceinline__ void transpose_item(const float* W, int ldw, int k0, int n0, bf16* WT, int ldk, int drow0, LAS float* scr, int lane) {
#pragma unroll 8
    for (int i = 0; i < 32; ++i) { const int kk = 2 * i + (lane >> 5); scr[kk * 33 + (lane & 31)] = W[(size_t)(k0 + kk) * ldw + n0 + (lane & 31)]; }
    LDS_WAIT();
    const int c = lane & 7;
#pragma unroll
    for (int j = 0; j < 4; ++j) { const int n = (lane >> 3) + 8 * j; const LAS float* s = scr + (8 * c) * 33 + n;
        u32x4 o; o.x = pk2(s[0 * 33], s[1 * 33]); o.y = pk2(s[2 * 33], s[3 * 33]); o.z = pk2(s[4 * 33], s[5 * 33]); o.w = pk2(s[6 * 33], s[7 * 33]);
        *(u32x4*)(WT + (size_t)(drow0 + n) * ldk + k0 + 8 * c) = o; }
    LDS_WAIT();
}

__device__ __forceinline__ void norm_row_bf16(const float* xrow, const float* gain, const float* scl, const float* sft, bf16* orow, int lane, unsigned char* o8 = nullptr) {
    f32x4 v[4]; float s = 0.f;
#pragma unroll
    for (int j = 0; j < 4; ++j) { v[j] = *(const f32x4*)(xrow + 4 * lane + 256 * j); s += (v[j].x * v[j].x + v[j].y * v[j].y) + (v[j].z * v[j].z + v[j].w * v[j].w); }
    const float rstd = rsqrtf(wave_sum(s) * (1.f / D) + EPS);
#pragma unroll
    for (int j = 0; j < 4; ++j) { const int c = 4 * lane + 256 * j;
        const f32x4 g = *(const f32x4*)(gain + c), sc = *(const f32x4*)(scl + c), sh = *(const f32x4*)(sft + c);
        const f32x4 y = v[j] * rstd * g * (sc + 1.f) + sh;
        u32x2 o; o.x = pk2(y.x, y.y); o.y = pk2(y.z, y.w); *(u32x2*)(orow + c) = o;
        if (o8) { int p8 = __builtin_amdgcn_cvt_pk_fp8_f32(__builtin_amdgcn_fmed3f(y.x, -448.f, 448.f), __builtin_amdgcn_fmed3f(y.y, -448.f, 448.f), 0, false);
            p8 = __builtin_amdgcn_cvt_pk_fp8_f32(__builtin_amdgcn_fmed3f(y.z, -448.f, 448.f), __builtin_amdgcn_fmed3f(y.w, -448.f, 448.f), p8, true); *(int*)(o8 + c) = p8; } }
}

__device__ __forceinline__ void convert_tile(Frame& F, const float* src, int ldw, bf16* dst, int ldk, int k0, int rowA, int rowB) {
    LAS bf16* T = (LAS bf16*)F.lds;
    const int tid = F.tid, w = F.wave, lane = F.lane;
    f32x4 v[8];
#pragma unroll
    for (int j = 0; j < 8; ++j) v[j] = *(const f32x4*)(src + (size_t)(8 * w + j) * ldw + 4 * lane);
#pragma unroll
    for (int j = 0; j < 8; ++j) { u32x2 o; o.x = pk2(v[j].x, v[j].y); o.y = pk2(v[j].z, v[j].w); *(LAS u32x2*)(T + (8 * w + j) * 264 + ((4 * lane) ^ (w << 3))) = o; }
    __syncthreads();
#pragma unroll
    for (int j = 0; j < 4; ++j) { const int p = tid + NTHR * j, kc = p & 7, n = p >> 3; const LAS bf16* t = T + (8 * kc) * 264 + (n ^ (kc << 3));
        u32x4 o; o.x = (unsigned)t[0] | ((unsigned)t[264] << 16); o.y = (unsigned)t[2 * 264] | ((unsigned)t[3 * 264] << 16);
        o.z = (unsigned)t[4 * 264] | ((unsigned)t[5 * 264] << 16); o.w = (unsigned)t[6 * 264] | ((unsigned)t[7 * 264] << 16);
        const int row = n < 128 ? rowA + n : rowB + n - 128;
        *(u32x4*)(dst + (size_t)row * ldk + k0 + 8 * kc) = o; }
    __syncthreads();
}

__device__ __forceinline__ void convert_tile8(Frame& F, const float* src, int ldw, unsigned char* dst8, int ldk, int k0, int rowA, int rowB, float scl) {
    LAS bf16* T = (LAS bf16*)F.lds;
    const int tid = F.tid, w = F.wave, lane = F.lane;
    f32x4 v[8];
#pragma unroll
    for (int j = 0; j < 8; ++j) v[j] = *(const f32x4*)(src + (size_t)(8 * w + j) * ldw + 4 * lane);
#pragma unroll
    for (int j = 0; j < 8; ++j) { const f32x4 q = v[j] * scl; u32x2 o; o.x = pk2(q.x, q.y); o.y = pk2(q.z, q.w); *(LAS u32x2*)(T + (8 * w + j) * 264 + ((4 * lane) ^ (w << 3))) = o; }
    __syncthreads();
#pragma unroll
    for (int j = 0; j < 4; ++j) { const int p = tid + NTHR * j, kc = p & 7, n = p >> 3; const LAS bf16* t = T + (8 * kc) * 264 + (n ^ (kc << 3));
        float f[8];
#pragma unroll
        for (int i = 0; i < 8; ++i) f[i] = __builtin_bit_cast(float, (unsigned)t[i * 264] << 16);
        int lo = __builtin_amdgcn_cvt_pk_fp8_f32(f[0], f[1], 0, false); lo = __builtin_amdgcn_cvt_pk_fp8_f32(f[2], f[3], lo, true);
        int hi = __builtin_amdgcn_cvt_pk_fp8_f32(f[4], f[5], 0, false); hi = __builtin_amdgcn_cvt_pk_fp8_f32(f[6], f[7], hi, true);
        const int row = n < 128 ? rowA + n : rowB + n - 128;
        u32x2 o; o.x = (unsigned)lo; o.y = (unsigned)hi;
        *(u32x2*)(dst8 + (size_t)row * ldk + k0 + 8 * kc) = o; }
    __syncthreads();
}

__device__ __forceinline__ void phase_g0(Frame& F) {
    float* mod = (float*)(F.ws + WS_MOD);
    {
        LAS float* sc = (LAS float*)F.lds; LAS float* red = sc + 3072;
        for (int u = blockIdx.x; u < 192; u += F.G) {
            const int l = u / 96, n0 = (u % 96) * 64;
            for (int i = F.tid; i < 3072; i += NTHR) { const int r = i >> 10, k = i & 1023; const float c = r < 2 ? F_C(F)[r * 1024 + k] : F_CCTX(F)[k]; sc[i] = c / (1.f + __expf(-c)); }
            __syncthreads();
            const int col = F.tid & 63, kg = F.tid >> 6;
            const float* W = F.in[4] + (size_t)l * 1024 * 6144 + n0 + col;
            float a0 = 0.f, a1 = 0.f, a2 = 0.f;
#pragma unroll 8
            for (int k = kg * 128; k < kg * 128 + 128; ++k) { const float w = W[(size_t)k * 6144]; a0 += sc[k] * w; a1 += sc[1024 + k] * w; a2 += sc[2048 + k] * w; }
            red[(kg * 3 + 0) * 64 + col] = a0; red[(kg * 3 + 1) * 64 + col] = a1; red[(kg * 3 + 2) * 64 + col] = a2;
            __syncthreads();
            if (F.tid < 192) { const int r = F.tid >> 6, cc = F.tid & 63; float s = F.in[5][l * 6144 + n0 + cc];
#pragma unroll
                for (int q = 0; q < 8; ++q) s += red[(q * 3 + r) * 64 + cc];
                mod[(l * 3 + r) * 6144 + n0 + cc] = s; }
            __syncthreads();
        }
    }
    {
        constexpr int PER_L = 16 * (13 + 4 + 1);
        for (int it = blockIdx.x; it < 2 * PER_L; it += F.G) {
            const int l = it / PER_L; int r = it % PER_L; const int kb = r / 18; r %= 18;
            if (r < 13) convert_tile(F, F.in[8] + (size_t)l * 1024 * INW + (size_t)(64 * kb) * INW + 256 * r, INW, (bf16*)(F.ws + WS_WIN) + (size_t)l * INW * 1024, 1024, 64 * kb, 256 * r, 256 * r + 128);
            else if (r < 17) convert_tile(F, F.in[18] + (size_t)l * 1024 * 1024 + (size_t)(64 * kb) * 1024 + 256 * (r - 13), 1024, (bf16*)(F.ws + WS_WOUT) + (size_t)l * 1024 * 1024, 1024, 64 * kb, 256 * (r - 13), 256 * (r - 13) + 128);
            else convert_tile(F, F.in[19] + (size_t)l * 1024 * 256 + (size_t)(64 * kb) * 256, 256, (bf16*)(F.ws + WS_WR) + (size_t)l * 256 * 1024, 1024, 64 * kb, 0, 128);
        }
    }
    {
        const int gt = blockIdx.x * NTHR + F.tid, NGT = F.G * NTHR;
        bf16* Fc = (bf16*)(F.ws + WS_TAB + TAB_FC); bf16* Fs = (bf16*)(F.ws + WS_TAB + TAB_FS); bf16* CS = (bf16*)(F.ws + WS_TAB + TAB_CS);
        for (int i = gt; i < 128 * 128; i += NGT) { const int k = i >> 7, n = i & 127; float s, c; sincospif((float)((k * n) & 127) * (1.f / 64.f), &s, &c); Fc[i] = f2bf(c); Fs[i] = f2bf(s); }
        for (int i = gt; i < 64 * 128; i += NGT) { const int m = i >> 7, kap = i & 127; float s, c; sincospif((float)((m * (kap & 63)) & 63) * (1.f / 32.f), &s, &c); CS[i] = f2bf(kap < 64 ? c : s); }
        bf16* C256 = (bf16*)(F.ws + WS_TAB + TAB_C256); bf16* S256 = (bf16*)(F.ws + WS_TAB + TAB_S256);
        for (int i = gt; i < 256 * 256; i += NGT) { const int k = i >> 8, n = i & 255; float sn, cs; sincospif((float)((k * n) & 255) * (1.f / 128.f), &sn, &cs); C256[i] = f2bf(cs); S256[i] = f2bf(-sn); }
        float* lb = (float*)(F.ws + WS_TAB + TAB_LB);
        for (int i = gt; i < 1024; i += NGT) { const int l = i >> 9, ch = i & 511; lb[i] = l == 0 ? 0.f : sigmoidf_(F.in[9][512 + ch] - F.in[9][ch]); }
        bf16* lw = (bf16*)(F.ws + WS_TAB + TAB_LRUW);
        for (int i = gt; i < 2 * 2 * 4 * 128 * 64; i += NGT) {
            const int k = i & 63, n = (i >> 6) & 127, ldh = i >> 13;
            const float v = n < 64 ? F.in[13][(size_t)ldh * 4096 + k * 64 + n] : F.in[15][(size_t)ldh * 4096 + k * 64 + (n - 64)];
            lw[i] = f2bf(v); }
        float* cl = (float*)(F.ws + WS_TAB + TAB_LRUCL);
        for (int i = gt; i < 1024; i += NGT) { const float lam = F.in[17][i]; const float sp = lam > 15.f ? __expf(-lam) : log1pf(__expf(-lam)); cl[i] = 8.f * sp; }
    }
}

__device__ __forceinline__ void hprep_rows(Frame& F, int l, const float* xlat, const float* xctx, int nrows, int voff_sh, int voff_sc, const float* gain, bool with8 = false) {
    const float* mod = (const float*)(F.ws + WS_MOD) + (size_t)l * 3 * 6144;
    bf16* HB = (bf16*)(F.ws + WS_HB);
    const int gw = blockIdx.x * NWAVES + F.wave, NGW = F.G * NWAVES;
    for (int m = gw; m < nrows; m += NGW) {
        const float* xr = m < TL ? xlat + (size_t)m * D : xctx + (size_t)(m - TL) * D; const int r = m < TL ? (m >> 14) : 2;
        norm_row_bf16(xr, gain, mod + r * 6144 + voff_sc, mod + r * 6144 + voff_sh, HB + (size_t)m * D, F.lane, with8 ? F.ws + WS_HB8 + (size_t)m * D : nullptr);
    }
}

__device__ __forceinline__ void cv_tile(Frame& F, int it_all) {
    const int l = it_all >= CV_TILES ? 1 : 0, it = it_all - l * CV_TILES;
    unsigned char* wb = F.ws + (l ? WS_WEXP1 : WS_WEXP);
    unsigned char* WGU = wb; unsigned char* WD = wb + WEXP_GU_BYTES;
    const int e = it / 48, t = it % 48;
    if (t < 32) {
        const int mat = t >> 4, kb = t & 15;
        const float* src = (e < 256 ? (mat == 0 ? F.in[21] : F.in[22]) + ((size_t)l * 256 + e) * 1024 * 256 : (mat == 0 ? F.in[24] : F.in[25]) + (size_t)l * 1024 * 256) + (size_t)(64 * kb) * 256;
        convert_tile8(F, src, 256, WGU, 1024, 64 * kb, e * 512 + mat * 128, e * 512 + 256 + mat * 128, 32.f);
    } else {
        const int kb = (t - 32) >> 2, nb = (t - 32) & 3;
        const float* src = (e < 256 ? F.in[23] + ((size_t)l * 256 + e) * 256 * 1024 : F.in[26] + (size_t)l * 256 * 1024) + (size_t)(64 * kb) * 1024 + 256 * nb;
        convert_tile8(F, src, 1024, WD, 256, 64 * kb, e * 1024 + 256 * nb, e * 1024 + 256 * nb + 128, 16.f);
    }
}
__device__ __forceinline__ int cv_pull(Frame& F) {
    volatile LAS int* slot = (volatile LAS int*)(F.lds + MISC_OFF) + 16;
    if (F.tid == 0) { const unsigned t = __hip_atomic_fetch_add((unsigned*)(F.ws + WS_CTL) + CW_CVQ, 1u, __ATOMIC_RELAXED, __HIP_MEMORY_SCOPE_AGENT); slot[0] = t < (unsigned)(2 * CV_TILES) ? (int)t : -1; }
    __syncthreads(); const int t = slot[0]; __syncthreads(); return t;
}
__device__ __forceinline__ void convert_experts(Frame& F, int l) {
    for (;;) { const int t = cv_pull(F); if (t < 0) break; cv_tile(F, t); if (t >= (l + 1) * CV_TILES) break; }
}

__device__ __forceinline__ void xcd_barrier_cv(const XcdBarrier& b, Frame& F) {
    volatile LAS unsigned* st = (volatile LAS unsigned*)(F.lds + MISC_OFF) + 20;
    asm volatile("s_waitcnt vmcnt(0)" ::: "memory");
    __syncthreads();
    if (threadIdx.x == 0) {
        unsigned* bar = b.bar;
        __builtin_amdgcn_s_waitcnt(0);
        unsigned nloc = b.st[0], nx = b.st[1];
        if (nloc == 0u) { xcd_barrier_complete(bar, b.x, nloc, nx); b.st[0] = nloc; b.st[1] = nx; }
        const unsigned old = xb_add(&bar[XB_XSUB(b.x)], 1u);
        const unsigned gen = old / nloc;
        if (old + 1u == (gen + 1u) * nloc) {
            __builtin_amdgcn_fence(__ATOMIC_RELEASE, "agent");
            asm volatile("s_waitcnt vmcnt(0)" ::: "memory");
            const unsigned og = xb_add(&bar[XB_TOP], 1u);
            const unsigned tg = og / nx;
            if (og + 1u == (tg + 1u) * nx) xb_add(&bar[XB_TOPGEN], 1u);
            else XB_SPIN(xb_ld(&bar[XB_TOPGEN]) == tg, bar);
            __builtin_amdgcn_fence(__ATOMIC_ACQUIRE, "agent");
            xb_add(&bar[XB_XGEN(b.x)], 1u);
            asm volatile("s_waitcnt vmcnt(0)" ::: "memory");
            st[0] = 0u;
        } else { st[0] = 1u; st[1] = gen; }
        st[2] = 0u;
    }
    __syncthreads();
    if (st[0]) {
        unsigned spins = 0u;
        for (;;) {
            int tile = -1;
            if (threadIdx.x == 0) {
                unsigned rel = xb_ld(&b.bar[XB_XGEN(b.x)]) != st[1] ? 1u : 0u;
                if (!rel && (++spins & 255u) == 0u) { if (xb_ld(&b.bar[XB_TMO])) rel = 1u; else if (spins > XB_SPIN_CAP) { atomicAdd(&b.bar[XB_TMO], 1u); rel = 1u; } }
                st[2] = rel;
                if (!rel && st[3] == 0u) { const unsigned t = __hip_atomic_fetch_add((unsigned*)(F.ws + WS_CTL) + CW_CVQ, 1u, __ATOMIC_RELAXED, __HIP_MEMORY_SCOPE_AGENT);
                    if (t < (unsigned)(2 * CV_TILES)) tile = (int)t; else st[3] = 1u; }
                st[4] = (unsigned)tile;
            }
            __syncthreads();
            const unsigned rel = st[2]; tile = (int)st[4];
            __syncthreads();
            if (rel) break;
            if (tile >= 0) cv_tile(F, tile); else __builtin_amdgcn_s_sleep(2);
        }
        if (threadIdx.x == 0) {
            st[3] = 0u;
            __builtin_amdgcn_fence(__ATOMIC_ACQUIRE, "agent");
            asm volatile("s_waitcnt vmcnt(0)" ::: "memory");
        }
    }
    __syncthreads();
}

constexpr int QS = 144, TS = 80;
constexpr int HG_QT = 0, HG_KT = 18432, HG_KTT = 36864, HG_VT = 57344, HG_SMT = 77824, HG_PM = 114688, HG_TOT = 124928, HG_BMID = 126976, HG_BEND = 127488, HG_RSS = 128000, HG_VR = 132096;
static_assert(HG_VR + 64 * QS * 2 <= MISC_OFF, "HGRN2 LDS map");

__device__ __forceinline__ float fast_rcp(float x) { return __builtin_amdgcn_rcpf(x); }
__device__ __forceinline__ f32x4 hg_ld4(const bf16* p) { const u32x2 v = *(const u32x2*)p;
    return (f32x4){__builtin_bit_cast(float, v.x << 16), __builtin_bit_cast(float, v.x & 0xffff0000u), __builtin_bit_cast(float, v.y << 16), __builtin_bit_cast(float, v.y & 0xffff0000u)}; }


template <int VAR>
__device__ __forceinline__ void hg_chunk_c1(Frame& F, const bf16* Zc, bf16* gq, bf16* gk, float* hv, const bf16* nz, const bf16* nq, const bool has_next, u32x4 (&zq)[4], int h, int rev, const float* lbp, f32x4 (&S)[8], float& dtot) {
    LAS bf16* Qt = (LAS bf16*)(F.lds + HG_QT); LAS bf16* Kt = (LAS bf16*)(F.lds + HG_KT); LAS bf16* KtT = (LAS bf16*)(F.lds + HG_KTT);
    LAS bf16* VT = (LAS bf16*)(F.lds + HG_VT); LAS bf16* Vr = (LAS bf16*)(F.lds + HG_VR);
    LAS float* tot = (LAS float*)(F.lds + HG_TOT); LAS float* bmid = (LAS float*)(F.lds + HG_BMID); LAS float* bend = (LAS float*)(F.lds + HG_BEND);
    LAS float* ebuf = (LAS float*)(F.lds + HG_RSS);
    const int tid = F.tid, lane = F.lane, w = F.wave, li = lane & 15, lq = lane >> 4;
    u32x4 vv[2];
#pragma unroll
    for (int j = 0; j < 2; ++j) { const int p = tid + NTHR * j, row = p >> 4, c16 = p & 15;
        vv[j] = *(const u32x4*)(Zc + (size_t)row * INW + ZV + h * 128 + 8 * c16);
        *(LAS u32x4*)(Kt + row * QS + 8 * c16) = zq[j]; *(LAS u32x4*)(Qt + row * QS + 8 * c16) = zq[2 + j]; }
    LDS_BARRIER();
    const int ch = tid & 127, tq = tid >> 7;
    const float lbv = lbp[h * 128 + ch], oml = 1.f - lbv;
    float cb[16];
#pragma unroll
    for (int i = 0; i < 16; ++i) { float z = bf2f(Kt[(16 * tq + i) * QS + ch]); z = fminf(fmaxf(z, -30.f), 30.f);
        if (VAR & 1) cb[i] = z * -0.01f; else { const float e = __expf(-z), sg = fast_rcp(1.f + e); cb[i] = __logf(lbv + oml * sg);
            Kt[(16 * tq + i) * QS + ch] = f2bf(oml * e * sg); } }
    if (tq == 2) bmid[ch] = cb[0];
    float run = 0.f;
    if (!rev) {
#pragma unroll
        for (int i = 0; i < 16; ++i) { run += cb[i]; cb[i] = run; }
    } else {
#pragma unroll
        for (int i = 15; i >= 0; --i) { run += cb[i]; cb[i] = run; }
    }
    tot[tq * 128 + ch] = run;
#pragma unroll
    for (int j = 0; j < 2; ++j) { const int p = tid + NTHR * j, row = p >> 4, c16 = p & 15; *(LAS u32x4*)(Vr + row * QS + 8 * c16) = vv[j]; }
    LDS_BARRIER();
    float bm, total;
    {
        const float t0 = tot[ch], t1 = tot[128 + ch], t2 = tot[256 + ch], t3 = tot[384 + ch];
        const float off = !rev ? ((tq > 0 ? t0 : 0.f) + (tq > 1 ? t1 : 0.f) + (tq > 2 ? t2 : 0.f)) : ((tq < 3 ? t3 : 0.f) + (tq < 2 ? t2 : 0.f) + (tq < 1 ? t1 : 0.f));
#pragma unroll
        for (int i = 0; i < 16; ++i) cb[i] += off;
        total = (t0 + t1) + (t2 + t3);
        bm = !rev ? (t0 + t1) + bmid[ch] : (t2 + t3);
        if (tq == 0) dtot += total;
    }
    if (!(VAR & 2)) {
        unsigned kp[8], vp[8];
#pragma unroll
        for (int i = 0; i < 16; ++i) { const float d = fminf(fmaxf(cb[i] - bm, -80.f), 80.f);
            const float ed = __expf(d);
            Qt[(16 * tq + i) * QS + ch] = f2bf(bf2f(Qt[(16 * tq + i) * QS + ch]) * ed);
            const unsigned kb = f2bfu(bf2f(Kt[(16 * tq + i) * QS + ch]) * fast_rcp(ed)); Kt[(16 * tq + i) * QS + ch] = (bf16)kb;
            const unsigned vb = Vr[(16 * tq + i) * QS + ch];
            if (i & 1) { kp[i >> 1] |= kb << 16; vp[i >> 1] |= vb << 16; } else { kp[i >> 1] = kb; vp[i >> 1] = vb; } }
        *(LAS u32x4*)(KtT + ch * TS + 16 * tq) = (u32x4){kp[0], kp[1], kp[2], kp[3]};
        *(LAS u32x4*)(KtT + ch * TS + 16 * tq + 8) = (u32x4){kp[4], kp[5], kp[6], kp[7]};
        *(LAS u32x4*)(VT + ch * TS + 16 * tq) = (u32x4){vp[0], vp[1], vp[2], vp[3]};
        *(LAS u32x4*)(VT + ch * TS + 16 * tq + 8) = (u32x4){vp[4], vp[5], vp[6], vp[7]};
        if (tid < 128) { const float e1 = __expf(bm), e2 = __expf(total - bm); hv[tid] = e1; hv[128 + tid] = e2; ebuf[tid] = e1; ebuf[128 + tid] = e2; }
    }
    if (has_next) {
#pragma unroll
        for (int j = 0; j < 2; ++j) { const int p = tid + NTHR * j, row = p >> 4, c16 = p & 15;
            zq[j] = *(const u32x4*)(nz + (size_t)row * INW + 8 * c16); zq[2 + j] = *(const u32x4*)(nq + (size_t)row * INW + 8 * c16); }
    }
    LDS_BARRIER();
    if (!(VAR & 4))
#pragma unroll
    for (int j = 0; j < 2; ++j) { const int p = tid + NTHR * j, row = p >> 4, c16 = p & 15;
        *(u32x4*)(gq + (size_t)row * 512 + 8 * c16) = *(const LAS u32x4*)(Qt + row * QS + 8 * c16);
        *(u32x4*)(gk + (size_t)row * 512 + 8 * c16) = *(const LAS u32x4*)(Kt + row * QS + 8 * c16); }
    if (!(VAR & 8)) {
#pragma unroll
    for (int i = 0; i < 8; ++i) S[i] = S[i] * *(const LAS f32x4*)(ebuf + 16 * i + 4 * lq);
    bf16x8 bv[2];
#pragma unroll
    for (int ks = 0; ks < 2; ++ks) bv[ks] = *(const LAS bf16x8*)(VT + (16 * w + li) * TS + 32 * ks + 8 * lq);
    bf16x8 ak[2][2];
#pragma unroll
    for (int ks = 0; ks < 2; ++ks) ak[0][ks] = *(const LAS bf16x8*)(KtT + li * TS + 32 * ks + 8 * lq);
#pragma unroll
    for (int i = 0; i < 8; ++i) { const int cb_ = i & 1;
        if (i < 7) {
#pragma unroll
            for (int ks = 0; ks < 2; ++ks) ak[cb_ ^ 1][ks] = *(const LAS bf16x8*)(KtT + (16 * (i + 1) + li) * TS + 32 * ks + 8 * lq); }
        __builtin_amdgcn_sched_barrier(0);
#pragma unroll
        for (int ks = 0; ks < 2; ++ks) S[i] = MFMA16(ak[cb_][ks], bv[ks], S[i]);
        S[i] = S[i] * *(const LAS f32x4*)(ebuf + 128 + 16 * i + 4 * lq); }
    }
    LDS_BARRIER();
}

struct HgPtrs { const bf16* q; const bf16* k; const bf16* v; const float* hv; };
__device__ __forceinline__ void hg_load6(const HgPtrs& P, int tid, u32x4 (&pre)[7]) {
    pre[6] = *(const u32x4*)(P.hv + 4 * (tid & 63));
#pragma unroll
    for (int j = 0; j < 2; ++j) { const int p = tid + NTHR * j, row = p >> 4, c16 = p & 15;
        pre[j] = *(const u32x4*)(P.q + (size_t)row * 512 + 8 * c16); pre[2 + j] = *(const u32x4*)(P.k + (size_t)row * 512 + 8 * c16); pre[4 + j] = *(const u32x4*)(P.v + (size_t)row * INW + 8 * c16); }
}
template <int VAR>
__device__ __forceinline__ void hg_chunk_c3(Frame& F, const u32x4 (&cur)[7], int rev, f32x4 (&S)[8], f32x4 (&O)[4], bool do_state, const bf16* Snext) {
    LAS bf16* Qt = (LAS bf16*)(F.lds + HG_QT); LAS bf16* Kt = (LAS bf16*)(F.lds + HG_KT); LAS bf16* KtT = (LAS bf16*)(F.lds + HG_KTT);
    LAS bf16* VT = (LAS bf16*)(F.lds + HG_VT); LAS bf16* SmT = (LAS bf16*)(F.lds + HG_SMT); LAS bf16* Pm = (LAS bf16*)(F.lds + HG_PM); LAS bf16* Vr = (LAS bf16*)(F.lds + HG_VR);
    const int tid = F.tid, lane = F.lane, w = F.wave, li = lane & 15, lq = lane >> 4;
#pragma unroll
    for (int j = 0; j < 2; ++j) { const int p = tid + NTHR * j, row = p >> 4, c16 = p & 15;
        *(LAS u32x4*)(Qt + row * QS + 8 * c16) = cur[j]; *(LAS u32x4*)(Kt + row * QS + 8 * c16) = cur[2 + j]; *(LAS u32x4*)(Vr + row * QS + 8 * c16) = cur[4 + j]; }
    LAS float* ebuf = (LAS float*)(F.lds + HG_BMID);
    if (tid < 64) *(LAS u32x4*)(ebuf + 4 * tid) = cur[6];
    LDS_BARRIER();
    if (!(VAR & 2)) {
        const int ch = tid & 127, tq = tid >> 7; unsigned kp[8], vp[8];
#pragma unroll
        for (int i = 0; i < 16; ++i) { const unsigned vb = Vr[(16 * tq + i) * QS + ch], kb = do_state ? (unsigned)Kt[(16 * tq + i) * QS + ch] : 0u;
            if (i & 1) { kp[i >> 1] |= kb << 16; vp[i >> 1] |= vb << 16; } else { kp[i >> 1] = kb; vp[i >> 1] = vb; } }
        *(LAS u32x4*)(VT + ch * TS + 16 * tq) = (u32x4){vp[0], vp[1], vp[2], vp[3]};
        *(LAS u32x4*)(VT + ch * TS + 16 * tq + 8) = (u32x4){vp[4], vp[5], vp[6], vp[7]};
        if (do_state) { *(LAS u32x4*)(KtT + ch * TS + 16 * tq) = (u32x4){kp[0], kp[1], kp[2], kp[3]}; *(LAS u32x4*)(KtT + ch * TS + 16 * tq + 8) = (u32x4){kp[4], kp[5], kp[6], kp[7]}; }
    }
#pragma unroll
    for (int i = 0; i < 8; ++i) { S[i] = S[i] * *(const LAS f32x4*)(ebuf + 16 * i + 4 * lq);
        u32x2 o; o.x = pk2(S[i].x, S[i].y); o.y = pk2(S[i].z, S[i].w); *(LAS u32x2*)(SmT + (16 * w + li) * QS + 16 * i + 4 * lq) = o; }
    if (Snext) {
#pragma unroll
        for (int i = 0; i < 8; ++i) S[i] = hg_ld4(Snext + (16 * w + li) * 128 + 16 * i + 4 * lq);
    }
    if (!(VAR & 4)) {
        const int tt = w >> 1;
        bf16x8 aq[4];
#pragma unroll
        for (int ks = 0; ks < 4; ++ks) aq[ks] = *(const LAS bf16x8*)(Qt + (16 * tt + li) * QS + 32 * ks + 8 * lq);
#pragma unroll
        for (int sj = 0; sj < 2; ++sj) { const int st = 2 * (w & 1) + sj; f32x4 acc = {0.f, 0.f, 0.f, 0.f};
#pragma unroll
            for (int ks = 0; ks < 4; ++ks) acc = MFMA16(aq[ks], *(const LAS bf16x8*)(Kt + (16 * st + li) * QS + 32 * ks + 8 * lq), acc);
#pragma unroll
            for (int r = 0; r < 4; ++r) { const int t = 16 * tt + 4 * lq + r, s = 16 * st + li; const bool keep = rev ? (s >= t) : (s <= t);
                Pm[t * TS + s] = f2bf(keep ? acc[r] : 0.f); } }
    }
    LDS_BARRIER();
    if (!(VAR & 8)) {
    bf16x8 bs[4], bv[2];
#pragma unroll
    for (int ks = 0; ks < 4; ++ks) bs[ks] = *(const LAS bf16x8*)(SmT + (16 * w + li) * QS + 32 * ks + 8 * lq);
#pragma unroll
    for (int ks = 0; ks < 2; ++ks) bv[ks] = *(const LAS bf16x8*)(VT + (16 * w + li) * TS + 32 * ks + 8 * lq);
    {
        bf16x8 aq[2][4], ap[2][2];
#pragma unroll
        for (int ks = 0; ks < 4; ++ks) aq[0][ks] = *(const LAS bf16x8*)(Qt + li * QS + 32 * ks + 8 * lq);
#pragma unroll
        for (int ks = 0; ks < 2; ++ks) ap[0][ks] = *(const LAS bf16x8*)(Pm + li * TS + 32 * ks + 8 * lq);
#pragma unroll
        for (int mt = 0; mt < 4; ++mt) { const int cb_ = mt & 1;
            if (mt < 3) {
#pragma unroll
                for (int ks = 0; ks < 4; ++ks) aq[cb_ ^ 1][ks] = *(const LAS bf16x8*)(Qt + (16 * (mt + 1) + li) * QS + 32 * ks + 8 * lq);
#pragma unroll
                for (int ks = 0; ks < 2; ++ks) ap[cb_ ^ 1][ks] = *(const LAS bf16x8*)(Pm + (16 * (mt + 1) + li) * TS + 32 * ks + 8 * lq); }
            __builtin_amdgcn_sched_barrier(0);
#pragma unroll
            for (int ks = 0; ks < 4; ++ks) O[mt] = MFMA16(aq[cb_][ks], bs[ks], O[mt]);
#pragma unroll
            for (int ks = 0; ks < 2; ++ks) O[mt] = MFMA16(ap[cb_][ks], bv[ks], O[mt]);
        }
    }
    __builtin_amdgcn_sched_barrier(0);
    if (do_state) {
        bf16x8 ak[2][2];
#pragma unroll
        for (int ks = 0; ks < 2; ++ks) ak[0][ks] = *(const LAS bf16x8*)(KtT + li * TS + 32 * ks + 8 * lq);
#pragma unroll
        for (int i = 0; i < 8; ++i) { const int cb_ = i & 1;
            if (i < 7) {
#pragma unroll
                for (int ks = 0; ks < 2; ++ks) ak[cb_ ^ 1][ks] = *(const LAS bf16x8*)(KtT + (16 * (i + 1) + li) * TS + 32 * ks + 8 * lq); }
            __builtin_amdgcn_sched_barrier(0);
#pragma unroll
            for (int ks = 0; ks < 2; ++ks) S[i] = MFMA16(ak[cb_][ks], bv[ks], S[i]);
            S[i] = S[i] * *(const LAS f32x4*)(ebuf + 128 + 16 * i + 4 * lq); }
    }
    }
    LDS_BARRIER();
}

__device__ __forceinline__ int hg_rowbase(int b, int slot) { return slot < 2 ? TL + b * CTXL + slot * 128 : b * SEQ + (slot - 2) * 128; }

template <int VAR>
__device__ __forceinline__ void hgrn2_c1(Frame& F, int l, int u0, int nunits, int G) {
    const bf16* Z = (const bf16*)(F.ws + WS_Z); const float* lbp = (const float*)(F.ws + WS_TAB + TAB_LB) + l * 512;
    bf16* GQ = (bf16*)(F.ws + WS_GE); bf16* GK = (bf16*)(F.ws + WS_GK); float* HV = (float*)(F.ws + WS_HV);
    if (u0 >= nunits) return;
    u32x4 zq[4];
    {   const int chain = u0 / HG_SLOTS, slot = u0 % HG_SLOTS, dir = chain & 1, b = chain >> 3, h = (chain >> 1) & 3;
        const bf16* zp = Z + (size_t)(hg_rowbase(b, slot) + (dir ? 64 : 0)) * INW;
#pragma unroll
        for (int j = 0; j < 2; ++j) { const int p = F.tid + NTHR * j, row = p >> 4, c16 = p & 15;
            zq[j] = *(const u32x4*)(zp + (size_t)row * INW + (dir ? ZFB : ZFF) + h * 128 + 8 * c16); zq[2 + j] = *(const u32x4*)(zp + (size_t)row * INW + ZQ + h * 128 + 8 * c16); } }
#pragma unroll 1
    for (int u = u0; u < nunits; u += G) {
        const int chain = u / HG_SLOTS, slot = u % HG_SLOTS, dir = chain & 1, b = chain >> 3, h = (chain >> 1) & 3;
        const int row0 = hg_rowbase(b, slot), zcol = (dir ? ZFB : ZFF) + h * 128;
        const int un = u + G; const bool has_nu = un < nunits;
        const int nchain = un / HG_SLOTS, nslot = un % HG_SLOTS, ndir = nchain & 1, nb = nchain >> 3, nh = (nchain >> 1) & 3;
        const bf16* nup = Z + (size_t)(hg_rowbase(nb, nslot) + (ndir ? 64 : 0)) * INW;
        f32x4 S[8]; float dtot = 0.f;
#pragma unroll
        for (int i = 0; i < 8; ++i) S[i] = (f32x4){0.f, 0.f, 0.f, 0.f};
#pragma unroll 1
        for (int step = 0; step < 2; ++step) { const int c = dir ? 1 - step : step; const size_t rowc = (size_t)(row0 + 64 * c);
            const bf16* nrow = step == 0 ? Z + (size_t)(row0 + 64 * (1 - c)) * INW : nup;
            const bf16* nz = nrow + (step == 0 ? zcol : (ndir ? ZFB : ZFF) + nh * 128); const bf16* nq = nrow + ZQ + (step == 0 ? h : nh) * 128;
            hg_chunk_c1<VAR>(F, Z + rowc * INW, GQ + ((size_t)dir * TT + rowc) * 512 + h * 128, GK + ((size_t)dir * TT + rowc) * 512 + h * 128,
                        HV + ((size_t)chain * (2 * HG_SLOTS) + slot * 2 + c) * 256, nz, nq, step == 0 || has_nu, zq, h, dir, lbp, S, dtot); }
        bf16* HS = (bf16*)(F.ws + WS_HS) + ((size_t)chain * HG_SLOTS + slot) * 16384;
        const int li = F.lane & 15, lq = F.lane >> 4, v = 16 * F.wave + li;
#pragma unroll
        for (int i = 0; i < 8; ++i) { u32x2 o; o.x = pk2(S[i].x, S[i].y); o.y = pk2(S[i].z, S[i].w); *(u32x2*)(HS + v * 128 + 16 * i + 4 * lq) = o; }
        if (F.tid < 128) ((float*)(F.ws + WS_HD))[((size_t)chain * HG_SLOTS + slot) * 128 + F.tid] = __expf(dtot);
    }
}

__device__ __forceinline__ void hgrn2_c2(Frame& F) {
    bf16* HS = (bf16*)(F.ws + WS_HS); const float* HD = (const float*)(F.ws + WS_HD);
    for (int task = blockIdx.x * NTHR + F.tid; task < 16 * 8192; task += F.G * NTHR) {
        const int chain = task >> 13, e2 = task & 8191, dir = chain & 1, ch2 = (e2 & 63) * 2;
        f32x2 run = {0.f, 0.f};
#pragma unroll 5
        for (int k = 0; k < HG_SLOTS; ++k) {
            const int slot = dir ? (k < 2 ? 1 - k : 131 - k) : k;
            unsigned* p = (unsigned*)(HS + ((size_t)chain * HG_SLOTS + slot) * 16384 + e2 * 2);
            const unsigned t2 = *p; const f32x2 tmp = {__builtin_bit_cast(float, t2 << 16), __builtin_bit_cast(float, t2 & 0xffff0000u)}, d = *(const f32x2*)(HD + ((size_t)chain * HG_SLOTS + slot) * 128 + ch2);
            *p = pk2(run.x, run.y); run = d * run + tmp;
        }
    }
}

template <int VAR>
__device__ __forceinline__ void hgrn2_c3(Frame& F, int l, int bh, int slot) {
    const int b = bh >> 2, h = bh & 3;
    const bf16* Z = (const bf16*)(F.ws + WS_Z);
    const bf16* GQ = (const bf16*)(F.ws + WS_GE); const bf16* GK = (const bf16*)(F.ws + WS_GK); const float* HV = (const float*)(F.ws + WS_HV);
    bf16* MIX = (bf16*)(F.ws + WS_MIX);
    const int row0 = hg_rowbase(b, slot);
    const int tid = F.tid, lane = F.lane, w = F.wave, li = lane & 15, lq = lane >> 4, v = 16 * w + li;
    u32x4 pa[7], pb[7];
    const float* HVf = HV + ((size_t)(bh * 2 + 0) * (2 * HG_SLOTS) + slot * 2) * 256; const float* HVb = HV + ((size_t)(bh * 2 + 1) * (2 * HG_SLOTS) + slot * 2) * 256;
    {   const size_t r0 = (size_t)row0, r1 = (size_t)(row0 + 64);
        HgPtrs P0{GQ + r0 * 512 + h * 128, GK + r0 * 512 + h * 128, Z + r0 * INW + ZV + h * 128, HVf};
        HgPtrs P1{GQ + r1 * 512 + h * 128, GK + r1 * 512 + h * 128, Z + r1 * INW + ZV + h * 128, HVf + 256};
        hg_load6(P0, tid, pa); hg_load6(P1, tid, pb); }
    if (tid < 32) *(LAS f32x4*)((LAS float*)(F.lds + HG_RSS) + 4 * tid) = *(const f32x4*)(F.in[10] + l * 128 + 4 * tid);
    f32x4 S[8];
    const bf16* HSb = (const bf16*)(F.ws + WS_HS) + ((size_t)(bh * 2 + 1) * HG_SLOTS + slot) * 16384;
    {   const bf16* HSf = (const bf16*)(F.ws + WS_HS) + ((size_t)(bh * 2 + 0) * HG_SLOTS + slot) * 16384;
#pragma unroll
        for (int i = 0; i < 8; ++i) S[i] = hg_ld4(HSf + v * 128 + 16 * i + 4 * lq); }
    f32x4 O[2][4];
#pragma unroll
    for (int c = 0; c < 2; ++c)
#pragma unroll
        for (int mt = 0; mt < 4; ++mt) O[c][mt] = (f32x4){0.f, 0.f, 0.f, 0.f};
#pragma unroll 1
    for (int st = 0; st < 4; ++st) {
        const int dir = st >> 1, c = (st == 1 || st == 2) ? 1 : 0;
        u32x4 cur[7];
#pragma unroll
        for (int j = 0; j < 7; ++j) { cur[j] = pa[j]; pa[j] = pb[j]; }
        if ((VAR & 1)) { } else if (st < 2) {
            const size_t rn = (size_t)(row0 + (st == 0 ? 64 : 0));
            HgPtrs Pn{GQ + ((size_t)TT + rn) * 512 + h * 128, GK + ((size_t)TT + rn) * 512 + h * 128, Z + rn * INW + ZV + h * 128, HVb + (st == 0 ? 256 : 0)};
            hg_load6(Pn, tid, pb);
        } else if (st == 2) {
#pragma unroll
            for (int j = 0; j < 4; ++j) pb[j] = *(const u32x4*)(Z + (size_t)(row0 + (tid >> 2)) * INW + ZG + h * 128 + 32 * (tid & 3) + 8 * j);
        }
        hg_chunk_c3<VAR>(F, cur, dir, S, O[0], (st & 1) == 0, st == 1 ? HSb : nullptr);
        if ((st & 1) == 0) {
#pragma unroll
            for (int mt = 0; mt < 4; ++mt) { const f32x4 t = O[0][mt]; O[0][mt] = O[1][mt]; O[1][mt] = t; }
        }
    }
    if (VAR & 16) { if (O[0][0][0] == 123.456f && O[1][3][2] == 1.f && S[0][0] == 2.f) MIX[0] = 1; return; }
    LAS float* Ot = (LAS float*)F.lds;
#pragma unroll
    for (int c = 0; c < 2; ++c)
#pragma unroll
        for (int mt = 0; mt < 4; ++mt)
#pragma unroll
            for (int r = 0; r < 4; ++r) Ot[(64 * c + 16 * mt + 4 * lq + r) * 132 + v] = O[c][mt][r];
    LDS_BARRIER();
    {   const int t = tid >> 2, v0 = 32 * (tid & 3);
        f32x4 x[8]; float ss = 0.f;
#pragma unroll
        for (int j = 0; j < 8; ++j) { x[j] = *(const LAS f32x4*)(Ot + t * 132 + v0 + 4 * j); ss += (x[j].x * x[j].x + x[j].y * x[j].y) + (x[j].z * x[j].z + x[j].w * x[j].w); }
        ss += __shfl_xor(ss, 1); ss += __shfl_xor(ss, 2);
        const float rs = rsqrtf(ss * (1.f / 128.f) + EPS);
        const LAS float* gain = (const LAS float*)(F.lds + HG_RSS) + v0;
#pragma unroll
        for (int k = 0; k < 4; ++k) { const u32x4 gq = pb[k]; const f32x4 g0 = *(const LAS f32x4*)(gain + 8 * k), g1 = *(const LAS f32x4*)(gain + 8 * k + 4);
            float o[8];
#pragma unroll
            for (int e = 0; e < 4; ++e) { const unsigned gw = e == 0 ? gq.x : e == 1 ? gq.y : e == 2 ? gq.z : gq.w;
                const float ga = __builtin_bit_cast(float, gw << 16), gb = __builtin_bit_cast(float, gw & 0xffff0000u);
                const float xa = e < 2 ? x[2 * k][2 * e] : x[2 * k + 1][2 * e - 4], xb = e < 2 ? x[2 * k][2 * e + 1] : x[2 * k + 1][2 * e - 3];
                const float na = e < 2 ? g0[2 * e] : g1[2 * e - 4], nb = e < 2 ? g0[2 * e + 1] : g1[2 * e - 3];
                o[2 * e] = xa * rs * na * ga * fast_rcp(1.f + __expf(-ga)); o[2 * e + 1] = xb * rs * nb * gb * fast_rcp(1.f + __expf(-gb)); }
            *(u32x4*)(MIX + (size_t)(row0 + t) * 1024 + h * 128 + v0 + 8 * k) = (u32x4){pk2(o[0], o[1]), pk2(o[2], o[3]), pk2(o[4], o[5]), pk2(o[6], o[7])}; }
    }
    LDS_BARRIER();
}

constexpr int LR_XR = 0, LR_XB = 35376, LR_HS = 69632;

__device__ __forceinline__ int lru_row(bool isctx, int b, int p) { return isctx ? TL + b * CTXL + p : b * SEQ + ((p & 255) << 6) + (p >> 8); }

template <bool FINAL>
__device__ __forceinline__ void lru_unit(Frame& F, int l, int b, int slot) {
    const bool isctx = slot < 4; const int p0 = isctx ? slot * 64 : (slot - 4) * 64, L = isctx ? CTXL : SEQ;
    const bf16* Z = (const bf16*)(F.ws + WS_Z);
    LAS bf16* Xr = (LAS bf16*)(F.lds + LR_XR); LAS bf16* XB = (LAS bf16*)(F.lds + LR_XB); LAS float* Hs = (LAS float*)(F.lds + LR_HS);
    const int tid = F.tid, lane = F.lane, w = F.wave, li = lane & 15, lq = lane >> 4;
    {   u32x4 v[5];
#pragma unroll
        for (int j = 0; j < 5; ++j) { const int idx = tid + NTHR * j, rr = idx >> 5, c16 = idx & 31, p = p0 - 2 + rr; v[j] = (u32x4){0u, 0u, 0u, 0u};
            if (idx < 67 * 32 && p >= 0 && p < L) v[j] = *(const u32x4*)(Z + (size_t)lru_row(isctx, b, p) * INW + ZXB + 8 * c16); }
#pragma unroll
        for (int j = 0; j < 5; ++j) { const int idx = tid + NTHR * j, rr = idx >> 5, c16 = idx & 31; if (idx < 67 * 32) *(LAS u32x4*)(Xr + rr * 264 + 8 * c16) = v[j]; } }
    LDS_BARRIER();
    {   const int ch = tid & 255, ph = tid >> 8;
        const float* cw = F.in[11] + (size_t)l * 4 * 256; const float w0 = cw[ch], w1 = cw[256 + ch], w2 = cw[512 + ch], w3 = cw[768 + ch], cb = F.in[12][l * 256 + ch];
        float x0 = bf2f(Xr[(32 * ph + 0) * 264 + ch]), x1 = bf2f(Xr[(32 * ph + 1) * 264 + ch]), x2 = bf2f(Xr[(32 * ph + 2) * 264 + ch]);
#pragma unroll 8
        for (int p = 32 * ph; p < 32 * ph + 32; ++p) { const float x3 = bf2f(Xr[(p + 3) * 264 + ch]);
            XB[p * 264 + ch] = f2bf(cb + w0 * x0 + w1 * x1 + w2 * x2 + w3 * x3); x0 = x1; x1 = x2; x2 = x3; } }
    LDS_BARRIER();
    {
        const int hh = w >> 1;
        float* LA = (float*)(F.ws + WS_LRUC); float* LH = (float*)(F.ws + WS_LRUC + LRUC_STRIDE); const float* LI = (const float*)(F.ws + WS_LRUC + 2 * LRUC_STRIDE);
        float hsum[4][4];
        bf16x8 nbr[2], nbi[2]; float nba, nbx, ncl, nC;
#define LRU_FETCH(itn) do { const int jn_ = 2 * (w & 1) + ((itn) >> 1), d_ = (itn) & 1, ch_ = hh * 64 + 16 * jn_ + li; \
            const bf16* Wl_ = (const bf16*)(F.ws + WS_TAB + TAB_LRUW) + ((size_t)((l * 2 + d_) * 4 + hh) * 128) * 64; \
            _Pragma("unroll") for (int ks = 0; ks < 2; ++ks) { nbr[ks] = *(const bf16x8*)(Wl_ + (16 * jn_ + li) * 64 + 32 * ks + 8 * lq); nbi[ks] = *(const bf16x8*)(Wl_ + (64 + 16 * jn_ + li) * 64 + 32 * ks + 8 * lq); } \
            nba = F.in[14][(l * 2 + d_) * 256 + ch_]; nbx = F.in[16][(l * 2 + d_) * 256 + ch_]; ncl = ((const float*)(F.ws + WS_TAB + TAB_LRUCL))[(l * 2 + d_) * 256 + ch_]; \
            nC = FINAL ? LI[((size_t)(b * 2 + d_) * LR_SLOTS + slot) * 256 + ch_] : 0.f; } while (0)
        LRU_FETCH(0);
#pragma unroll 1
        for (int it = 0; it < 4; ++it) {
            const int jn = 2 * (w & 1) + (it >> 1), d = it & 1;
            const int ch = hh * 64 + 16 * jn + li;
            const size_t cidx = ((size_t)(b * 2 + d) * LR_SLOTS + slot) * 256;
            bf16x8 br[2], bi[2];
#pragma unroll
            for (int ks = 0; ks < 2; ++ks) { br[ks] = nbr[ks]; bi[ks] = nbi[ks]; }
            const float ba = nba, bx = nbx, cl = ncl;
            float C = nC;
            if (it < 3) LRU_FETCH(it + 1);
            f32x4 ar[4], ai[4];
#pragma unroll
            for (int mt = 0; mt < 4; ++mt) { ar[mt] = (f32x4){0.f, 0.f, 0.f, 0.f}; ai[mt] = (f32x4){0.f, 0.f, 0.f, 0.f};
#pragma unroll
                for (int ks = 0; ks < 2; ++ks) { const bf16x8 a = *(const LAS bf16x8*)(XB + (16 * mt + li) * 264 + hh * 64 + 32 * ks + 8 * lq);
                    ar[mt] = MFMA16(a, br[ks], ar[mt]); ai[mt] = MFMA16(a, bi[ks], ai[mt]); } }
            float PA[4][4], PB[4][4];
#pragma unroll
            for (int mt = 0; mt < 4; ++mt)
#pragma unroll
                for (int r = 0; r < 4; ++r) { const int p = 16 * mt + 4 * lq + r;
                    const float rg = sigmoidf_(ar[mt][r] + ba), ig = sigmoidf_(ai[mt][r] + bx), la = -cl * rg;
                    const float x2 = 2.f * la, e2 = __expf(x2);
                    const float om = x2 > -0.03f ? -x2 * (1.f + 0.5f * x2 * (1.f + x2 * (1.f / 3.f))) : 1.f - e2;
                    PA[mt][r] = __expf(la); PB[mt][r] = __builtin_amdgcn_sqrtf(fmaxf(om, 0.f)) * ig * bf2f(XB[p * 264 + ch]); }
            float TA[4], TB[4], EA[4], EB[4];
#pragma unroll
            for (int mt = 0; mt < 4; ++mt) {
                float pa = 1.f, pb = 0.f;
#pragma unroll
                for (int j = 0; j < 4; ++j) { const int r = d ? 3 - j : j; const float a = PA[mt][r], bb = PB[mt][r]; pb = a * pb + bb; pa = a * pa; PA[mt][r] = pa; PB[mt][r] = pb; }
                float ea = 1.f, eb = 0.f, ta = 1.f, tb = 0.f;
#pragma unroll
                for (int j = 0; j < 4; ++j) { const int k = d ? 3 - j : j; const float ga = __shfl(pa, li + 16 * k), gb = __shfl(pb, li + 16 * k);
                    const bool before = d ? (k > lq) : (k < lq);
                    if (before) { eb = ga * eb + gb; ea = ga * ea; }
                    tb = ga * tb + gb; ta = ga * ta; }
                EA[mt] = ea; EB[mt] = eb; TA[mt] = ta; TB[mt] = tb;
            }
            float Atot = 1.f, Cin[4];
#pragma unroll
            for (int j = 0; j < 4; ++j) { const int mt = d ? 3 - j : j; Cin[mt] = C; C = TA[mt] * C + TB[mt]; Atot *= TA[mt]; }
            if (!FINAL) { if (lq == 0) { LA[cidx + ch] = Atot; LH[cidx + ch] = C; } }
            else {
#pragma unroll
                for (int mt = 0; mt < 4; ++mt) { const float base = EA[mt] * Cin[mt] + EB[mt];
#pragma unroll
                    for (int r = 0; r < 4; ++r) { const float hv = PA[mt][r] * base + PB[mt][r];
                        if (d == 0) hsum[mt][r] = hv; else Hs[(16 * mt + 4 * lq + r) * 256 + ch] = hsum[mt][r] + hv; } }
            }
        }
    }
#undef LRU_FETCH
    if (FINAL) {
        LDS_BARRIER();
        bf16* MIX = (bf16*)(F.ws + WS_MIX);
        u32x4 yq[4];
#pragma unroll
        for (int j = 0; j < 4; ++j) { const int task = tid + NTHR * j, p = task >> 5, c8 = task & 31; yq[j] = *(const u32x4*)(Z + (size_t)lru_row(isctx, b, p0 + p) * INW + ZYB + 8 * c8); }
#pragma unroll
        for (int j = 0; j < 4; ++j) { const int task = tid + NTHR * j, p = task >> 5, c8 = task & 31;
            const f32x4 h0 = *(const LAS f32x4*)(Hs + p * 256 + 8 * c8), h1 = *(const LAS f32x4*)(Hs + p * 256 + 8 * c8 + 4);
            float o[8];
#pragma unroll
            for (int e = 0; e < 4; ++e) { const unsigned yw = yq[j][e];
                const float ya = __builtin_bit_cast(float, yw << 16), yb = __builtin_bit_cast(float, yw & 0xffff0000u);
                const float ua = 0.7978845608f * (ya + 0.044715f * ya * ya * ya), ub = 0.7978845608f * (yb + 0.044715f * yb * yb * yb);
                const float ta = 1.f - 2.f * fast_rcp(1.f + __expf(2.f * ua)), tb = 1.f - 2.f * fast_rcp(1.f + __expf(2.f * ub));
                const float ha = e < 2 ? h0[2 * e] : h1[2 * e - 4], hb = e < 2 ? h0[2 * e + 1] : h1[2 * e - 3];
                o[2 * e] = ha * 0.5f * ya * (1.f + ta); o[2 * e + 1] = hb * 0.5f * yb * (1.f + tb); }
            *(u32x4*)(MIX + (size_t)lru_row(isctx, b, p0 + p) * 1024 + 512 + 8 * c8) = (u32x4){pk2(o[0], o[1]), pk2(o[2], o[3]), pk2(o[4], o[5]), pk2(o[6], o[7])}; }
    }
    LDS_BARRIER();
}

__device__ __forceinline__ void lru_carry(Frame& F) {
    if (blockIdx.x >= 16 || F.wave != 0) return;
    const int chain = blockIdx.x * 64 + F.lane, bd = chain >> 8, ch = chain & 255, d = bd & 1;
    const float* LA = (const float*)(F.ws + WS_LRUC); const float* LH = (const float*)(F.ws + WS_LRUC + LRUC_STRIDE); float* LI = (float*)(F.ws + WS_LRUC + 2 * LRUC_STRIDE);
    float h = 0.f;
    for (int k0 = 0; k0 < LR_SLOTS; k0 += 20) {
        float a[20], hh[20];
#pragma unroll
        for (int j = 0; j < 20; ++j) { const int k = k0 + j, slot = d ? (k < 4 ? 3 - k : 263 - k) : k; const size_t idx = ((size_t)bd * LR_SLOTS + slot) * 256 + ch; a[j] = LA[idx]; hh[j] = LH[idx]; }
#pragma unroll
        for (int j = 0; j < 20; ++j) { const int k = k0 + j, slot = d ? (k < 4 ? 3 - k : 263 - k) : k; const size_t idx = ((size_t)bd * LR_SLOTS + slot) * 256 + ch; LI[idx] = h; h = a[j] * h + hh[j]; }
    }
}

__device__ __forceinline__ void fft_f1(Frame& F, int b, int n2) {
    const bf16* Z = (const bf16*)(F.ws + WS_Z);
    const bf16* Fc = (const bf16*)(F.ws + WS_TAB + TAB_FC); const bf16* Fs = (const bf16*)(F.ws + WS_TAB + TAB_FS);
    bf16* FAr = (bf16*)(F.ws + WS_FA); bf16* FAi = FAr + (size_t)2 * 128 * 128 * 256;
    LAS bf16* DT = (LAS bf16*)F.lds;
    const int tid = F.tid, lane = F.lane, w = F.wave, li = lane & 15, lq = lane >> 4;
    {   const int c = tid & 255, nh = tid >> 8;
        const bf16* src = Z + ((size_t)(b * SEQ + 128 * (64 * nh) + n2)) * INW + ZU + c;
#pragma unroll 2
        for (int j = 0; j < 8; ++j) { unsigned pk[4];
#pragma unroll
            for (int i = 0; i < 4; ++i) pk[i] = (unsigned)src[(size_t)(128 * (8 * j + 2 * i)) * INW] | ((unsigned)src[(size_t)(128 * (8 * j + 2 * i + 1)) * INW] << 16);
            *(LAS u32x4*)(DT + c * 136 + 64 * nh + 8 * j) = (u32x4){pk[0], pk[1], pk[2], pk[3]}; } }
    LDS_BARRIER();
    bf16x8 fc[4], fs[4];
#pragma unroll
    for (int ks = 0; ks < 4; ++ks) { fc[ks] = *(const bf16x8*)(Fc + (16 * w + li) * 128 + 32 * ks + 8 * lq); fs[ks] = *(const bf16x8*)(Fs + (16 * w + li) * 128 + 32 * ks + 8 * lq); }
    float ct[4], st[4];
#pragma unroll
    for (int r = 0; r < 4; ++r) { const int k1 = 16 * w + 4 * lq + r; sincospif((float)((n2 * k1) & 16383) * (1.f / 8192.f), &st[r], &ct[r]); }
#pragma unroll 2
    for (int nt = 0; nt < 16; ++nt) {
        f32x4 re = {0.f, 0.f, 0.f, 0.f}, im = {0.f, 0.f, 0.f, 0.f};
#pragma unroll
        for (int ks = 0; ks < 4; ++ks) { const bf16x8 bb = *(const LAS bf16x8*)(DT + (16 * nt + li) * 136 + 32 * ks + 8 * lq); re = MFMA16(fc[ks], bb, re); im = MFMA16(fs[ks], bb, im); }
#pragma unroll
        for (int r = 0; r < 4; ++r) { const int k1 = 16 * w + 4 * lq + r, c = 16 * nt + li;
            const float R = re[r], I = -im[r];
            const size_t o = ((size_t)(b * 128 + k1) * 128 + n2) * 256 + c;
            FAr[o] = f2bf(R * ct[r] + I * st[r]); FAi[o] = f2bf(I * ct[r] - R * st[r]); }
    }
    LDS_BARRIER();
}

__device__ __forceinline__ void fft_f2(Frame& F, int b, int k1, int chalf) {
    const bf16* Fc = (const bf16*)(F.ws + WS_TAB + TAB_FC); const bf16* Fs = (const bf16*)(F.ws + WS_TAB + TAB_FS); const bf16* CS = (const bf16*)(F.ws + WS_TAB + TAB_CS);
    const bf16* FAr = (const bf16*)(F.ws + WS_FA); const bf16* FAi = FAr + (size_t)2 * 128 * 128 * 256;
    bf16* MIX = (bf16*)(F.ws + WS_MIX);
    LAS bf16* DTr = (LAS bf16*)F.lds; LAS bf16* DTi = DTr + 128 * 136;
    const int tid = F.tid, lane = F.lane, w = F.wave, li = lane & 15, lq = lane >> 4;
    LAS bf16* Wv = (LAS bf16*)(F.lds + 69632) + w * (16 * 2 * 136);
    {   u32x4 pr[4], pi[4];
#pragma unroll
        for (int j = 0; j < 4; ++j) { const int p = tid + NTHR * j, n2 = p >> 4, c8 = p & 15; const size_t o = ((size_t)(b * 128 + k1) * 128 + n2) * 256 + chalf * 128 + 8 * c8;
            pr[j] = *(const u32x4*)(FAr + o); pi[j] = *(const u32x4*)(FAi + o); }
#pragma unroll
        for (int j = 0; j < 4; ++j) { const int p = tid + NTHR * j, n2 = p >> 4, c8 = p & 15, col = n2 ^ (8 * c8);
#pragma unroll
            for (int i = 0; i < 8; ++i) { const unsigned wr_ = pr[j][i >> 1], wi_ = pi[j][i >> 1];
                DTr[(8 * c8 + i) * 136 + col] = (bf16)((i & 1) ? (wr_ >> 16) : (wr_ & 0xffffu)); DTi[(8 * c8 + i) * 136 + col] = (bf16)((i & 1) ? (wi_ >> 16) : (wi_ & 0xffffu)); } } }
    LDS_BARRIER();
    bf16x8 fc[4], fs[4];
#pragma unroll
    for (int ks = 0; ks < 4; ++ks) { fc[ks] = *(const bf16x8*)(Fc + (16 * w + li) * 128 + 32 * ks + 8 * lq); fs[ks] = *(const bf16x8*)(Fs + (16 * w + li) * 128 + 32 * ks + 8 * lq); }
#pragma unroll 2
    for (int nt = 0; nt < 8; ++nt) {
        f32x4 ur = {0.f, 0.f, 0.f, 0.f}, u1 = {0.f, 0.f, 0.f, 0.f}, u2 = {0.f, 0.f, 0.f, 0.f};
        const int sw = 2 * nt + (li >> 3);
#pragma unroll
        for (int ks = 0; ks < 4; ++ks) { const int off = (16 * nt + li) * 136 + 8 * ((4 * ks + lq) ^ sw);
            const bf16x8 br = *(const LAS bf16x8*)(DTr + off), bi = *(const LAS bf16x8*)(DTi + off);
            ur = MFMA16(fc[ks], br, ur); ur = MFMA16(fs[ks], bi, ur); u1 = MFMA16(fc[ks], bi, u1); u2 = MFMA16(fs[ks], br, u2); }
        const int gl = nt >> 2, cl = 16 * (nt & 3) + li;
#pragma unroll
        for (int r = 0; r < 4; ++r) { const int k2l = 4 * lq + r; Wv[(k2l * 2 + gl) * 136 + cl] = f2bf(ur[r]); Wv[(k2l * 2 + gl) * 136 + 64 + cl] = f2bf(u1[r] - u2[r]); }
    }
    LDS_BARRIER();
    LAS bf16* Yt = (LAS bf16*)F.lds;
#pragma unroll
    for (int gl = 0; gl < 2; ++gl)
#pragma unroll
        for (int mt = 0; mt < 4; ++mt) { f32x4 acc = {0.f, 0.f, 0.f, 0.f};
#pragma unroll
            for (int ks = 0; ks < 4; ++ks) acc = MFMA16(*(const LAS bf16x8*)(Wv + (li * 2 + gl) * 136 + 32 * ks + 8 * lq), *(const bf16x8*)(CS + (16 * mt + li) * 128 + 32 * ks + 8 * lq), acc);
#pragma unroll
            for (int r = 0; r < 4; ++r) Yt[(16 * w + 4 * lq + r) * 136 + gl * 64 + 16 * mt + li] = f2bf(acc[r] * (1.f / 1024.f)); }
    LDS_BARRIER();
#pragma unroll
    for (int j = 0; j < 4; ++j) { const int p = tid + NTHR * j, k2 = p >> 4, c8 = p & 15;
        *(u32x4*)(MIX + ((size_t)b * SEQ + k1 + 128 * k2) * 1024 + 768 + chalf * 128 + 8 * c8) = *(const LAS u32x4*)(Yt + k2 * 136 + 8 * c8); }
    LDS_BARRIER();
}

__device__ __forceinline__ void ctx_fourier(Frame& F, int b, int g) {
    const bf16* Z = (const bf16*)(F.ws + WS_Z); bf16* MIX = (bf16*)(F.ws + WS_MIX);
    const bf16* CS = (const bf16*)(F.ws + WS_TAB + TAB_CS); const bf16* C256 = (const bf16*)(F.ws + WS_TAB + TAB_C256); const bf16* S256 = (const bf16*)(F.ws + WS_TAB + TAB_S256);
    LAS bf16* PT = (LAS bf16*)F.lds; LAS bf16* QT = PT + 64 * 264;
    const int lane = F.lane, w = F.wave, li = lane & 15, lq = lane >> 4;
#pragma unroll 1
    for (int nj = 0; nj < 2; ++nj) { const int nt = 2 * w + nj;
        bf16x8 a[2];
#pragma unroll
        for (int ks = 0; ks < 2; ++ks) a[ks] = *(const bf16x8*)(Z + (size_t)(TL + b * CTXL + 16 * nt + li) * INW + ZU + g * 64 + 32 * ks + 8 * lq);
#pragma unroll
        for (int mt = 0; mt < 4; ++mt) { f32x4 p = {0.f, 0.f, 0.f, 0.f}, q = {0.f, 0.f, 0.f, 0.f};
#pragma unroll
            for (int ks = 0; ks < 2; ++ks) { p = MFMA16(a[ks], *(const bf16x8*)(CS + (16 * mt + li) * 128 + 32 * ks + 8 * lq), p); q = MFMA16(a[ks], *(const bf16x8*)(CS + (16 * mt + li) * 128 + 64 + 32 * ks + 8 * lq), q); }
            u32x2 o; o.x = pk2(p[0], p[1]); o.y = pk2(p[2], p[3]); *(LAS u32x2*)(PT + (16 * mt + li) * 264 + 16 * nt + 4 * lq) = o;
            o.x = pk2(q[0], q[1]); o.y = pk2(q[2], q[3]); *(LAS u32x2*)(QT + (16 * mt + li) * 264 + 16 * nt + 4 * lq) = o; } }
    LDS_BARRIER();
#pragma unroll 1
    for (int kj = 0; kj < 2; ++kj) { const int kt = 2 * w + kj;
        f32x4 acc[4];
#pragma unroll
        for (int mt = 0; mt < 4; ++mt) acc[mt] = (f32x4){0.f, 0.f, 0.f, 0.f};
#pragma unroll 2
        for (int ks = 0; ks < 8; ++ks) { const bf16x8 ac = *(const bf16x8*)(C256 + (16 * kt + li) * 256 + 32 * ks + 8 * lq), as = *(const bf16x8*)(S256 + (16 * kt + li) * 256 + 32 * ks + 8 * lq);
#pragma unroll
            for (int mt = 0; mt < 4; ++mt) { acc[mt] = MFMA16(ac, *(const LAS bf16x8*)(PT + (16 * mt + li) * 264 + 32 * ks + 8 * lq), acc[mt]); acc[mt] = MFMA16(as, *(const LAS bf16x8*)(QT + (16 * mt + li) * 264 + 32 * ks + 8 * lq), acc[mt]); } }
#pragma unroll
        for (int mt = 0; mt < 4; ++mt)
#pragma unroll
            for (int r = 0; r < 4; ++r) MIX[(size_t)(TL + b * CTXL + 16 * kt + 4 * lq + r) * 1024 + 768 + g * 64 + 16 * mt + li] = f2bf(acc[mt][r] * (1.f / 128.f)); }
    LDS_BARRIER();
}

__device__ __forceinline__ void route_phase(Frame& F, int l, int Tl) {
    LAS unsigned* hist = (LAS unsigned*)F.lds;
    for (int i = F.tid; i < 256; i += NTHR) hist[i] = 0u;
    __syncthreads();
    const float* logits = (const float*)(F.ws + WS_LOGIT); const float* br = F.in[20] + l * 256;
    int* sel_e = (int*)(F.ws + WS_SEL); float* sel_w = (float*)(F.ws + WS_SEL + SEL_STRIDE);
    const int lane = F.lane, gw = blockIdx.x * NWAVES + F.wave, NGW = F.G * NWAVES;
    const float NEG = -__builtin_inff();
    for (int t = gw; t < Tl; t += NGW) {
        const f32x4 lg = *(const f32x4*)(logits + (size_t)t * 256 + 4 * lane); const f32x4 bb = *(const f32x4*)(br + 4 * lane);
        float sc[4], cand[4];
#pragma unroll
        for (int i = 0; i < 4; ++i) { sc[i] = sigmoidf_(lg[i]); cand[i] = sc[i] + bb[i]; }
        float m1 = NEG, m2 = NEG;
#pragma unroll
        for (int i = 0; i < 4; ++i) { const float v = cand[i]; if (v > m1) { m2 = m1; m1 = v; } else if (v > m2) m2 = v; }
#pragma unroll
        for (int off = 1; off < 8; off <<= 1) { const float o1 = __shfl_xor(m1, off), o2 = __shfl_xor(m2, off); const float n1 = fmaxf(m1, o1), n2 = fmaxf(fminf(m1, o1), fmaxf(m2, o2)); m1 = n1; m2 = n2; }
        const float gs = m1 + m2; const int g = lane >> 3; int rank = 0;
#pragma unroll
        for (int q = 0; q < 8; ++q) { const float v = __shfl(gs, 8 * q); rank += (v > gs || (v == gs && q < g)) ? 1 : 0; }
        if (rank >= 4) {
#pragma unroll
            for (int i = 0; i < 4; ++i) cand[i] = NEG; }
        float wsum = 0.f, myw = 0.f; int mye = 0;
#pragma unroll 1
        for (int k = 0; k < TOPK; ++k) {
            float bv = cand[0]; int bidx = 4 * lane;
#pragma unroll
            for (int i = 1; i < 4; ++i) if (cand[i] > bv) { bv = cand[i]; bidx = 4 * lane + i; }
#pragma unroll
            for (int off = 1; off < 64; off <<= 1) { const float ov = __shfl_xor(bv, off); const int oi = __shfl_xor(bidx, off); if (ov > bv || (ov == bv && oi < bidx)) { bv = ov; bidx = oi; } }
            const int owner = bidx >> 2, which = bidx & 3;
            const float s = which == 0 ? sc[0] : which == 1 ? sc[1] : which == 2 ? sc[2] : sc[3];
            const float sw = __shfl(s, owner);
#pragma unroll
            for (int i = 0; i < 4; ++i) if (lane == owner && which == i) cand[i] = NEG;
            wsum += sw; if (lane == k) { myw = sw; mye = bidx; }
        }
        if (lane < TOPK) { sel_e[(size_t)t * 8 + lane] = mye; sel_w[(size_t)t * 8 + lane] = 2.5f * myw / wsum; (void)__hip_atomic_fetch_add(&hist[mye], 1u, __ATOMIC_RELAXED, __HIP_MEMORY_SCOPE_WORKGROUP); }
    }
    __syncthreads();
    unsigned* cnt = (unsigned*)(F.ws + WS_CTL) + CW_CNT + 1024 * l;
    for (int e = F.tid; e < 256; e += NTHR) if (hist[e]) atomicAdd(cnt + e, hist[e]);
    __syncthreads();
}

__device__ __forceinline__ void assign_phase(Frame& F, int l, int Tl) {
    LAS int* cntL = (LAS int*)F.lds; LAS int* pstart = cntL + 256; LAS unsigned* hist = (LAS unsigned*)(pstart + 260); LAS unsigned* base = hist + 256; LAS unsigned* hist2 = base + 256;
    unsigned* cnt = (unsigned*)(F.ws + WS_CTL) + CW_CNT + 1024 * l; unsigned* fill = cnt + 512;
    const int tid = F.tid, lane = F.lane;
    if (tid < 256) { cntL[tid] = (int)cnt[tid]; hist[tid] = 0u; hist2[tid] = 0u; }
    __syncthreads();
    if (F.wave == 0) {
        int p[4]; int s = 0;
#pragma unroll
        for (int i = 0; i < 4; ++i) { p[i] = (cntL[4 * lane + i] + 255) & ~255; s += p[i]; }
        int inc = s;
#pragma unroll
        for (int off = 1; off < 64; off <<= 1) { const int v = __shfl_up(inc, off); if (lane >= off) inc += v; }
        int ex = inc - s;
#pragma unroll
        for (int i = 0; i < 4; ++i) { pstart[4 * lane + i] = ex; ex += p[i]; }
        if (lane == 63) pstart[256] = inc;
    }
    __syncthreads();
    const int total_rows = pstart[256], ntile_r = total_rows >> 8, ntiles = ntile_r + (Tl >> 8);
    int* meta = (int*)(F.ws + WS_META); int* tile_expert = meta + 64;
    int* row_tok = (int*)(F.ws + WS_ROWTOK); const int* sel_e = (const int*)(F.ws + WS_SEL); int* tokpos = (int*)(F.ws + WS_SEL + 2 * SEL_STRIDE);
    if (blockIdx.x == 0) {
        if (tid == 0) { meta[0] = ntiles; meta[1] = total_rows; }
        if (tid < 256) { const int rt0 = pstart[tid] >> 8; for (int rt = rt0; rt < (pstart[tid + 1] >> 8); ++rt) tile_expert[rt] = tid | ((cntL[tid] - 256 * (rt - rt0) <= 128) ? 0x10000 : 0); }
        for (int rt = ntile_r + tid; rt < ntiles; rt += NTHR) tile_expert[rt] = 256;
    }
    for (int e = blockIdx.x; e < 256; e += F.G) for (int r = pstart[e] + cntL[e] + tid; r < pstart[e + 1]; r += NTHR) row_tok[r] = 0;
    const int TPW = (Tl + F.G - 1) / F.G, t0 = blockIdx.x * TPW, t1 = (t0 + TPW < Tl) ? t0 + TPW : Tl;
    for (int t = t0 + tid; t < t1; t += NTHR) row_tok[total_rows + t] = t;
    const int npairs = t1 > t0 ? (t1 - t0) * 8 : 0;
    for (int i = tid; i < npairs; i += NTHR) (void)__hip_atomic_fetch_add(&hist[sel_e[(size_t)t0 * 8 + i]], 1u, __ATOMIC_RELAXED, __HIP_MEMORY_SCOPE_WORKGROUP);
    __syncthreads();
    if (tid < 256) base[tid] = hist[tid] ? atomicAdd(fill + tid, hist[tid]) : 0u;
    __syncthreads();
    for (int i = tid; i < npairs; i += NTHR) { const int e = sel_e[(size_t)t0 * 8 + i]; const unsigned off = __hip_atomic_fetch_add(&hist2[e], 1u, __ATOMIC_RELAXED, __HIP_MEMORY_SCOPE_WORKGROUP);
        const int pos = pstart[e] + (int)base[e] + (int)off; row_tok[pos] = t0 + (i >> 3); tokpos[(size_t)t0 * 8 + i] = pos; }
    __syncthreads();
}

__device__ __forceinline__ void combine_phase(Frame& F, int l, int Tl) {
    const int* meta = (const int*)(F.ws + WS_META); const int total_rows = meta[1];
    const unsigned char* Y = (const unsigned char*)(F.ws + WS_Y); const int* tokpos = (const int*)(F.ws + WS_SEL + 2 * SEL_STRIDE); const float* sel_w = (const float*)(F.ws + WS_SEL + SEL_STRIDE);
    const float* mod = (const float*)(F.ws + WS_MOD);
    float* XC = (float*)(F.ws + WS_XC); bf16* HB = (bf16*)(F.ws + WS_HB);
    const int lane = F.lane, gw = blockIdx.x * NWAVES + F.wave, NGW = F.G * NWAVES;
    const int c0 = 16 * lane;
    const int ca = (lane >> 4) * 256 + ((lane >> 2) & 3) * 32 + (lane & 3) * 8, cb2 = ca + 128;
    for (int t = gw; t < Tl; t += NGW) {
        const int myp = lane < 8 ? tokpos[(size_t)t * 8 + lane] : 0; const float myw = lane < 8 ? sel_w[(size_t)t * 8 + lane] : 0.f;
        float* xr = t < TL ? F.out + (size_t)t * D : XC + (size_t)(t - TL) * D; const int r = t < TL ? (t >> 14) : 2;
        u32x4 yv[9];
        yv[8] = *(const u32x4*)(Y + (size_t)(total_rows + t) * 1024 + c0);
#pragma unroll
        for (int k = 0; k < TOPK; ++k) yv[k] = *(const u32x4*)(Y + (size_t)__shfl(myp, k) * 1024 + c0);
        f32x4 xv[4];
        xv[0] = *(const f32x4*)(xr + ca); xv[1] = *(const f32x4*)(xr + ca + 4); xv[2] = *(const f32x4*)(xr + cb2); xv[3] = *(const f32x4*)(xr + cb2 + 4);
        float y[16];
#pragma unroll
        for (int d = 0; d < 4; ++d) { const f32x2 a = __builtin_amdgcn_cvt_pk_f32_fp8((int)yv[8][d], false), bq = __builtin_amdgcn_cvt_pk_f32_fp8((int)yv[8][d], true);
            y[4 * d] = a.x; y[4 * d + 1] = a.y; y[4 * d + 2] = bq.x; y[4 * d + 3] = bq.y; }
#pragma unroll
        for (int k = 0; k < TOPK; ++k) { const float wk = __shfl(myw, k);
#pragma unroll
            for (int d = 0; d < 4; ++d) { const f32x2 a = __builtin_amdgcn_cvt_pk_f32_fp8((int)yv[k][d], false), bq = __builtin_amdgcn_cvt_pk_f32_fp8((int)yv[k][d], true);
                y[4 * d] += wk * a.x; y[4 * d + 1] += wk * a.y; y[4 * d + 2] += wk * bq.x; y[4 * d + 3] += wk * bq.y; } }
        const float* g2 = mod + (size_t)(l * 3 + r) * 6144 + 5120;
        f32x4 xn[4]; float s = 0.f;
#pragma unroll
        for (int j = 0; j < 4; ++j) { const int cj = (j < 2 ? ca : cb2) + 4 * (j & 1);
            xn[j] = xv[j] + *(const f32x4*)(g2 + cj) * (f32x4){y[4 * j], y[4 * j + 1], y[4 * j + 2], y[4 * j + 3]};
            s += (xn[j].x * xn[j].x + xn[j].y * xn[j].y) + (xn[j].z * xn[j].z + xn[j].w * xn[j].w); }
        const float rstd = rsqrtf(wave_sum(s) * (1.f / D) + EPS);
        if (l == 0) {
            const float* m1 = mod + (size_t)(3 + r) * 6144; const float* gain = F.in[6] + 1024;
            unsigned o[8];
#pragma unroll
            for (int j = 0; j < 4; ++j) { const int cj = (j < 2 ? ca : cb2) + 4 * (j & 1); *(f32x4*)(xr + cj) = xn[j];
                const f32x4 yv2 = xn[j] * rstd * *(const f32x4*)(gain + cj) * (*(const f32x4*)(m1 + 1024 + cj) + 1.f) + *(const f32x4*)(m1 + cj);
                o[2 * j] = pk2(yv2.x, yv2.y); o[2 * j + 1] = pk2(yv2.z, yv2.w); }
            *(u32x4*)(HB + (size_t)t * D + ca) = (u32x4){o[0], o[1], o[2], o[3]}; *(u32x4*)(HB + (size_t)t * D + cb2) = (u32x4){o[4], o[5], o[6], o[7]};
        } else {
            const float* gain = F.in[27];
#pragma unroll
            for (int j = 0; j < 4; ++j) { const int cj = (j < 2 ? ca : cb2) + 4 * (j & 1); *(f32x4*)(F.out + (size_t)t * D + cj) = xn[j] * rstd * *(const f32x4*)(gain + cj); }
        }
    }
}


#ifndef PH_EN
#define PH_EN 0xFFFFFFFFu
#endif
#define EN(j) ((PH_EN >> (j)) & 1u)
#ifndef U_EN
#define U_EN 0xFFu
#endif
#define UEN(j) ((U_EN >> (j)) & 1u)
#ifndef DUPMASK
#define DUPMASK 0u
#endif
#define REP(j) for (int rep_ = 0; rep_ < 1 + (int)((DUPMASK >> (j)) & 1u); ++rep_)
#ifndef DUPU
#define DUPU 0u
#endif
#define REPU(j) for (int repu_ = 0; repu_ < 1 + (int)((DUPU >> (j)) & 1u); ++repu_)
#define IN(k) (lo <= (k) && (k) < hi)
#define FRESH() do { asm volatile("" : "+v"(F.tid)); F.lane = F.tid & 63; } while (0)
#define SEAM(k) do { if (lo <= (k) && (k) + 1 < hi) xcd_barrier(bar); } while (0)
#define SEAMCV(k, lcv) do { if (lo <= (k) && (k) + 1 < hi) xcd_barrier_cv(bar, F); } while (0)
template <int l>
__device__ __forceinline__ void layer_phases(Frame& F, const XcdBarrier& bar, const int lo, const int hi) {
    const int bid = blockIdx.x, G = F.G;

        const int pb = 2 + 12 * l;
        const int Tl = l == 0 ? TT : TL;
        bf16* HB = (bf16*)(F.ws + WS_HB); bf16* Zb = (bf16*)(F.ws + WS_Z); bf16* MIX = (bf16*)(F.ws + WS_MIX);
        if (EN(2) && IN(pb + 0)) REP(2) { FRESH();
            pg8::Gemm g{HB, (const bf16*)(F.ws + WS_WIN) + (size_t)l * INW * 1024, nullptr, 1024}; pg8::StaticOrder S; S.init(TT, INW, G, bid);
            pg8::EpiBf16 E{Zb, INW};
            pg8::gemm_phase<pg8::EpiBf16, pg8::StaticOrder, false>(F.lds, g, S, E, F.tid);
            SEAMCV(pb + 0, l);
        }
        if (EN(3) && IN(pb + 1)) REP(3) { FRESH();
            REPU(0) if (UEN(0)) hgrn2_c1<0>(F, l, bid, 16 * HG_SLOTS, G);
            FRESH(); REPU(1) if (UEN(1)) for (int u = (bid + G - 32) % G; u < 2 * LR_SLOTS; u += G) lru_unit<false>(F, l, u / LR_SLOTS, u % LR_SLOTS);
            FRESH(); REPU(2) if (UEN(2)) for (int u = bid; u < 256; u += G) fft_f1(F, u >> 7, u & 127);
            FRESH(); REPU(3) if (UEN(3) && l == 0) for (int u = (bid + G - 64) % G; u < 8; u += G) ctx_fourier(F, u >> 2, u & 3);
            SEAMCV(pb + 1, l);
        }
        if (EN(4) && IN(pb + 2)) REP(4) { FRESH(); hgrn2_c2(F); lru_carry(F); SEAMCV(pb + 2, l); }
        if (EN(5) && IN(pb + 3)) REP(5) { FRESH();
            const int nslot = l == 0 ? HG_SLOTS : HG_SLOTS - 2, slot0 = l == 0 ? 0 : 2;
            FRESH(); REPU(4) if (UEN(4)) for (int u = bid; u < 8 * nslot; u += G) hgrn2_c3<0>(F, l, u / nslot, slot0 + u % nslot);
            const int nls = l == 0 ? LR_SLOTS : LR_SLOTS - 4, ls0 = l == 0 ? 0 : 4;
            FRESH(); REPU(5) if (UEN(5)) for (int u = (bid + G - 32) % G; u < 2 * nls; u += G) lru_unit<true>(F, l, u / nls, ls0 + u % nls);
            FRESH(); REPU(6) if (UEN(6)) for (int u = bid; u < 512; u += G) fft_f2(F, u >> 8, (u >> 1) & 127, u & 1);
            SEAMCV(pb + 3, l);
        }
        if (EN(6) && IN(pb + 4)) REP(6) { FRESH();
            pg8::Gemm g{MIX, (const bf16*)(F.ws + WS_WOUT) + (size_t)l * 1024 * 1024, nullptr, 1024}; pg8::StaticOrder S; S.init(Tl, 1024, G, bid);
            pg8::EpiResid E{l == 0 ? F_X(F) : (const float*)F.out, F.out, F_CTX(F), (float*)(F.ws + WS_XC), (const float*)(F.ws + WS_MOD) + (size_t)l * 3 * 6144};
            pg8::gemm_phase<pg8::EpiResid, pg8::StaticOrder, false>(F.lds, g, S, E, F.tid);
            SEAMCV(pb + 4, l);
        }
        if (EN(7) && IN(pb + 5)) REP(7) { FRESH();
            hprep_rows(F, l, F.out, (const float*)(F.ws + WS_XC), Tl, 3072, 4096, F.in[7] + l * 1024, true);
            SEAMCV(pb + 5, l);
        }
        if (EN(8) && IN(pb + 6)) REP(8) { FRESH();
            pg8::Gemm g{HB, (const bf16*)(F.ws + WS_WR) + (size_t)l * 256 * 1024, nullptr, 1024}; pg8::StaticOrder S; S.init(Tl, 256, G, bid);
            pg8::EpiF32 E{(float*)(F.ws + WS_LOGIT), 256};
            pg8::gemm_phase<pg8::EpiF32, pg8::StaticOrder, false>(F.lds, g, S, E, F.tid);
            SEAMCV(pb + 6, l);
        }
        if (EN(9) && IN(pb + 7)) REP(9) { FRESH(); route_phase(F, l, Tl); SEAMCV(pb + 7, l); }
        if (EN(10) && IN(pb + 8)) REP(10) { FRESH(); assign_phase(F, l, Tl); FRESH(); convert_experts(F, l); SEAMCV(pb + 8, l); }
        if (EN(11) && IN(pb + 9)) REP(11) { FRESH();
            const int* meta = (const int*)(F.ws + WS_META);
            pg8::Gemm g{(const bf16*)(F.ws + WS_HB8), (const bf16*)(F.ws + (l ? WS_WEXP1 : WS_WEXP)), (const int*)(F.ws + WS_ROWTOK), 512, 0x7a7a7a7a, 0x7f7f7f7f}; pg8::MoeOrder<2> S{meta + 64, meta[0], G, bid};
            pg8::EpiSwiglu8 E{F.ws + WS_HBUF};
            pg8::gemm_phase<pg8::EpiSwiglu8, pg8::MoeOrder<2>, true, true>(F.lds, g, S, E, F.tid);
            SEAMCV(pb + 9, l);
        }
        if (EN(12) && IN(pb + 10)) REP(12) { FRESH();
            const int* meta = (const int*)(F.ws + WS_META);
            pg8::Gemm g{(const bf16*)(F.ws + WS_HBUF), (const bf16*)(F.ws + (l ? WS_WEXP1 : WS_WEXP) + WEXP_GU_BYTES), nullptr, 128, 0x7b7b7b7b, 0x7d7d7d7d}; pg8::MoeOrder<4> S{meta + 64, meta[0], G, bid};
            pg8::EpiFp8 E{(unsigned char*)(F.ws + WS_Y), 1024};
            pg8::gemm_phase<pg8::EpiFp8, pg8::MoeOrder<4>, false, true>(F.lds, g, S, E, F.tid);
            SEAMCV(pb + 10, l);
        }
        if (EN(13) && IN(pb + 11)) REP(13) { FRESH(); combine_phase(F, l, Tl); SEAMCV(pb + 11, l); }
    }

constexpr int NPH = 26;
#ifndef BENCH_REPS
#define BENCH_REPS 2
#endif
__global__ void __launch_bounds__(NTHR, 2) fwd_kernel(Args args) {
    extern __shared__ __attribute__((aligned(16))) unsigned char lds_raw[];
    Frame F;
    F.lds = (LAS unsigned char*)lds_raw;
    F.tid = threadIdx.x; F.lane = F.tid & 63; F.wave = __builtin_amdgcn_readfirstlane(F.tid >> 6); F.G = gridDim.x;
    F.in = (const CAS cfptr*)__builtin_amdgcn_kernarg_segment_ptr();
    F.out = args.out; F.ws = args.ws;
    volatile LAS unsigned* MISC = (volatile LAS unsigned*)(F.lds + MISC_OFF);
    if (F.tid < 64) MISC[F.tid] = 0u;
    __syncthreads();
    XcdBarrier bar = xcd_barrier_post((unsigned*)(F.ws + WS_CTL) + CW_BAR, MISC + 8);
    const int lo = args.ph_lo, hi = args.ph_hi;
    const int bid = blockIdx.x, G = F.G;

    if (EN(0) && IN(0)) { FRESH(); phase_g0(F); SEAMCV(0, 0); }
    if (EN(1) && IN(1)) { FRESH(); hprep_rows(F, 0, F_X(F), F_CTX(F), TT, 0, 1024, F.in[6]); SEAMCV(1, 0); }

    layer_phases<0>(F, bar, lo, hi);
    layer_phases<1>(F, bar, lo, hi);
#ifdef BENCH_GEMM
    if (hi == NPH) { xcd_barrier(bar); FRESH();
        _Pragma("unroll 1") for (int rep = 0; rep < BENCH_REPS; ++rep) {
            const int* meta = (const int*)(F.ws + WS_META);
            pg8::Gemm g{(const bf16*)(F.ws + WS_HBUF), (const bf16*)(F.ws + WS_WEXP + WEXP_GU_BYTES), nullptr, 256}; pg8::MoeOrder<4> S{meta + 64, meta[0], F.G, (int)blockIdx.x};
#if BENCH_GEMM == 1
            pg8::EpiFp8 E{(unsigned char*)(F.ws + WS_Y), 1024}; pg8::gemm_phase<pg8::EpiFp8, pg8::MoeOrder<4>, false>(F.lds, g, S, E, F.tid);
#else
            pg8::EpiNone E{(bf16*)(F.ws + WS_Y)}; pg8::gemm_phase<pg8::EpiNone, pg8::MoeOrder<4>, false>(F.lds, g, S, E, F.tid);
#endif
            xcd_barrier(bar); } }
#endif
#ifdef BENCH_INPROJ
    if (hi == NPH) { xcd_barrier(bar); FRESH();
        _Pragma("unroll 1") for (int rep = 0; rep < BENCH_REPS; ++rep) {
            pg8::Gemm g{(const bf16*)(F.ws + WS_HB), (const bf16*)(F.ws + WS_WIN), nullptr, 1024}; pg8::StaticOrder S; S.init(TT, INW, F.G, (int)blockIdx.x);
#if BENCH_INPROJ == 1
            pg8::EpiBf16 E{(bf16*)(F.ws + WS_Z), INW}; pg8::gemm_phase<pg8::EpiBf16, pg8::StaticOrder, false>(F.lds, g, S, E, F.tid);
#else
            pg8::EpiNone E{(bf16*)(F.ws + WS_Z)}; pg8::gemm_phase<pg8::EpiNone, pg8::StaticOrder, false>(F.lds, g, S, E, F.tid);
#endif
            xcd_barrier(bar); } }
#endif
#ifdef BENCH_MOE1
    if (hi == NPH) { xcd_barrier(bar); FRESH();
        _Pragma("unroll 1") for (int rep = 0; rep < BENCH_REPS; ++rep) {
            const int* meta = (const int*)(F.ws + WS_META);
            pg8::MoeOrder<2> S{meta + 64, meta[0], F.G, (int)blockIdx.x};
#if BENCH_MOE1 == 1
            pg8::Gemm g{(const bf16*)(F.ws + WS_HB), (const bf16*)(F.ws + WS_WEXP1), (const int*)(F.ws + WS_ROWTOK), 1024};
            pg8::EpiSwiglu E{(bf16*)(F.ws + WS_HBUF)}; pg8::gemm_phase<pg8::EpiSwiglu, pg8::MoeOrder<2>, true>(F.lds, g, S, E, F.tid);
#elif BENCH_MOE1 == 2
            pg8::Gemm g{(const bf16*)(F.ws + WS_HB), (const bf16*)(F.ws + WS_WEXP1), (const int*)(F.ws + WS_ROWTOK), 1024};
            pg8::EpiNone E{(bf16*)(F.ws + WS_HBUF)}; pg8::gemm_phase<pg8::EpiNone, pg8::MoeOrder<2>, true>(F.lds, g, S, E, F.tid);
#else
            pg8::Gemm g{(const bf16*)(F.ws + WS_HB), (const bf16*)(F.ws + WS_WEXP1), nullptr, 1024};
            pg8::EpiNone E{(bf16*)(F.ws + WS_HBUF)}; pg8::gemm_phase<pg8::EpiNone, pg8::MoeOrder<2>, false>(F.lds, g, S, E, F.tid);
#endif
            xcd_barrier(bar); } }
#endif
#ifdef BENCH_X2
    if (hi == NPH) { xcd_barrier(bar); FRESH();
        _Pragma("unroll 1") for (int rep = 0; rep < BENCH_REPS; ++rep) { if (BENCH_X2 & 1) hgrn2_c2(F); if (BENCH_X2 & 2) lru_carry(F); xcd_barrier(bar); } }
#endif
#ifdef BENCH_C1
    if (hi == NPH) { xcd_barrier(bar); FRESH();
        _Pragma("unroll 1") for (int rep = 0; rep < BENCH_REPS; ++rep) hgrn2_c1<BENCH_C1>(F, 1, (int)blockIdx.x, 16 * HG_SLOTS, F.G); }
#endif
#ifdef BENCH_VAR
    if (hi == NPH) { xcd_barrier(bar); FRESH();
        _Pragma("unroll 1") for (int rep = 0; rep < BENCH_REPS; ++rep) for (int u = blockIdx.x; u < 8 * 128; u += F.G) hgrn2_c3<BENCH_VAR>(F, 1, u >> 7, 2 + (u & 127)); }
#endif
#undef IN
#undef SEAM
}

extern "C" void kernel_launch(void* const* d_in, const int* in_sizes, int n_in, void* d_out, int out_size, void* d_ws, size_t ws_size, hipStream_t stream) {
    static int grid = 0;
    if (grid == 0) {
        if (n_in != 28 || out_size != TL * D || ws_size < WS_END) { fprintf(stderr, "kernel_launch: unexpected problem (n_in %d, out %d, ws %zu < %zu)\n", n_in, out_size, ws_size, (size_t)WS_END); grid = -1; return; }
        int dev = 0, cus = 0, per_cu = 0;
        if (hipGetDevice(&dev) != hipSuccess || hipDeviceGetAttribute(&cus, hipDeviceAttributeMultiprocessorCount, dev) != hipSuccess) { grid = -1; return; }
        if (hipFuncSetAttribute((const void*)fwd_kernel, hipFuncAttributeMaxDynamicSharedMemorySize, LDS_BYTES) != hipSuccess) { fprintf(stderr, "kernel_launch: hipFuncSetAttribute failed\n"); grid = -1; return; }
        if (hipOccupancyMaxActiveBlocksPerMultiprocessor(&per_cu, (const void*)fwd_kernel, NTHR, LDS_BYTES) != hipSuccess || per_cu < 1) { fprintf(stderr, "kernel_launch: occupancy query says %d\n", per_cu); (void)hipGetLastError(); }
        grid = cus;
    }
    if (grid < 0) return;
    (void)hipMemsetAsync((char*)d_ws + WS_CTL, 0, CTL_ZERO_BYTES, stream);
    Args a{};
    for (int i = 0; i < 28; ++i) a.in[i] = (const float*)d_in[i];
    a.out = (float*)d_out; a.ws = (unsigned char*)d_ws;
#if MK_PER_PHASE
    for (int p = 0; p < NPH; ++p) { a.ph_lo = p; a.ph_hi = p + 1; hipLaunchKernelGGL(fwd_kernel, dim3(grid), dim3(NTHR), LDS_BYTES, stream, a); }
#else
    a.ph_lo = 0; a.ph_hi = NPH; hipLaunchKernelGGL(fwd_kernel, dim3(grid), dim3(NTHR), LDS_BYTES, stream, a);
#endif
}
```

```cpp
#include <hip/hip_runtime.h>
#include <cstdio>
#include <cstdint>

#ifndef MK_PER_PHASE
#define MK_PER_PHASE 0
#endif

#define LAS __attribute__((address_space(3)))
#define GAS __attribute__((address_space(1)))
typedef unsigned short bf16;
typedef short bf16x8 __attribute__((ext_vector_type(8)));
typedef float f32x4 __attribute__((ext_vector_type(4)));
typedef float f32x2 __attribute__((ext_vector_type(2)));
typedef unsigned u32x4 __attribute__((ext_vector_type(4)));
typedef unsigned u32x2 __attribute__((ext_vector_type(2)));
typedef int i32x4 __attribute__((ext_vector_type(4)));
typedef int i32x8 __attribute__((ext_vector_type(8)));

__device__ __forceinline__ float bf2f(bf16 v) { return __builtin_bit_cast(float, ((unsigned)v) << 16); }
typedef __bf16 bf16x2_t __attribute__((ext_vector_type(2)));
__device__ __forceinline__ unsigned pk2(float lo, float hi) { bf16x2_t v; v.x = (__bf16)lo; v.y = (__bf16)hi; return __builtin_bit_cast(unsigned, v); }
__device__ __forceinline__ bf16 f2bf(float f) { const __bf16 b = (__bf16)f; return __builtin_bit_cast(unsigned short, b); }
__device__ __forceinline__ unsigned f2bfu(float f) { return (unsigned)f2bf(f); }
#define MFMA16(a, b, c) __builtin_amdgcn_mfma_f32_16x16x32_bf16((a), (b), (c), 0, 0, 0)
#define LDS_WAIT() asm volatile("s_waitcnt lgkmcnt(0)" ::: "memory")
#define LDS_BARRIER() do { asm volatile("s_waitcnt lgkmcnt(0)" ::: "memory"); __builtin_amdgcn_s_barrier(); asm volatile("" ::: "memory"); } while (0)

namespace pg8 {
typedef unsigned short bf16_t;
constexpr int BM = 256, BK = 64, HALF = 128, HTB = HALF * BK * 2, STAGE_BYTES = 8 * HTB, NXCD = 8, WGM = 8;

__host__ __device__ __forceinline__ int lds_byte(int r, int c) { const int st = (r >> 4) * 2 + (c >> 5), rr = r & 15, cc = c & 31, ob = rr * 64 + cc * 2; return st * 1024 + (ob ^ (((ob >> 9) & 1) << 5)); }
__host__ __device__ __forceinline__ void stage_rc(int b, int& R, int& C) { const int st = b / 1024, sb = b % 1024, swz = sb ^ (((sb >> 9) & 1) << 5); R = (st >> 1) * 16 + swz / 64; C = (st & 1) * 32 + (swz % 64) / 2; }
__host__ __device__ __forceinline__ int perm32(int rho) { const int n = rho >> 4, i = rho & 15; return 8 * (i >> 2) + 4 * n + (i & 3); }

struct Unit { int pm, pn, pc, half; };
struct Gemm { const bf16_t* A; const bf16_t* Bt; const int* rows; int K; int sw = 0x7f7f7f7f, sx = 0x7f7f7f7f; };

struct StaticOrder {
    int nM, nN, nwg, G, c;
    __device__ void init(int M, int N, int G_, int c_) { nM = M / BM; nN = N / BM; nwg = nM * nN; G = G_; c = c_; }
    __device__ bool next(int i, Unit& u) const {
        const long L = (long)i * G + c; if (L >= nwg) return false;
        int wgid = (int)L; { const int q = nwg / NXCD, r = nwg % NXCD, xcd = wgid % NXCD, off = wgid / NXCD; wgid = (xcd < r ? xcd * (q + 1) : r * (q + 1) + (xcd - r) * q) + off; }
        const int nig = WGM * nN, gid = wgid / nig, fm = gid * WGM, gsz = (nM - fm) < WGM ? (nM - fm) : WGM;
        u.pm = fm + ((wgid % nig) % gsz); u.pn = (wgid % nig) / gsz; u.pc = u.pn; u.half = 0; return true;
    }
};
template <int NT> struct MoeOrder {
    const int* tile_expert; int n_tiles, G, c;
    __device__ bool next(int i, Unit& u) const {
        int rt, j;
        if ((G & 7) == 0) { const int x = c & 7, jw = c >> 3, per = G >> 3; const int t0 = (int)(((long)n_tiles * x) >> 3), t1 = (int)(((long)n_tiles * (x + 1)) >> 3);
            const int Lx = i * per + jw; if (Lx >= (t1 - t0) * NT) return false; rt = t0 + Lx / NT; j = Lx % NT; }
        else { const int L = i * G + c; if (L >= n_tiles * NT) return false; rt = L / NT; j = L % NT; }
        const int te = tile_expert[rt], e = te & 0xffff;
        u.pm = rt; u.pn = e * NT + j; u.pc = j; u.half = te >> 16; return true;
    }
};

__device__ __forceinline__ unsigned cvt_pk_bf16(float lo, float hi) { return pk2(lo, hi); }

struct EpiBf16 {
    static constexpr bool PERM = true;
    bf16_t* O; int ldc;
    __device__ __forceinline__ void operator()(const f32x4 (&acc)[2][2][4][2], const Unit& u, int wr, int wc, int fr, int fq) const {
        const int row0 = u.pm * BM + wr * 64 + fr, col0 = u.pc * BM + wc * 32 + 8 * fq;
#pragma unroll
        for (int ai = 0; ai < 2; ++ai)
#pragma unroll
            for (int m = 0; m < 4; ++m) { bf16_t* rowp = O + (size_t)(row0 + ai * HALF + m * 16) * ldc + col0;
#pragma unroll
                for (int bj = 0; bj < 2; ++bj) { const f32x4 v0 = acc[ai][bj][m][0], v1 = acc[ai][bj][m][1];
                    u32x4 w; w.x = cvt_pk_bf16(v0[0], v0[1]); w.y = cvt_pk_bf16(v0[2], v0[3]); w.z = cvt_pk_bf16(v1[0], v1[1]); w.w = cvt_pk_bf16(v1[2], v1[3]);
                    *(u32x4*)(rowp + bj * HALF) = w; } }
    }
};
struct EpiFp8 {
    static constexpr bool PERM = true;
    unsigned char* O; int ldc;
    static __device__ __forceinline__ unsigned pk4(const f32x4 v) {
        const float a = __builtin_amdgcn_fmed3f(v[0], -448.f, 448.f), b = __builtin_amdgcn_fmed3f(v[1], -448.f, 448.f), c = __builtin_amdgcn_fmed3f(v[2], -448.f, 448.f), d = __builtin_amdgcn_fmed3f(v[3], -448.f, 448.f);
        int p = __builtin_amdgcn_cvt_pk_fp8_f32(a, b, 0, false); p = __builtin_amdgcn_cvt_pk_fp8_f32(c, d, p, true); return (unsigned)p; }
    __device__ __forceinline__ void operator()(const f32x4 (&acc)[2][2][4][2], const Unit& u, int wr, int wc, int fr, int fq) const {
        const int row0 = u.pm * BM + wr * 64 + fr, pos0 = u.pc * BM + wc * 64 + 16 * fq;
#pragma unroll
        for (int ai = 0; ai < 2; ++ai) { if (ai == 1 && u.half) break;
#pragma unroll
            for (int m = 0; m < 4; ++m) { u32x4 w; w.x = pk4(acc[ai][0][m][0]); w.y = pk4(acc[ai][0][m][1]); w.z = pk4(acc[ai][1][m][0]); w.w = pk4(acc[ai][1][m][1]);
                *(u32x4*)(O + (size_t)(row0 + ai * HALF + m * 16) * ldc + pos0) = w; } }
    }
};
struct EpiNone {
    static constexpr bool PERM = true;
    bf16_t* O;
    __device__ __forceinline__ void operator()(const f32x4 (&acc)[2][2][4][2], const Unit& u, int wr, int wc, int fr, int fq) const {
        float s = 0.f;
#pragma unroll
        for (int ai = 0; ai < 2; ++ai)
#pragma unroll
            for (int bj = 0; bj < 2; ++bj)
#pragma unroll
                for (int m = 0; m < 4; ++m)
#pragma unroll
                    for (int n = 0; n < 2; ++n) s += acc[ai][bj][m][n][0] + acc[ai][bj][m][n][1] + acc[ai][bj][m][n][2] + acc[ai][bj][m][n][3];
        if (s == 123.4567f) O[u.pm + wr + wc + fr + fq] = 1;
    }
};
struct EpiF32 {
    static constexpr bool PERM = false;
    float* C; int ldc;
    __device__ __forceinline__ void operator()(const f32x4 (&acc)[2][2][4][2], const Unit& u, int wr, int wc, int fr, int fq) const {
        const int row0 = u.pm * BM + wr * 64 + fr, col0 = u.pc * BM + wc * 32 + 4 * fq;
#pragma unroll
        for (int ai = 0; ai < 2; ++ai)
#pragma unroll
            for (int m = 0; m < 4; ++m) { float* rowp = C + (size_t)(row0 + ai * HALF + m * 16) * ldc + col0;
#pragma unroll
                for (int bj = 0; bj < 2; ++bj)
#pragma unroll
                    for (int n = 0; n < 2; ++n) *(f32x4*)(rowp + bj * HALF + n * 16) = acc[ai][bj][m][n]; }
    }
};
struct EpiResid {
    static constexpr bool PERM = false;
    const float* src_lat; float* dst_lat; const float* src_ctx; float* dst_ctx; const float* gate;
    __device__ __forceinline__ void operator()(const f32x4 (&acc)[2][2][4][2], const Unit& u, int wr, int wc, int fr, int fq) const {
        const int col0 = u.pc * BM + wc * 32 + 4 * fq;
        const float* src; float* dst; const float* gv; int row0;
        if (u.pm < 128) { row0 = u.pm * BM + wr * 64 + fr; src = src_lat; dst = dst_lat; gv = gate + (u.pm >> 6) * 6144 + 2048; }
        else { row0 = (u.pm - 128) * BM + wr * 64 + fr; src = src_ctx; dst = dst_ctx; gv = gate + 2 * 6144 + 2048; }
        f32x4 g[2][2];
#pragma unroll
        for (int bj = 0; bj < 2; ++bj)
#pragma unroll
            for (int n = 0; n < 2; ++n) g[bj][n] = *(const f32x4*)(gv + col0 + bj * HALF + n * 16);
#pragma unroll
        for (int ai = 0; ai < 2; ++ai)
#pragma unroll
            for (int m = 0; m < 4; ++m) { const size_t off = (size_t)(row0 + ai * HALF + m * 16) * 1024 + col0;
#pragma unroll
                for (int bj = 0; bj < 2; ++bj)
#pragma unroll
                    for (int n = 0; n < 2; ++n) { const f32x4 xv = *(const f32x4*)(src + off + bj * HALF + n * 16);
                        *(f32x4*)(dst + off + bj * HALF + n * 16) = xv + g[bj][n] * acc[ai][bj][m][n]; } }
    }
};
struct EpiSwiglu {
    static constexpr bool PERM = true;
    bf16_t* H;
    __device__ __forceinline__ void operator()(const f32x4 (&acc)[2][2][4][2], const Unit& u, int wr, int wc, int fr, int fq) const {
        const int row0 = u.pm * BM + wr * 64 + fr, col0 = u.pc * HALF + wc * 32 + 8 * fq;
#pragma unroll
        for (int ai = 0; ai < 2; ++ai) { if (ai == 1 && u.half) break;
#pragma unroll
            for (int m = 0; m < 4; ++m) { float h[8];
#pragma unroll
                for (int n = 0; n < 2; ++n)
#pragma unroll
                    for (int j = 0; j < 4; ++j) { const float g = acc[ai][0][m][n][j], up = acc[ai][1][m][n][j]; h[n * 4 + j] = g * __builtin_amdgcn_rcpf(1.f + __expf(-g)) * up; }
                u32x4 w; w.x = cvt_pk_bf16(h[0], h[1]); w.y = cvt_pk_bf16(h[2], h[3]); w.z = cvt_pk_bf16(h[4], h[5]); w.w = cvt_pk_bf16(h[6], h[7]);
                *(u32x4*)(H + (size_t)(row0 + ai * HALF + m * 16) * 256 + col0) = w; } }
    }
};

struct EpiSwiglu8 {
    static constexpr bool PERM = true;
    unsigned char* H;
    __device__ __forceinline__ void operator()(const f32x4 (&acc)[2][2][4][2], const Unit& u, int wr, int wc, int fr, int fq) const {
        const int row0 = u.pm * BM + wr * 64 + fr, col0 = u.pc * HALF + wc * 32 + 8 * fq;
#pragma unroll
        for (int ai = 0; ai < 2; ++ai) { if (ai == 1 && u.half) break;
#pragma unroll
            for (int m = 0; m < 4; ++m) { float h[8];
#pragma unroll
                for (int n = 0; n < 2; ++n)
#pragma unroll
                    for (int j = 0; j < 4; ++j) { const float g = acc[ai][0][m][n][j], up = acc[ai][1][m][n][j]; h[n * 4 + j] = __builtin_amdgcn_fmed3f(4.f * g * __builtin_amdgcn_rcpf(1.f + __expf(-g)) * up, -448.f, 448.f); }
                int lo = __builtin_amdgcn_cvt_pk_fp8_f32(h[0], h[1], 0, false); lo = __builtin_amdgcn_cvt_pk_fp8_f32(h[2], h[3], lo, true);
                int hi = __builtin_amdgcn_cvt_pk_fp8_f32(h[4], h[5], 0, false); hi = __builtin_amdgcn_cvt_pk_fp8_f32(h[6], h[7], hi, true);
                u32x2 w; w.x = (unsigned)lo; w.y = (unsigned)hi;
                *(u32x2*)(H + (size_t)(row0 + ai * HALF + m * 16) * 256 + col0) = w; } }
    }
};

template <class Epi, class Sched, bool GATHER, bool FP8 = false>
__device__ __forceinline__ void gemm_phase(LAS unsigned char* lds, const Gemm g, const Sched& S, const Epi& E, const int tid) {
    const int wid = __builtin_amdgcn_readfirstlane(tid >> 6), lane = tid & 63, wr = wid >> 2, wc = wid & 3, fr = lane & 15, fq = lane >> 4;
    const int K = g.K, nt = K / BK;
    int RA[2], CA[2]; unsigned voffB[2];
#pragma unroll
    for (int i = 0; i < 2; ++i) { int R, C; stage_rc(tid * 16 + i * 8192, R, C); const int Rb = Epi::PERM ? ((R & ~31) + perm32(R & 31)) : R;
        RA[i] = R; CA[i] = C; voffB[i] = (unsigned)(Rb * K + C) * 2u; }
    const unsigned kstep = (unsigned)(BK * 2);
    const unsigned hstep = (unsigned)HALF * (unsigned)K * 2u;
    const unsigned tstep = 2u * hstep;
    const unsigned ldsw = (unsigned)wid * 1024u;
    const int aoff = lds_byte(wr * 64 + fr, fq * 8), boff = lds_byte(wc * 32 + fr, fq * 8);
    const __amdgpu_buffer_rsrc_t srdA = __builtin_amdgcn_make_buffer_rsrc((void*)g.A, (short)0, 0x7fffffff, 0x00020000);
    const __amdgpu_buffer_rsrc_t srdB = __builtin_amdgcn_make_buffer_rsrc((void*)g.Bt, (short)0, 0x7fffffff, 0x00020000);
#define PG8_SA(b, h) (((b) * 2 + (h)) * HTB)
#define PG8_SB(b, h) ((4 + (b) * 2 + (h)) * HTB)
#define PG8_STAGE(bufoff, soff, voff) do { _Pragma("unroll") for (int _i = 0; _i < 2; ++_i) \
        __builtin_amdgcn_raw_ptr_buffer_load_lds(srdB, (LAS unsigned*)(lds + (bufoff) + ldsw + _i * 8192), 16, (int)(voff)[_i], (int)(soff), 0, 0); } while (0)
#define PG8_STAGE2(bufoff, soff, v0, v1) do { \
        __builtin_amdgcn_raw_ptr_buffer_load_lds(srdA, (LAS unsigned*)(lds + (bufoff) + ldsw), 16, (int)(v0), (int)(soff), 0, 0); \
        __builtin_amdgcn_raw_ptr_buffer_load_lds(srdA, (LAS unsigned*)(lds + (bufoff) + ldsw + 8192), 16, (int)(v1), (int)(soff), 0, 0); } while (0)
#define PG8_LDA(dst, b, h) do { _Pragma("unroll") for (int m = 0; m < 4; ++m) _Pragma("unroll") for (int k = 0; k < 2; ++k) dst[m][k] = *(const LAS bf16x8*)(lds + PG8_SA(b, h) + aoff + m * 2048 + k * 1024); } while (0)
#define PG8_LDB(dst, b, h) do { _Pragma("unroll") for (int n = 0; n < 2; ++n) _Pragma("unroll") for (int k = 0; k < 2; ++k) dst[n][k] = *(const LAS bf16x8*)(lds + PG8_SB(b, h) + boff + n * 2048 + k * 1024); } while (0)
#define PG8_MMA(ai, bj, At, Bt) do { __builtin_amdgcn_s_setprio(1); _Pragma("unroll") for (int m = 0; m < 4; ++m) _Pragma("unroll") for (int n = 0; n < 2; ++n) { \
        if constexpr (FP8) { const i32x4 b0_ = __builtin_bit_cast(i32x4, Bt[n][0]), b1_ = __builtin_bit_cast(i32x4, Bt[n][1]), a0_ = __builtin_bit_cast(i32x4, At[m][0]), a1_ = __builtin_bit_cast(i32x4, At[m][1]); \
            const i32x8 w8_ = __builtin_shufflevector(b0_, b1_, 0, 1, 2, 3, 4, 5, 6, 7), x8_ = __builtin_shufflevector(a0_, a1_, 0, 1, 2, 3, 4, 5, 6, 7); \
            asm volatile("v_mfma_scale_f32_16x16x128_f8f6f4 %0, %1, %2, %0, %3, %4 op_sel_hi:[0,0,0]" : "+v"(acc[ai][bj][m][n]) : "v"(w8_), "v"(x8_), "v"(sw_), "v"(sx_)); } \
        else { _Pragma("unroll") for (int k = 0; k < 2; ++k) acc[ai][bj][m][n] = __builtin_amdgcn_mfma_f32_16x16x32_bf16(Bt[n][k], At[m][k], acc[ai][bj][m][n], 0, 0, 0); } } __builtin_amdgcn_s_setprio(0); } while (0)
#define PG8_WAIT_V(n) asm volatile("s_waitcnt vmcnt(" #n ")" ::: "memory")
#define PG8_WAIT_L(n) asm volatile("s_waitcnt lgkmcnt(" #n ")" ::: "memory")
#define PG8_BAR __builtin_amdgcn_s_barrier()
#define PG8_SCHED __builtin_amdgcn_sched_barrier(0)
    Unit cur, nxt; int ui = 0;
    if (!S.next(0, cur)) return;
    int sw_ = g.sw, sx_ = g.sx;
    if constexpr (FP8) asm volatile("" : "+v"(sw_), "+v"(sx_));
    else { (void)sw_; (void)sx_; }
    f32x4 acc[2][2][4][2];
#pragma unroll
    for (int a = 0; a < 2; ++a)
#pragma unroll
        for (int b = 0; b < 2; ++b)
#pragma unroll
            for (int m = 0; m < 4; ++m)
#pragma unroll
                for (int n = 0; n < 2; ++n) acc[a][b][m][n] = (f32x4){0.f, 0.f, 0.f, 0.f};
    bf16x8 At[4][2], B0[2][2], B1[2][2];
    unsigned c00, c01, c10, c11, n00, n01, n10, n11;
    unsigned cA, cB = (unsigned)cur.pn * tstep;
    if constexpr (GATHER) {
        const int* rp = g.rows + (size_t)cur.pm * BM; const unsigned rb = (unsigned)K * 2u;
        c00 = (unsigned)rp[RA[0]] * rb + (unsigned)CA[0] * 2u; c01 = (unsigned)rp[RA[1]] * rb + (unsigned)CA[1] * 2u;
        c10 = (unsigned)rp[HALF + RA[0]] * rb + (unsigned)CA[0] * 2u; c11 = (unsigned)rp[HALF + RA[1]] * rb + (unsigned)CA[1] * 2u;
        cA = 0u;
    } else {
        c00 = (unsigned)(RA[0] * K + CA[0]) * 2u; c01 = (unsigned)(RA[1] * K + CA[1]) * 2u;
        c10 = (unsigned)((HALF + RA[0]) * K + CA[0]) * 2u; c11 = (unsigned)((HALF + RA[1]) * K + CA[1]) * 2u;
        cA = (unsigned)cur.pm * tstep;
    }
    n00 = c00; n01 = c01; n10 = c10; n11 = c11;
    PG8_STAGE(PG8_SB(0, 0), cB, voffB); PG8_STAGE(PG8_SB(0, 1), cB + hstep, voffB); PG8_STAGE2(PG8_SA(0, 0), cA, c00, c01); PG8_STAGE2(PG8_SA(0, 1), cA, c10, c11);
    if (wr == 1) PG8_BAR;
    PG8_WAIT_V(2); PG8_BAR;
    PG8_STAGE(PG8_SB(1, 0), cB + kstep, voffB); PG8_STAGE2(PG8_SA(1, 0), cA + kstep, c00, c01); PG8_STAGE(PG8_SB(1, 1), cB + hstep + kstep, voffB);
    PG8_WAIT_V(6); PG8_BAR;
    for (;;) {
        const bool has_next = S.next(ui + 1, nxt);
        unsigned nA; const unsigned nB = has_next ? (unsigned)nxt.pn * tstep : cB;
        if constexpr (GATHER) {
            nA = 0u;
            if (has_next) { const int* rp = g.rows + (size_t)nxt.pm * BM; const unsigned rb = (unsigned)K * 2u;
                n00 = (unsigned)rp[RA[0]] * rb + (unsigned)CA[0] * 2u; n01 = (unsigned)rp[RA[1]] * rb + (unsigned)CA[1] * 2u;
                n10 = (unsigned)rp[HALF + RA[0]] * rb + (unsigned)CA[0] * 2u; n11 = (unsigned)rp[HALF + RA[1]] * rb + (unsigned)CA[1] * 2u; }
            else { n00 = c00; n01 = c01; n10 = c10; n11 = c11; }
        } else {
            nA = has_next ? (unsigned)nxt.pm * tstep : cA;
        }
        const bool hf = cur.half != 0;
#pragma unroll 1
        for (int t = 0; t < nt; t += 2) {
            const bool last = (t == nt - 2);
            const unsigned a1 = cA + (unsigned)(t + 1) * kstep;
            const unsigned a2 = last ? nA : cA + (unsigned)(t + 2) * kstep, b2 = last ? nB : cB + (unsigned)(t + 2) * kstep;
            const unsigned a3 = a2 + kstep, b3 = b2 + kstep;
            unsigned s00 = c00, s01 = c01, s10 = c10, s11 = c11;
            if constexpr (GATHER) { s00 = last ? n00 : c00; s01 = last ? n01 : c01; s10 = last ? n10 : c10; s11 = last ? n11 : c11; }
            PG8_LDB(B0, 0, 0); PG8_LDB(B1, 0, 1); PG8_SCHED; PG8_LDA(At, 0, 0); PG8_STAGE2(PG8_SA(1, 1), a1, c10, c11);
            PG8_WAIT_V(8); PG8_WAIT_L(0); PG8_BAR; PG8_MMA(0, 0, At, B0); PG8_MMA(0, 1, At, B1); PG8_BAR; PG8_SCHED;
            if (!hf) PG8_LDA(At, 0, 1); PG8_STAGE(PG8_SB(0, 0), b2, voffB); PG8_STAGE(PG8_SB(0, 1), b2 + hstep, voffB); PG8_STAGE2(PG8_SA(0, 0), a2, s00, s01);
            PG8_WAIT_V(8); PG8_WAIT_L(0); PG8_BAR; if (!hf) { PG8_MMA(1, 0, At, B0); PG8_MMA(1, 1, At, B1); } PG8_BAR; PG8_SCHED;
            PG8_LDB(B0, 1, 0); PG8_LDB(B1, 1, 1); PG8_SCHED; PG8_LDA(At, 1, 0); PG8_STAGE2(PG8_SA(0, 1), a2, s10, s11);
            PG8_WAIT_V(8); PG8_WAIT_L(0); PG8_BAR; PG8_MMA(0, 0, At, B0); PG8_MMA(0, 1, At, B1); PG8_BAR; PG8_SCHED;
            if (!hf) PG8_LDA(At, 1, 1); PG8_STAGE(PG8_SB(1, 0), b3, voffB); PG8_STAGE(PG8_SB(1, 1), b3 + hstep, voffB); PG8_STAGE2(PG8_SA(1, 0), a3, s00, s01);
            PG8_WAIT_V(8); PG8_WAIT_L(0); PG8_BAR; if (!hf) { PG8_MMA(1, 0, At, B0); PG8_MMA(1, 1, At, B1); } PG8_BAR; PG8_SCHED;
        }
        if (wr == 0) PG8_BAR;
        if constexpr (FP8) { asm volatile("s_nop 15\n\ts_nop 7" ::: "memory"); PG8_SCHED; }
        E(acc, cur, wr, wc, fr, fq);
        if (!has_next) break;
#pragma unroll
        for (int a = 0; a < 2; ++a)
#pragma unroll
            for (int b = 0; b < 2; ++b)
#pragma unroll
                for (int m = 0; m < 4; ++m)
#pragma unroll
                    for (int n = 0; n < 2; ++n) acc[a][b][m][n] = (f32x4){0.f, 0.f, 0.f, 0.f};
        cur = nxt; cA = nA; cB = nB; ++ui;
        if constexpr (GATHER) { c00 = n00; c01 = n01; c10 = n10; c11 = n11; }
        if (wr == 1) PG8_BAR;
    }
    PG8_WAIT_V(0);
    PG8_BAR;
#undef PG8_SA
#undef PG8_SB
#undef PG8_STAGE
#undef PG8_STAGE2
#undef PG8_LDA
#undef PG8_LDB
#undef PG8_MMA
#undef PG8_WAIT_V
#undef PG8_WAIT_L
#undef PG8_BAR
#undef PG8_SCHED
}
}

#define XB_TMO      128
#define XB_XCNT(j)  (256  + 64 * (j))
#define XB_XSUB(j)  (1280 + 64 * (j))
#define XB_XGEN(j)  (2304 + 64 * (j))
#define XB_TOP      3328
#define XB_TOPGEN   3392
#define XCD_BAR_WORDS 3456
#define XB_SPIN_CAP (1u << 18)

__device__ __forceinline__ unsigned xb_ld(unsigned* p)              { return __hip_atomic_load(p, __ATOMIC_RELAXED, __HIP_MEMORY_SCOPE_AGENT); }
__device__ __forceinline__ unsigned xb_add(unsigned* p, unsigned v) { return __hip_atomic_fetch_add(p, v, __ATOMIC_RELAXED, __HIP_MEMORY_SCOPE_AGENT); }
__device__ __forceinline__ unsigned xb_xcc_id() { return (unsigned)__builtin_amdgcn_s_getreg((3 << 11) | 20) & 0xFu; }
#define XB_SPIN(cond, bar) do { unsigned _sp = 0; while (cond) { __builtin_amdgcn_s_sleep(1); \
    if ((++_sp & 255u) == 0u) { if (xb_ld(&(bar)[XB_TMO])) break; if (_sp > XB_SPIN_CAP) { atomicAdd(&(bar)[XB_TMO], 1u); break; } } } } while (0)

struct XcdBarrier { unsigned* bar; unsigned x; volatile LAS unsigned* st; };

__device__ __forceinline__ XcdBarrier xcd_barrier_post(unsigned* bar, volatile LAS unsigned* st) {
    XcdBarrier b; b.bar = bar; b.x = xb_xcc_id(); b.st = st;
    if (threadIdx.x == 0) (void)xb_add(&bar[XB_XCNT(b.x)], 1u);
    return b;
}
__device__ __forceinline__ void xcd_barrier_complete(unsigned* bar, unsigned x, unsigned& nloc, unsigned& nx) {
    const unsigned G = gridDim.x * gridDim.y * gridDim.z;
    unsigned sum, cnt, mine, sp = 0u;
    for (;;) {
        sum = 0u; cnt = 0u; mine = 0u;
#pragma unroll 1
        for (unsigned j = 0; j < 16; ++j) { const unsigned c = xb_ld(&bar[XB_XCNT(j)]); sum += c; cnt += (c > 0u) ? 1u : 0u; mine = (j == x) ? c : mine; }
        if (sum == G) break;
        __builtin_amdgcn_s_sleep(1);
        if ((++sp & 255u) == 0u) { if (xb_ld(&bar[XB_TMO])) break; if (sp > XB_SPIN_CAP) { atomicAdd(&bar[XB_TMO], 1u); break; } }
    }
    nloc = mine > 0u ? mine : 1u; nx = cnt > 0u ? cnt : 1u;
}
__device__ __forceinline__ void xcd_barrier(const XcdBarrier& b) {
    asm volatile("s_waitcnt vmcnt(0)" ::: "memory");
    __syncthreads();
    if (threadIdx.x == 0) {
        unsigned* bar = b.bar;
        __builtin_amdgcn_s_waitcnt(0);
        unsigned nloc = b.st[0], nx = b.st[1];
        if (nloc == 0u) { xcd_barrier_complete(bar, b.x, nloc, nx); b.st[0] = nloc; b.st[1] = nx; }
        const unsigned old = xb_add(&bar[XB_XSUB(b.x)], 1u);
        const unsigned gen = old / nloc;
        if (old + 1u == (gen + 1u) * nloc) {
            __builtin_amdgcn_fence(__ATOMIC_RELEASE, "agent");
            asm volatile("s_waitcnt vmcnt(0)" ::: "memory");
            const unsigned og = xb_add(&bar[XB_TOP], 1u);
            const unsigned tg = og / nx;
            if (og + 1u == (tg + 1u) * nx) xb_add(&bar[XB_TOPGEN], 1u);
            else XB_SPIN(xb_ld(&bar[XB_TOPGEN]) == tg, bar);
            __builtin_amdgcn_fence(__ATOMIC_ACQUIRE, "agent");
            xb_add(&bar[XB_XGEN(b.x)], 1u);
            asm volatile("s_waitcnt vmcnt(0)" ::: "memory");
        } else {
            XB_SPIN(xb_ld(&bar[XB_XGEN(b.x)]) == gen, bar);
            __builtin_amdgcn_fence(__ATOMIC_ACQUIRE, "agent");
            asm volatile("s_waitcnt vmcnt(0)" ::: "memory");
        }
    }
    __syncthreads();
}

constexpr int D = 1024, NBATCH = 2, SEQ = 16384, CTXL = 256;
constexpr int TL = NBATCH * SEQ, TC = NBATCH * CTXL, TT = TL + TC;
constexpr int INW = 3328;
constexpr int ZQ = 0, ZFF = 512, ZFB = 1024, ZV = 1536, ZG = 2048, ZXB = 2560, ZYB = 2816, ZU = 3072;
constexpr int NEXP = 256, TOPK = 8;
constexpr float EPS = 1e-6f;
constexpr int NWAVES = 8, NTHR = 512;
constexpr int CV_TILES = 257 * 48;
constexpr int CV_OUTP = 248 * 6;
constexpr int CV_ROUT = 126 * 10;
constexpr int HG_SLOTS = 130;
constexpr int LR_SLOTS = 260;
constexpr int MAXROWS = 364800;

constexpr size_t MiB = 1u << 20;
constexpr size_t WS_CTL = 0, CTL_ZERO_BYTES = 1 * MiB;
constexpr size_t WS_MOD = 1 * MiB;
constexpr size_t WS_TAB = 2 * MiB;
constexpr size_t TAB_FC = 0, TAB_FS = 32768, TAB_CS = 65536, TAB_LB = 81920  , TAB_LRUW = 86016  , TAB_LRUCL = 348160  , TAB_C256 = 352256  , TAB_S256 = 483328  ;
constexpr size_t WS_META = 3 * MiB;
constexpr size_t WS_WIN = 4 * MiB;
constexpr size_t WS_WOUT = 18 * MiB;
constexpr size_t WS_WR = 22 * MiB;
constexpr size_t WS_XC = 24 * MiB;
constexpr size_t WS_LRUC = 26 * MiB;
constexpr size_t LRUC_STRIDE = (size_t)2 * 2 * LR_SLOTS * 256 * 4;
constexpr size_t WS_SEL = 30 * MiB;
constexpr size_t SEL_STRIDE = (size_t)TT * 8 * 4;
constexpr size_t WS_ROWTOK = 34 * MiB;
constexpr size_t WS_HD = 36 * MiB;
constexpr size_t WS_LOGIT = 38 * MiB;
constexpr size_t WS_HB = 72 * MiB;
constexpr size_t WS_WEXP = 138 * MiB;
constexpr size_t WEXP_GU_BYTES = (size_t)257 * 512 * 1024;
constexpr size_t WS_HB8 = 340 * MiB;
constexpr size_t WS_BIG = 524 * MiB;
constexpr size_t WS_Z = WS_BIG;
constexpr size_t WS_MIX = WS_BIG + 212 * MiB;
constexpr size_t WS_HS = WS_BIG + 278 * MiB;
constexpr size_t WS_FA = WS_BIG + 410 * MiB;
constexpr size_t WS_GE = WS_BIG + 442 * MiB;
constexpr size_t WS_GK = WS_BIG + 508 * MiB;
constexpr size_t WS_HV = WS_BIG + 574 * MiB;
constexpr size_t WS_HBUF = WS_BIG;
constexpr size_t WS_Y = WS_BIG + 180 * MiB;
constexpr size_t WS_WEXP1 = 1104 * MiB;
constexpr size_t WS_END = WS_WEXP1 + (size_t)257 * 768 * 1024;
static_assert(WS_Y + (size_t)MAXROWS * 1024 <= WS_WEXP1 && WS_HV + (size_t)16 * 2 * HG_SLOTS * 256 * 4 <= WS_WEXP1 && WS_GK + (size_t)2 * TT * 512 * 2 <= WS_HV && WS_GE + (size_t)2 * TT * 512 * 2 <= WS_GK && WS_FA + (size_t)2 * 2 * 128 * 128 * 256 * 2 <= WS_GE, "overlay regions end below the second weight buffer");
static_assert(WS_Z + (size_t)TT * INW * 2 <= WS_MIX && WS_MIX + (size_t)TT * 1024 * 2 <= WS_HS && WS_HS + (size_t)16 * HG_SLOTS * 65536 <= WS_FA, "mixer overlay map");
static_assert(WS_HBUF + (size_t)MAXROWS * 256 * 2 <= WS_Y && WS_WEXP + (size_t)257 * 768 * 1024 <= WS_HB8 && WS_HB8 + (size_t)TT * 1024 <= WS_BIG && WS_HB + (size_t)TT * 2048 <= WS_WEXP, "moe overlay map");
constexpr int CW_BAR = 4096;
constexpr int CW_CVQ = 8192;
constexpr int CW_CNT = 16384;

constexpr int LDS_BYTES = 151552;
constexpr int MISC_OFF = 150528;

struct Args { const float* in[28]; float* out; unsigned char* ws; int ph_lo, ph_hi; };

typedef const float* cfptr;
#define CAS __attribute__((address_space(4)))
struct Frame {
    LAS unsigned char* lds;
    int tid, lane, wave, G;
    const CAS cfptr* in;
    float* out; unsigned char* ws;
};
#define F_X(F)      ((F).in[0])
#define F_C(F)      ((F).in[1])
#define F_CTX(F)    ((F).in[2])
#define F_CCTX(F)   ((F).in[3])

__device__ __forceinline__ float wave_sum(float v) {
#pragma unroll
    for (int o = 1; o < 64; o <<= 1) v += __shfl_xor(v, o);
    return v;
}
__device__ __forceinline__ float sigmoidf_(float z) { return __builtin_amdgcn_rcpf(1.f + __expf(-z)); }

__device__ __forceinline__ void transpose_item(const float* W, int ldw, int k0, int n0, bf16* WT, int ldk, int drow0, LAS float* scr, int lane) {
#pragma unroll 8
    for (int i = 0; i < 32; ++i) { const int kk = 2 * i + (lane >> 5); scr[kk * 33 + (lane & 31)] = W[(size_t)(k0 + kk) * ldw + n0 + (lane & 31)]; }
    LDS_WAIT();
    const int c = lane & 7;
#pragma unroll
    for (int j = 0; j < 4; ++j) { const int n = (lane >> 3) + 8 * j; const LAS float* s = scr + (8 * c) * 33 + n;
        u32x4 o; o.x = pk2(s[0 * 33], s[1 * 33]); o.y = pk2(s[2 * 33], s[3 * 33]); o.z = pk2(s[4 * 33], s[5 * 33]); o.w = pk2(s[6 * 33], s[7 * 33]);
        *(u32x4*)(WT + (size_t)(drow0 + n) * ldk + k0 + 8 * c) = o; }
    LDS_WAIT();
}

__device__ __forceinline__ void norm_row_bf16(const float* xrow, const float* gain, const float* scl, const float* sft, bf16* orow, int lane, unsigned char* o8 = nullptr) {
    f32x4 v[4]; float s = 0.f;
#pragma unroll
    for (int j = 0; j < 4; ++j) { v[j] = *(const f32x4*)(xrow + 4 * lane + 256 * j); s += (v[j].x * v[j].x + v[j].y * v[j].y) + (v[j].z * v[j].z + v[j].w * v[j].w); }
    const float rstd = rsqrtf(wave_sum(s) * (1.f / D) + EPS);
#pragma unroll
    for (int j = 0; j < 4; ++j) { const int c = 4 * lane + 256 * j;
        const f32x4 g = *(const f32x4*)(gain + c), sc = *(const f32x4*)(scl + c), sh = *(const f32x4*)(sft + c);
        const f32x4 y = v[j] * rstd * g * (sc + 1.f) + sh;
        u32x2 o; o.x = pk2(y.x, y.y); o.y = pk2(y.z, y.w); *(u32x2*)(orow + c) = o;
        if (o8) { int p8 = __builtin_amdgcn_cvt_pk_fp8_f32(__builtin_amdgcn_fmed3f(y.x, -448.f, 448.f), __builtin_amdgcn_fmed3f(y.y, -448.f, 448.f), 0, false);
            p8 = __builtin_amdgcn_cvt_pk_fp8_f32(__builtin_amdgcn_fmed3f(y.z, -448.f, 448.f), __builtin_amdgcn_fmed3f(y.w, -448.f, 448.f), p8, true); *(int*)(o8 + c) = p8; } }
}

__device__ __forceinline__ void convert_tile(Frame& F, const float* src, int ldw, bf16* dst, int ldk, int k0, int rowA, int rowB) {
    LAS bf16* T = (LAS bf16*)F.lds;
    const int tid = F.tid, w = F.wave, lane = F.lane;
    f32x4 v[8];
#pragma unroll
    for (int j = 0; j < 8; ++j) v[j] = *(const f32x4*)(src + (size_t)(8 * w + j) * ldw + 4 * lane);
#pragma unroll
    for (int j = 0; j < 8; ++j) { u32x2 o; o.x = pk2(v[j].x, v[j].y); o.y = pk2(v[j].z, v[j].w); *(LAS u32x2*)(T + (8 * w + j) * 264 + ((4 * lane) ^ (w << 3))) = o; }
    __syncthreads();
#pragma unroll
    for (int j = 0; j < 4; ++j) { const int p = tid + NTHR * j, kc = p & 7, n = p >> 3; const LAS bf16* t = T + (8 * kc) * 264 + (n ^ (kc << 3));
        u32x4 o; o.x = (unsigned)t[0] | ((unsigned)t[264] << 16); o.y = (unsigned)t[2 * 264] | ((unsigned)t[3 * 264] << 16);
        o.z = (unsigned)t[4 * 264] | ((unsigned)t[5 * 264] << 16); o.w = (unsigned)t[6 * 264] | ((unsigned)t[7 * 264] << 16);
        const int row = n < 128 ? rowA + n : rowB + n - 128;
        *(u32x4*)(dst + (size_t)row * ldk + k0 + 8 * kc) = o; }
    __syncthreads();
}

__device__ __forceinline__ void convert_tile8(Frame& F, const float* src, int ldw, unsigned char* dst8, int ldk, int k0, int rowA, int rowB, float scl) {
    LAS bf16* T = (LAS bf16*)F.lds;
    const int tid = F.tid, w = F.wave, lane = F.lane;
    f32x4 v[8];
#pragma unroll
    for (int j = 0; j < 8; ++j) v[j] = *(const f32x4*)(src + (size_t)(8 * w + j) * ldw + 4 * lane);
#pragma unroll
    for (int j = 0; j < 8; ++j) { const f32x4 q = v[j] * scl; u32x2 o; o.x = pk2(q.x, q.y); o.y = pk2(q.z, q.w); *(LAS u32x2*)(T + (8 * w + j) * 264 + ((4 * lane) ^ (w << 3))) = o; }
    __syncthreads();
#pragma unroll
    for (int j = 0; j < 4; ++j) { const int p = tid + NTHR * j, kc = p & 7, n = p >> 3; const LAS bf16* t = T + (8 * kc) * 264 + (n ^ (kc << 3));
        float f[8];
#pragma unroll
        for (int i = 0; i < 8; ++i) f[i] = __builtin_bit_cast(float, (unsigned)t[i * 264] << 16);
        int lo = __builtin_amdgcn_cvt_pk_fp8_f32(f[0], f[1], 0, false); lo = __builtin_amdgcn_cvt_pk_fp8_f32(f[2], f[3], lo, true);
        int hi = __builtin_amdgcn_cvt_pk_fp8_f32(f[4], f[5], 0, false); hi = __builtin_amdgcn_cvt_pk_fp8_f32(f[6], f[7], hi, true);
        const int row = n < 128 ? rowA + n : rowB + n - 128;
        u32x2 o; o.x = (unsigned)lo; o.y = (unsigned)hi;
        *(u32x2*)(dst8 + (size_t)row * ldk + k0 + 8 * kc) = o; }
    __syncthreads();
}

__device__ __forceinline__ void phase_g0(Frame& F) {
    float* mod = (float*)(F.ws + WS_MOD);
    {
        LAS float* sc = (LAS float*)F.lds; LAS float* red = sc + 3072;
        for (int u = blockIdx.x; u < 192; u += F.G) {
            const int l = u / 96, n0 = (u % 96) * 64;
            for (int i = F.tid; i < 3072; i += NTHR) { const int r = i >> 10, k = i & 1023; const float c = r < 2 ? F_C(F)[r * 1024 + k] : F_CCTX(F)[k]; sc[i] = c / (1.f + __expf(-c)); }
            __syncthreads();
            const int col = F.tid & 63, kg = F.tid >> 6;
            const float* W = F.in[4] + (size_t)l * 1024 * 6144 + n0 + col;
            float a0 = 0.f, a1 = 0.f, a2 = 0.f;
#pragma unroll 8
            for (int k = kg * 128; k < kg * 128 + 128; ++k) { const float w = W[(size_t)k * 6144]; a0 += sc[k] * w; a1 += sc[1024 + k] * w; a2 += sc[2048 + k] * w; }
            red[(kg * 3 + 0) * 64 + col] = a0; red[(kg * 3 + 1) * 64 + col] = a1; red[(kg * 3 + 2) * 64 + col] = a2;
            __syncthreads();
            if (F.tid < 192) { const int r = F.tid >> 6, cc = F.tid & 63; float s = F.in[5][l * 6144 + n0 + cc];
#pragma unroll
                for (int q = 0; q < 8; ++q) s += red[(q * 3 + r) * 64 + cc];
                mod[(l * 3 + r) * 6144 + n0 + cc] = s; }
            __syncthreads();
        }
    }
    {
        constexpr int PER_L = 16 * (13 + 4 + 1);
        for (int it = blockIdx.x; it < 2 * PER_L; it += F.G) {
            const int l = it / PER_L; int r = it % PER_L; const int kb = r / 18; r %= 18;
            if (r < 13) convert_tile(F, F.in[8] + (size_t)l * 1024 * INW + (size_t)(64 * kb) * INW + 256 * r, INW, (bf16*)(F.ws + WS_WIN) + (size_t)l * INW * 1024, 1024, 64 * kb, 256 * r, 256 * r + 128);
            else if (r < 17) convert_tile(F, F.in[18] + (size_t)l * 1024 * 1024 + (size_t)(64 * kb) * 1024 + 256 * (r - 13), 1024, (bf16*)(F.ws + WS_WOUT) + (size_t)l * 1024 * 1024, 1024, 64 * kb, 256 * (r - 13), 256 * (r - 13) + 128);
            else convert_tile(F, F.in[19] + (size_t)l * 1024 * 256 + (size_t)(64 * kb) * 256, 256, (bf16*)(F.ws + WS_WR) + (size_t)l * 256 * 1024, 1024, 64 * kb, 0, 128);
        }
    }
    {
        const int gt = blockIdx.x * NTHR + F.tid, NGT = F.G * NTHR;
        bf16* Fc = (bf16*)(F.ws + WS_TAB + TAB_FC); bf16* Fs = (bf16*)(F.ws + WS_TAB + TAB_FS); bf16* CS = (bf16*)(F.ws + WS_TAB + TAB_CS);
        for (int i = gt; i < 128 * 128; i += NGT) { const int k = i >> 7, n = i & 127; float s, c; sincospif((float)((k * n) & 127) * (1.f / 64.f), &s, &c); Fc[i] = f2bf(c); Fs[i] = f2bf(s); }
        for (int i = gt; i < 64 * 128; i += NGT) { const int m = i >> 7, kap = i & 127; float s, c; sincospif((float)((m * (kap & 63)) & 63) * (1.f / 32.f), &s, &c); CS[i] = f2bf(kap < 64 ? c : s); }
        bf16* C256 = (bf16*)(F.ws + WS_TAB + TAB_C256); bf16* S256 = (bf16*)(F.ws + WS_TAB + TAB_S256);
        for (int i = gt; i < 256 * 256; i += NGT) { const int k = i >> 8, n = i & 255; float sn, cs; sincospif((float)((k * n) & 255) * (1.f / 128.f), &sn, &cs); C256[i] = f2bf(cs); S256[i] = f2bf(-sn); }
        float* lb = (float*)(F.ws + WS_TAB + TAB_LB);
        for (int i = gt; i < 1024; i += NGT) { const int l = i >> 9, ch = i & 511; lb[i] = l == 0 ? 0.f : sigmoidf_(F.in[9][512 + ch] - F.in[9][ch]); }
        bf16* lw = (bf16*)(F.ws + WS_TAB + TAB_LRUW);
        for (int i = gt; i < 2 * 2 * 4 * 128 * 64; i += NGT) {
            const int k = i & 63, n = (i >> 6) & 127, ldh = i >> 13;
            const float v = n < 64 ? F.in[13][(size_t)ldh * 4096 + k * 64 + n] : F.in[15][(size_t)ldh * 4096 + k * 64 + (n - 64)];
            lw[i] = f2bf(v); }
        float* cl = (float*)(F.ws + WS_TAB + TAB_LRUCL);
        for (int i = gt; i < 1024; i += NGT) { const float lam = F.in[17][i]; const float sp = lam > 15.f ? __expf(-lam) : log1pf(__expf(-lam)); cl[i] = 8.f * sp; }
    }
}

__device__ __forceinline__ void hprep_rows(Frame& F, int l, const float* xlat, const float* xctx, int nrows, int voff_sh, int voff_sc, const float* gain, bool with8 = false) {
    const float* mod = (const float*)(F.ws + WS_MOD) + (size_t)l * 3 * 6144;
    bf16* HB = (bf16*)(F.ws + WS_HB);
    const int gw = blockIdx.x * NWAVES + F.wave, NGW = F.G * NWAVES;
    for (int m = gw; m < nrows; m += NGW) {
        const float* xr = m < TL ? xlat + (size_t)m * D : xctx + (size_t)(m - TL) * D; const int r = m < TL ? (m >> 14) : 2;
        norm_row_bf16(xr, gain, mod + r * 6144 + voff_sc, mod + r * 6144 + voff_sh, HB + (size_t)m * D, F.lane, with8 ? F.ws + WS_HB8 + (size_t)m * D : nullptr);
    }
}

__device__ __forceinline__ void cv_tile(Frame& F, int it_all) {
    const int l = it_all >= CV_TILES ? 1 : 0, it = it_all - l * CV_TILES;
    unsigned char* wb = F.ws + (l ? WS_WEXP1 : WS_WEXP);
    unsigned char* WGU = wb; unsigned char* WD = wb + WEXP_GU_BYTES;
    const int e = it / 48, t = it % 48;
    if (t < 32) {
        const int mat = t >> 4, kb = t & 15;
        const float* src = (e < 256 ? (mat == 0 ? F.in[21] : F.in[22]) + ((size_t)l * 256 + e) * 1024 * 256 : (mat == 0 ? F.in[24] : F.in[25]) + (size_t)l * 1024 * 256) + (size_t)(64 * kb) * 256;
        convert_tile8(F, src, 256, WGU, 1024, 64 * kb, e * 512 + mat * 128, e * 512 + 256 + mat * 128, 32.f);
    } else {
        const int kb = (t - 32) >> 2, nb = (t - 32) & 3;
        const float* src = (e < 256 ? F.in[23] + ((size_t)l * 256 + e) * 256 * 1024 : F.in[26] + (size_t)l * 256 * 1024) + (size_t)(64 * kb) * 1024 + 256 * nb;
        convert_tile8(F, src, 1024, WD, 256, 64 * kb, e * 1024 + 256 * nb, e * 1024 + 256 * nb + 128, 16.f);
    }
}
__device__ __forceinline__ int cv_pull(Frame& F) {
    volatile LAS int* slot = (volatile LAS int*)(F.lds + MISC_OFF) + 16;
    if (F.tid == 0) { const unsigned t = __hip_atomic_fetch_add((unsigned*)(F.ws + WS_CTL) + CW_CVQ, 1u, __ATOMIC_RELAXED, __HIP_MEMORY_SCOPE_AGENT); slot[0] = t < (unsigned)(2 * CV_TILES) ? (int)t : -1; }
    __syncthreads(); const int t = slot[0]; __syncthreads(); return t;
}
__device__ __forceinline__ void convert_experts(Frame& F, int l) {
    for (;;) { const int t = cv_pull(F); if (t < 0) break; cv_tile(F, t); if (t >= (l + 1) * CV_TILES) break; }
}

__device__ __forceinline__ void xcd_barrier_cv(const XcdBarrier& b, Frame& F) {
    volatile LAS unsigned* st = (volatile LAS unsigned*)(F.lds + MISC_OFF) + 20;
    asm volatile("s_waitcnt vmcnt(0)" ::: "memory");
    __syncthreads();
    if (threadIdx.x == 0) {
        unsigned* bar = b.bar;
        __builtin_amdgcn_s_waitcnt(0);
        unsigned nloc = b.st[0], nx = b.st[1];
        if (nloc == 0u) { xcd_barrier_complete(bar, b.x, nloc, nx); b.st[0] = nloc; b.st[1] = nx; }
        const unsigned old = xb_add(&bar[XB_XSUB(b.x)], 1u);
        const unsigned gen = old / nloc;
        if (old + 1u == (gen + 1u) * nloc) {
            __builtin_amdgcn_fence(__ATOMIC_RELEASE, "agent");
            asm volatile("s_waitcnt vmcnt(0)" ::: "memory");
            const unsigned og = xb_add(&bar[XB_TOP], 1u);
            const unsigned tg = og / nx;
            if (og + 1u == (tg + 1u) * nx) xb_add(&bar[XB_TOPGEN], 1u);
            else XB_SPIN(xb_ld(&bar[XB_TOPGEN]) == tg, bar);
            __builtin_amdgcn_fence(__ATOMIC_ACQUIRE, "agent");
            xb_add(&bar[XB_XGEN(b.x)], 1u);
            asm volatile("s_waitcnt vmcnt(0)" ::: "memory");
            st[0] = 0u;
        } else { st[0] = 1u; st[1] = gen; }
        st[2] = 0u;
    }
    __syncthreads();
    if (st[0]) {
        unsigned spins = 0u;
        for (;;) {
            int tile = -1;
            if (threadIdx.x == 0) {
                unsigned rel = xb_ld(&b.bar[XB_XGEN(b.x)]) != st[1] ? 1u : 0u;
                if (!rel && (++spins & 255u) == 0u) { if (xb_ld(&b.bar[XB_TMO])) rel = 1u; else if (spins > XB_SPIN_CAP) { atomicAdd(&b.bar[XB_TMO], 1u); rel = 1u; } }
                st[2] = rel;
                if (!rel && st[3] == 0u) { const unsigned t = __hip_atomic_fetch_add((unsigned*)(F.ws + WS_CTL) + CW_CVQ, 1u, __ATOMIC_RELAXED, __HIP_MEMORY_SCOPE_AGENT);
                    if (t < (unsigned)(2 * CV_TILES)) tile = (int)t; else st[3] = 1u; }
                st[4] = (unsigned)tile;
            }
            __syncthreads();
            const unsigned rel = st[2]; tile = (int)st[4];
            __syncthreads();
            if (rel) break;
            if (tile >= 0) cv_tile(F, tile); else __builtin_amdgcn_s_sleep(2);
        }
        if (threadIdx.x == 0) {
            st[3] = 0u;
            __builtin_amdgcn_fence(__ATOMIC_ACQUIRE, "agent");
            asm volatile("s_waitcnt vmcnt(0)" ::: "memory");
        }
    }
    __syncthreads();
}

constexpr int QS = 144, TS = 80;
constexpr int HG_QT = 0, HG_KT = 18432, HG_KTT = 36864, HG_VT = 57344, HG_SMT = 77824, HG_PM = 114688, HG_TOT = 124928, HG_BMID = 126976, HG_BEND = 127488, HG_RSS = 128000, HG_VR = 132096;
static_assert(HG_VR + 64 * QS * 2 <= MISC_OFF, "HGRN2 LDS map");

__device__ __forceinline__ float fast_rcp(float x) { return __builtin_amdgcn_rcpf(x); }
__device__ __forceinline__ f32x4 hg_ld4(const bf16* p) { const u32x2 v = *(const u32x2*)p;
    return (f32x4){__builtin_bit_cast(float, v.x << 16), __builtin_bit_cast(float, v.x & 0xffff0000u), __builtin_bit_cast(float, v.y << 16), __builtin_bit_cast(float, v.y & 0xffff0000u)}; }


template <int VAR>
__device__ __forceinline__ void hg_chunk_c1(Frame& F, const bf16* Zc, bf16* gq, bf16* gk, float* hv, const bf16* nz, const bf16* nq, const bool has_next, u32x4 (&zq)[4], int h, int rev, const float* lbp, f32x4 (&S)[8], float& dtot) {
    LAS bf16* Qt = (LAS bf16*)(F.lds + HG_QT); LAS bf16* Kt = (LAS bf16*)(F.lds + HG_KT); LAS bf16* KtT = (LAS bf16*)(F.lds + HG_KTT);
    LAS bf16* VT = (LAS bf16*)(F.lds + HG_VT); LAS bf16* Vr = (LAS bf16*)(F.lds + HG_VR);
    LAS float* tot = (LAS float*)(F.lds + HG_TOT); LAS float* bmid = (LAS float*)(F.lds + HG_BMID); LAS float* bend = (LAS float*)(F.lds + HG_BEND);
    LAS float* ebuf = (LAS float*)(F.lds + HG_RSS);
    const int tid = F.tid, lane = F.lane, w = F.wave, li = lane & 15, lq = lane >> 4;
    u32x4 vv[2];
#pragma unroll
    for (int j = 0; j < 2; ++j) { const int p = tid + NTHR * j, row = p >> 4, c16 = p & 15;
        vv[j] = *(const u32x4*)(Zc + (size_t)row * INW + ZV + h * 128 + 8 * c16);
        *(LAS u32x4*)(Kt + row * QS + 8 * c16) = zq[j]; *(LAS u32x4*)(Qt + row * QS + 8 * c16) = zq[2 + j]; }
    LDS_BARRIER();
    const int ch = tid & 127, tq = tid >> 7;
    const float lbv = lbp[h * 128 + ch], oml = 1.f - lbv;
    float cb[16];
#pragma unroll
    for (int i = 0; i < 16; ++i) { float z = bf2f(Kt[(16 * tq + i) * QS + ch]); z = fminf(fmaxf(z, -30.f), 30.f);
        if (VAR & 1) cb[i] = z * -0.01f; else { const float e = __expf(-z), sg = fast_rcp(1.f + e); cb[i] = __logf(lbv + oml * sg);
            Kt[(16 * tq + i) * QS + ch] = f2bf(oml * e * sg); } }
    if (tq == 2) bmid[ch] = cb[0];
    float run = 0.f;
    if (!rev) {
#pragma unroll
        for (int i = 0; i < 16; ++i) { run += cb[i]; cb[i] = run; }
    } else {
#pragma unroll
        for (int i = 15; i >= 0; --i) { run += cb[i]; cb[i] = run; }
    }
    tot[tq * 128 + ch] = run;
#pragma unroll
    for (int j = 0; j < 2; ++j) { const int p = tid + NTHR * j, row = p >> 4, c16 = p & 15; *(LAS u32x4*)(Vr + row * QS + 8 * c16) = vv[j]; }
    LDS_BARRIER();
    float bm, total;
    {
        const float t0 = tot[ch], t1 = tot[128 + ch], t2 = tot[256 + ch], t3 = tot[384 + ch];
        const float off = !rev ? ((tq > 0 ? t0 : 0.f) + (tq > 1 ? t1 : 0.f) + (tq > 2 ? t2 : 0.f)) : ((tq < 3 ? t3 : 0.f) + (tq < 2 ? t2 : 0.f) + (tq < 1 ? t1 : 0.f));
#pragma unroll
        for (int i = 0; i < 16; ++i) cb[i] += off;
        total = (t0 + t1) + (t2 + t3);
        bm = !rev ? (t0 + t1) + bmid[ch] : (t2 + t3);
        if (tq == 0) dtot += total;
    }
    if (!(VAR & 2)) {
        unsigned kp[8], vp[8];
#pragma unroll
        for (int i = 0; i < 16; ++i) { const float d = fminf(fmaxf(cb[i] - bm, -80.f), 80.f);
            const float ed = __expf(d);
            Qt[(16 * tq + i) * QS + ch] = f2bf(bf2f(Qt[(16 * tq + i) * QS + ch]) * ed);
            const unsigned kb = f2bfu(bf2f(Kt[(16 * tq + i) * QS + ch]) * fast_rcp(ed)); Kt[(16 * tq + i) * QS + ch] = (bf16)kb;
            const unsigned vb = Vr[(16 * tq + i) * QS + ch];
            if (i & 1) { kp[i >> 1] |= kb << 16; vp[i >> 1] |= vb << 16; } else { kp[i >> 1] = kb; vp[i >> 1] = vb; } }
        *(LAS u32x4*)(KtT + ch * TS + 16 * tq) = (u32x4){kp[0], kp[1], kp[2], kp[3]};
        *(LAS u32x4*)(KtT + ch * TS + 16 * tq + 8) = (u32x4){kp[4], kp[5], kp[6], kp[7]};
        *(LAS u32x4*)(VT + ch * TS + 16 * tq) = (u32x4){vp[0], vp[1], vp[2], vp[3]};
        *(LAS u32x4*)(VT + ch * TS + 16 * tq + 8) = (u32x4){vp[4], vp[5], vp[6], vp[7]};
        if (tid < 128) { const float e1 = __expf(bm), e2 = __expf(total - bm); hv[tid] = e1; hv[128 + tid] = e2; ebuf[tid] = e1; ebuf[128 + tid] = e2; }
    }
    if (has_next) {
#pragma unroll
        for (int j = 0; j < 2; ++j) { const int p = tid + NTHR * j, row = p >> 4, c16 = p & 15;
            zq[j] = *(const u32x4*)(nz + (size_t)row * INW + 8 * c16); zq[2 + j] = *(const u32x4*)(nq + (size_t)row * INW + 8 * c16); }
    }
    LDS_BARRIER();
    if (!(VAR & 4))
#pragma unroll
    for (int j = 0; j < 2; ++j) { const int p = tid + NTHR * j, row = p >> 4, c16 = p & 15;
        *(u32x4*)(gq + (size_t)row * 512 + 8 * c16) = *(const LAS u32x4*)(Qt + row * QS + 8 * c16);
        *(u32x4*)(gk + (size_t)row * 512 + 8 * c16) = *(const LAS u32x4*)(Kt + row * QS + 8 * c16); }
    if (!(VAR & 8)) {
#pragma unroll
    for (int i = 0; i < 8; ++i) S[i] = S[i] * *(const LAS f32x4*)(ebuf + 16 * i + 4 * lq);
    bf16x8 bv[2];
#pragma unroll
    for (int ks = 0; ks < 2; ++ks) bv[ks] = *(const LAS bf16x8*)(VT + (16 * w + li) * TS + 32 * ks + 8 * lq);
    bf16x8 ak[2][2];
#pragma unroll
    for (int ks = 0; ks < 2; ++ks) ak[0][ks] = *(const LAS bf16x8*)(KtT + li * TS + 32 * ks + 8 * lq);
#pragma unroll
    for (int i = 0; i < 8; ++i) { const int cb_ = i & 1;
        if (i < 7) {
#pragma unroll
            for (int ks = 0; ks < 2; ++ks) ak[cb_ ^ 1][ks] = *(const LAS bf16x8*)(KtT + (16 * (i + 1) + li) * TS + 32 * ks + 8 * lq); }
        __builtin_amdgcn_sched_barrier(0);
#pragma unroll
        for (int ks = 0; ks < 2; ++ks) S[i] = MFMA16(ak[cb_][ks], bv[ks], S[i]);
        S[i] = S[i] * *(const LAS f32x4*)(ebuf + 128 + 16 * i + 4 * lq); }
    }
    LDS_BARRIER();
}

struct HgPtrs { const bf16* q; const bf16* k; const bf16* v; const float* hv; };
__device__ __forceinline__ void hg_load6(const HgPtrs& P, int tid, u32x4 (&pre)[7]) {
    pre[6] = *(const u32x4*)(P.hv + 4 * (tid & 63));
#pragma unroll
    for (int j = 0; j < 2; ++j) { const int p = tid + NTHR * j, row = p >> 4, c16 = p & 15;
        pre[j] = *(const u32x4*)(P.q + (size_t)row * 512 + 8 * c16); pre[2 + j] = *(const u32x4*)(P.k + (size_t)row * 512 + 8 * c16); pre[4 + j] = *(const u32x4*)(P.v + (size_t)row * INW + 8 * c16); }
}
template <int VAR>
__device__ __forceinline__ void hg_chunk_c3(Frame& F, const u32x4 (&cur)[7], int rev, f32x4 (&S)[8], f32x4 (&O)[4], bool do_state, const bf16* Snext) {
    LAS bf16* Qt = (LAS bf16*)(F.lds + HG_QT); LAS bf16* Kt = (LAS bf16*)(F.lds + HG_KT); LAS bf16* KtT = (LAS bf16*)(F.lds + HG_KTT);
    LAS bf16* VT = (LAS bf16*)(F.lds + HG_VT); LAS bf16* SmT = (LAS bf16*)(F.lds + HG_SMT); LAS bf16* Pm = (LAS bf16*)(F.lds + HG_PM); LAS bf16* Vr = (LAS bf16*)(F.lds + HG_VR);
    const int tid = F.tid, lane = F.lane, w = F.wave, li = lane & 15, lq = lane >> 4;
#pragma unroll
    for (int j = 0; j < 2; ++j) { const int p = tid + NTHR * j, row = p >> 4, c16 = p & 15;
        *(LAS u32x4*)(Qt + row * QS + 8 * c16) = cur[j]; *(LAS u32x4*)(Kt + row * QS + 8 * c16) = cur[2 + j]; *(LAS u32x4*)(Vr + row * QS + 8 * c16) = cur[4 + j]; }
    LAS float* ebuf = (LAS float*)(F.lds + HG_BMID);
    if (tid < 64) *(LAS u32x4*)(ebuf + 4 * tid) = cur[6];
    LDS_BARRIER();
    if (!(VAR & 2)) {
        const int ch = tid & 127, tq = tid >> 7; unsigned kp[8], vp[8];
#pragma unroll
        for (int i = 0; i < 16; ++i) { const unsigned vb = Vr[(16 * tq + i) * QS + ch], kb = do_state ? (unsigned)Kt[(16 * tq + i) * QS + ch] : 0u;
            if (i & 1) { kp[i >> 1] |= kb << 16; vp[i >> 1] |= vb << 16; } else { kp[i >> 1] = kb; vp[i >> 1] = vb; } }
        *(LAS u32x4*)(VT + ch * TS + 16 * tq) = (u32x4){vp[0], vp[1], vp[2], vp[3]};
        *(LAS u32x4*)(VT + ch * TS + 16 * tq + 8) = (u32x4){vp[4], vp[5], vp[6], vp[7]};
        if (do_state) { *(LAS u32x4*)(KtT + ch * TS + 16 * tq) = (u32x4){kp[0], kp[1], kp[2], kp[3]}; *(LAS u32x4*)(KtT + ch * TS + 16 * tq + 8) = (u32x4){kp[4], kp[5], kp[6], kp[7]}; }
    }
#pragma unroll
    for (int i = 0; i < 8; ++i) { S[i] = S[i] * *(const LAS f32x4*)(ebuf + 16 * i + 4 * lq);
        u32x2 o; o.x = pk2(S[i].x, S[i].y); o.y = pk2(S[i].z, S[i].w); *(LAS u32x2*)(SmT + (16 * w + li) * QS + 16 * i + 4 * lq) = o; }
    if (Snext) {
#pragma unroll
        for (int i = 0; i < 8; ++i) S[i] = hg_ld4(Snext + (16 * w + li) * 128 + 16 * i + 4 * lq);
    }
    if (!(VAR & 4)) {
        const int tt = w >> 1;
        bf16x8 aq[4];
#pragma unroll
        for (int ks = 0; ks < 4; ++ks) aq[ks] = *(const LAS bf16x8*)(Qt + (16 * tt + li) * QS + 32 * ks + 8 * lq);
#pragma unroll
        for (int sj = 0; sj < 2; ++sj) { const int st = 2 * (w & 1) + sj; f32x4 acc = {0.f, 0.f, 0.f, 0.f};
#pragma unroll
            for (int ks = 0; ks < 4; ++ks) acc = MFMA16(aq[ks], *(const LAS bf16x8*)(Kt + (16 * st + li) * QS + 32 * ks + 8 * lq), acc);
#pragma unroll
            for (int r = 0; r < 4; ++r) { const int t = 16 * tt + 4 * lq + r, s = 16 * st + li; const bool keep = rev ? (s >= t) : (s <= t);
                Pm[t * TS + s] = f2bf(keep ? acc[r] : 0.f); } }
    }
    LDS_BARRIER();
    if (!(VAR & 8)) {
    bf16x8 bs[4], bv[2];
#pragma unroll
    for (int ks = 0; ks < 4; ++ks) bs[ks] = *(const LAS bf16x8*)(SmT + (16 * w + li) * QS + 32 * ks + 8 * lq);
#pragma unroll
    for (int ks = 0; ks < 2; ++ks) bv[ks] = *(const LAS bf16x8*)(VT + (16 * w + li) * TS + 32 * ks + 8 * lq);
    {
        bf16x8 aq[2][4], ap[2][2];
#pragma unroll
        for (int ks = 0; ks < 4; ++ks) aq[0][ks] = *(const LAS bf16x8*)(Qt + li * QS + 32 * ks + 8 * lq);
#pragma unroll
        for (int ks = 0; ks < 2; ++ks) ap[0][ks] = *(const LAS bf16x8*)(Pm + li * TS + 32 * ks + 8 * lq);
#pragma unroll
        for (int mt = 0; mt < 4; ++mt) { const int cb_ = mt & 1;
            if (mt < 3) {
#pragma unroll
                for (int ks = 0; ks < 4; ++ks) aq[cb_ ^ 1][ks] = *(const LAS bf16x8*)(Qt + (16 * (mt + 1) + li) * QS + 32 * ks + 8 * lq);
#pragma unroll
                for (int ks = 0; ks < 2; ++ks) ap[cb_ ^ 1][ks] = *(const LAS bf16x8*)(Pm + (16 * (mt + 1) + li) * TS + 32 * ks + 8 * lq); }
            __builtin_amdgcn_sched_barrier(0);
#pragma unroll
            for (int ks = 0; ks < 4; ++ks) O[mt] = MFMA16(aq[cb_][ks], bs[ks], O[mt]);
#pragma unroll
            for (int ks = 0; ks < 2; ++ks) O[mt] = MFMA16(ap[cb_][ks], bv[ks], O[mt]);
        }
    }
    __builtin_amdgcn_sched_barrier(0);
    if (do_state) {
        bf16x8 ak[2][2];
#pragma unroll
        for (int ks = 0; ks < 2; ++ks) ak[0][ks] = *(const LAS bf16x8*)(KtT + li * TS + 32 * ks + 8 * lq);
#pragma unroll
        for (int i = 0; i < 8; ++i) { const int cb_ = i & 1;
            if (i < 7) {
#pragma unroll
                for (int ks = 0; ks < 2; ++ks) ak[cb_ ^ 1][ks] = *(const LAS bf16x8*)(KtT + (16 * (i + 1) + li) * TS + 32 * ks + 8 * lq); }
            __builtin_amdgcn_sched_barrier(0);
#pragma unroll
            for (int ks = 0; ks < 2; ++ks) S[i] = MFMA16(ak[cb_][ks], bv[ks], S[i]);
            S[i] = S[i] * *(const LAS f32x4*)(ebuf + 128 + 16 * i + 4 * lq); }
    }
    }
    LDS_BARRIER();
}

__device__ __forceinline__ int hg_rowbase(int b, int slot) { return slot < 2 ? TL + b * CTXL + slot * 128 : b * SEQ + (slot - 2) * 128; }

template <int VAR>
__device__ __forceinline__ void hgrn2_c1(Frame& F, int l, int u0, int nunits, int G) {
    const bf16* Z = (const bf16*)(F.ws + WS_Z); const float* lbp = (const float*)(F.ws + WS_TAB + TAB_LB) + l * 512;
    bf16* GQ = (bf16*)(F.ws + WS_GE); bf16* GK = (bf16*)(F.ws + WS_GK); float* HV = (float*)(F.ws + WS_HV);
    if (u0 >= nunits) return;
    u32x4 zq[4];
    {   const int chain = u0 / HG_SLOTS, slot = u0 % HG_SLOTS, dir = chain & 1, b = chain >> 3, h = (chain >> 1) & 3;
        const bf16* zp = Z + (size_t)(hg_rowbase(b, slot) + (dir ? 64 : 0)) * INW;
#pragma unroll
        for (int j = 0; j < 2; ++j) { const int p = F.tid + NTHR * j, row = p >> 4, c16 = p & 15;
            zq[j] = *(const u32x4*)(zp + (size_t)row * INW + (dir ? ZFB : ZFF) + h * 128 + 8 * c16); zq[2 + j] = *(const u32x4*)(zp + (size_t)row * INW + ZQ + h * 128 + 8 * c16); } }
#pragma unroll 1
    for (int u = u0; u < nunits; u += G) {
        const int chain = u / HG_SLOTS, slot = u % HG_SLOTS, dir = chain & 1, b = chain >> 3, h = (chain >> 1) & 3;
        const int row0 = hg_rowbase(b, slot), zcol = (dir ? ZFB : ZFF) + h * 128;
        const int un = u + G; const bool has_nu = un < nunits;
        const int nchain = un / HG_SLOTS, nslot = un % HG_SLOTS, ndir = nchain & 1, nb = nchain >> 3, nh = (nchain >> 1) & 3;
        const bf16* nup = Z + (size_t)(hg_rowbase(nb, nslot) + (ndir ? 64 : 0)) * INW;
        f32x4 S[8]; float dtot = 0.f;
#pragma unroll
        for (int i = 0; i < 8; ++i) S[i] = (f32x4){0.f, 0.f, 0.f, 0.f};
#pragma unroll 1
        for (int step = 0; step < 2; ++step) { const int c = dir ? 1 - step : step; const size_t rowc = (size_t)(row0 + 64 * c);
            const bf16* nrow = step == 0 ? Z + (size_t)(row0 + 64 * (1 - c)) * INW : nup;
            const bf16* nz = nrow + (step == 0 ? zcol : (ndir ? ZFB : ZFF) + nh * 128); const bf16* nq = nrow + ZQ + (step == 0 ? h : nh) * 128;
            hg_chunk_c1<VAR>(F, Z + rowc * INW, GQ + ((size_t)dir * TT + rowc) * 512 + h * 128, GK + ((size_t)dir * TT + rowc) * 512 + h * 128,
                        HV + ((size_t)chain * (2 * HG_SLOTS) + slot * 2 + c) * 256, nz, nq, step == 0 || has_nu, zq, h, dir, lbp, S, dtot); }
        bf16* HS = (bf16*)(F.ws + WS_HS) + ((size_t)chain * HG_SLOTS + slot) * 16384;
        const int li = F.lane & 15, lq = F.lane >> 4, v = 16 * F.wave + li;
#pragma unroll
        for (int i = 0; i < 8; ++i) { u32x2 o; o.x = pk2(S[i].x, S[i].y); o.y = pk2(S[i].z, S[i].w); *(u32x2*)(HS + v * 128 + 16 * i + 4 * lq) = o; }
        if (F.tid < 128) ((float*)(F.ws + WS_HD))[((size_t)chain * HG_SLOTS + slot) * 128 + F.tid] = __expf(dtot);
    }
}

__device__ __forceinline__ void hgrn2_c2(Frame& F) {
    bf16* HS = (bf16*)(F.ws + WS_HS); const float* HD = (const float*)(F.ws + WS_HD);
    constexpr int CB = 13;
    static_assert(HG_SLOTS % (2 * CB) == 0, "batching");
    for (int task = blockIdx.x * NTHR + F.tid; task < 16 * 8192; task += F.G * NTHR) {
        const int chain = task >> 13, e2 = task & 8191, dir = chain & 1, ch2 = (e2 & 63) * 2;
        unsigned* hs = (unsigned*)(HS + (size_t)chain * HG_SLOTS * 16384 + e2 * 2); const float* hd = HD + (size_t)chain * HG_SLOTS * 128 + ch2;
        f32x2 run = {0.f, 0.f};
        unsigned tA[CB], tB[CB]; f32x2 dA[CB], dB[CB];
#define C2_SLOT(k) (dir ? ((k) < 2 ? 1 - (k) : 131 - (k)) : (k))
#define C2_LOAD(t_, d_, k0) _Pragma("unroll") for (int j = 0; j < CB; ++j) { const int slot = C2_SLOT((k0) + j); t_[j] = hs[(size_t)slot * 8192]; d_[j] = *(const f32x2*)(hd + (size_t)slot * 128); }
#define C2_SCAN(t_, d_, k0) _Pragma("unroll") for (int j = 0; j < CB; ++j) { const int slot = C2_SLOT((k0) + j); const f32x2 tmp = {__builtin_bit_cast(float, t_[j] << 16), __builtin_bit_cast(float, t_[j] & 0xffff0000u)}; \
            hs[(size_t)slot * 8192] = pk2(run.x, run.y); run = d_[j] * run + tmp; }
        C2_LOAD(tA, dA, 0)
#pragma unroll 1
        for (int k0 = 0; k0 < HG_SLOTS; k0 += 2 * CB) {
            C2_LOAD(tB, dB, k0 + CB)
            C2_SCAN(tA, dA, k0)
            if (k0 + 2 * CB < HG_SLOTS) { C2_LOAD(tA, dA, k0 + 2 * CB) }
            C2_SCAN(tB, dB, k0 + CB)
        }
#undef C2_SLOT
#undef C2_LOAD
#undef C2_SCAN
    }
}

template <int VAR>
__device__ __forceinline__ void hgrn2_c3(Frame& F, int l, int bh, int slot) {
    const int b = bh >> 2, h = bh & 3;
    const bf16* Z = (const bf16*)(F.ws + WS_Z);
    const bf16* GQ = (const bf16*)(F.ws + WS_GE); const bf16* GK = (const bf16*)(F.ws + WS_GK); const float* HV = (const float*)(F.ws + WS_HV);
    bf16* MIX = (bf16*)(F.ws + WS_MIX);
    const int row0 = hg_rowbase(b, slot);
    const int tid = F.tid, lane = F.lane, w = F.wave, li = lane & 15, lq = lane >> 4, v = 16 * w + li;
    u32x4 pa[7], pb[7];
    const float* HVf = HV + ((size_t)(bh * 2 + 0) * (2 * HG_SLOTS) + slot * 2) * 256; const float* HVb = HV + ((size_t)(bh * 2 + 1) * (2 * HG_SLOTS) + slot * 2) * 256;
    {   const size_t r0 = (size_t)row0, r1 = (size_t)(row0 + 64);
        HgPtrs P0{GQ + r0 * 512 + h * 128, GK + r0 * 512 + h * 128, Z + r0 * INW + ZV + h * 128, HVf};
        HgPtrs P1{GQ + r1 * 512 + h * 128, GK + r1 * 512 + h * 128, Z + r1 * INW + ZV + h * 128, HVf + 256};
        hg_load6(P0, tid, pa); hg_load6(P1, tid, pb); }
    if (tid < 32) *(LAS f32x4*)((LAS float*)(F.lds + HG_RSS) + 4 * tid) = *(const f32x4*)(F.in[10] + l * 128 + 4 * tid);
    f32x4 S[8];
    const bf16* HSb = (const bf16*)(F.ws + WS_HS) + ((size_t)(bh * 2 + 1) * HG_SLOTS + slot) * 16384;
    {   const bf16* HSf = (const bf16*)(F.ws + WS_HS) + ((size_t)(bh * 2 + 0) * HG_SLOTS + slot) * 16384;
#pragma unroll
        for (int i = 0; i < 8; ++i) S[i] = hg_ld4(HSf + v * 128 + 16 * i + 4 * lq); }
    f32x4 O[2][4];
#pragma unroll
    for (int c = 0; c < 2; ++c)
#pragma unroll
        for (int mt = 0; mt < 4; ++mt) O[c][mt] = (f32x4){0.f, 0.f, 0.f, 0.f};
#pragma unroll 1
    for (int st = 0; st < 4; ++st) {
        const int dir = st >> 1, c = (st == 1 || st == 2) ? 1 : 0;
        u32x4 cur[7];
#pragma unroll
        for (int j = 0; j < 7; ++j) { cur[j] = pa[j]; pa[j] = pb[j]; }
        if ((VAR & 1)) { } else if (st < 2) {
            const size_t rn = (size_t)(row0 + (st == 0 ? 64 : 0));
            HgPtrs Pn{GQ + ((size_t)TT + rn) * 512 + h * 128, GK + ((size_t)TT + rn) * 512 + h * 128, Z + rn * INW + ZV + h * 128, HVb + (st == 0 ? 256 : 0)};
            hg_load6(Pn, tid, pb);
        } else if (st == 2) {
#pragma unroll
            for (int j = 0; j < 4; ++j) pb[j] = *(const u32x4*)(Z + (size_t)(row0 + (tid >> 2)) * INW + ZG + h * 128 + 32 * (tid & 3) + 8 * j);
        }
        hg_chunk_c3<VAR>(F, cur, dir, S, O[0], (st & 1) == 0, st == 1 ? HSb : nullptr);
        if ((st & 1) == 0) {
#pragma unroll
            for (int mt = 0; mt < 4; ++mt) { const f32x4 t = O[0][mt]; O[0][mt] = O[1][mt]; O[1][mt] = t; }
        }
    }
    if (VAR & 16) { if (O[0][0][0] == 123.456f && O[1][3][2] == 1.f && S[0][0] == 2.f) MIX[0] = 1; return; }
    LAS float* Ot = (LAS float*)F.lds;
#pragma unroll
    for (int c = 0; c < 2; ++c)
#pragma unroll
        for (int mt = 0; mt < 4; ++mt)
#pragma unroll
            for (int r = 0; r < 4; ++r) Ot[(64 * c + 16 * mt + 4 * lq + r) * 132 + v] = O[c][mt][r];
    LDS_BARRIER();
    {   const int t = tid >> 2, v0 = 32 * (tid & 3);
        f32x4 x[8]; float ss = 0.f;
#pragma unroll
        for (int j = 0; j < 8; ++j) { x[j] = *(const LAS f32x4*)(Ot + t * 132 + v0 + 4 * j); ss += (x[j].x * x[j].x + x[j].y * x[j].y) + (x[j].z * x[j].z + x[j].w * x[j].w); }
        ss += __shfl_xor(ss, 1); ss += __shfl_xor(ss, 2);
        const float rs = rsqrtf(ss * (1.f / 128.f) + EPS);
        const LAS float* gain = (const LAS float*)(F.lds + HG_RSS) + v0;
#pragma unroll
        for (int k = 0; k < 4; ++k) { const u32x4 gq = pb[k]; const f32x4 g0 = *(const LAS f32x4*)(gain + 8 * k), g1 = *(const LAS f32x4*)(gain + 8 * k + 4);
            float o[8];
#pragma unroll
            for (int e = 0; e < 4; ++e) { const unsigned gw = e == 0 ? gq.x : e == 1 ? gq.y : e == 2 ? gq.z : gq.w;
                const float ga = __builtin_bit_cast(float, gw << 16), gb = __builtin_bit_cast(float, gw & 0xffff0000u);
                const float xa = e < 2 ? x[2 * k][2 * e] : x[2 * k + 1][2 * e - 4], xb = e < 2 ? x[2 * k][2 * e + 1] : x[2 * k + 1][2 * e - 3];
                const float na = e < 2 ? g0[2 * e] : g1[2 * e - 4], nb = e < 2 ? g0[2 * e + 1] : g1[2 * e - 3];
                o[2 * e] = xa * rs * na * ga * fast_rcp(1.f + __expf(-ga)); o[2 * e + 1] = xb * rs * nb * gb * fast_rcp(1.f + __expf(-gb)); }
            *(u32x4*)(MIX + (size_t)(row0 + t) * 1024 + h * 128 + v0 + 8 * k) = (u32x4){pk2(o[0], o[1]), pk2(o[2], o[3]), pk2(o[4], o[5]), pk2(o[6], o[7])}; }
    }
    LDS_BARRIER();
}

constexpr int LR_XR = 0, LR_XB = 35376, LR_HS = 69632;

__device__ __forceinline__ int lru_row(bool isctx, int b, int p) { return isctx ? TL + b * CTXL + p : b * SEQ + ((p & 255) << 6) + (p >> 8); }

template <bool FINAL>
__device__ __forceinline__ void lru_unit(Frame& F, int l, int b, int slot) {
    const bool isctx = slot < 4; const int p0 = isctx ? slot * 64 : (slot - 4) * 64, L = isctx ? CTXL : SEQ;
    const bf16* Z = (const bf16*)(F.ws + WS_Z);
    LAS bf16* Xr = (LAS bf16*)(F.lds + LR_XR); LAS bf16* XB = (LAS bf16*)(F.lds + LR_XB); LAS float* Hs = (LAS float*)(F.lds + LR_HS);
    const int tid = F.tid, lane = F.lane, w = F.wave, li = lane & 15, lq = lane >> 4;
    {   u32x4 v[5];
#pragma unroll
        for (int j = 0; j < 5; ++j) { const int idx = tid + NTHR * j, rr = idx >> 5, c16 = idx & 31, p = p0 - 2 + rr; v[j] = (u32x4){0u, 0u, 0u, 0u};
            if (idx < 67 * 32 && p >= 0 && p < L) v[j] = *(const u32x4*)(Z + (size_t)lru_row(isctx, b, p) * INW + ZXB + 8 * c16); }
#pragma unroll
        for (int j = 0; j < 5; ++j) { const int idx = tid + NTHR * j, rr = idx >> 5, c16 = idx & 31; if (idx < 67 * 32) *(LAS u32x4*)(Xr + rr * 264 + 8 * c16) = v[j]; } }
    LDS_BARRIER();
    {   const int ch = tid & 255, ph = tid >> 8;
        const float* cw = F.in[11] + (size_t)l * 4 * 256; const float w0 = cw[ch], w1 = cw[256 + ch], w2 = cw[512 + ch], w3 = cw[768 + ch], cb = F.in[12][l * 256 + ch];
        float x0 = bf2f(Xr[(32 * ph + 0) * 264 + ch]), x1 = bf2f(Xr[(32 * ph + 1) * 264 + ch]), x2 = bf2f(Xr[(32 * ph + 2) * 264 + ch]);
#pragma unroll 8
        for (int p = 32 * ph; p < 32 * ph + 32; ++p) { const float x3 = bf2f(Xr[(p + 3) * 264 + ch]);
            XB[p * 264 + ch] = f2bf(cb + w0 * x0 + w1 * x1 + w2 * x2 + w3 * x3); x0 = x1; x1 = x2; x2 = x3; } }
    LDS_BARRIER();
    {
        const int hh = w >> 1;
        float* LA = (float*)(F.ws + WS_LRUC); float* LH = (float*)(F.ws + WS_LRUC + LRUC_STRIDE); const float* LI = (const float*)(F.ws + WS_LRUC + 2 * LRUC_STRIDE);
        float hsum[4][4];
        bf16x8 nbr[2], nbi[2]; float nba, nbx, ncl, nC;
#define LRU_FETCH(itn) do { const int jn_ = 2 * (w & 1) + ((itn) >> 1), d_ = (itn) & 1, ch_ = hh * 64 + 16 * jn_ + li; \
            const bf16* Wl_ = (const bf16*)(F.ws + WS_TAB + TAB_LRUW) + ((size_t)((l * 2 + d_) * 4 + hh) * 128) * 64; \
            _Pragma("unroll") for (int ks = 0; ks < 2; ++ks) { nbr[ks] = *(const bf16x8*)(Wl_ + (16 * jn_ + li) * 64 + 32 * ks + 8 * lq); nbi[ks] = *(const bf16x8*)(Wl_ + (64 + 16 * jn_ + li) * 64 + 32 * ks + 8 * lq); } \
            nba = F.in[14][(l * 2 + d_) * 256 + ch_]; nbx = F.in[16][(l * 2 + d_) * 256 + ch_]; ncl = ((const float*)(F.ws + WS_TAB + TAB_LRUCL))[(l * 2 + d_) * 256 + ch_]; \
            nC = FINAL ? LI[((size_t)(b * 2 + d_) * LR_SLOTS + slot) * 256 + ch_] : 0.f; } while (0)
        LRU_FETCH(0);
#pragma unroll 1
        for (int it = 0; it < 4; ++it) {
            const int jn = 2 * (w & 1) + (it >> 1), d = it & 1;
            const int ch = hh * 64 + 16 * jn + li;
            const size_t cidx = ((size_t)(b * 2 + d) * LR_SLOTS + slot) * 256;
            bf16x8 br[2], bi[2];
#pragma unroll
            for (int ks = 0; ks < 2; ++ks) { br[ks] = nbr[ks]; bi[ks] = nbi[ks]; }
            const float ba = nba, bx = nbx, cl = ncl;
            float C = nC;
            if (it < 3) LRU_FETCH(it + 1);
            f32x4 ar[4], ai[4];
#pragma unroll
            for (int mt = 0; mt < 4; ++mt) { ar[mt] = (f32x4){0.f, 0.f, 0.f, 0.f}; ai[mt] = (f32x4){0.f, 0.f, 0.f, 0.f};
#pragma unroll
                for (int ks = 0; ks < 2; ++ks) { const bf16x8 a = *(const LAS bf16x8*)(XB + (16 * mt + li) * 264 + hh * 64 + 32 * ks + 8 * lq);
                    ar[mt] = MFMA16(a, br[ks], ar[mt]); ai[mt] = MFMA16(a, bi[ks], ai[mt]); } }
            float PA[4][4], PB[4][4];
#pragma unroll
            for (int mt = 0; mt < 4; ++mt)
#pragma unroll
                for (int r = 0; r < 4; ++r) { const int p = 16 * mt + 4 * lq + r;
                    const float rg = sigmoidf_(ar[mt][r] + ba), ig = sigmoidf_(ai[mt][r] + bx), la = -cl * rg;
                    const float x2 = 2.f * la, e2 = __expf(x2);
                    const float om = x2 > -0.03f ? -x2 * (1.f + 0.5f * x2 * (1.f + x2 * (1.f / 3.f))) : 1.f - e2;
                    PA[mt][r] = __expf(la); PB[mt][r] = __builtin_amdgcn_sqrtf(fmaxf(om, 0.f)) * ig * bf2f(XB[p * 264 + ch]); }
            float TA[4], TB[4], EA[4], EB[4];
#pragma unroll
            for (int mt = 0; mt < 4; ++mt) {
                float pa = 1.f, pb = 0.f;
#pragma unroll
                for (int j = 0; j < 4; ++j) { const int r = d ? 3 - j : j; const float a = PA[mt][r], bb = PB[mt][r]; pb = a * pb + bb; pa = a * pa; PA[mt][r] = pa; PB[mt][r] = pb; }
                float ea = 1.f, eb = 0.f, ta = 1.f, tb = 0.f;
#pragma unroll
                for (int j = 0; j < 4; ++j) { const int k = d ? 3 - j : j; const float ga = __shfl(pa, li + 16 * k), gb = __shfl(pb, li + 16 * k);
                    const bool before = d ? (k > lq) : (k < lq);
                    if (before) { eb = ga * eb + gb; ea = ga * ea; }
                    tb = ga * tb + gb; ta = ga * ta; }
                EA[mt] = ea; EB[mt] = eb; TA[mt] = ta; TB[mt] = tb;
            }
            float Atot = 1.f, Cin[4];
#pragma unroll
            for (int j = 0; j < 4; ++j) { const int mt = d ? 3 - j : j; Cin[mt] = C; C = TA[mt] * C + TB[mt]; Atot *= TA[mt]; }
            if (!FINAL) { if (lq == 0) { LA[cidx + ch] = Atot; LH[cidx + ch] = C; } }
            else {
#pragma unroll
                for (int mt = 0; mt < 4; ++mt) { const float base = EA[mt] * Cin[mt] + EB[mt];
#pragma unroll
                    for (int r = 0; r < 4; ++r) { const float hv = PA[mt][r] * base + PB[mt][r];
                        if (d == 0) hsum[mt][r] = hv; else Hs[(16 * mt + 4 * lq + r) * 256 + ch] = hsum[mt][r] + hv; } }
            }
        }
    }
#undef LRU_FETCH
    if (FINAL) {
        LDS_BARRIER();
        bf16* MIX = (bf16*)(F.ws + WS_MIX);
        u32x4 yq[4];
#pragma unroll
        for (int j = 0; j < 4; ++j) { const int task = tid + NTHR * j, p = task >> 5, c8 = task & 31; yq[j] = *(const u32x4*)(Z + (size_t)lru_row(isctx, b, p0 + p) * INW + ZYB + 8 * c8); }
#pragma unroll
        for (int j = 0; j < 4; ++j) { const int task = tid + NTHR * j, p = task >> 5, c8 = task & 31;
            const f32x4 h0 = *(const LAS f32x4*)(Hs + p * 256 + 8 * c8), h1 = *(const LAS f32x4*)(Hs + p * 256 + 8 * c8 + 4);
            float o[8];
#pragma unroll
            for (int e = 0; e < 4; ++e) { const unsigned yw = yq[j][e];
                const float ya = __builtin_bit_cast(float, yw << 16), yb = __builtin_bit_cast(float, yw & 0xffff0000u);
                const float ua = 0.7978845608f * (ya + 0.044715f * ya * ya * ya), ub = 0.7978845608f * (yb + 0.044715f * yb * yb * yb);
                const float ta = 1.f - 2.f * fast_rcp(1.f + __expf(2.f * ua)), tb = 1.f - 2.f * fast_rcp(1.f + __expf(2.f * ub));
                const float ha = e < 2 ? h0[2 * e] : h1[2 * e - 4], hb = e < 2 ? h0[2 * e + 1] : h1[2 * e - 3];
                o[2 * e] = ha * 0.5f * ya * (1.f + ta); o[2 * e + 1] = hb * 0.5f * yb * (1.f + tb); }
            *(u32x4*)(MIX + (size_t)lru_row(isctx, b, p0 + p) * 1024 + 512 + 8 * c8) = (u32x4){pk2(o[0], o[1]), pk2(o[2], o[3]), pk2(o[4], o[5]), pk2(o[6], o[7])}; }
    }
    LDS_BARRIER();
}

__device__ __forceinline__ void lru_carry(Frame& F) {
    if (blockIdx.x >= 16 || F.wave != 0) return;
    const int chain = blockIdx.x * 64 + F.lane, bd = chain >> 8, ch = chain & 255, d = bd & 1;
    const float* LA = (const float*)(F.ws + WS_LRUC); const float* LH = (const float*)(F.ws + WS_LRUC + LRUC_STRIDE); float* LI = (float*)(F.ws + WS_LRUC + 2 * LRUC_STRIDE);
    float h = 0.f;
    constexpr int LB = 26;
    static_assert(LR_SLOTS % (2 * LB) == 0, "batching");
    float aA[LB], hA[LB], aB[LB], hB[LB];
#define LC_IDX(k) (((size_t)bd * LR_SLOTS + (d ? ((k) < 4 ? 3 - (k) : 263 - (k)) : (k))) * 256 + ch)
#define LC_LOAD(a_, h_, k0) _Pragma("unroll") for (int j = 0; j < LB; ++j) { const size_t idx = LC_IDX((k0) + j); a_[j] = LA[idx]; h_[j] = LH[idx]; }
#define LC_SCAN(a_, h_, k0) _Pragma("unroll") for (int j = 0; j < LB; ++j) { const size_t idx = LC_IDX((k0) + j); LI[idx] = h; h = a_[j] * h + h_[j]; }
    LC_LOAD(aA, hA, 0)
#pragma unroll 1
    for (int k0 = 0; k0 < LR_SLOTS; k0 += 2 * LB) {
        LC_LOAD(aB, hB, k0 + LB)
        LC_SCAN(aA, hA, k0)
        if (k0 + 2 * LB < LR_SLOTS) { LC_LOAD(aA, hA, k0 + 2 * LB) }
        LC_SCAN(aB, hB, k0 + LB)
    }
#undef LC_IDX
#undef LC_LOAD
#undef LC_SCAN
}

__device__ __forceinline__ void fft_f1(Frame& F, int b, int n2) {
    const bf16* Z = (const bf16*)(F.ws + WS_Z);
    const bf16* Fc = (const bf16*)(F.ws + WS_TAB + TAB_FC); const bf16* Fs = (const bf16*)(F.ws + WS_TAB + TAB_FS);
    bf16* FAr = (bf16*)(F.ws + WS_FA); bf16* FAi = FAr + (size_t)2 * 128 * 128 * 256;
    LAS bf16* DT = (LAS bf16*)F.lds;
    const int tid = F.tid, lane = F.lane, w = F.wave, li = lane & 15, lq = lane >> 4;
    {   const int c = tid & 255, nh = tid >> 8;
        const bf16* src = Z + ((size_t)(b * SEQ + 128 * (64 * nh) + n2)) * INW + ZU + c;
#pragma unroll 2
        for (int j = 0; j < 8; ++j) { unsigned pk[4];
#pragma unroll
            for (int i = 0; i < 4; ++i) pk[i] = (unsigned)src[(size_t)(128 * (8 * j + 2 * i)) * INW] | ((unsigned)src[(size_t)(128 * (8 * j + 2 * i + 1)) * INW] << 16);
            *(LAS u32x4*)(DT + c * 136 + 64 * nh + 8 * j) = (u32x4){pk[0], pk[1], pk[2], pk[3]}; } }
    LDS_BARRIER();
    bf16x8 fc[4], fs[4];
#pragma unroll
    for (int ks = 0; ks < 4; ++ks) { fc[ks] = *(const bf16x8*)(Fc + (16 * w + li) * 128 + 32 * ks + 8 * lq); fs[ks] = *(const bf16x8*)(Fs + (16 * w + li) * 128 + 32 * ks + 8 * lq); }
    float ct[4], st[4];
#pragma unroll
    for (int r = 0; r < 4; ++r) { const int k1 = 16 * w + 4 * lq + r; sincospif((float)((n2 * k1) & 16383) * (1.f / 8192.f), &st[r], &ct[r]); }
#pragma unroll 2
    for (int nt = 0; nt < 16; ++nt) {
        f32x4 re = {0.f, 0.f, 0.f, 0.f}, im = {0.f, 0.f, 0.f, 0.f};
#pragma unroll
        for (int ks = 0; ks < 4; ++ks) { const bf16x8 bb = *(const LAS bf16x8*)(DT + (16 * nt + li) * 136 + 32 * ks + 8 * lq); re = MFMA16(fc[ks], bb, re); im = MFMA16(fs[ks], bb, im); }
#pragma unroll
        for (int r = 0; r < 4; ++r) { const int k1 = 16 * w + 4 * lq + r, c = 16 * nt + li;
            const float R = re[r], I = -im[r];
            const size_t o = ((size_t)(b * 128 + k1) * 128 + n2) * 256 + c;
            FAr[o] = f2bf(R * ct[r] + I * st[r]); FAi[o] = f2bf(I * ct[r] - R * st[r]); }
    }
    LDS_BARRIER();
}

__device__ __forceinline__ void fft_f2(Frame& F, int b, int k1, int chalf) {
    const bf16* Fc = (const bf16*)(F.ws + WS_TAB + TAB_FC); const bf16* Fs = (const bf16*)(F.ws + WS_TAB + TAB_FS); const bf16* CS = (const bf16*)(F.ws + WS_TAB + TAB_CS);
    const bf16* FAr = (const bf16*)(F.ws + WS_FA); const bf16* FAi = FAr + (size_t)2 * 128 * 128 * 256;
    bf16* MIX = (bf16*)(F.ws + WS_MIX);
    LAS bf16* DTr = (LAS bf16*)F.lds; LAS bf16* DTi = DTr + 128 * 136;
    const int tid = F.tid, lane = F.lane, w = F.wave, li = lane & 15, lq = lane >> 4;
    LAS bf16* Wv = (LAS bf16*)(F.lds + 69632) + w * (16 * 2 * 136);
    {   u32x4 pr[4], pi[4];
#pragma unroll
        for (int j = 0; j < 4; ++j) { const int p = tid + NTHR * j, n2 = p >> 4, c8 = p & 15; const size_t o = ((size_t)(b * 128 + k1) * 128 + n2) * 256 + chalf * 128 + 8 * c8;
            pr[j] = *(const u32x4*)(FAr + o); pi[j] = *(const u32x4*)(FAi + o); }
#pragma unroll
        for (int j = 0; j < 4; ++j) { const int p = tid + NTHR * j, n2 = p >> 4, c8 = p & 15, col = n2 ^ (8 * c8);
#pragma unroll
            for (int i = 0; i < 8; ++i) { const unsigned wr_ = pr[j][i >> 1], wi_ = pi[j][i >> 1];
                DTr[(8 * c8 + i) * 136 + col] = (bf16)((i & 1) ? (wr_ >> 16) : (wr_ & 0xffffu)); DTi[(8 * c8 + i) * 136 + col] = (bf16)((i & 1) ? (wi_ >> 16) : (wi_ & 0xffffu)); } } }
    LDS_BARRIER();
    bf16x8 fc[4], fs[4];
#pragma unroll
    for (int ks = 0; ks < 4; ++ks) { fc[ks] = *(const bf16x8*)(Fc + (16 * w + li) * 128 + 32 * ks + 8 * lq); fs[ks] = *(const bf16x8*)(Fs + (16 * w + li) * 128 + 32 * ks + 8 * lq); }
#pragma unroll 2
    for (int nt = 0; nt < 8; ++nt) {
        f32x4 ur = {0.f, 0.f, 0.f, 0.f}, u1 = {0.f, 0.f, 0.f, 0.f}, u2 = {0.f, 0.f, 0.f, 0.f};
        const int sw = 2 * nt + (li >> 3);
#pragma unroll
        for (int ks = 0; ks < 4; ++ks) { const int off = (16 * nt + li) * 136 + 8 * ((4 * ks + lq) ^ sw);
            const bf16x8 br = *(const LAS bf16x8*)(DTr + off), bi = *(const LAS bf16x8*)(DTi + off);
            ur = MFMA16(fc[ks], br, ur); ur = MFMA16(fs[ks], bi, ur); u1 = MFMA16(fc[ks], bi, u1); u2 = MFMA16(fs[ks], br, u2); }
        const int gl = nt >> 2, cl = 16 * (nt & 3) + li;
#pragma unroll
        for (int r = 0; r < 4; ++r) { const int k2l = 4 * lq + r; Wv[(k2l * 2 + gl) * 136 + cl] = f2bf(ur[r]); Wv[(k2l * 2 + gl) * 136 + 64 + cl] = f2bf(u1[r] - u2[r]); }
    }
    LDS_BARRIER();
    LAS bf16* Yt = (LAS bf16*)F.lds;
#pragma unroll
    for (int gl = 0; gl < 2; ++gl)
#pragma unroll
        for (int mt = 0; mt < 4; ++mt) { f32x4 acc = {0.f, 0.f, 0.f, 0.f};
#pragma unroll
            for (int ks = 0; ks < 4; ++ks) acc = MFMA16(*(const LAS bf16x8*)(Wv + (li * 2 + gl) * 136 + 32 * ks + 8 * lq), *(const bf16x8*)(CS + (16 * mt + li) * 128 + 32 * ks + 8 * lq), acc);
#pragma unroll
            for (int r = 0; r < 4; ++r) Yt[(16 * w + 4 * lq + r) * 136 + gl * 64 + 16 * mt + li] = f2bf(acc[r] * (1.f / 1024.f)); }
    LDS_BARRIER();
#pragma unroll
    for (int j = 0; j < 4; ++j) { const int p = tid + NTHR * j, k2 = p >> 4, c8 = p & 15;
        *(u32x4*)(MIX + ((size_t)b * SEQ + k1 + 128 * k2) * 1024 + 768 + chalf * 128 + 8 * c8) = *(const LAS u32x4*)(Yt + k2 * 136 + 8 * c8); }
    LDS_BARRIER();
}

__device__ __forceinline__ void ctx_fourier(Frame& F, int b, int g) {
    const bf16* Z = (const bf16*)(F.ws + WS_Z); bf16* MIX = (bf16*)(F.ws + WS_MIX);
    const bf16* CS = (const bf16*)(F.ws + WS_TAB + TAB_CS); const bf16* C256 = (const bf16*)(F.ws + WS_TAB + TAB_C256); const bf16* S256 = (const bf16*)(F.ws + WS_TAB + TAB_S256);
    LAS bf16* PT = (LAS bf16*)F.lds; LAS bf16* QT = PT + 64 * 264;
    const int lane = F.lane, w = F.wave, li = lane & 15, lq = lane >> 4;
#pragma unroll 1
    for (int nj = 0; nj < 2; ++nj) { const int nt = 2 * w + nj;
        bf16x8 a[2];
#pragma unroll
        for (int ks = 0; ks < 2; ++ks) a[ks] = *(const bf16x8*)(Z + (size_t)(TL + b * CTXL + 16 * nt + li) * INW + ZU + g * 64 + 32 * ks + 8 * lq);
#pragma unroll
        for (int mt = 0; mt < 4; ++mt) { f32x4 p = {0.f, 0.f, 0.f, 0.f}, q = {0.f, 0.f, 0.f, 0.f};
#pragma unroll
            for (int ks = 0; ks < 2; ++ks) { p = MFMA16(a[ks], *(const bf16x8*)(CS + (16 * mt + li) * 128 + 32 * ks + 8 * lq), p); q = MFMA16(a[ks], *(const bf16x8*)(CS + (16 * mt + li) * 128 + 64 + 32 * ks + 8 * lq), q); }
            u32x2 o; o.x = pk2(p[0], p[1]); o.y = pk2(p[2], p[3]); *(LAS u32x2*)(PT + (16 * mt + li) * 264 + 16 * nt + 4 * lq) = o;
            o.x = pk2(q[0], q[1]); o.y = pk2(q[2], q[3]); *(LAS u32x2*)(QT + (16 * mt + li) * 264 + 16 * nt + 4 * lq) = o; } }
    LDS_BARRIER();
#pragma unroll 1
    for (int kj = 0; kj < 2; ++kj) { const int kt = 2 * w + kj;
        f32x4 acc[4];
#pragma unroll
        for (int mt = 0; mt < 4; ++mt) acc[mt] = (f32x4){0.f, 0.f, 0.f, 0.f};
#pragma unroll 2
        for (int ks = 0; ks < 8; ++ks) { const bf16x8 ac = *(const bf16x8*)(C256 + (16 * kt + li) * 256 + 32 * ks + 8 * lq), as = *(const bf16x8*)(S256 + (16 * kt + li) * 256 + 32 * ks + 8 * lq);
#pragma unroll
            for (int mt = 0; mt < 4; ++mt) { acc[mt] = MFMA16(ac, *(const LAS bf16x8*)(PT + (16 * mt + li) * 264 + 32 * ks + 8 * lq), acc[mt]); acc[mt] = MFMA16(as, *(const LAS bf16x8*)(QT + (16 * mt + li) * 264 + 32 * ks + 8 * lq), acc[mt]); } }
#pragma unroll
        for (int mt = 0; mt < 4; ++mt)
#pragma unroll
            for (int r = 0; r < 4; ++r) MIX[(size_t)(TL + b * CTXL + 16 * kt + 4 * lq + r) * 1024 + 768 + g * 64 + 16 * mt + li] = f2bf(acc[mt][r] * (1.f / 128.f)); }
    LDS_BARRIER();
}

__device__ __forceinline__ void route_phase(Frame& F, int l, int Tl) {
    LAS unsigned* hist = (LAS unsigned*)F.lds;
    for (int i = F.tid; i < 256; i += NTHR) hist[i] = 0u;
    __syncthreads();
    const float* logits = (const float*)(F.ws + WS_LOGIT); const float* br = F.in[20] + l * 256;
    int* sel_e = (int*)(F.ws + WS_SEL); float* sel_w = (float*)(F.ws + WS_SEL + SEL_STRIDE);
    const int lane = F.lane, gw = blockIdx.x * NWAVES + F.wave, NGW = F.G * NWAVES;
    const float NEG = -__builtin_inff();
    for (int t = gw; t < Tl; t += NGW) {
        const f32x4 lg = *(const f32x4*)(logits + (size_t)t * 256 + 4 * lane); const f32x4 bb = *(const f32x4*)(br + 4 * lane);
        float sc[4], cand[4];
#pragma unroll
        for (int i = 0; i < 4; ++i) { sc[i] = sigmoidf_(lg[i]); cand[i] = sc[i] + bb[i]; }
        float m1 = NEG, m2 = NEG;
#pragma unroll
        for (int i = 0; i < 4; ++i) { const float v = cand[i]; if (v > m1) { m2 = m1; m1 = v; } else if (v > m2) m2 = v; }
#pragma unroll
        for (int off = 1; off < 8; off <<= 1) { const float o1 = __shfl_xor(m1, off), o2 = __shfl_xor(m2, off); const float n1 = fmaxf(m1, o1), n2 = fmaxf(fminf(m1, o1), fmaxf(m2, o2)); m1 = n1; m2 = n2; }
        const float gs = m1 + m2; const int g = lane >> 3; int rank = 0;
#pragma unroll
        for (int q = 0; q < 8; ++q) { const float v = __shfl(gs, 8 * q); rank += (v > gs || (v == gs && q < g)) ? 1 : 0; }
        if (rank >= 4) {
#pragma unroll
            for (int i = 0; i < 4; ++i) cand[i] = NEG; }
        float wsum = 0.f, myw = 0.f; int mye = 0;
#pragma unroll 1
        for (int k = 0; k < TOPK; ++k) {
            float bv = cand[0]; int bidx = 4 * lane;
#pragma unroll
            for (int i = 1; i < 4; ++i) if (cand[i] > bv) { bv = cand[i]; bidx = 4 * lane + i; }
#pragma unroll
            for (int off = 1; off < 64; off <<= 1) { const float ov = __shfl_xor(bv, off); const int oi = __shfl_xor(bidx, off); if (ov > bv || (ov == bv && oi < bidx)) { bv = ov; bidx = oi; } }
            const int owner = bidx >> 2, which = bidx & 3;
            const float s = which == 0 ? sc[0] : which == 1 ? sc[1] : which == 2 ? sc[2] : sc[3];
            const float sw = __shfl(s, owner);
#pragma unroll
            for (int i = 0; i < 4; ++i) if (lane == owner && which == i) cand[i] = NEG;
            wsum += sw; if (lane == k) { myw = sw; mye = bidx; }
        }
        if (lane < TOPK) { sel_e[(size_t)t * 8 + lane] = mye; sel_w[(size_t)t * 8 + lane] = 2.5f * myw / wsum; (void)__hip_atomic_fetch_add(&hist[mye], 1u, __ATOMIC_RELAXED, __HIP_MEMORY_SCOPE_WORKGROUP); }
    }
    __syncthreads();
    unsigned* cnt = (unsigned*)(F.ws + WS_CTL) + CW_CNT + 1024 * l;
    for (int e = F.tid; e < 256; e += NTHR) if (hist[e]) atomicAdd(cnt + e, hist[e]);
    __syncthreads();
}

__device__ __forceinline__ void assign_phase(Frame& F, int l, int Tl) {
    LAS int* cntL = (LAS int*)F.lds; LAS int* pstart = cntL + 256; LAS unsigned* hist = (LAS unsigned*)(pstart + 260); LAS unsigned* base = hist + 256; LAS unsigned* hist2 = base + 256;
    unsigned* cnt = (unsigned*)(F.ws + WS_CTL) + CW_CNT + 1024 * l; unsigned* fill = cnt + 512;
    const int tid = F.tid, lane = F.lane;
    if (tid < 256) { cntL[tid] = (int)cnt[tid]; hist[tid] = 0u; hist2[tid] = 0u; }
    __syncthreads();
    if (F.wave == 0) {
        int p[4]; int s = 0;
#pragma unroll
        for (int i = 0; i < 4; ++i) { p[i] = (cntL[4 * lane + i] + 255) & ~255; s += p[i]; }
        int inc = s;
#pragma unroll
        for (int off = 1; off < 64; off <<= 1) { const int v = __shfl_up(inc, off); if (lane >= off) inc += v; }
        int ex = inc - s;
#pragma unroll
        for (int i = 0; i < 4; ++i) { pstart[4 * lane + i] = ex; ex += p[i]; }
        if (lane == 63) pstart[256] = inc;
    }
    __syncthreads();
    const int total_rows = pstart[256], ntile_r = total_rows >> 8, ntiles = ntile_r + (Tl >> 8);
    int* meta = (int*)(F.ws + WS_META); int* tile_expert = meta + 64;
    int* row_tok = (int*)(F.ws + WS_ROWTOK); const int* sel_e = (const int*)(F.ws + WS_SEL); int* tokpos = (int*)(F.ws + WS_SEL + 2 * SEL_STRIDE);
    if (blockIdx.x == 0) {
        if (tid == 0) { meta[0] = ntiles; meta[1] = total_rows; }
        if (tid < 256) { const int rt0 = pstart[tid] >> 8; for (int rt = rt0; rt < (pstart[tid + 1] >> 8); ++rt) tile_expert[rt] = tid | ((cntL[tid] - 256 * (rt - rt0) <= 128) ? 0x10000 : 0); }
        for (int rt = ntile_r + tid; rt < ntiles; rt += NTHR) tile_expert[rt] = 256;
    }
    for (int e = blockIdx.x; e < 256; e += F.G) for (int r = pstart[e] + cntL[e] + tid; r < pstart[e + 1]; r += NTHR) row_tok[r] = 0;
    const int TPW = (Tl + F.G - 1) / F.G, t0 = blockIdx.x * TPW, t1 = (t0 + TPW < Tl) ? t0 + TPW : Tl;
    for (int t = t0 + tid; t < t1; t += NTHR) row_tok[total_rows + t] = t;
    const int npairs = t1 > t0 ? (t1 - t0) * 8 : 0;
    for (int i = tid; i < npairs; i += NTHR) (void)__hip_atomic_fetch_add(&hist[sel_e[(size_t)t0 * 8 + i]], 1u, __ATOMIC_RELAXED, __HIP_MEMORY_SCOPE_WORKGROUP);
    __syncthreads();
    if (tid < 256) base[tid] = hist[tid] ? atomicAdd(fill + tid, hist[tid]) : 0u;
    __syncthreads();
    for (int i = tid; i < npairs; i += NTHR) { const int e = sel_e[(size_t)t0 * 8 + i]; const unsigned off = __hip_atomic_fetch_add(&hist2[e], 1u, __ATOMIC_RELAXED, __HIP_MEMORY_SCOPE_WORKGROUP);
        const int pos = pstart[e] + (int)base[e] + (int)off; row_tok[pos] = t0 + (i >> 3); tokpos[(size_t)t0 * 8 + i] = pos; }
    __syncthreads();
}

__device__ __forceinline__ void combine_phase(Frame& F, int l, int Tl) {
    const int* meta = (const int*)(F.ws + WS_META); const int total_rows = meta[1];
    const unsigned char* Y = (const unsigned char*)(F.ws + WS_Y); const int* tokpos = (const int*)(F.ws + WS_SEL + 2 * SEL_STRIDE); const float* sel_w = (const float*)(F.ws + WS_SEL + SEL_STRIDE);
    const float* mod = (const float*)(F.ws + WS_MOD);
    float* XC = (float*)(F.ws + WS_XC); bf16* HB = (bf16*)(F.ws + WS_HB);
    const int lane = F.lane, gw = blockIdx.x * NWAVES + F.wave, NGW = F.G * NWAVES;
    const int c0 = 16 * lane;
    const int ca = (lane >> 4) * 256 + ((lane >> 2) & 3) * 32 + (lane & 3) * 8, cb2 = ca + 128;
    for (int t = gw; t < Tl; t += NGW) {
        const int myp = lane < 8 ? tokpos[(size_t)t * 8 + lane] : 0; const float myw = lane < 8 ? sel_w[(size_t)t * 8 + lane] : 0.f;
        float* xr = t < TL ? F.out + (size_t)t * D : XC + (size_t)(t - TL) * D; const int r = t < TL ? (t >> 14) : 2;
        u32x4 yv[9];
        yv[8] = *(const u32x4*)(Y + (size_t)(total_rows + t) * 1024 + c0);
#pragma unroll
        for (int k = 0; k < TOPK; ++k) yv[k] = *(const u32x4*)(Y + (size_t)__shfl(myp, k) * 1024 + c0);
        f32x4 xv[4];
        xv[0] = *(const f32x4*)(xr + ca); xv[1] = *(const f32x4*)(xr + ca + 4); xv[2] = *(const f32x4*)(xr + cb2); xv[3] = *(const f32x4*)(xr + cb2 + 4);
        float y[16];
#pragma unroll
        for (int d = 0; d < 4; ++d) { const f32x2 a = __builtin_amdgcn_cvt_pk_f32_fp8((int)yv[8][d], false), bq = __builtin_amdgcn_cvt_pk_f32_fp8((int)yv[8][d], true);
            y[4 * d] = a.x; y[4 * d + 1] = a.y; y[4 * d + 2] = bq.x; y[4 * d + 3] = bq.y; }
#pragma unroll
        for (int k = 0; k < TOPK; ++k) { const float wk = __shfl(myw, k);
#pragma unroll
            for (int d = 0; d < 4; ++d) { const f32x2 a = __builtin_amdgcn_cvt_pk_f32_fp8((int)yv[k][d], false), bq = __builtin_amdgcn_cvt_pk_f32_fp8((int)yv[k][d], true);
                y[4 * d] += wk * a.x; y[4 * d + 1] += wk * a.y; y[4 * d + 2] += wk * bq.x; y[4 * d + 3] += wk * bq.y; } }
        const float* g2 = mod + (size_t)(l * 3 + r) * 6144 + 5120;
        f32x4 xn[4]; float s = 0.f;
#pragma unroll
        for (int j = 0; j < 4; ++j) { const int cj = (j < 2 ? ca : cb2) + 4 * (j & 1);
            xn[j] = xv[j] + *(const f32x4*)(g2 + cj) * (f32x4){y[4 * j], y[4 * j + 1], y[4 * j + 2], y[4 * j + 3]};
            s += (xn[j].x * xn[j].x + xn[j].y * xn[j].y) + (xn[j].z * xn[j].z + xn[j].w * xn[j].w); }
        const float rstd = rsqrtf(wave_sum(s) * (1.f / D) + EPS);
        if (l == 0) {
            const float* m1 = mod + (size_t)(3 + r) * 6144; const float* gain = F.in[6] + 1024;
            unsigned o[8];
#pragma unroll
            for (int j = 0; j < 4; ++j) { const int cj = (j < 2 ? ca : cb2) + 4 * (j & 1); *(f32x4*)(xr + cj) = xn[j];
                const f32x4 yv2 = xn[j] * rstd * *(const f32x4*)(gain + cj) * (*(const f32x4*)(m1 + 1024 + cj) + 1.f) + *(const f32x4*)(m1 + cj);
                o[2 * j] = pk2(yv2.x, yv2.y); o[2 * j + 1] = pk2(yv2.z, yv2.w); }
            *(u32x4*)(HB + (size_t)t * D + ca) = (u32x4){o[0], o[1], o[2], o[3]}; *(u32x4*)(HB + (size_t)t * D + cb2) = (u32x4){o[4], o[5], o[6], o[7]};
        } else {
            const float* gain = F.in[27];
#pragma unroll
            for (int j = 0; j < 4; ++j) { const int cj = (j < 2 ? ca : cb2) + 4 * (j & 1); *(f32x4*)(F.out + (size_t)t * D + cj) = xn[j] * rstd * *(const f32x4*)(gain + cj); }
        }
    }
}


#ifndef PH_EN
#define PH_EN 0xFFFFFFFFu
#endif
#define EN(j) ((PH_EN >> (j)) & 1u)
#ifndef U_EN
#define U_EN 0xFFu
#endif
#define UEN(j) ((U_EN >> (j)) & 1u)
#ifndef DUPMASK
#define DUPMASK 0u
#endif
#define REP(j) for (int rep_ = 0; rep_ < 1 + (int)((DUPMASK >> (j)) & 1u); ++rep_)
#ifndef DUPU
#define DUPU 0u
#endif
#define REPU(j) for (int repu_ = 0; repu_ < 1 + (int)((DUPU >> (j)) & 1u); ++repu_)
#define IN(k) (lo <= (k) && (k) < hi)
#define FRESH() do { asm volatile("" : "+v"(F.tid)); F.lane = F.tid & 63; } while (0)
#define SEAM(k) do { if (lo <= (k) && (k) + 1 < hi) xcd_barrier(bar); } while (0)
#define SEAMCV(k, lcv) do { if (lo <= (k) && (k) + 1 < hi) xcd_barrier_cv(bar, F); } while (0)
template <int l>
__device__ __forceinline__ void layer_phases(Frame& F, const XcdBarrier& bar, const int lo, const int hi) {
    const int bid = blockIdx.x, G = F.G;

        const int pb = 2 + 12 * l;
        const int Tl = l == 0 ? TT : TL;
        bf16* HB = (bf16*)(F.ws + WS_HB); bf16* Zb = (bf16*)(F.ws + WS_Z); bf16* MIX = (bf16*)(F.ws + WS_MIX);
        if (EN(2) && IN(pb + 0)) REP(2) { FRESH();
            pg8::Gemm g{HB, (const bf16*)(F.ws + WS_WIN) + (size_t)l * INW * 1024, nullptr, 1024}; pg8::StaticOrder S; S.init(TT, INW, G, bid);
            pg8::EpiBf16 E{Zb, INW};
            pg8::gemm_phase<pg8::EpiBf16, pg8::StaticOrder, false>(F.lds, g, S, E, F.tid);
            SEAMCV(pb + 0, l);
        }
        if (EN(3) && IN(pb + 1)) REP(3) { FRESH();
            REPU(0) if (UEN(0)) hgrn2_c1<0>(F, l, bid, 16 * HG_SLOTS, G);
            FRESH(); REPU(1) if (UEN(1)) for (int u = (bid + G - 32) % G; u < 2 * LR_SLOTS; u += G) lru_unit<false>(F, l, u / LR_SLOTS, u % LR_SLOTS);
            FRESH(); REPU(2) if (UEN(2)) for (int u = bid; u < 256; u += G) fft_f1(F, u >> 7, u & 127);
            FRESH(); REPU(3) if (UEN(3) && l == 0) for (int u = (bid + G - 64) % G; u < 8; u += G) ctx_fourier(F, u >> 2, u & 3);
            SEAMCV(pb + 1, l);
        }
        if (EN(4) && IN(pb + 2)) REP(4) { FRESH(); hgrn2_c2(F); lru_carry(F); SEAMCV(pb + 2, l); }
        if (EN(5) && IN(pb + 3)) REP(5) { FRESH();
            const int nslot = l == 0 ? HG_SLOTS : HG_SLOTS - 2, slot0 = l == 0 ? 0 : 2;
            FRESH(); REPU(4) if (UEN(4)) for (int u = bid; u < 8 * nslot; u += G) hgrn2_c3<0>(F, l, u / nslot, slot0 + u % nslot);
            const int nls = l == 0 ? LR_SLOTS : LR_SLOTS - 4, ls0 = l == 0 ? 0 : 4;
            FRESH(); REPU(5) if (UEN(5)) for (int u = (bid + G - 32) % G; u < 2 * nls; u += G) lru_unit<true>(F, l, u / nls, ls0 + u % nls);
            FRESH(); REPU(6) if (UEN(6)) for (int u = bid; u < 512; u += G) fft_f2(F, u >> 8, (u >> 1) & 127, u & 1);
            SEAMCV(pb + 3, l);
        }
        if (EN(6) && IN(pb + 4)) REP(6) { FRESH();
            pg8::Gemm g{MIX, (const bf16*)(F.ws + WS_WOUT) + (size_t)l * 1024 * 1024, nullptr, 1024}; pg8::StaticOrder S; S.init(Tl, 1024, G, bid);
            pg8::EpiResid E{l == 0 ? F_X(F) : (const float*)F.out, F.out, F_CTX(F), (float*)(F.ws + WS_XC), (const float*)(F.ws + WS_MOD) + (size_t)l * 3 * 6144};
            pg8::gemm_phase<pg8::EpiResid, pg8::StaticOrder, false>(F.lds, g, S, E, F.tid);
            SEAMCV(pb + 4, l);
        }
        if (EN(7) && IN(pb + 5)) REP(7) { FRESH();
            hprep_rows(F, l, F.out, (const float*)(F.ws + WS_XC), Tl, 3072, 4096, F.in[7] + l * 1024, true);
            SEAMCV(pb + 5, l);
        }
        if (EN(8) && IN(pb + 6)) REP(8) { FRESH();
            pg8::Gemm g{HB, (const bf16*)(F.ws + WS_WR) + (size_t)l * 256 * 1024, nullptr, 1024}; pg8::StaticOrder S; S.init(Tl, 256, G, bid);
            pg8::EpiF32 E{(float*)(F.ws + WS_LOGIT), 256};
            pg8::gemm_phase<pg8::EpiF32, pg8::StaticOrder, false>(F.lds, g, S, E, F.tid);
            SEAMCV(pb + 6, l);
        }
        if (EN(9) && IN(pb + 7)) REP(9) { FRESH(); route_phase(F, l, Tl); SEAMCV(pb + 7, l); }
        if (EN(10) && IN(pb + 8)) REP(10) { FRESH(); assign_phase(F, l, Tl); FRESH(); convert_experts(F, l); SEAMCV(pb + 8, l); }
        if (EN(11) && IN(pb + 9)) REP(11) { FRESH();
            const int* meta = (const int*)(F.ws + WS_META);
            pg8::Gemm g{(const bf16*)(F.ws + WS_HB8), (const bf16*)(F.ws + (l ? WS_WEXP1 : WS_WEXP)), (const int*)(F.ws + WS_ROWTOK), 512, 0x7a7a7a7a, 0x7f7f7f7f}; pg8::MoeOrder<2> S{meta + 64, meta[0], G, bid};
            pg8::EpiSwiglu8 E{F.ws + WS_HBUF};
            pg8::gemm_phase<pg8::EpiSwiglu8, pg8::MoeOrder<2>, true, true>(F.lds, g, S, E, F.tid);
            SEAMCV(pb + 9, l);
        }
        if (EN(12) && IN(pb + 10)) REP(12) { FRESH();
            const int* meta = (const int*)(F.ws + WS_META);
            pg8::Gemm g{(const bf16*)(F.ws + WS_HBUF), (const bf16*)(F.ws + (l ? WS_WEXP1 : WS_WEXP) + WEXP_GU_BYTES), nullptr, 128, 0x7b7b7b7b, 0x7d7d7d7d}; pg8::MoeOrder<4> S{meta + 64, meta[0], G, bid};
            pg8::EpiFp8 E{(unsigned char*)(F.ws + WS_Y), 1024};
            pg8::gemm_phase<pg8::EpiFp8, pg8::MoeOrder<4>, false, true>(F.lds, g, S, E, F.tid);
            SEAMCV(pb + 10, l);
        }
        if (EN(13) && IN(pb + 11)) REP(13) { FRESH(); combine_phase(F, l, Tl); SEAMCV(pb + 11, l); }
    }

constexpr int NPH = 26;
#ifndef BENCH_REPS
#define BENCH_REPS 2
#endif
__global__ void __launch_bounds__(NTHR, 2) fwd_kernel(Args args) {
    extern __shared__ __attribute__((aligned(16))) unsigned char lds_raw[];
    Frame F;
    F.lds = (LAS unsigned char*)lds_raw;
    F.tid = threadIdx.x; F.lane = F.tid & 63; F.wave = __builtin_amdgcn_readfirstlane(F.tid >> 6); F.G = gridDim.x;
    F.in = (const CAS cfptr*)__builtin_amdgcn_kernarg_segment_ptr();
    F.out = args.out; F.ws = args.ws;
    volatile LAS unsigned* MISC = (volatile LAS unsigned*)(F.lds + MISC_OFF);
    if (F.tid < 64) MISC[F.tid] = 0u;
    __syncthreads();
    XcdBarrier bar = xcd_barrier_post((unsigned*)(F.ws + WS_CTL) + CW_BAR, MISC + 8);
    const int lo = args.ph_lo, hi = args.ph_hi;
    const int bid = blockIdx.x, G = F.G;

    if (EN(0) && IN(0)) { FRESH(); phase_g0(F); SEAMCV(0, 0); }
    if (EN(1) && IN(1)) { FRESH(); hprep_rows(F, 0, F_X(F), F_CTX(F), TT, 0, 1024, F.in[6]); SEAMCV(1, 0); }

    layer_phases<0>(F, bar, lo, hi);
    layer_phases<1>(F, bar, lo, hi);
#ifdef BENCH_GEMM
    if (hi == NPH) { xcd_barrier(bar); FRESH();
        _Pragma("unroll 1") for (int rep = 0; rep < BENCH_REPS; ++rep) {
            const int* meta = (const int*)(F.ws + WS_META);
            pg8::Gemm g{(const bf16*)(F.ws + WS_HBUF), (const bf16*)(F.ws + WS_WEXP + WEXP_GU_BYTES), nullptr, 256}; pg8::MoeOrder<4> S{meta + 64, meta[0], F.G, (int)blockIdx.x};
#if BENCH_GEMM == 1
            pg8::EpiFp8 E{(unsigned char*)(F.ws + WS_Y), 1024}; pg8::gemm_phase<pg8::EpiFp8, pg8::MoeOrder<4>, false>(F.lds, g, S, E, F.tid);
#else
            pg8::EpiNone E{(bf16*)(F.ws + WS_Y)}; pg8::gemm_phase<pg8::EpiNone, pg8::MoeOrder<4>, false>(F.lds, g, S, E, F.tid);
#endif
            xcd_barrier(bar); } }
#endif
#ifdef BENCH_INPROJ
    if (hi == NPH) { xcd_barrier(bar); FRESH();
        _Pragma("unroll 1") for (int rep = 0; rep < BENCH_REPS; ++rep) {
            pg8::Gemm g{(const bf16*)(F.ws + WS_HB), (const bf16*)(F.ws + WS_WIN), nullptr, 1024}; pg8::StaticOrder S; S.init(TT, INW, F.G, (int)blockIdx.x);
#if BENCH_INPROJ == 1
            pg8::EpiBf16 E{(bf16*)(F.ws + WS_Z), INW}; pg8::gemm_phase<pg8::EpiBf16, pg8::StaticOrder, false>(F.lds, g, S, E, F.tid);
#else
            pg8::EpiNone E{(bf16*)(F.ws + WS_Z)}; pg8::gemm_phase<pg8::EpiNone, pg8::StaticOrder, false>(F.lds, g, S, E, F.tid);
#endif
            xcd_barrier(bar); } }
#endif
#ifdef BENCH_MOE1
    if (hi == NPH) { xcd_barrier(bar); FRESH();
        _Pragma("unroll 1") for (int rep = 0; rep < BENCH_REPS; ++rep) {
            const int* meta = (const int*)(F.ws + WS_META);
            pg8::MoeOrder<2> S{meta + 64, meta[0], F.G, (int)blockIdx.x};
#if BENCH_MOE1 == 1
            pg8::Gemm g{(const bf16*)(F.ws + WS_HB), (const bf16*)(F.ws + WS_WEXP1), (const int*)(F.ws + WS_ROWTOK), 1024};
            pg8::EpiSwiglu E{(bf16*)(F.ws + WS_HBUF)}; pg8::gemm_phase<pg8::EpiSwiglu, pg8::MoeOrder<2>, true>(F.lds, g, S, E, F.tid);
#elif BENCH_MOE1 == 2
            pg8::Gemm g{(const bf16*)(F.ws + WS_HB), (const bf16*)(F.ws + WS_WEXP1), (const int*)(F.ws + WS_ROWTOK), 1024};
            pg8::EpiNone E{(bf16*)(F.ws + WS_HBUF)}; pg8::gemm_phase<pg8::EpiNone, pg8::MoeOrder<2>, true>(F.lds, g, S, E, F.tid);
#else
            pg8::Gemm g{(const bf16*)(F.ws + WS_HB), (const bf16*)(F.ws + WS_WEXP1), nullptr, 1024};
            pg8::EpiNone E{(bf16*)(F.ws + WS_HBUF)}; pg8::gemm_phase<pg8::EpiNone, pg8::MoeOrder<2>, false>(F.lds, g, S, E, F.tid);
#endif
            xcd_barrier(bar); } }
#endif
#ifdef BENCH_X2
    if (hi == NPH) { xcd_barrier(bar); FRESH();
        _Pragma("unroll 1") for (int rep = 0; rep < BENCH_REPS; ++rep) { if (BENCH_X2 & 1) hgrn2_c2(F); if (BENCH_X2 & 2) lru_carry(F); xcd_barrier(bar); } }
#endif
#ifdef BENCH_C1
    if (hi == NPH) { xcd_barrier(bar); FRESH();
        _Pragma("unroll 1") for (int rep = 0; rep < BENCH_REPS; ++rep) hgrn2_c1<BENCH_C1>(F, 1, (int)blockIdx.x, 16 * HG_SLOTS, F.G); }
#endif
#ifdef BENCH_VAR
    if (hi == NPH) { xcd_barrier(bar); FRESH();
        _Pragma("unroll 1") for (int rep = 0; rep < BENCH_REPS; ++rep) for (int u = blockIdx.x; u < 8 * 128; u += F.G) hgrn2_c3<BENCH_VAR>(F, 1, u >> 7, 2 + (u & 127)); }
#endif
#undef IN
#undef SEAM
}

extern "C" void kernel_launch(void* const* d_in, const int* in_sizes, int n_in, void* d_out, int out_size, void* d_ws, size_t ws_size, hipStream_t stream) {
    static int grid = 0;
    if (grid == 0) {
        if (n_in != 28 || out_size != TL * D || ws_size < WS_END) { fprintf(stderr, "kernel_launch: unexpected problem (n_in %d, out %d, ws %zu < %zu)\n", n_in, out_size, ws_size, (size_t)WS_END); grid = -1; return; }
        int dev = 0, cus = 0, per_cu = 0;
        if (hipGetDevice(&dev) != hipSuccess || hipDeviceGetAttribute(&cus, hipDeviceAttributeMultiprocessorCount, dev) != hipSuccess) { grid = -1; return; }
        if (hipFuncSetAttribute((const void*)fwd_kernel, hipFuncAttributeMaxDynamicSharedMemorySize, LDS_BYTES) != hipSuccess) { fprintf(stderr, "kernel_launch: hipFuncSetAttribute failed\n"); grid = -1; return; }
        if (hipOccupancyMaxActiveBlocksPerMultiprocessor(&per_cu, (const void*)fwd_kernel, NTHR, LDS_BYTES) != hipSuccess || per_cu < 1) { fprintf(stderr, "kernel_launch: occupancy query says %d\n", per_cu); (void)hipGetLastError(); }
        grid = cus;
    }
    if (grid < 0) return;
    (void)hipMemsetAsync((char*)d_ws + WS_CTL, 0, CTL_ZERO_BYTES, stream);
    Args a{};
    for (int i = 0; i < 28; ++i) a.in[i] = (const float*)d_in[i];
    a.out = (float*)d_out; a.ws = (unsigned char*)d_ws;
#if MK_PER_PHASE
    for (int p = 0; p < NPH; ++p) { a.ph_lo = p; a.ph_hi = p + 1; hipLaunchKernelGGL(fwd_kernel, dim3(grid), dim3(NTHR), LDS_BYTES, stream, a); }
#else
    a.ph_lo = 0; a.ph_hi = NPH; hipLaunchKernelGGL(fwd_kernel, dim3(grid), dim3(NTHR), LDS_BYTES, stream, a);
#endif
}
```

```cpp
#include <hip/hip_runtime.h>
#include <cstdio>
#include <cstdint>

#ifndef MK_PER_PHASE
#define MK_PER_PHASE 0
#endif

#define LAS __attribute__((address_space(3)))
#define GAS __attribute__((address_space(1)))
typedef unsigned short bf16;
typedef short bf16x8 __attribute__((ext_vector_type(8)));
typedef float f32x4 __attribute__((ext_vector_type(4)));
typedef float f32x2 __attribute__((ext_vector_type(2)));
typedef unsigned u32x4 __attribute__((ext_vector_type(4)));
typedef unsigned u32x2 __attribute__((ext_vector_type(2)));
typedef int i32x4 __attribute__((ext_vector_type(4)));
typedef int i32x8 __attribute__((ext_vector_type(8)));

__device__ __forceinline__ float bf2f(bf16 v) { return __builtin_bit_cast(float, ((unsigned)v) << 16); }
typedef __bf16 bf16x2_t __attribute__((ext_vector_type(2)));
__device__ __forceinline__ unsigned pk2(float lo, float hi) { bf16x2_t v; v.x = (__bf16)lo; v.y = (__bf16)hi; return __builtin_bit_cast(unsigned, v); }
__device__ __forceinline__ bf16 f2bf(float f) { const __bf16 b = (__bf16)f; return __builtin_bit_cast(unsigned short, b); }
__device__ __forceinline__ unsigned f2bfu(float f) { return (unsigned)f2bf(f); }
#define MFMA16(a, b, c) __builtin_amdgcn_mfma_f32_16x16x32_bf16((a), (b), (c), 0, 0, 0)
#define LDS_WAIT() asm volatile("s_waitcnt lgkmcnt(0)" ::: "memory")
#define LDS_BARRIER() do { asm volatile("s_waitcnt lgkmcnt(0)" ::: "memory"); __builtin_amdgcn_s_barrier(); asm volatile("" ::: "memory"); } while (0)

namespace pg8 {
typedef unsigned short bf16_t;
constexpr int BM = 256, BK = 64, HALF = 128, HTB = HALF * BK * 2, STAGE_BYTES = 8 * HTB, NXCD = 8, WGM = 8;

__host__ __device__ __forceinline__ int lds_byte(int r, int c) { const int st = (r >> 4) * 2 + (c >> 5), rr = r & 15, cc = c & 31, ob = rr * 64 + cc * 2; return st * 1024 + (ob ^ (((ob >> 9) & 1) << 5)); }
__host__ __device__ __forceinline__ void stage_rc(int b, int& R, int& C) { const int st = b / 1024, sb = b % 1024, swz = sb ^ (((sb >> 9) & 1) << 5); R = (st >> 1) * 16 + swz / 64; C = (st & 1) * 32 + (swz % 64) / 2; }
__host__ __device__ __forceinline__ int perm32(int rho) { const int n = rho >> 4, i = rho & 15; return 8 * (i >> 2) + 4 * n + (i & 3); }

struct Unit { int pm, pn, pc, half; };
struct Gemm { const bf16_t* A; const bf16_t* Bt; const int* rows; int K; int sw = 0x7f7f7f7f, sx = 0x7f7f7f7f; };

struct StaticOrder {
    int nM, nN, nwg, G, c;
    __device__ void init(int M, int N, int G_, int c_) { nM = M / BM; nN = N / BM; nwg = nM * nN; G = G_; c = c_; }
    __device__ bool next(int i, Unit& u) const {
        const long L = (long)i * G + c; if (L >= nwg) return false;
        int wgid = (int)L; { const int q = nwg / NXCD, r = nwg % NXCD, xcd = wgid % NXCD, off = wgid / NXCD; wgid = (xcd < r ? xcd * (q + 1) : r * (q + 1) + (xcd - r) * q) + off; }
        const int nig = WGM * nN, gid = wgid / nig, fm = gid * WGM, gsz = (nM - fm) < WGM ? (nM - fm) : WGM;
        u.pm = fm + ((wgid % nig) % gsz); u.pn = (wgid % nig) / gsz; u.pc = u.pn; u.half = 0; return true;
    }
};
template <int NT> struct MoeOrder {
    const int* tile_expert; int n_tiles, G, c;
    __device__ bool next(int i, Unit& u) const {
        int rt, j;
        if ((G & 7) == 0) { const int x = c & 7, jw = c >> 3, per = G >> 3; const int t0 = (int)(((long)n_tiles * x) >> 3), t1 = (int)(((long)n_tiles * (x + 1)) >> 3);
            const int Lx = i * per + jw; if (Lx >= (t1 - t0) * NT) return false; rt = t0 + Lx / NT; j = Lx % NT; }
        else { const int L = i * G + c; if (L >= n_tiles * NT) return false; rt = L / NT; j = L % NT; }
        const int te = tile_expert[rt], e = te & 0xffff;
        u.pm = rt; u.pn = e * NT + j; u.pc = j; u.half = te >> 16; return true;
    }
};

__device__ __forceinline__ unsigned cvt_pk_bf16(float lo, float hi) { return pk2(lo, hi); }

struct EpiBf16 {
    static constexpr bool PERM = true;
    bf16_t* O; int ldc;
    __device__ __forceinline__ void operator()(const f32x4 (&acc)[2][2][4][2], const Unit& u, int wr, int wc, int fr, int fq) const {
        const int row0 = u.pm * BM + wr * 64 + fr, col0 = u.pc * BM + wc * 32 + 8 * fq;
#pragma unroll
        for (int ai = 0; ai < 2; ++ai)
#pragma unroll
            for (int m = 0; m < 4; ++m) { bf16_t* rowp = O + (size_t)(row0 + ai * HALF + m * 16) * ldc + col0;
#pragma unroll
                for (int bj = 0; bj < 2; ++bj) { const f32x4 v0 = acc[ai][bj][m][0], v1 = acc[ai][bj][m][1];
                    u32x4 w; w.x = cvt_pk_bf16(v0[0], v0[1]); w.y = cvt_pk_bf16(v0[2], v0[3]); w.z = cvt_pk_bf16(v1[0], v1[1]); w.w = cvt_pk_bf16(v1[2], v1[3]);
                    *(u32x4*)(rowp + bj * HALF) = w; } }
    }
};
struct EpiFp8 {
    static constexpr bool PERM = true;
    unsigned char* O; int ldc;
    static __device__ __forceinline__ unsigned pk4(const f32x4 v) {
        const float a = __builtin_amdgcn_fmed3f(v[0], -448.f, 448.f), b = __builtin_amdgcn_fmed3f(v[1], -448.f, 448.f), c = __builtin_amdgcn_fmed3f(v[2], -448.f, 448.f), d = __builtin_amdgcn_fmed3f(v[3], -448.f, 448.f);
        int p = __builtin_amdgcn_cvt_pk_fp8_f32(a, b, 0, false); p = __builtin_amdgcn_cvt_pk_fp8_f32(c, d, p, true); return (unsigned)p; }
    __device__ __forceinline__ void operator()(const f32x4 (&acc)[2][2][4][2], const Unit& u, int wr, int wc, int fr, int fq) const {
        const int row0 = u.pm * BM + wr * 64 + fr, pos0 = u.pc * BM + wc * 64 + 16 * fq;
#pragma unroll
        for (int ai = 0; ai < 2; ++ai) { if (ai == 1 && u.half) break;
#pragma unroll
            for (int m = 0; m < 4; ++m) { u32x4 w; w.x = pk4(acc[ai][0][m][0]); w.y = pk4(acc[ai][0][m][1]); w.z = pk4(acc[ai][1][m][0]); w.w = pk4(acc[ai][1][m][1]);
                *(u32x4*)(O + (size_t)(row0 + ai * HALF + m * 16) * ldc + pos0) = w; } }
    }
};
struct EpiNone {
    static constexpr bool PERM = true;
    bf16_t* O;
    __device__ __forceinline__ void operator()(const f32x4 (&acc)[2][2][4][2], const Unit& u, int wr, int wc, int fr, int fq) const {
        float s = 0.f;
#pragma unroll
        for (int ai = 0; ai < 2; ++ai)
#pragma unroll
            for (int bj = 0; bj < 2; ++bj)
#pragma unroll
                for (int m = 0; m < 4; ++m)
#pragma unroll
                    for (int n = 0; n < 2; ++n) s += acc[ai][bj][m][n][0] + acc[ai][bj][m][n][1] + acc[ai][bj][m][n][2] + acc[ai][bj][m][n][3];
        if (s == 123.4567f) O[u.pm + wr + wc + fr + fq] = 1;
    }
};
struct EpiF32 {
    static constexpr bool PERM = false;
    float* C; int ldc;
    __device__ __forceinline__ void operator()(const f32x4 (&acc)[2][2][4][2], const Unit& u, int wr, int wc, int fr, int fq) const {
        const int row0 = u.pm * BM + wr * 64 + fr, col0 = u.pc * BM + wc * 32 + 4 * fq;
#pragma unroll
        for (int ai = 0; ai < 2; ++ai)
#pragma unroll
            for (int m = 0; m < 4; ++m) { float* rowp = C + (size_t)(row0 + ai * HALF + m * 16) * ldc + col0;
#pragma unroll
                for (int bj = 0; bj < 2; ++bj)
#pragma unroll
                    for (int n = 0; n < 2; ++n) *(f32x4*)(rowp + bj * HALF + n * 16) = acc[ai][bj][m][n]; }
    }
};
struct EpiResid {
    static constexpr bool PERM = false;
    const float* src_lat; float* dst_lat; const float* src_ctx; float* dst_ctx; const float* gate;
    __device__ __forceinline__ void operator()(const f32x4 (&acc)[2][2][4][2], const Unit& u, int wr, int wc, int fr, int fq) const {
        const int col0 = u.pc * BM + wc * 32 + 4 * fq;
        const float* src; float* dst; const float* gv; int row0;
        if (u.pm < 128) { row0 = u.pm * BM + wr * 64 + fr; src = src_lat; dst = dst_lat; gv = gate + (u.pm >> 6) * 6144 + 2048; }
        else { row0 = (u.pm - 128) * BM + wr * 64 + fr; src = src_ctx; dst = dst_ctx; gv = gate + 2 * 6144 + 2048; }
        f32x4 g[2][2];
#pragma unroll
        for (int bj = 0; bj < 2; ++bj)
#pragma unroll
            for (int n = 0; n < 2; ++n) g[bj][n] = *(const f32x4*)(gv + col0 + bj * HALF + n * 16);
#pragma unroll
        for (int ai = 0; ai < 2; ++ai)
#pragma unroll
            for (int m = 0; m < 4; ++m) { const size_t off = (size_t)(row0 + ai * HALF + m * 16) * 1024 + col0;
#pragma unroll
                for (int bj = 0; bj < 2; ++bj)
#pragma unroll
                    for (int n = 0; n < 2; ++n) { const f32x4 xv = *(const f32x4*)(src + off + bj * HALF + n * 16);
                        *(f32x4*)(dst + off + bj * HALF + n * 16) = xv + g[bj][n] * acc[ai][bj][m][n]; } }
    }
};
struct EpiSwiglu {
    static constexpr bool PERM = true;
    bf16_t* H;
    __device__ __forceinline__ void operator()(const f32x4 (&acc)[2][2][4][2], const Unit& u, int wr, int wc, int fr, int fq) const {
        const int row0 = u.pm * BM + wr * 64 + fr, col0 = u.pc * HALF + wc * 32 + 8 * fq;
#pragma unroll
        for (int ai = 0; ai < 2; ++ai) { if (ai == 1 && u.half) break;
#pragma unroll
            for (int m = 0; m < 4; ++m) { float h[8];
#pragma unroll
                for (int n = 0; n < 2; ++n)
#pragma unroll
                    for (int j = 0; j < 4; ++j) { const float g = acc[ai][0][m][n][j], up = acc[ai][1][m][n][j]; h[n * 4 + j] = g * __builtin_amdgcn_rcpf(1.f + __expf(-g)) * up; }
                u32x4 w; w.x = cvt_pk_bf16(h[0], h[1]); w.y = cvt_pk_bf16(h[2], h[3]); w.z = cvt_pk_bf16(h[4], h[5]); w.w = cvt_pk_bf16(h[6], h[7]);
                *(u32x4*)(H + (size_t)(row0 + ai * HALF + m * 16) * 256 + col0) = w; } }
    }
};

struct EpiSwiglu8 {
    static constexpr bool PERM = true;
    unsigned char* H;
    __device__ __forceinline__ void operator()(const f32x4 (&acc)[2][2][4][2], const Unit& u, int wr, int wc, int fr, int fq) const {
        const int row0 = u.pm * BM + wr * 64 + fr, col0 = u.pc * HALF + wc * 32 + 8 * fq;
#pragma unroll
        for (int ai = 0; ai < 2; ++ai) { if (ai == 1 && u.half) break;
#pragma unroll
            for (int m = 0; m < 4; ++m) { float h[8];
#pragma unroll
                for (int n = 0; n < 2; ++n)
#pragma unroll
                    for (int j = 0; j < 4; ++j) { const float g = acc[ai][0][m][n][j], up = acc[ai][1][m][n][j]; h[n * 4 + j] = __builtin_amdgcn_fmed3f(4.f * g * __builtin_amdgcn_rcpf(1.f + __expf(-g)) * up, -448.f, 448.f); }
                int lo = __builtin_amdgcn_cvt_pk_fp8_f32(h[0], h[1], 0, false); lo = __builtin_amdgcn_cvt_pk_fp8_f32(h[2], h[3], lo, true);
                int hi = __builtin_amdgcn_cvt_pk_fp8_f32(h[4], h[5], 0, false); hi = __builtin_amdgcn_cvt_pk_fp8_f32(h[6], h[7], hi, true);
                u32x2 w; w.x = (unsigned)lo; w.y = (unsigned)hi;
                *(u32x2*)(H + (size_t)(row0 + ai * HALF + m * 16) * 256 + col0) = w; } }
    }
};

template <class Epi, class Sched, bool GATHER, bool FP8 = false>
__device__ __forceinline__ void gemm_phase(LAS unsigned char* lds, const Gemm g, const Sched& S, const Epi& E, const int tid) {
    const int wid = __builtin_amdgcn_readfirstlane(tid >> 6), lane = tid & 63, wr = wid >> 2, wc = wid & 3, fr = lane & 15, fq = lane >> 4;
    const int K = g.K, nt = K / BK;
    int RA[2], CA[2]; unsigned voffB[2];
#pragma unroll
    for (int i = 0; i < 2; ++i) { int R, C; stage_rc(tid * 16 + i * 8192, R, C); const int Rb = Epi::PERM ? ((R & ~31) + perm32(R & 31)) : R;
        RA[i] = R; CA[i] = C; voffB[i] = (unsigned)(Rb * K + C) * 2u; }
    const unsigned kstep = (unsigned)(BK * 2);
    const unsigned hstep = (unsigned)HALF * (unsigned)K * 2u;
    const unsigned tstep = 2u * hstep;
    const unsigned ldsw = (unsigned)wid * 1024u;
    const int aoff = lds_byte(wr * 64 + fr, fq * 8), boff = lds_byte(wc * 32 + fr, fq * 8);
    const __amdgpu_buffer_rsrc_t srdA = __builtin_amdgcn_make_buffer_rsrc((void*)g.A, (short)0, 0x7fffffff, 0x00020000);
    const __amdgpu_buffer_rsrc_t srdB = __builtin_amdgcn_make_buffer_rsrc((void*)g.Bt, (short)0, 0x7fffffff, 0x00020000);
#define PG8_SA(b, h) (((b) * 2 + (h)) * HTB)
#define PG8_SB(b, h) ((4 + (b) * 2 + (h)) * HTB)
#define PG8_STAGE(bufoff, soff, voff) do { _Pragma("unroll") for (int _i = 0; _i < 2; ++_i) \
        __builtin_amdgcn_raw_ptr_buffer_load_lds(srdB, (LAS unsigned*)(lds + (bufoff) + ldsw + _i * 8192), 16, (int)(voff)[_i], (int)(soff), 0, 0); } while (0)
#define PG8_STAGE2(bufoff, soff, v0, v1) do { \
        __builtin_amdgcn_raw_ptr_buffer_load_lds(srdA, (LAS unsigned*)(lds + (bufoff) + ldsw), 16, (int)(v0), (int)(soff), 0, 0); \
        __builtin_amdgcn_raw_ptr_buffer_load_lds(srdA, (LAS unsigned*)(lds + (bufoff) + ldsw + 8192), 16, (int)(v1), (int)(soff), 0, 0); } while (0)
#define PG8_LDA(dst, b, h) do { _Pragma("unroll") for (int m = 0; m < 4; ++m) _Pragma("unroll") for (int k = 0; k < 2; ++k) dst[m][k] = *(const LAS bf16x8*)(lds + PG8_SA(b, h) + aoff + m * 2048 + k * 1024); } while (0)
#define PG8_LDB(dst, b, h) do { _Pragma("unroll") for (int n = 0; n < 2; ++n) _Pragma("unroll") for (int k = 0; k < 2; ++k) dst[n][k] = *(const LAS bf16x8*)(lds + PG8_SB(b, h) + boff + n * 2048 + k * 1024); } while (0)
#define PG8_MMA(ai, bj, At, Bt) do { __builtin_amdgcn_s_setprio(1); _Pragma("unroll") for (int m = 0; m < 4; ++m) _Pragma("unroll") for (int n = 0; n < 2; ++n) { \
        if constexpr (FP8) { const i32x4 b0_ = __builtin_bit_cast(i32x4, Bt[n][0]), b1_ = __builtin_bit_cast(i32x4, Bt[n][1]), a0_ = __builtin_bit_cast(i32x4, At[m][0]), a1_ = __builtin_bit_cast(i32x4, At[m][1]); \
            const i32x8 w8_ = __builtin_shufflevector(b0_, b1_, 0, 1, 2, 3, 4, 5, 6, 7), x8_ = __builtin_shufflevector(a0_, a1_, 0, 1, 2, 3, 4, 5, 6, 7); \
            asm volatile("v_mfma_scale_f32_16x16x128_f8f6f4 %0, %1, %2, %0, %3, %4 op_sel_hi:[0,0,0]" : "+v"(acc[ai][bj][m][n]) : "v"(w8_), "v"(x8_), "v"(sw_), "v"(sx_)); } \
        else { _Pragma("unroll") for (int k = 0; k < 2; ++k) acc[ai][bj][m][n] = __builtin_amdgcn_mfma_f32_16x16x32_bf16(Bt[n][k], At[m][k], acc[ai][bj][m][n], 0, 0, 0); } } __builtin_amdgcn_s_setprio(0); } while (0)
#define PG8_WAIT_V(n) asm volatile("s_waitcnt vmcnt(" #n ")" ::: "memory")
#define PG8_WAIT_L(n) asm volatile("s_waitcnt lgkmcnt(" #n ")" ::: "memory")
#define PG8_BAR __builtin_amdgcn_s_barrier()
#define PG8_SCHED __builtin_amdgcn_sched_barrier(0)
    Unit cur, nxt; int ui = 0;
    if (!S.next(0, cur)) return;
    int sw_ = g.sw, sx_ = g.sx;
    if constexpr (FP8) asm volatile("" : "+v"(sw_), "+v"(sx_));
    else { (void)sw_; (void)sx_; }
    f32x4 acc[2][2][4][2];
#pragma unroll
    for (int a = 0; a < 2; ++a)
#pragma unroll
        for (int b = 0; b < 2; ++b)
#pragma unroll
            for (int m = 0; m < 4; ++m)
#pragma unroll
                for (int n = 0; n < 2; ++n) acc[a][b][m][n] = (f32x4){0.f, 0.f, 0.f, 0.f};
    bf16x8 At[4][2], B0[2][2], B1[2][2];
    unsigned c00, c01, c10, c11, n00, n01, n10, n11;
    unsigned cA, cB = (unsigned)cur.pn * tstep;
    if constexpr (GATHER) {
        const int* rp = g.rows + (size_t)cur.pm * BM; const unsigned rb = (unsigned)K * 2u;
        c00 = (unsigned)rp[RA[0]] * rb + (unsigned)CA[0] * 2u; c01 = (unsigned)rp[RA[1]] * rb + (unsigned)CA[1] * 2u;
        c10 = (unsigned)rp[HALF + RA[0]] * rb + (unsigned)CA[0] * 2u; c11 = (unsigned)rp[HALF + RA[1]] * rb + (unsigned)CA[1] * 2u;
        cA = 0u;
    } else {
        c00 = (unsigned)(RA[0] * K + CA[0]) * 2u; c01 = (unsigned)(RA[1] * K + CA[1]) * 2u;
        c10 = (unsigned)((HALF + RA[0]) * K + CA[0]) * 2u; c11 = (unsigned)((HALF + RA[1]) * K + CA[1]) * 2u;
        cA = (unsigned)cur.pm * tstep;
    }
    n00 = c00; n01 = c01; n10 = c10; n11 = c11;
    PG8_STAGE(PG8_SB(0, 0), cB, voffB); PG8_STAGE(PG8_SB(0, 1), cB + hstep, voffB); PG8_STAGE2(PG8_SA(0, 0), cA, c00, c01); PG8_STAGE2(PG8_SA(0, 1), cA, c10, c11);
    if (wr == 1) PG8_BAR;
    PG8_WAIT_V(2); PG8_BAR;
    PG8_STAGE(PG8_SB(1, 0), cB + kstep, voffB); PG8_STAGE2(PG8_SA(1, 0), cA + kstep, c00, c01); PG8_STAGE(PG8_SB(1, 1), cB + hstep + kstep, voffB);
    PG8_WAIT_V(6); PG8_BAR;
    for (;;) {
        const bool has_next = S.next(ui + 1, nxt);
        unsigned nA; const unsigned nB = has_next ? (unsigned)nxt.pn * tstep : cB;
        if constexpr (GATHER) {
            nA = 0u;
            if (has_next) { const int* rp = g.rows + (size_t)nxt.pm * BM; const unsigned rb = (unsigned)K * 2u;
                n00 = (unsigned)rp[RA[0]] * rb + (unsigned)CA[0] * 2u; n01 = (unsigned)rp[RA[1]] * rb + (unsigned)CA[1] * 2u;
                n10 = (unsigned)rp[HALF + RA[0]] * rb + (unsigned)CA[0] * 2u; n11 = (unsigned)rp[HALF + RA[1]] * rb + (unsigned)CA[1] * 2u; }
            else { n00 = c00; n01 = c01; n10 = c10; n11 = c11; }
        } else {
            nA = has_next ? (unsigned)nxt.pm * tstep : cA;
        }
        const bool hf = cur.half != 0;
#pragma unroll 1
        for (int t = 0; t < nt; t += 2) {
            const bool last = (t == nt - 2);
            const unsigned a1 = cA + (unsigned)(t + 1) * kstep;
            const unsigned a2 = last ? nA : cA + (unsigned)(t + 2) * kstep, b2 = last ? nB : cB + (unsigned)(t + 2) * kstep;
            const unsigned a3 = a2 + kstep, b3 = b2 + kstep;
            unsigned s00 = c00, s01 = c01, s10 = c10, s11 = c11;
            if constexpr (GATHER) { s00 = last ? n00 : c00; s01 = last ? n01 : c01; s10 = last ? n10 : c10; s11 = last ? n11 : c11; }
            PG8_LDB(B0, 0, 0); PG8_LDB(B1, 0, 1); PG8_SCHED; PG8_LDA(At, 0, 0); PG8_STAGE2(PG8_SA(1, 1), a1, c10, c11);
            PG8_WAIT_V(8); PG8_WAIT_L(0); PG8_BAR; PG8_MMA(0, 0, At, B0); PG8_MMA(0, 1, At, B1); PG8_BAR; PG8_SCHED;
            if (!hf) PG8_LDA(At, 0, 1); PG8_STAGE(PG8_SB(0, 0), b2, voffB); PG8_STAGE(PG8_SB(0, 1), b2 + hstep, voffB); PG8_STAGE2(PG8_SA(0, 0), a2, s00, s01);
            PG8_WAIT_V(8); PG8_WAIT_L(0); PG8_BAR; if (!hf) { PG8_MMA(1, 0, At, B0); PG8_MMA(1, 1, At, B1); } PG8_BAR; PG8_SCHED;
            PG8_LDB(B0, 1, 0); PG8_LDB(B1, 1, 1); PG8_SCHED; PG8_LDA(At, 1, 0); PG8_STAGE2(PG8_SA(0, 1), a2, s10, s11);
            PG8_WAIT_V(8); PG8_WAIT_L(0); PG8_BAR; PG8_MMA(0, 0, At, B0); PG8_MMA(0, 1, At, B1); PG8_BAR; PG8_SCHED;
            if (!hf) PG8_LDA(At, 1, 1); PG8_STAGE(PG8_SB(1, 0), b3, voffB); PG8_STAGE(PG8_SB(1, 1), b3 + hstep, voffB); PG8_STAGE2(PG8_SA(1, 0), a3, s00, s01);
            PG8_WAIT_V(8); PG8_WAIT_L(0); PG8_BAR; if (!hf) { PG8_MMA(1, 0, At, B0); PG8_MMA(1, 1, At, B1); } PG8_BAR; PG8_SCHED;
        }
        if (wr == 0) PG8_BAR;
        if constexpr (FP8) { asm volatile("s_nop 15\n\ts_nop 7" ::: "memory"); PG8_SCHED; }
        E(acc, cur, wr, wc, fr, fq);
        if (!has_next) break;
#pragma unroll
        for (int a = 0; a < 2; ++a)
#pragma unroll
            for (int b = 0; b < 2; ++b)
#pragma unroll
                for (int m = 0; m < 4; ++m)
#pragma unroll
                    for (int n = 0; n < 2; ++n) acc[a][b][m][n] = (f32x4){0.f, 0.f, 0.f, 0.f};
        cur = nxt; cA = nA; cB = nB; ++ui;
        if constexpr (GATHER) { c00 = n00; c01 = n01; c10 = n10; c11 = n11; }
        if (wr == 1) PG8_BAR;
    }
    PG8_WAIT_V(0);
    PG8_BAR;
#undef PG8_SA
#undef PG8_SB
#undef PG8_STAGE
#undef PG8_STAGE2
#undef PG8_LDA
#undef PG8_LDB
#undef PG8_MMA
#undef PG8_WAIT_V
#undef PG8_WAIT_L
#undef PG8_BAR
#undef PG8_SCHED
}
}

#define XB_TMO      128
#define XB_XCNT(j)  (256  + 64 * (j))
#define XB_XSUB(j)  (1280 + 64 * (j))
#define XB_XGEN(j)  (2304 + 64 * (j))
#define XB_TOP      3328
#define XB_TOPGEN   3392
#define XCD_BAR_WORDS 3456
#define XB_SPIN_CAP (1u << 18)

__device__ __forceinline__ unsigned xb_ld(unsigned* p)              { return __hip_atomic_load(p, __ATOMIC_RELAXED, __HIP_MEMORY_SCOPE_AGENT); }
__device__ __forceinline__ unsigned xb_add(unsigned* p, unsigned v) { return __hip_atomic_fetch_add(p, v, __ATOMIC_RELAXED, __HIP_MEMORY_SCOPE_AGENT); }
__device__ __forceinline__ unsigned xb_xcc_id() { return (unsigned)__builtin_amdgcn_s_getreg((3 << 11) | 20) & 0xFu; }
#define XB_SPIN(cond, bar) do { unsigned _sp = 0; while (cond) { __builtin_amdgcn_s_sleep(1); \
    if ((++_sp & 255u) == 0u) { if (xb_ld(&(bar)[XB_TMO])) break; if (_sp > XB_SPIN_CAP) { atomicAdd(&(bar)[XB_TMO], 1u); break; } } } } while (0)

struct XcdBarrier { unsigned* bar; unsigned x; volatile LAS unsigned* st; };

__device__ __forceinline__ XcdBarrier xcd_barrier_post(unsigned* bar, volatile LAS unsigned* st) {
    XcdBarrier b; b.bar = bar; b.x = xb_xcc_id(); b.st = st;
    if (threadIdx.x == 0) (void)xb_add(&bar[XB_XCNT(b.x)], 1u);
    return b;
}
__device__ __forceinline__ void xcd_barrier_complete(unsigned* bar, unsigned x, unsigned& nloc, unsigned& nx) {
    const unsigned G = gridDim.x * gridDim.y * gridDim.z;
    unsigned sum, cnt, mine, sp = 0u;
    for (;;) {
        sum = 0u; cnt = 0u; mine = 0u;
#pragma unroll 1
        for (unsigned j = 0; j < 16; ++j) { const unsigned c = xb_ld(&bar[XB_XCNT(j)]); sum += c; cnt += (c > 0u) ? 1u : 0u; mine = (j == x) ? c : mine; }
        if (sum == G) break;
        __builtin_amdgcn_s_sleep(1);
        if ((++sp & 255u) == 0u) { if (xb_ld(&bar[XB_TMO])) break; if (sp > XB_SPIN_CAP) { atomicAdd(&bar[XB_TMO], 1u); break; } }
    }
    nloc = mine > 0u ? mine : 1u; nx = cnt > 0u ? cnt : 1u;
}
__device__ __forceinline__ void xcd_barrier(const XcdBarrier& b) {
    asm volatile("s_waitcnt vmcnt(0)" ::: "memory");
    __syncthreads();
    if (threadIdx.x == 0) {
        unsigned* bar = b.bar;
        __builtin_amdgcn_s_waitcnt(0);
        unsigned nloc = b.st[0], nx = b.st[1];
        if (nloc == 0u) { xcd_barrier_complete(bar, b.x, nloc, nx); b.st[0] = nloc; b.st[1] = nx; }
        const unsigned old = xb_add(&bar[XB_XSUB(b.x)], 1u);
        const unsigned gen = old / nloc;
        if (old + 1u == (gen + 1u) * nloc) {
            __builtin_amdgcn_fence(__ATOMIC_RELEASE, "agent");
            asm volatile("s_waitcnt vmcnt(0)" ::: "memory");
            const unsigned og = xb_add(&bar[XB_TOP], 1u);
            const unsigned tg = og / nx;
            if (og + 1u == (tg + 1u) * nx) xb_add(&bar[XB_TOPGEN], 1u);
            else XB_SPIN(xb_ld(&bar[XB_TOPGEN]) == tg, bar);
            __builtin_amdgcn_fence(__ATOMIC_ACQUIRE, "agent");
            xb_add(&bar[XB_XGEN(b.x)], 1u);
            asm volatile("s_waitcnt vmcnt(0)" ::: "memory");
        } else {
            XB_SPIN(xb_ld(&bar[XB_XGEN(b.x)]) == gen, bar);
            __builtin_amdgcn_fence(__ATOMIC_ACQUIRE, "agent");
            asm volatile("s_waitcnt vmcnt(0)" ::: "memory");
        }
    }
    __syncthreads();
}

constexpr int D = 1024, NBATCH = 2, SEQ = 16384, CTXL = 256;
constexpr int TL = NBATCH * SEQ, TC = NBATCH * CTXL, TT = TL + TC;
constexpr int INW = 3328;
constexpr int ZQ = 0, ZFF = 512, ZFB = 1024, ZV = 1536, ZG = 2048, ZXB = 2560, ZYB = 2816, ZU = 3072;
constexpr int NEXP = 256, TOPK = 8;
constexpr float EPS = 1e-6f;
constexpr int NWAVES = 8, NTHR = 512;
constexpr int CV_TILES = 257 * 48;
constexpr int CV_OUTP = 248 * 6;
constexpr int CV_ROUT = 126 * 10;
constexpr int HG_SLOTS = 130;
constexpr int LR_SLOTS = 260;
constexpr int MAXROWS = 364800;

constexpr size_t MiB = 1u << 20;
constexpr size_t WS_CTL = 0, CTL_ZERO_BYTES = 1 * MiB;
constexpr size_t WS_MOD = 1 * MiB;
constexpr size_t WS_TAB = 2 * MiB;
constexpr size_t TAB_FC = 0, TAB_FS = 32768, TAB_CS = 65536, TAB_LB = 81920  , TAB_LRUW = 86016  , TAB_LRUCL = 348160  , TAB_C256 = 352256  , TAB_S256 = 483328  ;
constexpr size_t WS_META = 3 * MiB;
constexpr size_t WS_WIN = 4 * MiB;
constexpr size_t WS_WOUT = 18 * MiB;
constexpr size_t WS_WR = 22 * MiB;
constexpr size_t WS_XC = 24 * MiB;
constexpr size_t WS_LRUC = 26 * MiB;
constexpr size_t LRUC_STRIDE = (size_t)2 * 2 * LR_SLOTS * 256 * 4;
constexpr size_t WS_SEL = 30 * MiB;
constexpr size_t SEL_STRIDE = (size_t)TT * 8 * 4;
constexpr size_t WS_ROWTOK = 34 * MiB;
constexpr size_t WS_HD = 36 * MiB;
constexpr size_t WS_LOGIT = 38 * MiB;
constexpr size_t WS_HB = 72 * MiB;
constexpr size_t WS_WEXP = 138 * MiB;
constexpr size_t WEXP_GU_BYTES = (size_t)257 * 512 * 1024;
constexpr size_t WS_HB8 = 340 * MiB;
constexpr size_t WS_BIG = 524 * MiB;
constexpr size_t WS_Z = WS_BIG;
constexpr size_t WS_MIX = WS_BIG + 212 * MiB;
constexpr size_t WS_HS = WS_BIG + 278 * MiB;
constexpr size_t WS_FA = WS_BIG + 410 * MiB;
constexpr size_t WS_GE = WS_BIG + 442 * MiB;
constexpr size_t WS_GK = WS_BIG + 508 * MiB;
constexpr size_t WS_HV = WS_BIG + 574 * MiB;
constexpr size_t WS_HBUF = WS_BIG;
constexpr size_t WS_Y = WS_BIG + 180 * MiB;
constexpr size_t WS_WEXP1 = 1104 * MiB;
constexpr size_t WS_END = WS_WEXP1 + (size_t)257 * 768 * 1024;
static_assert(WS_Y + (size_t)MAXROWS * 1024 <= WS_WEXP1 && WS_HV + (size_t)16 * 2 * HG_SLOTS * 256 * 4 <= WS_WEXP1 && WS_GK + (size_t)2 * TT * 512 * 2 <= WS_HV && WS_GE + (size_t)2 * TT * 512 * 2 <= WS_GK && WS_FA + (size_t)2 * 2 * 128 * 128 * 256 * 2 <= WS_GE, "overlay regions end below the second weight buffer");
static_assert(WS_Z + (size_t)TT * INW * 2 <= WS_MIX && WS_MIX + (size_t)TT * 1024 * 2 <= WS_HS && WS_HS + (size_t)16 * HG_SLOTS * 65536 <= WS_FA, "mixer overlay map");
static_assert(WS_HBUF + (size_t)MAXROWS * 256 * 2 <= WS_Y && WS_WEXP + (size_t)257 * 768 * 1024 <= WS_HB8 && WS_HB8 + (size_t)TT * 1024 <= WS_BIG && WS_HB + (size_t)TT * 2048 <= WS_WEXP, "moe overlay map");
constexpr int CW_BAR = 4096;
constexpr int CW_CVQ = 8192;
constexpr int CW_CNT = 16384;

constexpr int LDS_BYTES = 151552;
constexpr int MISC_OFF = 150528;

struct Args { const float* in[28]; float* out; unsigned char* ws; int ph_lo, ph_hi; };

typedef const float* cfptr;
#define CAS __attribute__((address_space(4)))
struct Frame {
    LAS unsigned char* lds;
    int tid, lane, wave, G;
    const CAS cfptr* in;
    float* out; unsigned char* ws;
};
#define F_X(F)      ((F).in[0])
#define F_C(F)      ((F).in[1])
#define F_CTX(F)    ((F).in[2])
#define F_CCTX(F)   ((F).in[3])

__device__ __forceinline__ float wave_sum(float v) {
#pragma unroll
    for (int o = 1; o < 64; o <<= 1) v += __shfl_xor(v, o);
    return v;
}
__device__ __forceinline__ float sigmoidf_(float z) { return __builtin_amdgcn_rcpf(1.f + __expf(-z)); }

__device__ __forceinline__ void transpose_item(const float* W, int ldw, int k0, int n0, bf16* WT, int ldk, int drow0, LAS float* scr, int lane) {
#pragma unroll 8
    for (int i = 0; i < 32; ++i) { const int kk = 2 * i + (lane >> 5); scr[kk * 33 + (lane & 31)] = W[(size_t)(k0 + kk) * ldw + n0 + (lane & 31)]; }
    LDS_WAIT();
    const int c = lane & 7;
#pragma unroll
    for (int j = 0; j < 4; ++j) { const int n = (lane >> 3) + 8 * j; const LAS float* s = scr + (8 * c) * 33 + n;
        u32x4 o; o.x = pk2(s[0 * 33], s[1 * 33]); o.y = pk2(s[2 * 33], s[3 * 33]); o.z = pk2(s[4 * 33], s[5 * 33]); o.w = pk2(s[6 * 33], s[7 * 33]);
        *(u32x4*)(WT + (size_t)(drow0 + n) * ldk + k0 + 8 * c) = o; }
    LDS_WAIT();
}

__device__ __forceinline__ void norm_row_bf16(const float* xrow, const float* gain, const float* scl, const float* sft, bf16* orow, int lane, unsigned char* o8 = nullptr) {
    f32x4 v[4]; float s = 0.f;
#pragma unroll
    for (int j = 0; j < 4; ++j) { v[j] = *(const f32x4*)(xrow + 4 * lane + 256 * j); s += (v[j].x * v[j].x + v[j].y * v[j].y) + (v[j].z * v[j].z + v[j].w * v[j].w); }
    const float rstd = rsqrtf(wave_sum(s) * (1.f / D) + EPS);
#pragma unroll
    for (int j = 0; j < 4; ++j) { const int c = 4 * lane + 256 * j;
        const f32x4 g = *(const f32x4*)(gain + c), sc = *(const f32x4*)(scl + c), sh = *(const f32x4*)(sft + c);
        const f32x4 y = v[j] * rstd * g * (sc + 1.f) + sh;
        u32x2 o; o.x = pk2(y.x, y.y); o.y = pk2(y.z, y.w); *(u32x2*)(orow + c) = o;
        if (o8) { int p8 = __builtin_amdgcn_cvt_pk_fp8_f32(__builtin_amdgcn_fmed3f(y.x, -448.f, 448.f), __builtin_amdgcn_fmed3f(y.y, -448.f, 448.f), 0, false);
            p8 = __builtin_amdgcn_cvt_pk_fp8_f32(__builtin_amdgcn_fmed3f(y.z, -448.f, 448.f), __builtin_amdgcn_fmed3f(y.w, -448.f, 448.f), p8, true); *(int*)(o8 + c) = p8; } }
}

__device__ __forceinline__ void convert_tile(Frame& F, const float* src, int ldw, bf16* dst, int ldk, int k0, int rowA, int rowB) {
    LAS bf16* T = (LAS bf16*)F.lds;
    const int tid = F.tid, w = F.wave, lane = F.lane;
    f32x4 v[8];
#pragma unroll
    for (int j = 0; j < 8; ++j) v[j] = *(const f32x4*)(src + (size_t)(8 * w + j) * ldw + 4 * lane);
#pragma unroll
    for (int j = 0; j < 8; ++j) { u32x2 o; o.x = pk2(v[j].x, v[j].y); o.y = pk2(v[j].z, v[j].w); *(LAS u32x2*)(T + (8 * w + j) * 264 + ((4 * lane) ^ (w << 3))) = o; }
    __syncthreads();
#pragma unroll
    for (int j = 0; j < 4; ++j) { const int p = tid + NTHR * j, kc = p & 7, n = p >> 3; const LAS bf16* t = T + (8 * kc) * 264 + (n ^ (kc << 3));
        u32x4 o; o.x = (unsigned)t[0] | ((unsigned)t[264] << 16); o.y = (unsigned)t[2 * 264] | ((unsigned)t[3 * 264] << 16);
        o.z = (unsigned)t[4 * 264] | ((unsigned)t[5 * 264] << 16); o.w = (unsigned)t[6 * 264] | ((unsigned)t[7 * 264] << 16);
        const int row = n < 128 ? rowA + n : rowB + n - 128;
        *(u32x4*)(dst + (size_t)row * ldk + k0 + 8 * kc) = o; }
    __syncthreads();
}

__device__ __forceinline__ void convert_tile8(Frame& F, const float* src, int ldw, unsigned char* dst8, int ldk, int k0, int rowA, int rowB, float scl) {
    LAS bf16* T = (LAS bf16*)F.lds;
    const int tid = F.tid, w = F.wave, lane = F.lane;
    f32x4 v[8];
#pragma unroll
    for (int j = 0; j < 8; ++j) v[j] = *(const f32x4*)(src + (size_t)(8 * w + j) * ldw + 4 * lane);
#pragma unroll
    for (int j = 0; j < 8; ++j) { const f32x4 q = v[j] * scl; u32x2 o; o.x = pk2(q.x, q.y); o.y = pk2(q.z, q.w); *(LAS u32x2*)(T + (8 * w + j) * 264 + ((4 * lane) ^ (w << 3))) = o; }
    __syncthreads();
#pragma unroll
    for (int j = 0; j < 4; ++j) { const int p = tid + NTHR * j, kc = p & 7, n = p >> 3; const LAS bf16* t = T + (8 * kc) * 264 + (n ^ (kc << 3));
        float f[8];
#pragma unroll
        for (int i = 0; i < 8; ++i) f[i] = __builtin_bit_cast(float, (unsigned)t[i * 264] << 16);
        int lo = __builtin_amdgcn_cvt_pk_fp8_f32(f[0], f[1], 0, false); lo = __builtin_amdgcn_cvt_pk_fp8_f32(f[2], f[3], lo, true);
        int hi = __builtin_amdgcn_cvt_pk_fp8_f32(f[4], f[5], 0, false); hi = __builtin_amdgcn_cvt_pk_fp8_f32(f[6], f[7], hi, true);
        const int row = n < 128 ? rowA + n : rowB + n - 128;
        u32x2 o; o.x = (unsigned)lo; o.y = (unsigned)hi;
        *(u32x2*)(dst8 + (size_t)row * ldk + k0 + 8 * kc) = o; }
    __syncthreads();
}

__device__ __forceinline__ void phase_g0(Frame& F) {
    float* mod = (float*)(F.ws + WS_MOD);
    {
        LAS float* sc = (LAS float*)F.lds; LAS float* red = sc + 3072;
        for (int u = blockIdx.x; u < 192; u += F.G) {
            const int l = u / 96, n0 = (u % 96) * 64;
            for (int i = F.tid; i < 3072; i += NTHR) { const int r = i >> 10, k = i & 1023; const float c = r < 2 ? F_C(F)[r * 1024 + k] : F_CCTX(F)[k]; sc[i] = c / (1.f + __expf(-c)); }
            __syncthreads();
            const int col = F.tid & 63, kg = F.tid >> 6;
            const float* W = F.in[4] + (size_t)l * 1024 * 6144 + n0 + col;
            float a0 = 0.f, a1 = 0.f, a2 = 0.f;
#pragma unroll 8
            for (int k = kg * 128; k < kg * 128 + 128; ++k) { const float w = W[(size_t)k * 6144]; a0 += sc[k] * w; a1 += sc[1024 + k] * w; a2 += sc[2048 + k] * w; }
            red[(kg * 3 + 0) * 64 + col] = a0; red[(kg * 3 + 1) * 64 + col] = a1; red[(kg * 3 + 2) * 64 + col] = a2;
            __syncthreads();
            if (F.tid < 192) { const int r = F.tid >> 6, cc = F.tid & 63; float s = F.in[5][l * 6144 + n0 + cc];
#pragma unroll
                for (int q = 0; q < 8; ++q) s += red[(q * 3 + r) * 64 + cc];
                mod[(l * 3 + r) * 6144 + n0 + cc] = s; }
            __syncthreads();
        }
    }
    {
        constexpr int PER_L = 16 * (13 + 4 + 1);
        for (int it = blockIdx.x; it < 2 * PER_L; it += F.G) {
            const int l = it / PER_L; int r = it % PER_L; const int kb = r / 18; r %= 18;
            if (r < 13) convert_tile(F, F.in[8] + (size_t)l * 1024 * INW + (size_t)(64 * kb) * INW + 256 * r, INW, (bf16*)(F.ws + WS_WIN) + (size_t)l * INW * 1024, 1024, 64 * kb, 256 * r, 256 * r + 128);
            else if (r < 17) convert_tile(F, F.in[18] + (size_t)l * 1024 * 1024 + (size_t)(64 * kb) * 1024 + 256 * (r - 13), 1024, (bf16*)(F.ws + WS_WOUT) + (size_t)l * 1024 * 1024, 1024, 64 * kb, 256 * (r - 13), 256 * (r - 13) + 128);
            else convert_tile(F, F.in[19] + (size_t)l * 1024 * 256 + (size_t)(64 * kb) * 256, 256, (bf16*)(F.ws + WS_WR) + (size_t)l * 256 * 1024, 1024, 64 * kb, 0, 128);
        }
    }
    {
        const int gt = blockIdx.x * NTHR + F.tid, NGT = F.G * NTHR;
        bf16* Fc = (bf16*)(F.ws + WS_TAB + TAB_FC); bf16* Fs = (bf16*)(F.ws + WS_TAB + TAB_FS); bf16* CS = (bf16*)(F.ws + WS_TAB + TAB_CS);
        for (int i = gt; i < 128 * 128; i += NGT) { const int k = i >> 7, n = i & 127; float s, c; sincospif((float)((k * n) & 127) * (1.f / 64.f), &s, &c); Fc[i] = f2bf(c); Fs[i] = f2bf(s); }
        for (int i = gt; i < 64 * 128; i += NGT) { const int m = i >> 7, kap = i & 127; float s, c; sincospif((float)((m * (kap & 63)) & 63) * (1.f / 32.f), &s, &c); CS[i] = f2bf(kap < 64 ? c : s); }
        bf16* C256 = (bf16*)(F.ws + WS_TAB + TAB_C256); bf16* S256 = (bf16*)(F.ws + WS_TAB + TAB_S256);
        for (int i = gt; i < 256 * 256; i += NGT) { const int k = i >> 8, n = i & 255; float sn, cs; sincospif((float)((k * n) & 255) * (1.f / 128.f), &sn, &cs); C256[i] = f2bf(cs); S256[i] = f2bf(-sn); }
        float* lb = (float*)(F.ws + WS_TAB + TAB_LB);
        for (int i = gt; i < 1024; i += NGT) { const int l = i >> 9, ch = i & 511; lb[i] = l == 0 ? 0.f : sigmoidf_(F.in[9][512 + ch] - F.in[9][ch]); }
        bf16* lw = (bf16*)(F.ws + WS_TAB + TAB_LRUW);
        for (int i = gt; i < 2 * 2 * 4 * 128 * 64; i += NGT) {
            const int k = i & 63, n = (i >> 6) & 127, ldh = i >> 13;
            const float v = n < 64 ? F.in[13][(size_t)ldh * 4096 + k * 64 + n] : F.in[15][(size_t)ldh * 4096 + k * 64 + (n - 64)];
            lw[i] = f2bf(v); }
        float* cl = (float*)(F.ws + WS_TAB + TAB_LRUCL);
        for (int i = gt; i < 1024; i += NGT) { const float lam = F.in[17][i]; const float sp = lam > 15.f ? __expf(-lam) : log1pf(__expf(-lam)); cl[i] = 8.f * sp; }
    }
}

__device__ __forceinline__ void hprep_rows(Frame& F, int l, const float* xlat, const float* xctx, int nrows, int voff_sh, int voff_sc, const float* gain, bool with8 = false) {
    const float* mod = (const float*)(F.ws + WS_MOD) + (size_t)l * 3 * 6144;
    bf16* HB = (bf16*)(F.ws + WS_HB);
    const int gw = blockIdx.x * NWAVES + F.wave, NGW = F.G * NWAVES;
    for (int m = gw; m < nrows; m += NGW) {
        const float* xr = m < TL ? xlat + (size_t)m * D : xctx + (size_t)(m - TL) * D; const int r = m < TL ? (m >> 14) : 2;
        norm_row_bf16(xr, gain, mod + r * 6144 + voff_sc, mod + r * 6144 + voff_sh, HB + (size_t)m * D, F.lane, with8 ? F.ws + WS_HB8 + (size_t)m * D : nullptr);
    }
}

__device__ __forceinline__ void cv_tile(Frame& F, int it_all) {
    const int l = it_all >= CV_TILES ? 1 : 0, it = it_all - l * CV_TILES;
    unsigned char* wb = F.ws + (l ? WS_WEXP1 : WS_WEXP);
    unsigned char* WGU = wb; unsigned char* WD = wb + WEXP_GU_BYTES;
    const int e = it / 48, t = it % 48;
    if (t < 32) {
        const int mat = t >> 4, kb = t & 15;
        const float* src = (e < 256 ? (mat == 0 ? F.in[21] : F.in[22]) + ((size_t)l * 256 + e) * 1024 * 256 : (mat == 0 ? F.in[24] : F.in[25]) + (size_t)l * 1024 * 256) + (size_t)(64 * kb) * 256;
        convert_tile8(F, src, 256, WGU, 1024, 64 * kb, e * 512 + mat * 128, e * 512 + 256 + mat * 128, 32.f);
    } else {
        const int kb = (t - 32) >> 2, nb = (t - 32) & 3;
        const float* src = (e < 256 ? F.in[23] + ((size_t)l * 256 + e) * 256 * 1024 : F.in[26] + (size_t)l * 256 * 1024) + (size_t)(64 * kb) * 1024 + 256 * nb;
        convert_tile8(F, src, 1024, WD, 256, 64 * kb, e * 1024 + 256 * nb, e * 1024 + 256 * nb + 128, 16.f);
    }
}
__device__ __forceinline__ int cv_pull(Frame& F) {
    volatile LAS int* slot = (volatile LAS int*)(F.lds + MISC_OFF) + 16;
    if (F.tid == 0) { const unsigned t = __hip_atomic_fetch_add((unsigned*)(F.ws + WS_CTL) + CW_CVQ, 1u, __ATOMIC_RELAXED, __HIP_MEMORY_SCOPE_AGENT); slot[0] = t < (unsigned)(2 * CV_TILES) ? (int)t : -1; }
    __syncthreads(); const int t = slot[0]; __syncthreads(); return t;
}
__device__ __forceinline__ void convert_experts(Frame& F, int l) {
    for (;;) { const int t = cv_pull(F); if (t < 0) break; cv_tile(F, t); if (t >= (l + 1) * CV_TILES) break; }
}

__device__ __forceinline__ void xcd_barrier_cv(const XcdBarrier& b, Frame& F) {
    volatile LAS unsigned* st = (volatile LAS unsigned*)(F.lds + MISC_OFF) + 20;
    asm volatile("s_waitcnt vmcnt(0)" ::: "memory");
    __syncthreads();
    if (threadIdx.x == 0) {
        unsigned* bar = b.bar;
        __builtin_amdgcn_s_waitcnt(0);
        unsigned nloc = b.st[0], nx = b.st[1];
        if (nloc == 0u) { xcd_barrier_complete(bar, b.x, nloc, nx); b.st[0] = nloc; b.st[1] = nx; }
        const unsigned old = xb_add(&bar[XB_XSUB(b.x)], 1u);
        const unsigned gen = old / nloc;
        if (old + 1u == (gen + 1u) * nloc) {
            __builtin_amdgcn_fence(__ATOMIC_RELEASE, "agent");
            asm volatile("s_waitcnt vmcnt(0)" ::: "memory");
            const unsigned og = xb_add(&bar[XB_TOP], 1u);
            const unsigned tg = og / nx;
            if (og + 1u == (tg + 1u) * nx) xb_add(&bar[XB_TOPGEN], 1u);
            else XB_SPIN(xb_ld(&bar[XB_TOPGEN]) == tg, bar);
            __builtin_amdgcn_fence(__ATOMIC_ACQUIRE, "agent");
            xb_add(&bar[XB_XGEN(b.x)], 1u);
            asm volatile("s_waitcnt vmcnt(0)" ::: "memory");
            st[0] = 0u;
        } else { st[0] = 1u; st[1] = gen; }
        st[2] = 0u;
    }
    __syncthreads();
    if (st[0]) {
        unsigned spins = 0u;
        for (;;) {
            int tile = -1;
            if (threadIdx.x == 0) {
                unsigned rel = xb_ld(&b.bar[XB_XGEN(b.x)]) != st[1] ? 1u : 0u;
                if (!rel && (++spins & 255u) == 0u) { if (xb_ld(&b.bar[XB_TMO])) rel = 1u; else if (spins > XB_SPIN_CAP) { atomicAdd(&b.bar[XB_TMO], 1u); rel = 1u; } }
                st[2] = rel;
                if (!rel && st[3] == 0u) { const unsigned t = __hip_atomic_fetch_add((unsigned*)(F.ws + WS_CTL) + CW_CVQ, 1u, __ATOMIC_RELAXED, __HIP_MEMORY_SCOPE_AGENT);
                    if (t < (unsigned)(2 * CV_TILES)) tile = (int)t; else st[3] = 1u; }
                st[4] = (unsigned)tile;
            }
            __syncthreads();
            const unsigned rel = st[2]; tile = (int)st[4];
            __syncthreads();
            if (rel) break;
            if (tile >= 0) cv_tile(F, tile); else __builtin_amdgcn_s_sleep(2);
        }
        if (threadIdx.x == 0) {
            st[3] = 0u;
            __builtin_amdgcn_fence(__ATOMIC_ACQUIRE, "agent");
            asm volatile("s_waitcnt vmcnt(0)" ::: "memory");
        }
    }
    __syncthreads();
}

constexpr int QS = 144, TS = 80;
constexpr int HG_QT = 0, HG_KT = 18432, HG_KTT = 36864, HG_VT = 57344, HG_SMT = 77824, HG_PM = 114688, HG_TOT = 124928, HG_BMID = 126976, HG_BEND = 127488, HG_RSS = 128000, HG_VR = 132096;
static_assert(HG_VR + 64 * QS * 2 <= MISC_OFF, "HGRN2 LDS map");

__device__ __forceinline__ float fast_rcp(float x) { return __builtin_amdgcn_rcpf(x); }
__device__ __forceinline__ f32x4 hg_ld4(const bf16* p) { const u32x2 v = *(const u32x2*)p;
    return (f32x4){__builtin_bit_cast(float, v.x << 16), __builtin_bit_cast(float, v.x & 0xffff0000u), __builtin_bit_cast(float, v.y << 16), __builtin_bit_cast(float, v.y & 0xffff0000u)}; }


template <int VAR>
__device__ __forceinline__ void hg_chunk_c1(Frame& F, const bf16* Zc, bf16* gq, bf16* gk, float* hv, const bf16* nz, const bf16* nq, const bool has_next, u32x4 (&zq)[4], int h, int rev, const float* lbp, f32x4 (&S)[8], float& dtot) {
    LAS bf16* Qt = (LAS bf16*)(F.lds + HG_QT); LAS bf16* Kt = (LAS bf16*)(F.lds + HG_KT); LAS bf16* KtT = (LAS bf16*)(F.lds + HG_KTT);
    LAS bf16* VT = (LAS bf16*)(F.lds + HG_VT); LAS bf16* Vr = (LAS bf16*)(F.lds + HG_VR);
    LAS float* tot = (LAS float*)(F.lds + HG_TOT); LAS float* bmid = (LAS float*)(F.lds + HG_BMID); LAS float* bend = (LAS float*)(F.lds + HG_BEND);
    LAS float* ebuf = (LAS float*)(F.lds + HG_RSS);
    const int tid = F.tid, lane = F.lane, w = F.wave, li = lane & 15, lq = lane >> 4;
    u32x4 vv[2];
#pragma unroll
    for (int j = 0; j < 2; ++j) { const int p = tid + NTHR * j, row = p >> 4, c16 = p & 15;
        vv[j] = *(const u32x4*)(Zc + (size_t)row * INW + ZV + h * 128 + 8 * c16);
        *(LAS u32x4*)(Kt + row * QS + 8 * c16) = zq[j]; *(LAS u32x4*)(Qt + row * QS + 8 * c16) = zq[2 + j]; }
    LDS_BARRIER();
    const int ch = tid & 127, tq = tid >> 7;
    const float lbv = lbp[h * 128 + ch], oml = 1.f - lbv;
    float cb[16];
#pragma unroll
    for (int i = 0; i < 16; ++i) { float z = bf2f(Kt[(16 * tq + i) * QS + ch]); z = fminf(fmaxf(z, -30.f), 30.f);
        if (VAR & 1) cb[i] = z * -0.01f; else { const float e = __expf(-z), sg = fast_rcp(1.f + e); cb[i] = __logf(lbv + oml * sg);
            Kt[(16 * tq + i) * QS + ch] = f2bf(oml * e * sg); } }
    if (tq == 2) bmid[ch] = cb[0];
    float run = 0.f;
    if (!rev) {
#pragma unroll
        for (int i = 0; i < 16; ++i) { run += cb[i]; cb[i] = run; }
    } else {
#pragma unroll
        for (int i = 15; i >= 0; --i) { run += cb[i]; cb[i] = run; }
    }
    tot[tq * 128 + ch] = run;
#pragma unroll
    for (int j = 0; j < 2; ++j) { const int p = tid + NTHR * j, row = p >> 4, c16 = p & 15; *(LAS u32x4*)(Vr + row * QS + 8 * c16) = vv[j]; }
    LDS_BARRIER();
    float bm, total;
    {
        const float t0 = tot[ch], t1 = tot[128 + ch], t2 = tot[256 + ch], t3 = tot[384 + ch];
        const float off = !rev ? ((tq > 0 ? t0 : 0.f) + (tq > 1 ? t1 : 0.f) + (tq > 2 ? t2 : 0.f)) : ((tq < 3 ? t3 : 0.f) + (tq < 2 ? t2 : 0.f) + (tq < 1 ? t1 : 0.f));
#pragma unroll
        for (int i = 0; i < 16; ++i) cb[i] += off;
        total = (t0 + t1) + (t2 + t3);
        bm = !rev ? (t0 + t1) + bmid[ch] : (t2 + t3);
        if (tq == 0) dtot += total;
    }
    if (!(VAR & 2)) {
        unsigned kp[8], vp[8];
#pragma unroll
        for (int i = 0; i < 16; ++i) { const float d = fminf(fmaxf(cb[i] - bm, -80.f), 80.f);
            const float ed = __expf(d);
            Qt[(16 * tq + i) * QS + ch] = f2bf(bf2f(Qt[(16 * tq + i) * QS + ch]) * ed);
            const unsigned kb = f2bfu(bf2f(Kt[(16 * tq + i) * QS + ch]) * fast_rcp(ed)); Kt[(16 * tq + i) * QS + ch] = (bf16)kb;
            const unsigned vb = Vr[(16 * tq + i) * QS + ch];
            if (i & 1) { kp[i >> 1] |= kb << 16; vp[i >> 1] |= vb << 16; } else { kp[i >> 1] = kb; vp[i >> 1] = vb; } }
        *(LAS u32x4*)(KtT + ch * TS + 16 * tq) = (u32x4){kp[0], kp[1], kp[2], kp[3]};
        *(LAS u32x4*)(KtT + ch * TS + 16 * tq + 8) = (u32x4){kp[4], kp[5], kp[6], kp[7]};
        *(LAS u32x4*)(VT + ch * TS + 16 * tq) = (u32x4){vp[0], vp[1], vp[2], vp[3]};
        *(LAS u32x4*)(VT + ch * TS + 16 * tq + 8) = (u32x4){vp[4], vp[5], vp[6], vp[7]};
        if (tid < 128) { const float e1 = __expf(bm), e2 = __expf(total - bm); hv[tid] = e1; hv[128 + tid] = e2; ebuf[tid] = e1; ebuf[128 + tid] = e2; }
    }
    if (has_next) {
#pragma unroll
        for (int j = 0; j < 2; ++j) { const int p = tid + NTHR * j, row = p >> 4, c16 = p & 15;
            zq[j] = *(const u32x4*)(nz + (size_t)row * INW + 8 * c16); zq[2 + j] = *(const u32x4*)(nq + (size_t)row * INW + 8 * c16); }
    }
    LDS_BARRIER();
    if (!(VAR & 4))
#pragma unroll
    for (int j = 0; j < 2; ++j) { const int p = tid + NTHR * j, row = p >> 4, c16 = p & 15;
        *(u32x4*)(gq + (size_t)row * 512 + 8 * c16) = *(const LAS u32x4*)(Qt + row * QS + 8 * c16);
        *(u32x4*)(gk + (size_t)row * 512 + 8 * c16) = *(const LAS u32x4*)(Kt + row * QS + 8 * c16); }
    if (!(VAR & 8)) {
#pragma unroll
    for (int i = 0; i < 8; ++i) S[i] = S[i] * *(const LAS f32x4*)(ebuf + 16 * i + 4 * lq);
    bf16x8 bv[2];
#pragma unroll
    for (int ks = 0; ks < 2; ++ks) bv[ks] = *(const LAS bf16x8*)(VT + (16 * w + li) * TS + 32 * ks + 8 * lq);
    bf16x8 ak[2][2];
#pragma unroll
    for (int ks = 0; ks < 2; ++ks) ak[0][ks] = *(const LAS bf16x8*)(KtT + li * TS + 32 * ks + 8 * lq);
#pragma unroll
    for (int i = 0; i < 8; ++i) { const int cb_ = i & 1;
        if (i < 7) {
#pragma unroll
            for (int ks = 0; ks < 2; ++ks) ak[cb_ ^ 1][ks] = *(const LAS bf16x8*)(KtT + (16 * (i + 1) + li) * TS + 32 * ks + 8 * lq); }
        __builtin_amdgcn_sched_barrier(0);
#pragma unroll
        for (int ks = 0; ks < 2; ++ks) S[i] = MFMA16(ak[cb_][ks], bv[ks], S[i]);
        S[i] = S[i] * *(const LAS f32x4*)(ebuf + 128 + 16 * i + 4 * lq); }
    }
    LDS_BARRIER();
}

struct HgPtrs { const bf16* q; const bf16* k; const bf16* v; const float* hv; };
__device__ __forceinline__ void hg_load6(const HgPtrs& P, int tid, u32x4 (&pre)[7]) {
    pre[6] = *(const u32x4*)(P.hv + 4 * (tid & 63));
#pragma unroll
    for (int j = 0; j < 2; ++j) { const int p = tid + NTHR * j, row = p >> 4, c16 = p & 15;
        pre[j] = *(const u32x4*)(P.q + (size_t)row * 512 + 8 * c16); pre[2 + j] = *(const u32x4*)(P.k + (size_t)row * 512 + 8 * c16); pre[4 + j] = *(const u32x4*)(P.v + (size_t)row * INW + 8 * c16); }
}
template <int VAR>
__device__ __forceinline__ void hg_chunk_c3(Frame& F, const u32x4 (&cur)[7], int rev, f32x4 (&S)[8], f32x4 (&O)[4], bool do_state, const bf16* Snext) {
    LAS bf16* Qt = (LAS bf16*)(F.lds + HG_QT); LAS bf16* Kt = (LAS bf16*)(F.lds + HG_KT); LAS bf16* KtT = (LAS bf16*)(F.lds + HG_KTT);
    LAS bf16* VT = (LAS bf16*)(F.lds + HG_VT); LAS bf16* SmT = (LAS bf16*)(F.lds + HG_SMT); LAS bf16* Pm = (LAS bf16*)(F.lds + HG_PM); LAS bf16* Vr = (LAS bf16*)(F.lds + HG_VR);
    const int tid = F.tid, lane = F.lane, w = F.wave, li = lane & 15, lq = lane >> 4;
#pragma unroll
    for (int j = 0; j < 2; ++j) { const int p = tid + NTHR * j, row = p >> 4, c16 = p & 15;
        *(LAS u32x4*)(Qt + row * QS + 8 * c16) = cur[j]; *(LAS u32x4*)(Kt + row * QS + 8 * c16) = cur[2 + j]; *(LAS u32x4*)(Vr + row * QS + 8 * c16) = cur[4 + j]; }
    LAS float* ebuf = (LAS float*)(F.lds + HG_BMID);
    if (tid < 64) *(LAS u32x4*)(ebuf + 4 * tid) = cur[6];
    LDS_BARRIER();
    if (!(VAR & 2)) {
        const int ch = tid & 127, tq = tid >> 7; unsigned kp[8], vp[8];
#pragma unroll
        for (int i = 0; i < 16; ++i) { const unsigned vb = Vr[(16 * tq + i) * QS + ch], kb = do_state ? (unsigned)Kt[(16 * tq + i) * QS + ch] : 0u;
            if (i & 1) { kp[i >> 1] |= kb << 16; vp[i >> 1] |= vb << 16; } else { kp[i >> 1] = kb; vp[i >> 1] = vb; } }
        *(LAS u32x4*)(VT + ch * TS + 16 * tq) = (u32x4){vp[0], vp[1], vp[2], vp[3]};
        *(LAS u32x4*)(VT + ch * TS + 16 * tq + 8) = (u32x4){vp[4], vp[5], vp[6], vp[7]};
        if (do_state) { *(LAS u32x4*)(KtT + ch * TS + 16 * tq) = (u32x4){kp[0], kp[1], kp[2], kp[3]}; *(LAS u32x4*)(KtT + ch * TS + 16 * tq + 8) = (u32x4){kp[4], kp[5], kp[6], kp[7]}; }
    }
#pragma unroll
    for (int i = 0; i < 8; ++i) { S[i] = S[i] * *(const LAS f32x4*)(ebuf + 16 * i + 4 * lq);
        u32x2 o; o.x = pk2(S[i].x, S[i].y); o.y = pk2(S[i].z, S[i].w); *(LAS u32x2*)(SmT + (16 * w + li) * QS + 16 * i + 4 * lq) = o; }
    if (Snext) {
#pragma unroll
        for (int i = 0; i < 8; ++i) S[i] = hg_ld4(Snext + (16 * w + li) * 128 + 16 * i + 4 * lq);
    }
    if (!(VAR & 4)) {
        const int tt = w >> 1;
        bf16x8 aq[4];
#pragma unroll
        for (int ks = 0; ks < 4; ++ks) aq[ks] = *(const LAS bf16x8*)(Qt + (16 * tt + li) * QS + 32 * ks + 8 * lq);
#pragma unroll
        for (int sj = 0; sj < 2; ++sj) { const int st = 2 * (w & 1) + sj; f32x4 acc = {0.f, 0.f, 0.f, 0.f};
#pragma unroll
            for (int ks = 0; ks < 4; ++ks) acc = MFMA16(aq[ks], *(const LAS bf16x8*)(Kt + (16 * st + li) * QS + 32 * ks + 8 * lq), acc);
#pragma unroll
            for (int r = 0; r < 4; ++r) { const int t = 16 * tt + 4 * lq + r, s = 16 * st + li; const bool keep = rev ? (s >= t) : (s <= t);
                Pm[t * TS + s] = f2bf(keep ? acc[r] : 0.f); } }
    }
    LDS_BARRIER();
    if (!(VAR & 8)) {
    bf16x8 bs[4], bv[2];
#pragma unroll
    for (int ks = 0; ks < 4; ++ks) bs[ks] = *(const LAS bf16x8*)(SmT + (16 * w + li) * QS + 32 * ks + 8 * lq);
#pragma unroll
    for (int ks = 0; ks < 2; ++ks) bv[ks] = *(const LAS bf16x8*)(VT + (16 * w + li) * TS + 32 * ks + 8 * lq);
    {
        bf16x8 aq[2][4], ap[2][2];
#pragma unroll
        for (int ks = 0; ks < 4; ++ks) aq[0][ks] = *(const LAS bf16x8*)(Qt + li * QS + 32 * ks + 8 * lq);
#pragma unroll
        for (int ks = 0; ks < 2; ++ks) ap[0][ks] = *(const LAS bf16x8*)(Pm + li * TS + 32 * ks + 8 * lq);
#pragma unroll
        for (int mt = 0; mt < 4; ++mt) { const int cb_ = mt & 1;
            if (mt < 3) {
#pragma unroll
                for (int ks = 0; ks < 4; ++ks) aq[cb_ ^ 1][ks] = *(const LAS bf16x8*)(Qt + (16 * (mt + 1) + li) * QS + 32 * ks + 8 * lq);
#pragma unroll
                for (int ks = 0; ks < 2; ++ks) ap[cb_ ^ 1][ks] = *(const LAS bf16x8*)(Pm + (16 * (mt + 1) + li) * TS + 32 * ks + 8 * lq); }
            __builtin_amdgcn_sched_barrier(0);
#pragma unroll
            for (int ks = 0; ks < 4; ++ks) O[mt] = MFMA16(aq[cb_][ks], bs[ks], O[mt]);
#pragma unroll
            for (int ks = 0; ks < 2; ++ks) O[mt] = MFMA16(ap[cb_][ks], bv[ks], O[mt]);
        }
    }
    __builtin_amdgcn_sched_barrier(0);
    if (do_state) {
        bf16x8 ak[2][2];
#pragma unroll
        for (int ks = 0; ks < 2; ++ks) ak[0][ks] = *(const LAS bf16x8*)(KtT + li * TS + 32 * ks + 8 * lq);
#pragma unroll
        for (int i = 0; i < 8; ++i) { const int cb_ = i & 1;
            if (i < 7) {
#pragma unroll
                for (int ks = 0; ks < 2; ++ks) ak[cb_ ^ 1][ks] = *(const LAS bf16x8*)(KtT + (16 * (i + 1) + li) * TS + 32 * ks + 8 * lq); }
            __builtin_amdgcn_sched_barrier(0);
#pragma unroll
            for (int ks = 0; ks < 2; ++ks) S[i] = MFMA16(ak[cb_][ks], bv[ks], S[i]);
            S[i] = S[i] * *(const LAS f32x4*)(ebuf + 128 + 16 * i + 4 * lq); }
    }
    }
    LDS_BARRIER();
}

__device__ __forceinline__ int hg_rowbase(int b, int slot) { return slot < 2 ? TL + b * CTXL + slot * 128 : b * SEQ + (slot - 2) * 128; }

template <int VAR>
__device__ __forceinline__ void hgrn2_c1(Frame& F, int l, int u0, int nunits, int G) {
    const bf16* Z = (const bf16*)(F.ws + WS_Z); const float* lbp = (const float*)(F.ws + WS_TAB + TAB_LB) + l * 512;
    bf16* GQ = (bf16*)(F.ws + WS_GE); bf16* GK = (bf16*)(F.ws + WS_GK); float* HV = (float*)(F.ws + WS_HV);
    if (u0 >= nunits) return;
    u32x4 zq[4];
    {   const int chain = u0 / HG_SLOTS, slot = u0 % HG_SLOTS, dir = chain & 1, b = chain >> 3, h = (chain >> 1) & 3;
        const bf16* zp = Z + (size_t)(hg_rowbase(b, slot) + (dir ? 64 : 0)) * INW;
#pragma unroll
        for (int j = 0; j < 2; ++j) { const int p = F.tid + NTHR * j, row = p >> 4, c16 = p & 15;
            zq[j] = *(const u32x4*)(zp + (size_t)row * INW + (dir ? ZFB : ZFF) + h * 128 + 8 * c16); zq[2 + j] = *(const u32x4*)(zp + (size_t)row * INW + ZQ + h * 128 + 8 * c16); } }
#pragma unroll 1
    for (int u = u0; u < nunits; u += G) {
        const int chain = u / HG_SLOTS, slot = u % HG_SLOTS, dir = chain & 1, b = chain >> 3, h = (chain >> 1) & 3;
        const int row0 = hg_rowbase(b, slot), zcol = (dir ? ZFB : ZFF) + h * 128;
        const int un = u + G; const bool has_nu = un < nunits;
        const int nchain = un / HG_SLOTS, nslot = un % HG_SLOTS, ndir = nchain & 1, nb = nchain >> 3, nh = (nchain >> 1) & 3;
        const bf16* nup = Z + (size_t)(hg_rowbase(nb, nslot) + (ndir ? 64 : 0)) * INW;
        f32x4 S[8]; float dtot = 0.f;
#pragma unroll
        for (int i = 0; i < 8; ++i) S[i] = (f32x4){0.f, 0.f, 0.f, 0.f};
#pragma unroll 1
        for (int step = 0; step < 2; ++step) { const int c = dir ? 1 - step : step; const size_t rowc = (size_t)(row0 + 64 * c);
            const bf16* nrow = step == 0 ? Z + (size_t)(row0 + 64 * (1 - c)) * INW : nup;
            const bf16* nz = nrow + (step == 0 ? zcol : (ndir ? ZFB : ZFF) + nh * 128); const bf16* nq = nrow + ZQ + (step == 0 ? h : nh) * 128;
            hg_chunk_c1<VAR>(F, Z + rowc * INW, GQ + ((size_t)dir * TT + rowc) * 512 + h * 128, GK + ((size_t)dir * TT + rowc) * 512 + h * 128,
                        HV + ((size_t)chain * (2 * HG_SLOTS) + slot * 2 + c) * 256, nz, nq, step == 0 || has_nu, zq, h, dir, lbp, S, dtot); }
        bf16* HS = (bf16*)(F.ws + WS_HS) + ((size_t)chain * HG_SLOTS + slot) * 16384;
        const int li = F.lane & 15, lq = F.lane >> 4, v = 16 * F.wave + li;
#pragma unroll
        for (int i = 0; i < 8; ++i) { u32x2 o; o.x = pk2(S[i].x, S[i].y); o.y = pk2(S[i].z, S[i].w); *(u32x2*)(HS + v * 128 + 16 * i + 4 * lq) = o; }
        if (F.tid < 128) ((float*)(F.ws + WS_HD))[((size_t)chain * HG_SLOTS + slot) * 128 + F.tid] = __expf(dtot);
    }
}

__device__ __forceinline__ void hgrn2_c2(Frame& F) {
    bf16* HS = (bf16*)(F.ws + WS_HS); const float* HD = (const float*)(F.ws + WS_HD);
    constexpr int CB = 13;
    static_assert(HG_SLOTS % (2 * CB) == 0, "batching");
    for (int task = blockIdx.x * NTHR + F.tid; task < 16 * 8192; task += F.G * NTHR) {
        const int chain = task >> 13, e2 = task & 8191, dir = chain & 1, ch2 = (e2 & 63) * 2;
        unsigned* hs = (unsigned*)(HS + (size_t)chain * HG_SLOTS * 16384 + e2 * 2); const float* hd = HD + (size_t)chain * HG_SLOTS * 128 + ch2;
        f32x2 run = {0.f, 0.f};
        unsigned tA[CB], tB[CB]; f32x2 dA[CB], dB[CB];
#define C2_SLOT(k) (dir ? ((k) < 2 ? 1 - (k) : 131 - (k)) : (k))
#define C2_LOAD(t_, d_, k0) _Pragma("unroll") for (int j = 0; j < CB; ++j) { const int slot = C2_SLOT((k0) + j); t_[j] = hs[(size_t)slot * 8192]; d_[j] = *(const f32x2*)(hd + (size_t)slot * 128); }
#define C2_SCAN(t_, d_, k0) _Pragma("unroll") for (int j = 0; j < CB; ++j) { const int slot = C2_SLOT((k0) + j); const f32x2 tmp = {__builtin_bit_cast(float, t_[j] << 16), __builtin_bit_cast(float, t_[j] & 0xffff0000u)}; \
            hs[(size_t)slot * 8192] = pk2(run.x, run.y); run = d_[j] * run + tmp; }
        C2_LOAD(tA, dA, 0)
#pragma unroll 1
        for (int k0 = 0; k0 < HG_SLOTS; k0 += 2 * CB) {
            C2_LOAD(tB, dB, k0 + CB)
            C2_SCAN(tA, dA, k0)
            if (k0 + 2 * CB < HG_SLOTS) { C2_LOAD(tA, dA, k0 + 2 * CB) }
            C2_SCAN(tB, dB, k0 + CB)
        }
#undef C2_SLOT
#undef C2_LOAD
#undef C2_SCAN
    }
}

template <int VAR>
__device__ __forceinline__ void hgrn2_c3(Frame& F, int l, int bh, int slot) {
    const int b = bh >> 2, h = bh & 3;
    const bf16* Z = (const bf16*)(F.ws + WS_Z);
    const bf16* GQ = (const bf16*)(F.ws + WS_GE); const bf16* GK = (const bf16*)(F.ws + WS_GK); const float* HV = (const float*)(F.ws + WS_HV);
    bf16* MIX = (bf16*)(F.ws + WS_MIX);
    const int row0 = hg_rowbase(b, slot);
    const int tid = F.tid, lane = F.lane, w = F.wave, li = lane & 15, lq = lane >> 4, v = 16 * w + li;
    u32x4 pa[7], pb[7];
    const float* HVf = HV + ((size_t)(bh * 2 + 0) * (2 * HG_SLOTS) + slot * 2) * 256; const float* HVb = HV + ((size_t)(bh * 2 + 1) * (2 * HG_SLOTS) + slot * 2) * 256;
    {   const size_t r0 = (size_t)row0, r1 = (size_t)(row0 + 64);
        HgPtrs P0{GQ + r0 * 512 + h * 128, GK + r0 * 512 + h * 128, Z + r0 * INW + ZV + h * 128, HVf};
        HgPtrs P1{GQ + r1 * 512 + h * 128, GK + r1 * 512 + h * 128, Z + r1 * INW + ZV + h * 128, HVf + 256};
        hg_load6(P0, tid, pa); hg_load6(P1, tid, pb); }
    if (tid < 32) *(LAS f32x4*)((LAS float*)(F.lds + HG_RSS) + 4 * tid) = *(const f32x4*)(F.in[10] + l * 128 + 4 * tid);
    f32x4 S[8];
    const bf16* HSb = (const bf16*)(F.ws + WS_HS) + ((size_t)(bh * 2 + 1) * HG_SLOTS + slot) * 16384;
    {   const bf16* HSf = (const bf16*)(F.ws + WS_HS) + ((size_t)(bh * 2 + 0) * HG_SLOTS + slot) * 16384;
#pragma unroll
        for (int i = 0; i < 8; ++i) S[i] = hg_ld4(HSf + v * 128 + 16 * i + 4 * lq); }
    f32x4 O[2][4];
#pragma unroll
    for (int c = 0; c < 2; ++c)
#pragma unroll
        for (int mt = 0; mt < 4; ++mt) O[c][mt] = (f32x4){0.f, 0.f, 0.f, 0.f};
#pragma unroll 1
    for (int st = 0; st < 4; ++st) {
        const int dir = st >> 1, c = (st == 1 || st == 2) ? 1 : 0;
        u32x4 cur[7];
#pragma unroll
        for (int j = 0; j < 7; ++j) { cur[j] = pa[j]; pa[j] = pb[j]; }
        if ((VAR & 1)) { } else if (st < 2) {
            const size_t rn = (size_t)(row0 + (st == 0 ? 64 : 0));
            HgPtrs Pn{GQ + ((size_t)TT + rn) * 512 + h * 128, GK + ((size_t)TT + rn) * 512 + h * 128, Z + rn * INW + ZV + h * 128, HVb + (st == 0 ? 256 : 0)};
            hg_load6(Pn, tid, pb);
        } else if (st == 2) {
#pragma unroll
            for (int j = 0; j < 4; ++j) pb[j] = *(const u32x4*)(Z + (size_t)(row0 + (tid >> 2)) * INW + ZG + h * 128 + 32 * (tid & 3) + 8 * j);
        }
        hg_chunk_c3<VAR>(F, cur, dir, S, O[0], (st & 1) == 0, st == 1 ? HSb : nullptr);
        if ((st & 1) == 0) {
#pragma unroll
            for (int mt = 0; mt < 4; ++mt) { const f32x4 t = O[0][mt]; O[0][mt] = O[1][mt]; O[1][mt] = t; }
        }
    }
    if (VAR & 16) { if (O[0][0][0] == 123.456f && O[1][3][2] == 1.f && S[0][0] == 2.f) MIX[0] = 1; return; }
    LAS float* Ot = (LAS float*)F.lds;
#pragma unroll
    for (int c = 0; c < 2; ++c)
#pragma unroll
        for (int mt = 0; mt < 4; ++mt)
#pragma unroll
            for (int r = 0; r < 4; ++r) Ot[(64 * c + 16 * mt + 4 * lq + r) * 132 + v] = O[c][mt][r];
    LDS_BARRIER();
    {   const int t = tid >> 2, v0 = 32 * (tid & 3);
        f32x4 x[8]; float ss = 0.f;
#pragma unroll
        for (int j = 0; j < 8; ++j) { x[j] = *(const LAS f32x4*)(Ot + t * 132 + v0 + 4 * j); ss += (x[j].x * x[j].x + x[j].y * x[j].y) + (x[j].z * x[j].z + x[j].w * x[j].w); }
        ss += __shfl_xor(ss, 1); ss += __shfl_xor(ss, 2);
        const float rs = rsqrtf(ss * (1.f / 128.f) + EPS);
        const LAS float* gain = (const LAS float*)(F.lds + HG_RSS) + v0;
#pragma unroll
        for (int k = 0; k < 4; ++k) { const u32x4 gq = pb[k]; const f32x4 g0 = *(const LAS f32x4*)(gain + 8 * k), g1 = *(const LAS f32x4*)(gain + 8 * k + 4);
            float o[8];
#pragma unroll
            for (int e = 0; e < 4; ++e) { const unsigned gw = e == 0 ? gq.x : e == 1 ? gq.y : e == 2 ? gq.z : gq.w;
                const float ga = __builtin_bit_cast(float, gw << 16), gb = __builtin_bit_cast(float, gw & 0xffff0000u);
                const float xa = e < 2 ? x[2 * k][2 * e] : x[2 * k + 1][2 * e - 4], xb = e < 2 ? x[2 * k][2 * e + 1] : x[2 * k + 1][2 * e - 3];
                const float na = e < 2 ? g0[2 * e] : g1[2 * e - 4], nb = e < 2 ? g0[2 * e + 1] : g1[2 * e - 3];
                o[2 * e] = xa * rs * na * ga * fast_rcp(1.f + __expf(-ga)); o[2 * e + 1] = xb * rs * nb * gb * fast_rcp(1.f + __expf(-gb)); }
            *(u32x4*)(MIX + (size_t)(row0 + t) * 1024 + h * 128 + v0 + 8 * k) = (u32x4){pk2(o[0], o[1]), pk2(o[2], o[3]), pk2(o[4], o[5]), pk2(o[6], o[7])}; }
    }
    LDS_BARRIER();
}

constexpr int LR_XR = 0, LR_XB = 35376, LR_HS = 69632;

__device__ __forceinline__ int lru_row(bool isctx, int b, int p) { return isctx ? TL + b * CTXL + p : b * SEQ + ((p & 255) << 6) + (p >> 8); }

template <bool FINAL>
__device__ __forceinline__ void lru_unit(Frame& F, int l, int b, int slot) {
    const bool isctx = slot < 4; const int p0 = isctx ? slot * 64 : (slot - 4) * 64, L = isctx ? CTXL : SEQ;
    const bf16* Z = (const bf16*)(F.ws + WS_Z);
    LAS bf16* Xr = (LAS bf16*)(F.lds + LR_XR); LAS bf16* XB = (LAS bf16*)(F.lds + LR_XB); LAS float* Hs = (LAS float*)(F.lds + LR_HS);
    const int tid = F.tid, lane = F.lane, w = F.wave, li = lane & 15, lq = lane >> 4;
    {   u32x4 v[5];
#pragma unroll
        for (int j = 0; j < 5; ++j) { const int idx = tid + NTHR * j, rr = idx >> 5, c16 = idx & 31, p = p0 - 2 + rr; v[j] = (u32x4){0u, 0u, 0u, 0u};
            if (idx < 67 * 32 && p >= 0 && p < L) v[j] = *(const u32x4*)(Z + (size_t)lru_row(isctx, b, p) * INW + ZXB + 8 * c16); }
#pragma unroll
        for (int j = 0; j < 5; ++j) { const int idx = tid + NTHR * j, rr = idx >> 5, c16 = idx & 31; if (idx < 67 * 32) *(LAS u32x4*)(Xr + rr * 264 + 8 * c16) = v[j]; } }
    LDS_BARRIER();
    {   const int ch = tid & 255, ph = tid >> 8;
        const float* cw = F.in[11] + (size_t)l * 4 * 256; const float w0 = cw[ch], w1 = cw[256 + ch], w2 = cw[512 + ch], w3 = cw[768 + ch], cb = F.in[12][l * 256 + ch];
        float x0 = bf2f(Xr[(32 * ph + 0) * 264 + ch]), x1 = bf2f(Xr[(32 * ph + 1) * 264 + ch]), x2 = bf2f(Xr[(32 * ph + 2) * 264 + ch]);
#pragma unroll 8
        for (int p = 32 * ph; p < 32 * ph + 32; ++p) { const float x3 = bf2f(Xr[(p + 3) * 264 + ch]);
            XB[p * 264 + ch] = f2bf(cb + w0 * x0 + w1 * x1 + w2 * x2 + w3 * x3); x0 = x1; x1 = x2; x2 = x3; } }
    LDS_BARRIER();
    {
        const int hh = w >> 1;
        float* LA = (float*)(F.ws + WS_LRUC); float* LH = (float*)(F.ws + WS_LRUC + LRUC_STRIDE); const float* LI = (const float*)(F.ws + WS_LRUC + 2 * LRUC_STRIDE);
        float hsum[4][4];
        bf16x8 nbr[2], nbi[2]; float nba, nbx, ncl, nC;
#define LRU_FETCH(itn) do { const int jn_ = 2 * (w & 1) + ((itn) >> 1), d_ = (itn) & 1, ch_ = hh * 64 + 16 * jn_ + li; \
            const bf16* Wl_ = (const bf16*)(F.ws + WS_TAB + TAB_LRUW) + ((size_t)((l * 2 + d_) * 4 + hh) * 128) * 64; \
            _Pragma("unroll") for (int ks = 0; ks < 2; ++ks) { nbr[ks] = *(const bf16x8*)(Wl_ + (16 * jn_ + li) * 64 + 32 * ks + 8 * lq); nbi[ks] = *(const bf16x8*)(Wl_ + (64 + 16 * jn_ + li) * 64 + 32 * ks + 8 * lq); } \
            nba = F.in[14][(l * 2 + d_) * 256 + ch_]; nbx = F.in[16][(l * 2 + d_) * 256 + ch_]; ncl = ((const float*)(F.ws + WS_TAB + TAB_LRUCL))[(l * 2 + d_) * 256 + ch_]; \
            nC = FINAL ? LI[((size_t)(b * 2 + d_) * LR_SLOTS + slot) * 256 + ch_] : 0.f; } while (0)
        LRU_FETCH(0);
#pragma unroll 1
        for (int it = 0; it < 4; ++it) {
            const int jn = 2 * (w & 1) + (it >> 1), d = it & 1;
            const int ch = hh * 64 + 16 * jn + li;
            const size_t cidx = ((size_t)(b * 2 + d) * LR_SLOTS + slot) * 256;
            bf16x8 br[2], bi[2];
#pragma unroll
            for (int ks = 0; ks < 2; ++ks) { br[ks] = nbr[ks]; bi[ks] = nbi[ks]; }
            const float ba = nba, bx = nbx, cl = ncl;
            float C = nC;
            if (it < 3) LRU_FETCH(it + 1);
            f32x4 ar[4], ai[4];
#pragma unroll
            for (int mt = 0; mt < 4; ++mt) { ar[mt] = (f32x4){0.f, 0.f, 0.f, 0.f}; ai[mt] = (f32x4){0.f, 0.f, 0.f, 0.f};
#pragma unroll
                for (int ks = 0; ks < 2; ++ks) { const bf16x8 a = *(const LAS bf16x8*)(XB + (16 * mt + li) * 264 + hh * 64 + 32 * ks + 8 * lq);
                    ar[mt] = MFMA16(a, br[ks], ar[mt]); ai[mt] = MFMA16(a, bi[ks], ai[mt]); } }
            float PA[4][4], PB[4][4];
#pragma unroll
            for (int mt = 0; mt < 4; ++mt)
#pragma unroll
                for (int r = 0; r < 4; ++r) { const int p = 16 * mt + 4 * lq + r;
                    const float rg = sigmoidf_(ar[mt][r] + ba), ig = sigmoidf_(ai[mt][r] + bx), la = -cl * rg;
                    const float x2 = 2.f * la, e2 = __expf(x2);
                    const float om = x2 > -0.03f ? -x2 * (1.f + 0.5f * x2 * (1.f + x2 * (1.f / 3.f))) : 1.f - e2;
                    PA[mt][r] = __expf(la); PB[mt][r] = __builtin_amdgcn_sqrtf(fmaxf(om, 0.f)) * ig * bf2f(XB[p * 264 + ch]); }
            float TA[4], TB[4], EA[4], EB[4];
#pragma unroll
            for (int mt = 0; mt < 4; ++mt) {
                float pa = 1.f, pb = 0.f;
#pragma unroll
                for (int j = 0; j < 4; ++j) { const int r = d ? 3 - j : j; const float a = PA[mt][r], bb = PB[mt][r]; pb = a * pb + bb; pa = a * pa; PA[mt][r] = pa; PB[mt][r] = pb; }
                float ea = 1.f, eb = 0.f, ta = 1.f, tb = 0.f;
#pragma unroll
                for (int j = 0; j < 4; ++j) { const int k = d ? 3 - j : j; const float ga = __shfl(pa, li + 16 * k), gb = __shfl(pb, li + 16 * k);
                    const bool before = d ? (k > lq) : (k < lq);
                    if (before) { eb = ga * eb + gb; ea = ga * ea; }
                    tb = ga * tb + gb; ta = ga * ta; }
                EA[mt] = ea; EB[mt] = eb; TA[mt] = ta; TB[mt] = tb;
            }
            float Atot = 1.f, Cin[4];
#pragma unroll
            for (int j = 0; j < 4; ++j) { const int mt = d ? 3 - j : j; Cin[mt] = C; C = TA[mt] * C + TB[mt]; Atot *= TA[mt]; }
            if (!FINAL) { if (lq == 0) { LA[cidx + ch] = Atot; LH[cidx + ch] = C; } }
            else {
#pragma unroll
                for (int mt = 0; mt < 4; ++mt) { const float base = EA[mt] * Cin[mt] + EB[mt];
#pragma unroll
                    for (int r = 0; r < 4; ++r) { const float hv = PA[mt][r] * base + PB[mt][r];
                        if (d == 0) hsum[mt][r] = hv; else Hs[(16 * mt + 4 * lq + r) * 256 + ch] = hsum[mt][r] + hv; } }
            }
        }
    }
#undef LRU_FETCH
    if (FINAL) {
        LDS_BARRIER();
        bf16* MIX = (bf16*)(F.ws + WS_MIX);
        u32x4 yq[4];
#pragma unroll
        for (int j = 0; j < 4; ++j) { const int task = tid + NTHR * j, p = task >> 5, c8 = task & 31; yq[j] = *(const u32x4*)(Z + (size_t)lru_row(isctx, b, p0 + p) * INW + ZYB + 8 * c8); }
#pragma unroll
        for (int j = 0; j < 4; ++j) { const int task = tid + NTHR * j, p = task >> 5, c8 = task & 31;
            const f32x4 h0 = *(const LAS f32x4*)(Hs + p * 256 + 8 * c8), h1 = *(const LAS f32x4*)(Hs + p * 256 + 8 * c8 + 4);
            float o[8];
#pragma unroll
            for (int e = 0; e < 4; ++e) { const unsigned yw = yq[j][e];
                const float ya = __builtin_bit_cast(float, yw << 16), yb = __builtin_bit_cast(float, yw & 0xffff0000u);
                const float ua = 0.7978845608f * (ya + 0.044715f * ya * ya * ya), ub = 0.7978845608f * (yb + 0.044715f * yb * yb * yb);
                const float ta = 1.f - 2.f * fast_rcp(1.f + __expf(2.f * ua)), tb = 1.f - 2.f * fast_rcp(1.f + __expf(2.f * ub));
                const float ha = e < 2 ? h0[2 * e] : h1[2 * e - 4], hb = e < 2 ? h0[2 * e + 1] : h1[2 * e - 3];
                o[2 * e] = ha * 0.5f * ya * (1.f + ta); o[2 * e + 1] = hb * 0.5f * yb * (1.f + tb); }
            *(u32x4*)(MIX + (size_t)lru_row(isctx, b, p0 + p) * 1024 + 512 + 8 * c8) = (u32x4){pk2(o[0], o[1]), pk2(o[2], o[3]), pk2(o[4], o[5]), pk2(o[6], o[7])}; }
    }
    LDS_BARRIER();
}

__device__ __forceinline__ void lru_carry(Frame& F) {
    if (blockIdx.x >= 16 || F.wave != 0) return;
    const int chain = blockIdx.x * 64 + F.lane, bd = chain >> 8, ch = chain & 255, d = bd & 1;
    const float* LA = (const float*)(F.ws + WS_LRUC); const float* LH = (const float*)(F.ws + WS_LRUC + LRUC_STRIDE); float* LI = (float*)(F.ws + WS_LRUC + 2 * LRUC_STRIDE);
    float h = 0.f;
    constexpr int LB = 26;
    static_assert(LR_SLOTS % (2 * LB) == 0, "batching");
    float aA[LB], hA[LB], aB[LB], hB[LB];
#define LC_IDX(k) (((size_t)bd * LR_SLOTS + (d ? ((k) < 4 ? 3 - (k) : 263 - (k)) : (k))) * 256 + ch)
#define LC_LOAD(a_, h_, k0) _Pragma("unroll") for (int j = 0; j < LB; ++j) { const size_t idx = LC_IDX((k0) + j); a_[j] = LA[idx]; h_[j] = LH[idx]; }
#define LC_SCAN(a_, h_, k0) _Pragma("unroll") for (int j = 0; j < LB; ++j) { const size_t idx = LC_IDX((k0) + j); LI[idx] = h; h = a_[j] * h + h_[j]; }
    LC_LOAD(aA, hA, 0)
#pragma unroll 1
    for (int k0 = 0; k0 < LR_SLOTS; k0 += 2 * LB) {
        LC_LOAD(aB, hB, k0 + LB)
        LC_SCAN(aA, hA, k0)
        if (k0 + 2 * LB < LR_SLOTS) { LC_LOAD(aA, hA, k0 + 2 * LB) }
        LC_SCAN(aB, hB, k0 + LB)
    }
#undef LC_IDX
#undef LC_LOAD
#undef LC_SCAN
}

__device__ __forceinline__ void fft_f1(Frame& F, int b, int n2) {
    const bf16* Z = (const bf16*)(F.ws + WS_Z);
    const bf16* Fc = (const bf16*)(F.ws + WS_TAB + TAB_FC); const bf16* Fs = (const bf16*)(F.ws + WS_TAB + TAB_FS);
    bf16* FAr = (bf16*)(F.ws + WS_FA); bf16* FAi = FAr + (size_t)2 * 128 * 128 * 256;
    LAS bf16* DT = (LAS bf16*)F.lds;
    const int tid = F.tid, lane = F.lane, w = F.wave, li = lane & 15, lq = lane >> 4;
    {   const int c = tid & 255, nh = tid >> 8;
        const bf16* src = Z + ((size_t)(b * SEQ + 128 * (64 * nh) + n2)) * INW + ZU + c;
#pragma unroll 2
        for (int j = 0; j < 8; ++j) { unsigned pk[4];
#pragma unroll
            for (int i = 0; i < 4; ++i) pk[i] = (unsigned)src[(size_t)(128 * (8 * j + 2 * i)) * INW] | ((unsigned)src[(size_t)(128 * (8 * j + 2 * i + 1)) * INW] << 16);
            *(LAS u32x4*)(DT + c * 136 + 64 * nh + 8 * j) = (u32x4){pk[0], pk[1], pk[2], pk[3]}; } }
    LDS_BARRIER();
    bf16x8 fc[4], fs[4];
#pragma unroll
    for (int ks = 0; ks < 4; ++ks) { fc[ks] = *(const bf16x8*)(Fc + (16 * w + li) * 128 + 32 * ks + 8 * lq); fs[ks] = *(const bf16x8*)(Fs + (16 * w + li) * 128 + 32 * ks + 8 * lq); }
    float ct[4], st[4];
#pragma unroll
    for (int r = 0; r < 4; ++r) { const int k1 = 16 * w + 4 * lq + r; sincospif((float)((n2 * k1) & 16383) * (1.f / 8192.f), &st[r], &ct[r]); }
#pragma unroll 2
    for (int nt = 0; nt < 16; ++nt) {
        f32x4 re = {0.f, 0.f, 0.f, 0.f}, im = {0.f, 0.f, 0.f, 0.f};
#pragma unroll
        for (int ks = 0; ks < 4; ++ks) { const bf16x8 bb = *(const LAS bf16x8*)(DT + (16 * nt + li) * 136 + 32 * ks + 8 * lq); re = MFMA16(fc[ks], bb, re); im = MFMA16(fs[ks], bb, im); }
#pragma unroll
        for (int r = 0; r < 4; ++r) { const int k1 = 16 * w + 4 * lq + r, c = 16 * nt + li;
            const float R = re[r], I = -im[r];
            const size_t o = ((size_t)(b * 128 + k1) * 128 + n2) * 256 + c;
            FAr[o] = f2bf(R * ct[r] + I * st[r]); FAi[o] = f2bf(I * ct[r] - R * st[r]); }
    }
    LDS_BARRIER();
}

__device__ __forceinline__ void fft_f2(Frame& F, int b, int k1, int chalf) {
    const bf16* Fc = (const bf16*)(F.ws + WS_TAB + TAB_FC); const bf16* Fs = (const bf16*)(F.ws + WS_TAB + TAB_FS); const bf16* CS = (const bf16*)(F.ws + WS_TAB + TAB_CS);
    const bf16* FAr = (const bf16*)(F.ws + WS_FA); const bf16* FAi = FAr + (size_t)2 * 128 * 128 * 256;
    bf16* MIX = (bf16*)(F.ws + WS_MIX);
    LAS bf16* DTr = (LAS bf16*)F.lds; LAS bf16* DTi = DTr + 128 * 136;
    const int tid = F.tid, lane = F.lane, w = F.wave, li = lane & 15, lq = lane >> 4;
    LAS bf16* Wv = (LAS bf16*)(F.lds + 69632) + w * (16 * 2 * 136);
    {   u32x4 pr[4], pi[4];
#pragma unroll
        for (int j = 0; j < 4; ++j) { const int p = tid + NTHR * j, n2 = p >> 4, c8 = p & 15; const size_t o = ((size_t)(b * 128 + k1) * 128 + n2) * 256 + chalf * 128 + 8 * c8;
            pr[j] = *(const u32x4*)(FAr + o); pi[j] = *(const u32x4*)(FAi + o); }
#pragma unroll
        for (int j = 0; j < 4; ++j) { const int p = tid + NTHR * j, n2 = p >> 4, c8 = p & 15, col = n2 ^ (8 * c8);
#pragma unroll
            for (int i = 0; i < 8; ++i) { const unsigned wr_ = pr[j][i >> 1], wi_ = pi[j][i >> 1];
                DTr[(8 * c8 + i) * 136 + col] = (bf16)((i & 1) ? (wr_ >> 16) : (wr_ & 0xffffu)); DTi[(8 * c8 + i) * 136 + col] = (bf16)((i & 1) ? (wi_ >> 16) : (wi_ & 0xffffu)); } } }
    LDS_BARRIER();
    bf16x8 fc[4], fs[4];
#pragma unroll
    for (int ks = 0; ks < 4; ++ks) { fc[ks] = *(const bf16x8*)(Fc + (16 * w + li) * 128 + 32 * ks + 8 * lq); fs[ks] = *(const bf16x8*)(Fs + (16 * w + li) * 128 + 32 * ks + 8 * lq); }
#pragma unroll 2
    for (int nt = 0; nt < 8; ++nt) {
        f32x4 ur = {0.f, 0.f, 0.f, 0.f}, u1 = {0.f, 0.f, 0.f, 0.f}, u2 = {0.f, 0.f, 0.f, 0.f};
        const int sw = 2 * nt + (li >> 3);
#pragma unroll
        for (int ks = 0; ks < 4; ++ks) { const int off = (16 * nt + li) * 136 + 8 * ((4 * ks + lq) ^ sw);
            const bf16x8 br = *(const LAS bf16x8*)(DTr + off), bi = *(const LAS bf16x8*)(DTi + off);
            ur = MFMA16(fc[ks], br, ur); ur = MFMA16(fs[ks], bi, ur); u1 = MFMA16(fc[ks], bi, u1); u2 = MFMA16(fs[ks], br, u2); }
        const int gl = nt >> 2, cl = 16 * (nt & 3) + li;
#pragma unroll
        for (int r = 0; r < 4; ++r) { const int k2l = 4 * lq + r; Wv[(k2l * 2 + gl) * 136 + cl] = f2bf(ur[r]); Wv[(k2l * 2 + gl) * 136 + 64 + cl] = f2bf(u1[r] - u2[r]); }
    }
    LDS_BARRIER();
    LAS bf16* Yt = (LAS bf16*)F.lds;
#pragma unroll
    for (int gl = 0; gl < 2; ++gl)
#pragma unroll
        for (int mt = 0; mt < 4; ++mt) { f32x4 acc = {0.f, 0.f, 0.f, 0.f};
#pragma unroll
            for (int ks = 0; ks < 4; ++ks) acc = MFMA16(*(const LAS bf16x8*)(Wv + (li * 2 + gl) * 136 + 32 * ks + 8 * lq), *(const bf16x8*)(CS + (16 * mt + li) * 128 + 32 * ks + 8 * lq), acc);
#pragma unroll
            for (int r = 0; r < 4; ++r) Yt[(16 * w + 4 * lq + r) * 136 + gl * 64 + 16 * mt + li] = f2bf(acc[r] * (1.f / 1024.f)); }
    LDS_BARRIER();
#pragma unroll
    for (int j = 0; j < 4; ++j) { const int p = tid + NTHR * j, k2 = p >> 4, c8 = p & 15;
        *(u32x4*)(MIX + ((size_t)b * SEQ + k1 + 128 * k2) * 1024 + 768 + chalf * 128 + 8 * c8) = *(const LAS u32x4*)(Yt + k2 * 136 + 8 * c8); }
    LDS_BARRIER();
}

__device__ __forceinline__ void ctx_fourier(Frame& F, int b, int g) {
    const bf16* Z = (const bf16*)(F.ws + WS_Z); bf16* MIX = (bf16*)(F.ws + WS_MIX);
    const bf16* CS = (const bf16*)(F.ws + WS_TAB + TAB_CS); const bf16* C256 = (const bf16*)(F.ws + WS_TAB + TAB_C256); const bf16* S256 = (const bf16*)(F.ws + WS_TAB + TAB_S256);
    LAS bf16* PT = (LAS bf16*)F.lds; LAS bf16* QT = PT + 64 * 264;
    const int lane = F.lane, w = F.wave, li = lane & 15, lq = lane >> 4;
#pragma unroll 1
    for (int nj = 0; nj < 2; ++nj) { const int nt = 2 * w + nj;
        bf16x8 a[2];
#pragma unroll
        for (int ks = 0; ks < 2; ++ks) a[ks] = *(const bf16x8*)(Z + (size_t)(TL + b * CTXL + 16 * nt + li) * INW + ZU + g * 64 + 32 * ks + 8 * lq);
#pragma unroll
        for (int mt = 0; mt < 4; ++mt) { f32x4 p = {0.f, 0.f, 0.f, 0.f}, q = {0.f, 0.f, 0.f, 0.f};
#pragma unroll
            for (int ks = 0; ks < 2; ++ks) { p = MFMA16(a[ks], *(const bf16x8*)(CS + (16 * mt + li) * 128 + 32 * ks + 8 * lq), p); q = MFMA16(a[ks], *(const bf16x8*)(CS + (16 * mt + li) * 128 + 64 + 32 * ks + 8 * lq), q); }
            u32x2 o; o.x = pk2(p[0], p[1]); o.y = pk2(p[2], p[3]); *(LAS u32x2*)(PT + (16 * mt + li) * 264 + 16 * nt + 4 * lq) = o;
            o.x = pk2(q[0], q[1]); o.y = pk2(q[2], q[3]); *(LAS u32x2*)(QT + (16 * mt + li) * 264 + 16 * nt + 4 * lq) = o; } }
    LDS_BARRIER();
#pragma unroll 1
    for (int kj = 0; kj < 2; ++kj) { const int kt = 2 * w + kj;
        f32x4 acc[4];
#pragma unroll
        for (int mt = 0; mt < 4; ++mt) acc[mt] = (f32x4){0.f, 0.f, 0.f, 0.f};
#pragma unroll 2
        for (int ks = 0; ks < 8; ++ks) { const bf16x8 ac = *(const bf16x8*)(C256 + (16 * kt + li) * 256 + 32 * ks + 8 * lq), as = *(const bf16x8*)(S256 + (16 * kt + li) * 256 + 32 * ks + 8 * lq);
#pragma unroll
            for (int mt = 0; mt < 4; ++mt) { acc[mt] = MFMA16(ac, *(const LAS bf16x8*)(PT + (16 * mt + li) * 264 + 32 * ks + 8 * lq), acc[mt]); acc[mt] = MFMA16(as, *(const LAS bf16x8*)(QT + (16 * mt + li) * 264 + 32 * ks + 8 * lq), acc[mt]); } }
#pragma unroll
        for (int mt = 0; mt < 4; ++mt)
#pragma unroll
            for (int r = 0; r < 4; ++r) MIX[(size_t)(TL + b * CTXL + 16 * kt + 4 * lq + r) * 1024 + 768 + g * 64 + 16 * mt + li] = f2bf(acc[mt][r] * (1.f / 128.f)); }
    LDS_BARRIER();
}

template <int CTRL> __device__ __forceinline__ float dpp_f(float v) { const int i = __builtin_bit_cast(int, v); return __builtin_bit_cast(float, __builtin_amdgcn_update_dpp(i, i, CTRL, 0xf, 0xf, false)); }
template <int CTRL> __device__ __forceinline__ int dpp_i(int v) { return __builtin_amdgcn_update_dpp(v, v, CTRL, 0xf, 0xf, false); }
template <int CTRL, int RMASK> __device__ __forceinline__ float dppm_f(float v) { const int i = __builtin_bit_cast(int, v); return __builtin_bit_cast(float, __builtin_amdgcn_update_dpp(i, i, CTRL, RMASK, 0xf, false)); }
template <int CTRL, int RMASK> __device__ __forceinline__ int dppm_i(int v) { return __builtin_amdgcn_update_dpp(v, v, CTRL, RMASK, 0xf, false); }
__device__ __forceinline__ float rdlane_f(float v, int lane) { return __builtin_bit_cast(float, __builtin_amdgcn_readlane(__builtin_bit_cast(int, v), lane)); }

__device__ __forceinline__ void route_phase(Frame& F, int l, int Tl) {
    LAS unsigned* hist = (LAS unsigned*)F.lds;
    for (int i = F.tid; i < 256; i += NTHR) hist[i] = 0u;
    __syncthreads();
    const float* logits = (const float*)(F.ws + WS_LOGIT); const float* br = F.in[20] + l * 256;
    int* sel_e = (int*)(F.ws + WS_SEL); float* sel_w = (float*)(F.ws + WS_SEL + SEL_STRIDE);
    const int lane = F.lane, gw = blockIdx.x * NWAVES + F.wave, NGW = F.G * NWAVES;
    const float NEG = -__builtin_inff();
    const f32x4 bb = *(const f32x4*)(br + 4 * lane);
    f32x4 lgn = (f32x4){0.f, 0.f, 0.f, 0.f};
    if (gw < Tl) lgn = *(const f32x4*)(logits + (size_t)gw * 256 + 4 * lane);
    for (int t = gw; t < Tl; t += NGW) {
        const f32x4 lg = lgn;
        if (t + NGW < Tl) lgn = *(const f32x4*)(logits + (size_t)(t + NGW) * 256 + 4 * lane);
        float sc[4], cand[4];
#pragma unroll
        for (int i = 0; i < 4; ++i) { sc[i] = sigmoidf_(lg[i]); cand[i] = sc[i] + bb[i]; }
        float m1 = NEG, m2 = NEG;
#pragma unroll
        for (int i = 0; i < 4; ++i) { const float v = cand[i]; if (v > m1) { m2 = m1; m1 = v; } else if (v > m2) m2 = v; }
#define RT_TOP2(CTRL) { const float o1 = dpp_f<CTRL>(m1), o2 = dpp_f<CTRL>(m2); const float n1 = fmaxf(m1, o1), n2 = fmaxf(fminf(m1, o1), fmaxf(m2, o2)); m1 = n1; m2 = n2; }
        RT_TOP2(0xB1) RT_TOP2(0x4E) RT_TOP2(0x141)
#undef RT_TOP2
        const float gs = m1 + m2; const int g = lane >> 3; int rank = 0;
#pragma unroll
        for (int q = 0; q < 8; ++q) { const float v = rdlane_f(gs, 8 * q); rank += (int)((v > gs) | ((v == gs) & (q < g))); }
        const bool drop = rank >= 4;
#pragma unroll
        for (int i = 0; i < 4; ++i) cand[i] = drop ? NEG : cand[i];
        float wsum = 0.f, myw = 0.f; int mye = 0;
#pragma unroll 1
        for (int k = 0; k < TOPK; ++k) {
            float bv = cand[0], bs = sc[0]; int bidx = 4 * lane;
#pragma unroll
            for (int i = 1; i < 4; ++i) { const bool tk = cand[i] > bv; bv = tk ? cand[i] : bv; bs = tk ? sc[i] : bs; bidx = tk ? 4 * lane + i : bidx; }
#define RT_ARGMAX(OV, OI, OS) { const float ov = (OV); const int oi = (OI); const float os = (OS); const bool tk = (ov > bv) | ((ov == bv) & (oi < bidx)); bv = tk ? ov : bv; bidx = tk ? oi : bidx; bs = tk ? os : bs; }
            RT_ARGMAX(dpp_f<0xB1>(bv), dpp_i<0xB1>(bidx), dpp_f<0xB1>(bs))
            RT_ARGMAX(dpp_f<0x4E>(bv), dpp_i<0x4E>(bidx), dpp_f<0x4E>(bs))
            RT_ARGMAX(dpp_f<0x141>(bv), dpp_i<0x141>(bidx), dpp_f<0x141>(bs))
            RT_ARGMAX(dpp_f<0x140>(bv), dpp_i<0x140>(bidx), dpp_f<0x140>(bs))
            RT_ARGMAX((dppm_f<0x142, 0xE>(bv)), (dppm_i<0x142, 0xE>(bidx)), (dppm_f<0x142, 0xE>(bs)))
            RT_ARGMAX((dppm_f<0x143, 0xC>(bv)), (dppm_i<0x143, 0xC>(bidx)), (dppm_f<0x143, 0xC>(bs)))
#undef RT_ARGMAX
            const int ui = __builtin_amdgcn_readlane(bidx, 63); const float sw = rdlane_f(bs, 63);
#pragma unroll
            for (int i = 0; i < 4; ++i) cand[i] = (4 * lane + i == ui) ? NEG : cand[i];
            wsum += sw; myw = (lane == k) ? sw : myw; mye = (lane == k) ? ui : mye;
        }
        if (lane < TOPK) { sel_e[(size_t)t * 8 + lane] = mye; sel_w[(size_t)t * 8 + lane] = 2.5f * myw / wsum; (void)__hip_atomic_fetch_add(&hist[mye], 1u, __ATOMIC_RELAXED, __HIP_MEMORY_SCOPE_WORKGROUP); }
    }
    __syncthreads();
    unsigned* cnt = (unsigned*)(F.ws + WS_CTL) + CW_CNT + 1024 * l;
    for (int e = F.tid; e < 256; e += NTHR) if (hist[e]) atomicAdd(cnt + e, hist[e]);
    __syncthreads();
}

__device__ __forceinline__ void assign_phase(Frame& F, int l, int Tl) {
    LAS int* cntL = (LAS int*)F.lds; LAS int* pstart = cntL + 256; LAS unsigned* hist = (LAS unsigned*)(pstart + 260); LAS unsigned* base = hist + 256; LAS unsigned* hist2 = base + 256;
    unsigned* cnt = (unsigned*)(F.ws + WS_CTL) + CW_CNT + 1024 * l; unsigned* fill = cnt + 512;
    const int tid = F.tid, lane = F.lane;
    if (tid < 256) { cntL[tid] = (int)cnt[tid]; hist[tid] = 0u; hist2[tid] = 0u; }
    __syncthreads();
    if (F.wave == 0) {
        int p[4]; int s = 0;
#pragma unroll
        for (int i = 0; i < 4; ++i) { p[i] = (cntL[4 * lane + i] + 255) & ~255; s += p[i]; }
        int inc = s;
#pragma unroll
        for (int off = 1; off < 64; off <<= 1) { const int v = __shfl_up(inc, off); if (lane >= off) inc += v; }
        int ex = inc - s;
#pragma unroll
        for (int i = 0; i < 4; ++i) { pstart[4 * lane + i] = ex; ex += p[i]; }
        if (lane == 63) pstart[256] = inc;
    }
    __syncthreads();
    const int total_rows = pstart[256], ntile_r = total_rows >> 8, ntiles = ntile_r + (Tl >> 8);
    int* meta = (int*)(F.ws + WS_META); int* tile_expert = meta + 64;
    int* row_tok = (int*)(F.ws + WS_ROWTOK); const int* sel_e = (const int*)(F.ws + WS_SEL); int* tokpos = (int*)(F.ws + WS_SEL + 2 * SEL_STRIDE);
    if (blockIdx.x == 0) {
        if (tid == 0) { meta[0] = ntiles; meta[1] = total_rows; }
        if (tid < 256) { const int rt0 = pstart[tid] >> 8; for (int rt = rt0; rt < (pstart[tid + 1] >> 8); ++rt) tile_expert[rt] = tid | ((cntL[tid] - 256 * (rt - rt0) <= 128) ? 0x10000 : 0); }
        for (int rt = ntile_r + tid; rt < ntiles; rt += NTHR) tile_expert[rt] = 256;
    }
    for (int e = blockIdx.x; e < 256; e += F.G) for (int r = pstart[e] + cntL[e] + tid; r < pstart[e + 1]; r += NTHR) row_tok[r] = 0;
    const int TPW = (Tl + F.G - 1) / F.G, t0 = blockIdx.x * TPW, t1 = (t0 + TPW < Tl) ? t0 + TPW : Tl;
    for (int t = t0 + tid; t < t1; t += NTHR) row_tok[total_rows + t] = t;
    const int npairs = t1 > t0 ? (t1 - t0) * 8 : 0;
    for (int i = tid; i < npairs; i += NTHR) (void)__hip_atomic_fetch_add(&hist[sel_e[(size_t)t0 * 8 + i]], 1u, __ATOMIC_RELAXED, __HIP_MEMORY_SCOPE_WORKGROUP);
    __syncthreads();
    if (tid < 256) base[tid] = hist[tid] ? atomicAdd(fill + tid, hist[tid]) : 0u;
    __syncthreads();
    for (int i = tid; i < npairs; i += NTHR) { const int e = sel_e[(size_t)t0 * 8 + i]; const unsigned off = __hip_atomic_fetch_add(&hist2[e], 1u, __ATOMIC_RELAXED, __HIP_MEMORY_SCOPE_WORKGROUP);
        const int pos = pstart[e] + (int)base[e] + (int)off; row_tok[pos] = t0 + (i >> 3); tokpos[(size_t)t0 * 8 + i] = pos; }
    __syncthreads();
}

__device__ __forceinline__ void combine_phase(Frame& F, int l, int Tl) {
    const int* meta = (const int*)(F.ws + WS_META); const int total_rows = meta[1];
    const unsigned char* Y = (const unsigned char*)(F.ws + WS_Y); const int* tokpos = (const int*)(F.ws + WS_SEL + 2 * SEL_STRIDE); const float* sel_w = (const float*)(F.ws + WS_SEL + SEL_STRIDE);
    const float* mod = (const float*)(F.ws + WS_MOD);
    float* XC = (float*)(F.ws + WS_XC); bf16* HB = (bf16*)(F.ws + WS_HB);
    const int lane = F.lane, gw = blockIdx.x * NWAVES + F.wave, NGW = F.G * NWAVES;
    const int c0 = 16 * lane;
    const int ca = (lane >> 4) * 256 + ((lane >> 2) & 3) * 32 + (lane & 3) * 8, cb2 = ca + 128;
    for (int t = gw; t < Tl; t += NGW) {
        const int myp = lane < 8 ? tokpos[(size_t)t * 8 + lane] : 0; const float myw = lane < 8 ? sel_w[(size_t)t * 8 + lane] : 0.f;
        float* xr = t < TL ? F.out + (size_t)t * D : XC + (size_t)(t - TL) * D; const int r = t < TL ? (t >> 14) : 2;
        u32x4 yv[9];
        yv[8] = *(const u32x4*)(Y + (size_t)(total_rows + t) * 1024 + c0);
#pragma unroll
        for (int k = 0; k < TOPK; ++k) yv[k] = *(const u32x4*)(Y + (size_t)__shfl(myp, k) * 1024 + c0);
        f32x4 xv[4];
        xv[0] = *(const f32x4*)(xr + ca); xv[1] = *(const f32x4*)(xr + ca + 4); xv[2] = *(const f32x4*)(xr + cb2); xv[3] = *(const f32x4*)(xr + cb2 + 4);
        float y[16];
#pragma unroll
        for (int d = 0; d < 4; ++d) { const f32x2 a = __builtin_amdgcn_cvt_pk_f32_fp8((int)yv[8][d], false), bq = __builtin_amdgcn_cvt_pk_f32_fp8((int)yv[8][d], true);
            y[4 * d] = a.x; y[4 * d + 1] = a.y; y[4 * d + 2] = bq.x; y[4 * d + 3] = bq.y; }
#pragma unroll
        for (int k = 0; k < TOPK; ++k) { const float wk = __shfl(myw, k);
#pragma unroll
            for (int d = 0; d < 4; ++d) { const f32x2 a = __builtin_amdgcn_cvt_pk_f32_fp8((int)yv[k][d], false), bq = __builtin_amdgcn_cvt_pk_f32_fp8((int)yv[k][d], true);
                y[4 * d] += wk * a.x; y[4 * d + 1] += wk * a.y; y[4 * d + 2] += wk * bq.x; y[4 * d + 3] += wk * bq.y; } }
        const float* g2 = mod + (size_t)(l * 3 + r) * 6144 + 5120;
        f32x4 xn[4]; float s = 0.f;
#pragma unroll
        for (int j = 0; j < 4; ++j) { const int cj = (j < 2 ? ca : cb2) + 4 * (j & 1);
            xn[j] = xv[j] + *(const f32x4*)(g2 + cj) * (f32x4){y[4 * j], y[4 * j + 1], y[4 * j + 2], y[4 * j + 3]};
            s += (xn[j].x * xn[j].x + xn[j].y * xn[j].y) + (xn[j].z * xn[j].z + xn[j].w * xn[j].w); }
        const float rstd = rsqrtf(wave_sum(s) * (1.f / D) + EPS);
        if (l == 0) {
            const float* m1 = mod + (size_t)(3 + r) * 6144; const float* gain = F.in[6] + 1024;
            unsigned o[8];
#pragma unroll
            for (int j = 0; j < 4; ++j) { const int cj = (j < 2 ? ca : cb2) + 4 * (j & 1); *(f32x4*)(xr + cj) = xn[j];
                const f32x4 yv2 = xn[j] * rstd * *(const f32x4*)(gain + cj) * (*(const f32x4*)(m1 + 1024 + cj) + 1.f) + *(const f32x4*)(m1 + cj);
                o[2 * j] = pk2(yv2.x, yv2.y); o[2 * j + 1] = pk2(yv2.z, yv2.w); }
            *(u32x4*)(HB + (size_t)t * D + ca) = (u32x4){o[0], o[1], o[2], o[3]}; *(u32x4*)(HB + (size_t)t * D + cb2) = (u32x4){o[4], o[5], o[6], o[7]};
        } else {
            const float* gain = F.in[27];
#pragma unroll
            for (int j = 0; j < 4; ++j) { const int cj = (j < 2 ? ca : cb2) + 4 * (j & 1); *(f32x4*)(F.out + (size_t)t * D + cj) = xn[j] * rstd * *(const f32x4*)(gain + cj); }
        }
    }
}


#ifndef PH_EN
#define PH_EN 0xFFFFFFFFu
#endif
#define EN(j) ((PH_EN >> (j)) & 1u)
#ifndef U_EN
#define U_EN 0xFFu
#endif
#define UEN(j) ((U_EN >> (j)) & 1u)
#ifndef DUPMASK
#define DUPMASK 0u
#endif
#define REP(j) for (int rep_ = 0; rep_ < 1 + (int)((DUPMASK >> (j)) & 1u); ++rep_)
#ifndef DUPU
#define DUPU 0u
#endif
#define REPU(j) for (int repu_ = 0; repu_ < 1 + (int)((DUPU >> (j)) & 1u); ++repu_)
#define IN(k) (lo <= (k) && (k) < hi)
#define FRESH() do { asm volatile("" : "+v"(F.tid)); F.lane = F.tid & 63; } while (0)
#define SEAM(k) do { if (lo <= (k) && (k) + 1 < hi) xcd_barrier(bar); } while (0)
#define SEAMCV(k, lcv) do { if (lo <= (k) && (k) + 1 < hi) xcd_barrier_cv(bar, F); } while (0)
template <int l>
__device__ __forceinline__ void layer_phases(Frame& F, const XcdBarrier& bar, const int lo, const int hi) {
    const int bid = blockIdx.x, G = F.G;

        const int pb = 2 + 12 * l;
        const int Tl = l == 0 ? TT : TL;
        bf16* HB = (bf16*)(F.ws + WS_HB); bf16* Zb = (bf16*)(F.ws + WS_Z); bf16* MIX = (bf16*)(F.ws + WS_MIX);
        if (EN(2) && IN(pb + 0)) REP(2) { FRESH();
            pg8::Gemm g{HB, (const bf16*)(F.ws + WS_WIN) + (size_t)l * INW * 1024, nullptr, 1024}; pg8::StaticOrder S; S.init(TT, INW, G, bid);
            pg8::EpiBf16 E{Zb, INW};
            pg8::gemm_phase<pg8::EpiBf16, pg8::StaticOrder, false>(F.lds, g, S, E, F.tid);
            SEAMCV(pb + 0, l);
        }
        if (EN(3) && IN(pb + 1)) REP(3) { FRESH();
            REPU(0) if (UEN(0)) hgrn2_c1<0>(F, l, bid, 16 * HG_SLOTS, G);
            FRESH(); REPU(1) if (UEN(1)) for (int u = (bid + G - 32) % G; u < 2 * LR_SLOTS; u += G) lru_unit<false>(F, l, u / LR_SLOTS, u % LR_SLOTS);
            FRESH(); REPU(2) if (UEN(2)) for (int u = bid; u < 256; u += G) fft_f1(F, u >> 7, u & 127);
            FRESH(); REPU(3) if (UEN(3) && l == 0) for (int u = (bid + G - 64) % G; u < 8; u += G) ctx_fourier(F, u >> 2, u & 3);
            SEAMCV(pb + 1, l);
        }
        if (EN(4) && IN(pb + 2)) REP(4) { FRESH(); hgrn2_c2(F); lru_carry(F); SEAMCV(pb + 2, l); }
        if (EN(5) && IN(pb + 3)) REP(5) { FRESH();
            const int nslot = l == 0 ? HG_SLOTS : HG_SLOTS - 2, slot0 = l == 0 ? 0 : 2;
            FRESH(); REPU(4) if (UEN(4)) for (int u = bid; u < 8 * nslot; u += G) hgrn2_c3<0>(F, l, u / nslot, slot0 + u % nslot);
            const int nls = l == 0 ? LR_SLOTS : LR_SLOTS - 4, ls0 = l == 0 ? 0 : 4;
            FRESH(); REPU(5) if (UEN(5)) for (int u = (bid + G - 32) % G; u < 2 * nls; u += G) lru_unit<true>(F, l, u / nls, ls0 + u % nls);
            FRESH(); REPU(6) if (UEN(6)) for (int u = bid; u < 512; u += G) fft_f2(F, u >> 8, (u >> 1) & 127, u & 1);
            SEAMCV(pb + 3, l);
        }
        if (EN(6) && IN(pb + 4)) REP(6) { FRESH();
            pg8::Gemm g{MIX, (const bf16*)(F.ws + WS_WOUT) + (size_t)l * 1024 * 1024, nullptr, 1024}; pg8::StaticOrder S; S.init(Tl, 1024, G, bid);
            pg8::EpiResid E{l == 0 ? F_X(F) : (const float*)F.out, F.out, F_CTX(F), (float*)(F.ws + WS_XC), (const float*)(F.ws + WS_MOD) + (size_t)l * 3 * 6144};
            pg8::gemm_phase<pg8::EpiResid, pg8::StaticOrder, false>(F.lds, g, S, E, F.tid);
            SEAMCV(pb + 4, l);
        }
        if (EN(7) && IN(pb + 5)) REP(7) { FRESH();
            hprep_rows(F, l, F.out, (const float*)(F.ws + WS_XC), Tl, 3072, 4096, F.in[7] + l * 1024, true);
            SEAMCV(pb + 5, l);
        }
        if (EN(8) && IN(pb + 6)) REP(8) { FRESH();
            pg8::Gemm g{HB, (const bf16*)(F.ws + WS_WR) + (size_t)l * 256 * 1024, nullptr, 1024}; pg8::StaticOrder S; S.init(Tl, 256, G, bid);
            pg8::EpiF32 E{(float*)(F.ws + WS_LOGIT), 256};
            pg8::gemm_phase<pg8::EpiF32, pg8::StaticOrder, false>(F.lds, g, S, E, F.tid);
            SEAMCV(pb + 6, l);
        }
        if (EN(9) && IN(pb + 7)) REP(9) { FRESH(); route_phase(F, l, Tl); SEAMCV(pb + 7, l); }
        if (EN(10) && IN(pb + 8)) REP(10) { FRESH(); assign_phase(F, l, Tl); FRESH(); convert_experts(F, l); SEAMCV(pb + 8, l); }
        if (EN(11) && IN(pb + 9)) REP(11) { FRESH();
            const int* meta = (const int*)(F.ws + WS_META);
            pg8::Gemm g{(const bf16*)(F.ws + WS_HB8), (const bf16*)(F.ws + (l ? WS_WEXP1 : WS_WEXP)), (const int*)(F.ws + WS_ROWTOK), 512, 0x7a7a7a7a, 0x7f7f7f7f}; pg8::MoeOrder<2> S{meta + 64, meta[0], G, bid};
            pg8::EpiSwiglu8 E{F.ws + WS_HBUF};
            pg8::gemm_phase<pg8::EpiSwiglu8, pg8::MoeOrder<2>, true, true>(F.lds, g, S, E, F.tid);
            SEAMCV(pb + 9, l);
        }
        if (EN(12) && IN(pb + 10)) REP(12) { FRESH();
            const int* meta = (const int*)(F.ws + WS_META);
            pg8::Gemm g{(const bf16*)(F.ws + WS_HBUF), (const bf16*)(F.ws + (l ? WS_WEXP1 : WS_WEXP) + WEXP_GU_BYTES), nullptr, 128, 0x7b7b7b7b, 0x7d7d7d7d}; pg8::MoeOrder<4> S{meta + 64, meta[0], G, bid};
            pg8::EpiFp8 E{(unsigned char*)(F.ws + WS_Y), 1024};
            pg8::gemm_phase<pg8::EpiFp8, pg8::MoeOrder<4>, false, true>(F.lds, g, S, E, F.tid);
            SEAMCV(pb + 10, l);
        }
        if (EN(13) && IN(pb + 11)) REP(13) { FRESH(); combine_phase(F, l, Tl); SEAMCV(pb + 11, l); }
    }

constexpr int NPH = 26;
#ifndef BENCH_REPS
#define BENCH_REPS 2
#endif
__global__ void __launch_bounds__(NTHR, 2) fwd_kernel(Args args) {
    extern __shared__ __attribute__((aligned(16))) unsigned char lds_raw[];
    Frame F;
    F.lds = (LAS unsigned char*)lds_raw;
    F.tid = threadIdx.x; F.lane = F.tid & 63; F.wave = __builtin_amdgcn_readfirstlane(F.tid >> 6); F.G = gridDim.x;
    F.in = (const CAS cfptr*)__builtin_amdgcn_kernarg_segment_ptr();
    F.out = args.out; F.ws = args.ws;
    volatile LAS unsigned* MISC = (volatile LAS unsigned*)(F.lds + MISC_OFF);
    if (F.tid < 64) MISC[F.tid] = 0u;
    __syncthreads();
    XcdBarrier bar = xcd_barrier_post((unsigned*)(F.ws + WS_CTL) + CW_BAR, MISC + 8);
    const int lo = args.ph_lo, hi = args.ph_hi;
    const int bid = blockIdx.x, G = F.G;

    if (EN(0) && IN(0)) { FRESH(); phase_g0(F); SEAMCV(0, 0); }
    if (EN(1) && IN(1)) { FRESH(); hprep_rows(F, 0, F_X(F), F_CTX(F), TT, 0, 1024, F.in[6]); SEAMCV(1, 0); }

    layer_phases<0>(F, bar, lo, hi);
    layer_phases<1>(F, bar, lo, hi);
#ifdef BENCH_GEMM
    if (hi == NPH) { xcd_barrier(bar); FRESH();
        _Pragma("unroll 1") for (int rep = 0; rep < BENCH_REPS; ++rep) {
            const int* meta = (const int*)(F.ws + WS_META);
            pg8::Gemm g{(const bf16*)(F.ws + WS_HBUF), (const bf16*)(F.ws + WS_WEXP + WEXP_GU_BYTES), nullptr, 256}; pg8::MoeOrder<4> S{meta + 64, meta[0], F.G, (int)blockIdx.x};
#if BENCH_GEMM == 1
            pg8::EpiFp8 E{(unsigned char*)(F.ws + WS_Y), 1024}; pg8::gemm_phase<pg8::EpiFp8, pg8::MoeOrder<4>, false>(F.lds, g, S, E, F.tid);
#else
            pg8::EpiNone E{(bf16*)(F.ws + WS_Y)}; pg8::gemm_phase<pg8::EpiNone, pg8::MoeOrder<4>, false>(F.lds, g, S, E, F.tid);
#endif
            xcd_barrier(bar); } }
#endif
#ifdef BENCH_INPROJ
    if (hi == NPH) { xcd_barrier(bar); FRESH();
        _Pragma("unroll 1") for (int rep = 0; rep < BENCH_REPS; ++rep) {
            pg8::Gemm g{(const bf16*)(F.ws + WS_HB), (const bf16*)(F.ws + WS_WIN), nullptr, 1024}; pg8::StaticOrder S; S.init(TT, INW, F.G, (int)blockIdx.x);
#if BENCH_INPROJ == 1
            pg8::EpiBf16 E{(bf16*)(F.ws + WS_Z), INW}; pg8::gemm_phase<pg8::EpiBf16, pg8::StaticOrder, false>(F.lds, g, S, E, F.tid);
#else
            pg8::EpiNone E{(bf16*)(F.ws + WS_Z)}; pg8::gemm_phase<pg8::EpiNone, pg8::StaticOrder, false>(F.lds, g, S, E, F.tid);
#endif
            xcd_barrier(bar); } }
#endif
#ifdef BENCH_MOE1
    if (hi == NPH) { xcd_barrier(bar); FRESH();
        _Pragma("unroll 1") for (int rep = 0; rep < BENCH_REPS; ++rep) {
            const int* meta = (const int*)(F.ws + WS_META);
            pg8::MoeOrder<2> S{meta + 64, meta[0], F.G, (int)blockIdx.x};
#if BENCH_MOE1 == 1
            pg8::Gemm g{(const bf16*)(F.ws + WS_HB), (const bf16*)(F.ws + WS_WEXP1), (const int*)(F.ws + WS_ROWTOK), 1024};
            pg8::EpiSwiglu E{(bf16*)(F.ws + WS_HBUF)}; pg8::gemm_phase<pg8::EpiSwiglu, pg8::MoeOrder<2>, true>(F.lds, g, S, E, F.tid);
#elif BENCH_MOE1 == 2
            pg8::Gemm g{(const bf16*)(F.ws + WS_HB), (const bf16*)(F.ws + WS_WEXP1), (const int*)(F.ws + WS_ROWTOK), 1024};
            pg8::EpiNone E{(bf16*)(F.ws + WS_HBUF)}; pg8::gemm_phase<pg8::EpiNone, pg8::MoeOrder<2>, true>(F.lds, g, S, E, F.tid);
#else
            pg8::Gemm g{(const bf16*)(F.ws + WS_HB), (const bf16*)(F.ws + WS_WEXP1), nullptr, 1024};
            pg8::EpiNone E{(bf16*)(F.ws + WS_HBUF)}; pg8::gemm_phase<pg8::EpiNone, pg8::MoeOrder<2>, false>(F.lds, g, S, E, F.tid);
#endif
            xcd_barrier(bar); } }
#endif
#ifdef BENCH_X2
    if (hi == NPH) { xcd_barrier(bar); FRESH();
        _Pragma("unroll 1") for (int rep = 0; rep < BENCH_REPS; ++rep) { if (BENCH_X2 & 1) hgrn2_c2(F); if (BENCH_X2 & 2) lru_carry(F); xcd_barrier(bar); } }
#endif
#ifdef BENCH_C1
    if (hi == NPH) { xcd_barrier(bar); FRESH();
        _Pragma("unroll 1") for (int rep = 0; rep < BENCH_REPS; ++rep) hgrn2_c1<BENCH_C1>(F, 1, (int)blockIdx.x, 16 * HG_SLOTS, F.G); }
#endif
#ifdef BENCH_VAR
    if (hi == NPH) { xcd_barrier(bar); FRESH();
        _Pragma("unroll 1") for (int rep = 0; rep < BENCH_REPS; ++rep) for (int u = blockIdx.x; u < 8 * 128; u += F.G) hgrn2_c3<BENCH_VAR>(F, 1, u >> 7, 2 + (u & 127)); }
#endif
#undef IN
#undef SEAM
}

extern "C" void kernel_launch(void* const* d_in, const int* in_sizes, int n_in, void* d_out, int out_size, void* d_ws, size_t ws_size, hipStream_t stream) {
    static int grid = 0;
    if (grid == 0) {
        if (n_in != 28 || out_size != TL * D || ws_size < WS_END) { fprintf(stderr, "kernel_launch: unexpected problem (n_in %d, out %d, ws %zu < %zu)\n", n_in, out_size, ws_size, (size_t)WS_END); grid = -1; return; }
        int dev = 0, cus = 0, per_cu = 0;
        if (hipGetDevice(&dev) != hipSuccess || hipDeviceGetAttribute(&cus, hipDeviceAttributeMultiprocessorCount, dev) != hipSuccess) { grid = -1; return; }
        if (hipFuncSetAttribute((const void*)fwd_kernel, hipFuncAttributeMaxDynamicSharedMemorySize, LDS_BYTES) != hipSuccess) { fprintf(stderr, "kernel_launch: hipFuncSetAttribute failed\n"); grid = -1; return; }
        if (hipOccupancyMaxActiveBlocksPerMultiprocessor(&per_cu, (const void*)fwd_kernel, NTHR, LDS_BYTES) != hipSuccess || per_cu < 1) { fprintf(stderr, "kernel_launch: occupancy query says %d\n", per_cu); (void)hipGetLastError(); }
        grid = cus;
    }
    if (grid < 0) return;
    (void)hipMemsetAsync((char*)d_ws + WS_CTL, 0, CTL_ZERO_BYTES, stream);
    Args a{};
    for (int i = 0; i < 28; ++i) a.in[i] = (const float*)d_in[i];
    a.out = (float*)d_out; a.ws = (unsigned char*)d_ws;
#if MK_PER_PHASE
    for (int p = 0; p < NPH; ++p) { a.ph_lo = p; a.ph_hi = p + 1; hipLaunchKernelGGL(fwd_kernel, dim3(grid), dim3(NTHR), LDS_BYTES, stream, a); }
#else
    a.ph_lo = 0; a.ph_hi = NPH; hipLaunchKernelGGL(fwd_kernel, dim3(grid), dim3(NTHR), LDS_BYTES, stream, a);
#endif
}
```

```cpp
#include <hip/hip_runtime.h>
#include <cstdio>
#include <cstdint>

#ifndef MK_PER_PHASE
#define MK_PER_PHASE 0
#endif

#define LAS __attribute__((address_space(3)))
#define GAS __attribute__((address_space(1)))
typedef unsigned short bf16;
typedef short bf16x8 __attribute__((ext_vector_type(8)));
typedef float f32x4 __attribute__((ext_vector_type(4)));
typedef float f32x2 __attribute__((ext_vector_type(2)));
typedef unsigned u32x4 __attribute__((ext_vector_type(4)));
typedef unsigned u32x2 __attribute__((ext_vector_type(2)));
typedef int i32x4 __attribute__((ext_vector_type(4)));
typedef int i32x8 __attribute__((ext_vector_type(8)));

__device__ __forceinline__ float bf2f(bf16 v) { return __builtin_bit_cast(float, ((unsigned)v) << 16); }
typedef __bf16 bf16x2_t __attribute__((ext_vector_type(2)));
__device__ __forceinline__ unsigned pk2(float lo, float hi) { bf16x2_t v; v.x = (__bf16)lo; v.y = (__bf16)hi; return __builtin_bit_cast(unsigned, v); }
__device__ __forceinline__ bf16 f2bf(float f) { const __bf16 b = (__bf16)f; return __builtin_bit_cast(unsigned short, b); }
__device__ __forceinline__ unsigned f2bfu(float f) { return (unsigned)f2bf(f); }
#define MFMA16(a, b, c) __builtin_amdgcn_mfma_f32_16x16x32_bf16((a), (b), (c), 0, 0, 0)
#define LDS_WAIT() asm volatile("s_waitcnt lgkmcnt(0)" ::: "memory")
#define LDS_BARRIER() do { asm volatile("s_waitcnt lgkmcnt(0)" ::: "memory"); __builtin_amdgcn_s_barrier(); asm volatile("" ::: "memory"); } while (0)

namespace pg8 {
typedef unsigned short bf16_t;
constexpr int BM = 256, BK = 64, HALF = 128, HTB = HALF * BK * 2, STAGE_BYTES = 8 * HTB, NXCD = 8, WGM = 8;

__host__ __device__ __forceinline__ int lds_byte(int r, int c) { const int st = (r >> 4) * 2 + (c >> 5), rr = r & 15, cc = c & 31, ob = rr * 64 + cc * 2; return st * 1024 + (ob ^ (((ob >> 9) & 1) << 5)); }
__host__ __device__ __forceinline__ void stage_rc(int b, int& R, int& C) { const int st = b / 1024, sb = b % 1024, swz = sb ^ (((sb >> 9) & 1) << 5); R = (st >> 1) * 16 + swz / 64; C = (st & 1) * 32 + (swz % 64) / 2; }
__host__ __device__ __forceinline__ int perm32(int rho) { const int n = rho >> 4, i = rho & 15; return 8 * (i >> 2) + 4 * n + (i & 3); }

struct Unit { int pm, pn, pc, half; };
struct Gemm { const bf16_t* A; const bf16_t* Bt; const int* rows; int K; int sw = 0x7f7f7f7f, sx = 0x7f7f7f7f; };

struct StaticOrder {
    int nM, nN, nwg, G, c;
    __device__ void init(int M, int N, int G_, int c_) { nM = M / BM; nN = N / BM; nwg = nM * nN; G = G_; c = c_; }
    __device__ bool next(int i, Unit& u) const {
        const long L = (long)i * G + c; if (L >= nwg) return false;
        int wgid = (int)L; { const int q = nwg / NXCD, r = nwg % NXCD, xcd = wgid % NXCD, off = wgid / NXCD; wgid = (xcd < r ? xcd * (q + 1) : r * (q + 1) + (xcd - r) * q) + off; }
        const int nig = WGM * nN, gid = wgid / nig, fm = gid * WGM, gsz = (nM - fm) < WGM ? (nM - fm) : WGM;
        u.pm = fm + ((wgid % nig) % gsz); u.pn = (wgid % nig) / gsz; u.pc = u.pn; u.half = 0; return true;
    }
};
template <int NT> struct MoeOrder {
    const int* tile_expert; int n_tiles, G, c;
    __device__ bool next(int i, Unit& u) const {
        int rt, j;
        if ((G & 7) == 0) { const int x = c & 7, jw = c >> 3, per = G >> 3; const int t0 = (int)(((long)n_tiles * x) >> 3), t1 = (int)(((long)n_tiles * (x + 1)) >> 3);
            const int Lx = i * per + jw; if (Lx >= (t1 - t0) * NT) return false; rt = t0 + Lx / NT; j = Lx % NT; }
        else { const int L = i * G + c; if (L >= n_tiles * NT) return false; rt = L / NT; j = L % NT; }
        const int te = tile_expert[rt], e = te & 0xffff;
        u.pm = rt; u.pn = e * NT + j; u.pc = j; u.half = te >> 16; return true;
    }
};

__device__ __forceinline__ unsigned cvt_pk_bf16(float lo, float hi) { return pk2(lo, hi); }

struct EpiBf16 {
    static constexpr bool PERM = true;
    bf16_t* O; int ldc;
    __device__ __forceinline__ void operator()(const f32x4 (&acc)[2][2][4][2], const Unit& u, int wr, int wc, int fr, int fq) const {
        const int row0 = u.pm * BM + wr * 64 + fr, col0 = u.pc * BM + wc * 32 + 8 * fq;
#pragma unroll
        for (int ai = 0; ai < 2; ++ai)
#pragma unroll
            for (int m = 0; m < 4; ++m) { bf16_t* rowp = O + (size_t)(row0 + ai * HALF + m * 16) * ldc + col0;
#pragma unroll
                for (int bj = 0; bj < 2; ++bj) { const f32x4 v0 = acc[ai][bj][m][0], v1 = acc[ai][bj][m][1];
                    u32x4 w; w.x = cvt_pk_bf16(v0[0], v0[1]); w.y = cvt_pk_bf16(v0[2], v0[3]); w.z = cvt_pk_bf16(v1[0], v1[1]); w.w = cvt_pk_bf16(v1[2], v1[3]);
                    *(u32x4*)(rowp + bj * HALF) = w; } }
    }
};
struct EpiFp8 {
    static constexpr bool PERM = true;
    unsigned char* O; int ldc;
    static __device__ __forceinline__ unsigned pk4(const f32x4 v) {
        const float a = __builtin_amdgcn_fmed3f(v[0], -448.f, 448.f), b = __builtin_amdgcn_fmed3f(v[1], -448.f, 448.f), c = __builtin_amdgcn_fmed3f(v[2], -448.f, 448.f), d = __builtin_amdgcn_fmed3f(v[3], -448.f, 448.f);
        int p = __builtin_amdgcn_cvt_pk_fp8_f32(a, b, 0, false); p = __builtin_amdgcn_cvt_pk_fp8_f32(c, d, p, true); return (unsigned)p; }
    __device__ __forceinline__ void operator()(const f32x4 (&acc)[2][2][4][2], const Unit& u, int wr, int wc, int fr, int fq) const {
        const int row0 = u.pm * BM + wr * 64 + fr, pos0 = u.pc * BM + wc * 64 + 16 * fq;
#pragma unroll
        for (int ai = 0; ai < 2; ++ai) { if (ai == 1 && u.half) break;
#pragma unroll
            for (int m = 0; m < 4; ++m) { u32x4 w; w.x = pk4(acc[ai][0][m][0]); w.y = pk4(acc[ai][0][m][1]); w.z = pk4(acc[ai][1][m][0]); w.w = pk4(acc[ai][1][m][1]);
                *(u32x4*)(O + (size_t)(row0 + ai * HALF + m * 16) * ldc + pos0) = w; } }
    }
};
struct EpiNone {
    static constexpr bool PERM = true;
    bf16_t* O;
    __device__ __forceinline__ void operator()(const f32x4 (&acc)[2][2][4][2], const Unit& u, int wr, int wc, int fr, int fq) const {
        float s = 0.f;
#pragma unroll
        for (int ai = 0; ai < 2; ++ai)
#pragma unroll
            for (int bj = 0; bj < 2; ++bj)
#pragma unroll
                for (int m = 0; m < 4; ++m)
#pragma unroll
                    for (int n = 0; n < 2; ++n) s += acc[ai][bj][m][n][0] + acc[ai][bj][m][n][1] + acc[ai][bj][m][n][2] + acc[ai][bj][m][n][3];
        if (s == 123.4567f) O[u.pm + wr + wc + fr + fq] = 1;
    }
};
struct EpiF32 {
    static constexpr bool PERM = false;
    float* C; int ldc;
    __device__ __forceinline__ void operator()(const f32x4 (&acc)[2][2][4][2], const Unit& u, int wr, int wc, int fr, int fq) const {
        const int row0 = u.pm * BM + wr * 64 + fr, col0 = u.pc * BM + wc * 32 + 4 * fq;
#pragma unroll
        for (int ai = 0; ai < 2; ++ai)
#pragma unroll
            for (int m = 0; m < 4; ++m) { float* rowp = C + (size_t)(row0 + ai * HALF + m * 16) * ldc + col0;
#pragma unroll
                for (int bj = 0; bj < 2; ++bj)
#pragma unroll
                    for (int n = 0; n < 2; ++n) *(f32x4*)(rowp + bj * HALF + n * 16) = acc[ai][bj][m][n]; }
    }
};
struct EpiResid {
    static constexpr bool PERM = false;
    const float* src_lat; float* dst_lat; const float* src_ctx; float* dst_ctx; const float* gate;
    __device__ __forceinline__ void operator()(const f32x4 (&acc)[2][2][4][2], const Unit& u, int wr, int wc, int fr, int fq) const {
        const int col0 = u.pc * BM + wc * 32 + 4 * fq;
        const float* src; float* dst; const float* gv; int row0;
        if (u.pm < 128) { row0 = u.pm * BM + wr * 64 + fr; src = src_lat; dst = dst_lat; gv = gate + (u.pm >> 6) * 6144 + 2048; }
        else { row0 = (u.pm - 128) * BM + wr * 64 + fr; src = src_ctx; dst = dst_ctx; gv = gate + 2 * 6144 + 2048; }
        f32x4 g[2][2];
#pragma unroll
        for (int bj = 0; bj < 2; ++bj)
#pragma unroll
            for (int n = 0; n < 2; ++n) g[bj][n] = *(const f32x4*)(gv + col0 + bj * HALF + n * 16);
#pragma unroll
        for (int ai = 0; ai < 2; ++ai)
#pragma unroll
            for (int m = 0; m < 4; ++m) { const size_t off = (size_t)(row0 + ai * HALF + m * 16) * 1024 + col0;
#pragma unroll
                for (int bj = 0; bj < 2; ++bj)
#pragma unroll
                    for (int n = 0; n < 2; ++n) { const f32x4 xv = *(const f32x4*)(src + off + bj * HALF + n * 16);
                        *(f32x4*)(dst + off + bj * HALF + n * 16) = xv + g[bj][n] * acc[ai][bj][m][n]; } }
    }
};
struct EpiSwiglu {
    static constexpr bool PERM = true;
    bf16_t* H;
    __device__ __forceinline__ void operator()(const f32x4 (&acc)[2][2][4][2], const Unit& u, int wr, int wc, int fr, int fq) const {
        const int row0 = u.pm * BM + wr * 64 + fr, col0 = u.pc * HALF + wc * 32 + 8 * fq;
#pragma unroll
        for (int ai = 0; ai < 2; ++ai) { if (ai == 1 && u.half) break;
#pragma unroll
            for (int m = 0; m < 4; ++m) { float h[8];
#pragma unroll
                for (int n = 0; n < 2; ++n)
#pragma unroll
                    for (int j = 0; j < 4; ++j) { const float g = acc[ai][0][m][n][j], up = acc[ai][1][m][n][j]; h[n * 4 + j] = g * __builtin_amdgcn_rcpf(1.f + __expf(-g)) * up; }
                u32x4 w; w.x = cvt_pk_bf16(h[0], h[1]); w.y = cvt_pk_bf16(h[2], h[3]); w.z = cvt_pk_bf16(h[4], h[5]); w.w = cvt_pk_bf16(h[6], h[7]);
                *(u32x4*)(H + (size_t)(row0 + ai * HALF + m * 16) * 256 + col0) = w; } }
    }
};

struct EpiSwiglu8 {
    static constexpr bool PERM = true;
    unsigned char* H;
    __device__ __forceinline__ void operator()(const f32x4 (&acc)[2][2][4][2], const Unit& u, int wr, int wc, int fr, int fq) const {
        const int row0 = u.pm * BM + wr * 64 + fr, col0 = u.pc * HALF + wc * 32 + 8 * fq;
#pragma unroll
        for (int ai = 0; ai < 2; ++ai) { if (ai == 1 && u.half) break;
#pragma unroll
            for (int m = 0; m < 4; ++m) { float h[8];
#pragma unroll
                for (int n = 0; n < 2; ++n)
#pragma unroll
                    for (int j = 0; j < 4; ++j) { const float g = acc[ai][0][m][n][j], up = acc[ai][1][m][n][j]; h[n * 4 + j] = __builtin_amdgcn_fmed3f(4.f * g * __builtin_amdgcn_rcpf(1.f + __expf(-g)) * up, -448.f, 448.f); }
                int lo = __builtin_amdgcn_cvt_pk_fp8_f32(h[0], h[1], 0, false); lo = __builtin_amdgcn_cvt_pk_fp8_f32(h[2], h[3], lo, true);
                int hi = __builtin_amdgcn_cvt_pk_fp8_f32(h[4], h[5], 0, false); hi = __builtin_amdgcn_cvt_pk_fp8_f32(h[6], h[7], hi, true);
                u32x2 w; w.x = (unsigned)lo; w.y = (unsigned)hi;
                *(u32x2*)(H + (size_t)(row0 + ai * HALF + m * 16) * 256 + col0) = w; } }
    }
};

template <class Epi, class Sched, bool GATHER, bool FP8 = false>
__device__ __forceinline__ void gemm_phase(LAS unsigned char* lds, const Gemm g, const Sched& S, const Epi& E, const int tid) {
    const int wid = __builtin_amdgcn_readfirstlane(tid >> 6), lane = tid & 63, wr = wid >> 2, wc = wid & 3, fr = lane & 15, fq = lane >> 4;
    const int K = g.K, nt = K / BK;
    int RA[2], CA[2]; unsigned voffB[2];
#pragma unroll
    for (int i = 0; i < 2; ++i) { int R, C; stage_rc(tid * 16 + i * 8192, R, C); const int Rb = Epi::PERM ? ((R & ~31) + perm32(R & 31)) : R;
        RA[i] = R; CA[i] = C; voffB[i] = (unsigned)(Rb * K + C) * 2u; }
    const unsigned kstep = (unsigned)(BK * 2);
    const unsigned hstep = (unsigned)HALF * (unsigned)K * 2u;
    const unsigned tstep = 2u * hstep;
    const unsigned ldsw = (unsigned)wid * 1024u;
    const int aoff = lds_byte(wr * 64 + fr, fq * 8), boff = lds_byte(wc * 32 + fr, fq * 8);
    const __amdgpu_buffer_rsrc_t srdA = __builtin_amdgcn_make_buffer_rsrc((void*)g.A, (short)0, 0x7fffffff, 0x00020000);
    const __amdgpu_buffer_rsrc_t srdB = __builtin_amdgcn_make_buffer_rsrc((void*)g.Bt, (short)0, 0x7fffffff, 0x00020000);
#define PG8_SA(b, h) (((b) * 2 + (h)) * HTB)
#define PG8_SB(b, h) ((4 + (b) * 2 + (h)) * HTB)
#define PG8_STAGE(bufoff, soff, voff) do { _Pragma("unroll") for (int _i = 0; _i < 2; ++_i) \
        __builtin_amdgcn_raw_ptr_buffer_load_lds(srdB, (LAS unsigned*)(lds + (bufoff) + ldsw + _i * 8192), 16, (int)(voff)[_i], (int)(soff), 0, 0); } while (0)
#define PG8_STAGE2(bufoff, soff, v0, v1) do { \
        __builtin_amdgcn_raw_ptr_buffer_load_lds(srdA, (LAS unsigned*)(lds + (bufoff) + ldsw), 16, (int)(v0), (int)(soff), 0, 0); \
        __builtin_amdgcn_raw_ptr_buffer_load_lds(srdA, (LAS unsigned*)(lds + (bufoff) + ldsw + 8192), 16, (int)(v1), (int)(soff), 0, 0); } while (0)
#define PG8_LDA(dst, b, h) do { _Pragma("unroll") for (int m = 0; m < 4; ++m) _Pragma("unroll") for (int k = 0; k < 2; ++k) dst[m][k] = *(const LAS bf16x8*)(lds + PG8_SA(b, h) + aoff + m * 2048 + k * 1024); } while (0)
#define PG8_LDB(dst, b, h) do { _Pragma("unroll") for (int n = 0; n < 2; ++n) _Pragma("unroll") for (int k = 0; k < 2; ++k) dst[n][k] = *(const LAS bf16x8*)(lds + PG8_SB(b, h) + boff + n * 2048 + k * 1024); } while (0)
#define PG8_MMA(ai, bj, At, Bt) do { __builtin_amdgcn_s_setprio(1); _Pragma("unroll") for (int m = 0; m < 4; ++m) _Pragma("unroll") for (int n = 0; n < 2; ++n) { \
        if constexpr (FP8) { const i32x4 b0_ = __builtin_bit_cast(i32x4, Bt[n][0]), b1_ = __builtin_bit_cast(i32x4, Bt[n][1]), a0_ = __builtin_bit_cast(i32x4, At[m][0]), a1_ = __builtin_bit_cast(i32x4, At[m][1]); \
            const i32x8 w8_ = __builtin_shufflevector(b0_, b1_, 0, 1, 2, 3, 4, 5, 6, 7), x8_ = __builtin_shufflevector(a0_, a1_, 0, 1, 2, 3, 4, 5, 6, 7); \
            asm volatile("v_mfma_scale_f32_16x16x128_f8f6f4 %0, %1, %2, %0, %3, %4 op_sel_hi:[0,0,0]" : "+v"(acc[ai][bj][m][n]) : "v"(w8_), "v"(x8_), "v"(sw_), "v"(sx_)); } \
        else { _Pragma("unroll") for (int k = 0; k < 2; ++k) acc[ai][bj][m][n] = __builtin_amdgcn_mfma_f32_16x16x32_bf16(Bt[n][k], At[m][k], acc[ai][bj][m][n], 0, 0, 0); } } __builtin_amdgcn_s_setprio(0); } while (0)
#define PG8_WAIT_V(n) asm volatile("s_waitcnt vmcnt(" #n ")" ::: "memory")
#define PG8_WAIT_L(n) asm volatile("s_waitcnt lgkmcnt(" #n ")" ::: "memory")
#define PG8_BAR __builtin_amdgcn_s_barrier()
#define PG8_SCHED __builtin_amdgcn_sched_barrier(0)
    Unit cur, nxt; int ui = 0;
    if (!S.next(0, cur)) return;
    int sw_ = g.sw, sx_ = g.sx;
    if constexpr (FP8) asm volatile("" : "+v"(sw_), "+v"(sx_));
    else { (void)sw_; (void)sx_; }
    f32x4 acc[2][2][4][2];
#pragma unroll
    for (int a = 0; a < 2; ++a)
#pragma unroll
        for (int b = 0; b < 2; ++b)
#pragma unroll
            for (int m = 0; m < 4; ++m)
#pragma unroll
                for (int n = 0; n < 2; ++n) acc[a][b][m][n] = (f32x4){0.f, 0.f, 0.f, 0.f};
    bf16x8 At[4][2], B0[2][2], B1[2][2];
    unsigned c00, c01, c10, c11, n00, n01, n10, n11;
    unsigned cA, cB = (unsigned)cur.pn * tstep;
    if constexpr (GATHER) {
        const int* rp = g.rows + (size_t)cur.pm * BM; const unsigned rb = (unsigned)K * 2u;
        c00 = (unsigned)rp[RA[0]] * rb + (unsigned)CA[0] * 2u; c01 = (unsigned)rp[RA[1]] * rb + (unsigned)CA[1] * 2u;
        c10 = (unsigned)rp[HALF + RA[0]] * rb + (unsigned)CA[0] * 2u; c11 = (unsigned)rp[HALF + RA[1]] * rb + (unsigned)CA[1] * 2u;
        cA = 0u;
    } else {
        c00 = (unsigned)(RA[0] * K + CA[0]) * 2u; c01 = (unsigned)(RA[1] * K + CA[1]) * 2u;
        c10 = (unsigned)((HALF + RA[0]) * K + CA[0]) * 2u; c11 = (unsigned)((HALF + RA[1]) * K + CA[1]) * 2u;
        cA = (unsigned)cur.pm * tstep;
    }
    n00 = c00; n01 = c01; n10 = c10; n11 = c11;
    PG8_STAGE(PG8_SB(0, 0), cB, voffB); PG8_STAGE(PG8_SB(0, 1), cB + hstep, voffB); PG8_STAGE2(PG8_SA(0, 0), cA, c00, c01); PG8_STAGE2(PG8_SA(0, 1), cA, c10, c11);
    if (wr == 1) PG8_BAR;
    PG8_WAIT_V(2); PG8_BAR;
    PG8_STAGE(PG8_SB(1, 0), cB + kstep, voffB); PG8_STAGE2(PG8_SA(1, 0), cA + kstep, c00, c01); PG8_STAGE(PG8_SB(1, 1), cB + hstep + kstep, voffB);
    PG8_WAIT_V(6); PG8_BAR;
    for (;;) {
        const bool has_next = S.next(ui + 1, nxt);
        unsigned nA; const unsigned nB = has_next ? (unsigned)nxt.pn * tstep : cB;
        if constexpr (GATHER) {
            nA = 0u;
            if (has_next) { const int* rp = g.rows + (size_t)nxt.pm * BM; const unsigned rb = (unsigned)K * 2u;
                n00 = (unsigned)rp[RA[0]] * rb + (unsigned)CA[0] * 2u; n01 = (unsigned)rp[RA[1]] * rb + (unsigned)CA[1] * 2u;
                n10 = (unsigned)rp[HALF + RA[0]] * rb + (unsigned)CA[0] * 2u; n11 = (unsigned)rp[HALF + RA[1]] * rb + (unsigned)CA[1] * 2u; }
            else { n00 = c00; n01 = c01; n10 = c10; n11 = c11; }
        } else {
            nA = has_next ? (unsigned)nxt.pm * tstep : cA;
        }
        const bool hf = cur.half != 0;
#pragma unroll 1
        for (int t = 0; t < nt; t += 2) {
            const bool last = (t == nt - 2);
            const unsigned a1 = cA + (unsigned)(t + 1) * kstep;
            const unsigned a2 = last ? nA : cA + (unsigned)(t + 2) * kstep, b2 = last ? nB : cB + (unsigned)(t + 2) * kstep;
            const unsigned a3 = a2 + kstep, b3 = b2 + kstep;
            unsigned s00 = c00, s01 = c01, s10 = c10, s11 = c11;
            if constexpr (GATHER) { s00 = last ? n00 : c00; s01 = last ? n01 : c01; s10 = last ? n10 : c10; s11 = last ? n11 : c11; }
            PG8_LDB(B0, 0, 0); PG8_LDB(B1, 0, 1); PG8_SCHED; PG8_LDA(At, 0, 0); PG8_STAGE2(PG8_SA(1, 1), a1, c10, c11);
            PG8_WAIT_V(8); PG8_WAIT_L(0); PG8_BAR; PG8_MMA(0, 0, At, B0); PG8_MMA(0, 1, At, B1); PG8_BAR; PG8_SCHED;
            if (!hf) PG8_LDA(At, 0, 1); PG8_STAGE(PG8_SB(0, 0), b2, voffB); PG8_STAGE(PG8_SB(0, 1), b2 + hstep, voffB); PG8_STAGE2(PG8_SA(0, 0), a2, s00, s01);
            PG8_WAIT_V(8); PG8_WAIT_L(0); PG8_BAR; if (!hf) { PG8_MMA(1, 0, At, B0); PG8_MMA(1, 1, At, B1); } PG8_BAR; PG8_SCHED;
            PG8_LDB(B0, 1, 0); PG8_LDB(B1, 1, 1); PG8_SCHED; PG8_LDA(At, 1, 0); PG8_STAGE2(PG8_SA(0, 1), a2, s10, s11);
            PG8_WAIT_V(8); PG8_WAIT_L(0); PG8_BAR; PG8_MMA(0, 0, At, B0); PG8_MMA(0, 1, At, B1); PG8_BAR; PG8_SCHED;
            if (!hf) PG8_LDA(At, 1, 1); PG8_STAGE(PG8_SB(1, 0), b3, voffB); PG8_STAGE(PG8_SB(1, 1), b3 + hstep, voffB); PG8_STAGE2(PG8_SA(1, 0), a3, s00, s01);
            PG8_WAIT_V(8); PG8_WAIT_L(0); PG8_BAR; if (!hf) { PG8_MMA(1, 0, At, B0); PG8_MMA(1, 1, At, B1); } PG8_BAR; PG8_SCHED;
        }
        if (wr == 0) PG8_BAR;
        if constexpr (FP8) { asm volatile("s_nop 15\n\ts_nop 7" ::: "memory"); PG8_SCHED; }
        E(acc, cur, wr, wc, fr, fq);
        if (!has_next) break;
#pragma unroll
        for (int a = 0; a < 2; ++a)
#pragma unroll
            for (int b = 0; b < 2; ++b)
#pragma unroll
                for (int m = 0; m < 4; ++m)
#pragma unroll
                    for (int n = 0; n < 2; ++n) acc[a][b][m][n] = (f32x4){0.f, 0.f, 0.f, 0.f};
        cur = nxt; cA = nA; cB = nB; ++ui;
        if constexpr (GATHER) { c00 = n00; c01 = n01; c10 = n10; c11 = n11; }
        if (wr == 1) PG8_BAR;
    }
    PG8_WAIT_V(0);
    PG8_BAR;
#undef PG8_SA
#undef PG8_SB
#undef PG8_STAGE
#undef PG8_STAGE2
#undef PG8_LDA
#undef PG8_LDB
#undef PG8_MMA
#undef PG8_WAIT_V
#undef PG8_WAIT_L
#undef PG8_BAR
#undef PG8_SCHED
}
}

#define XB_TMO      128
#define XB_XCNT(j)  (256  + 64 * (j))
#define XB_XSUB(j)  (1280 + 64 * (j))
#define XB_XGEN(j)  (2304 + 64 * (j))
#define XB_TOP      3328
#define XB_TOPGEN   3392
#define XCD_BAR_WORDS 3456
#define XB_SPIN_CAP (1u << 18)

__device__ __forceinline__ unsigned xb_ld(unsigned* p)              { return __hip_atomic_load(p, __ATOMIC_RELAXED, __HIP_MEMORY_SCOPE_AGENT); }
__device__ __forceinline__ unsigned xb_add(unsigned* p, unsigned v) { return __hip_atomic_fetch_add(p, v, __ATOMIC_RELAXED, __HIP_MEMORY_SCOPE_AGENT); }
__device__ __forceinline__ unsigned xb_xcc_id() { return (unsigned)__builtin_amdgcn_s_getreg((3 << 11) | 20) & 0xFu; }
#define XB_SPIN(cond, bar) do { unsigned _sp = 0; while (cond) { __builtin_amdgcn_s_sleep(1); \
    if ((++_sp & 255u) == 0u) { if (xb_ld(&(bar)[XB_TMO])) break; if (_sp > XB_SPIN_CAP) { atomicAdd(&(bar)[XB_TMO], 1u); break; } } } } while (0)

struct XcdBarrier { unsigned* bar; unsigned x; volatile LAS unsigned* st; };

__device__ __forceinline__ XcdBarrier xcd_barrier_post(unsigned* bar, volatile LAS unsigned* st) {
    XcdBarrier b; b.bar = bar; b.x = xb_xcc_id(); b.st = st;
    if (threadIdx.x == 0) (void)xb_add(&bar[XB_XCNT(b.x)], 1u);
    return b;
}
__device__ __forceinline__ void xcd_barrier_complete(unsigned* bar, unsigned x, unsigned& nloc, unsigned& nx) {
    const unsigned G = gridDim.x * gridDim.y * gridDim.z;
    unsigned sum, cnt, mine, sp = 0u;
    for (;;) {
        sum = 0u; cnt = 0u; mine = 0u;
#pragma unroll 1
        for (unsigned j = 0; j < 16; ++j) { const unsigned c = xb_ld(&bar[XB_XCNT(j)]); sum += c; cnt += (c > 0u) ? 1u : 0u; mine = (j == x) ? c : mine; }
        if (sum == G) break;
        __builtin_amdgcn_s_sleep(1);
        if ((++sp & 255u) == 0u) { if (xb_ld(&bar[XB_TMO])) break; if (sp > XB_SPIN_CAP) { atomicAdd(&bar[XB_TMO], 1u); break; } }
    }
    nloc = mine > 0u ? mine : 1u; nx = cnt > 0u ? cnt : 1u;
}
__device__ __forceinline__ void xcd_barrier(const XcdBarrier& b) {
    asm volatile("s_waitcnt vmcnt(0)" ::: "memory");
    __syncthreads();
    if (threadIdx.x == 0) {
        unsigned* bar = b.bar;
        __builtin_amdgcn_s_waitcnt(0);
        unsigned nloc = b.st[0], nx = b.st[1];
        if (nloc == 0u) { xcd_barrier_complete(bar, b.x, nloc, nx); b.st[0] = nloc; b.st[1] = nx; }
        const unsigned old = xb_add(&bar[XB_XSUB(b.x)], 1u);
        const unsigned gen = old / nloc;
        if (old + 1u == (gen + 1u) * nloc) {
            __builtin_amdgcn_fence(__ATOMIC_RELEASE, "agent");
            asm volatile("s_waitcnt vmcnt(0)" ::: "memory");
            const unsigned og = xb_add(&bar[XB_TOP], 1u);
            const unsigned tg = og / nx;
            if (og + 1u == (tg + 1u) * nx) xb_add(&bar[XB_TOPGEN], 1u);
            else XB_SPIN(xb_ld(&bar[XB_TOPGEN]) == tg, bar);
            __builtin_amdgcn_fence(__ATOMIC_ACQUIRE, "agent");
            xb_add(&bar[XB_XGEN(b.x)], 1u);
            asm volatile("s_waitcnt vmcnt(0)" ::: "memory");
        } else {
            XB_SPIN(xb_ld(&bar[XB_XGEN(b.x)]) == gen, bar);
            __builtin_amdgcn_fence(__ATOMIC_ACQUIRE, "agent");
            asm volatile("s_waitcnt vmcnt(0)" ::: "memory");
        }
    }
    __syncthreads();
}

constexpr int D = 1024, NBATCH = 2, SEQ = 16384, CTXL = 256;
constexpr int TL = NBATCH * SEQ, TC = NBATCH * CTXL, TT = TL + TC;
constexpr int INW = 3328;
constexpr int ZQ = 0, ZFF = 512, ZFB = 1024, ZV = 1536, ZG = 2048, ZXB = 2560, ZYB = 2816, ZU = 3072;
constexpr int NEXP = 256, TOPK = 8;
constexpr float EPS = 1e-6f;
constexpr int NWAVES = 8, NTHR = 512;
constexpr int CV_TILES = 257 * 48;
constexpr int CV_OUTP = 248 * 6;
constexpr int CV_ROUT = 126 * 10;
constexpr int HG_SLOTS = 130;
constexpr int LR_SLOTS = 260;
constexpr int MAXROWS = 364800;

constexpr size_t MiB = 1u << 20;
constexpr size_t WS_CTL = 0, CTL_ZERO_BYTES = 1 * MiB;
constexpr size_t WS_MOD = 1 * MiB;
constexpr size_t WS_TAB = 2 * MiB;
constexpr size_t TAB_FC = 0, TAB_FS = 32768, TAB_CS = 65536, TAB_LB = 81920  , TAB_LRUW = 86016  , TAB_LRUCL = 348160  , TAB_C256 = 352256  , TAB_S256 = 483328  ;
constexpr size_t WS_META = 3 * MiB;
constexpr size_t WS_WIN = 4 * MiB;
constexpr size_t WS_WOUT = 18 * MiB;
constexpr size_t WS_WR = 22 * MiB;
constexpr size_t WS_XC = 24 * MiB;
constexpr size_t WS_LRUC = 26 * MiB;
constexpr size_t LRUC_STRIDE = (size_t)2 * 2 * LR_SLOTS * 256 * 4;
constexpr size_t WS_SEL = 30 * MiB;
constexpr size_t SEL_STRIDE = (size_t)TT * 8 * 4;
constexpr size_t WS_ROWTOK = 34 * MiB;
constexpr size_t WS_HD = 36 * MiB;
constexpr size_t WS_LOGIT = 38 * MiB;
constexpr size_t WS_HB = 72 * MiB;
constexpr size_t WS_WEXP = 138 * MiB;
constexpr size_t WEXP_GU_BYTES = (size_t)257 * 512 * 1024;
constexpr size_t WS_HB8 = 340 * MiB;
constexpr size_t WS_BIG = 524 * MiB;
constexpr size_t WS_Z = WS_BIG;
constexpr size_t WS_MIX = WS_BIG + 212 * MiB;
constexpr size_t WS_HS = WS_BIG + 278 * MiB;
constexpr size_t WS_FA = WS_BIG + 410 * MiB;
constexpr size_t WS_GE = WS_BIG + 442 * MiB;
constexpr size_t WS_GK = WS_BIG + 508 * MiB;
constexpr size_t WS_HV = WS_BIG + 574 * MiB;
constexpr size_t WS_HBUF = WS_BIG;
constexpr size_t WS_Y = WS_BIG + 180 * MiB;
constexpr size_t WS_WEXP1 = 1104 * MiB;
constexpr size_t WS_END = WS_WEXP1 + (size_t)257 * 768 * 1024;
static_assert(WS_Y + (size_t)MAXROWS * 1024 <= WS_WEXP1 && WS_HV + (size_t)16 * 2 * HG_SLOTS * 256 * 4 <= WS_WEXP1 && WS_GK + (size_t)2 * TT * 512 * 2 <= WS_HV && WS_GE + (size_t)2 * TT * 512 * 2 <= WS_GK && WS_FA + (size_t)2 * 2 * 128 * 128 * 256 * 2 <= WS_GE, "overlay regions end below the second weight buffer");
static_assert(WS_Z + (size_t)TT * INW * 2 <= WS_MIX && WS_MIX + (size_t)TT * 1024 * 2 <= WS_HS && WS_HS + (size_t)16 * HG_SLOTS * 65536 <= WS_FA, "mixer overlay map");
static_assert(WS_HBUF + (size_t)MAXROWS * 256 * 2 <= WS_Y && WS_WEXP + (size_t)257 * 768 * 1024 <= WS_HB8 && WS_HB8 + (size_t)TT * 1024 <= WS_BIG && WS_HB + (size_t)TT * 2048 <= WS_WEXP, "moe overlay map");
constexpr int CW_BAR = 4096;
constexpr int CW_CVQ = 8192;
constexpr int CW_CNT = 16384;

constexpr int LDS_BYTES = 151552;
constexpr int MISC_OFF = 150528;

struct Args { const float* in[28]; float* out; unsigned char* ws; int ph_lo, ph_hi; };

typedef const float* cfptr;
#define CAS __attribute__((address_space(4)))
struct Frame {
    LAS unsigned char* lds;
    int tid, lane, wave, G;
    const CAS cfptr* in;
    float* out; unsigned char* ws;
};
#define F_X(F)      ((F).in[0])
#define F_C(F)      ((F).in[1])
#define F_CTX(F)    ((F).in[2])
#define F_CCTX(F)   ((F).in[3])

template <int CTRL> __device__ __forceinline__ float dpp_f(float v) { const int i = __builtin_bit_cast(int, v); return __builtin_bit_cast(float, __builtin_amdgcn_update_dpp(i, i, CTRL, 0xf, 0xf, false)); }
template <int CTRL> __device__ __forceinline__ int dpp_i(int v) { return __builtin_amdgcn_update_dpp(v, v, CTRL, 0xf, 0xf, false); }
__device__ __forceinline__ float rdlane_f(float v, int lane) { return __builtin_bit_cast(float, __builtin_amdgcn_readlane(__builtin_bit_cast(int, v), lane)); }
__device__ __forceinline__ float wave_sum(float v) {
    v += dpp_f<0xB1>(v); v += dpp_f<0x4E>(v); v += dpp_f<0x141>(v); v += dpp_f<0x140>(v);
    return (rdlane_f(v, 0) + rdlane_f(v, 16)) + (rdlane_f(v, 32) + rdlane_f(v, 48));
}
__device__ __forceinline__ float sigmoidf_(float z) { return __builtin_amdgcn_rcpf(1.f + __expf(-z)); }

__device__ __forceinline__ void transpose_item(const float* W, int ldw, int k0, int n0, bf16* WT, int ldk, int drow0, LAS float* scr, int lane) {
#pragma unroll 8
    for (int i = 0; i < 32; ++i) { const int kk = 2 * i + (lane >> 5); scr[kk * 33 + (lane & 31)] = W[(size_t)(k0 + kk) * ldw + n0 + (lane & 31)]; }
    LDS_WAIT();
    const int c = lane & 7;
#pragma unroll
    for (int j = 0; j < 4; ++j) { const int n = (lane >> 3) + 8 * j; const LAS float* s = scr + (8 * c) * 33 + n;
        u32x4 o; o.x = pk2(s[0 * 33], s[1 * 33]); o.y = pk2(s[2 * 33], s[3 * 33]); o.z = pk2(s[4 * 33], s[5 * 33]); o.w = pk2(s[6 * 33], s[7 * 33]);
        *(u32x4*)(WT + (size_t)(drow0 + n) * ldk + k0 + 8 * c) = o; }
    LDS_WAIT();
}

__device__ __forceinline__ void norm_row_bf16(const float* xrow, const float* gain, const float* scl, const float* sft, bf16* orow, int lane, unsigned char* o8 = nullptr) {
    f32x4 v[4]; float s = 0.f;
#pragma unroll
    for (int j = 0; j < 4; ++j) { v[j] = *(const f32x4*)(xrow + 4 * lane + 256 * j); s += (v[j].x * v[j].x + v[j].y * v[j].y) + (v[j].z * v[j].z + v[j].w * v[j].w); }
    const float rstd = rsqrtf(wave_sum(s) * (1.f / D) + EPS);
#pragma unroll
    for (int j = 0; j < 4; ++j) { const int c = 4 * lane + 256 * j;
        const f32x4 g = *(const f32x4*)(gain + c), sc = *(const f32x4*)(scl + c), sh = *(const f32x4*)(sft + c);
        const f32x4 y = v[j] * rstd * g * (sc + 1.f) + sh;
        u32x2 o; o.x = pk2(y.x, y.y); o.y = pk2(y.z, y.w); *(u32x2*)(orow + c) = o;
        if (o8) { int p8 = __builtin_amdgcn_cvt_pk_fp8_f32(__builtin_amdgcn_fmed3f(y.x, -448.f, 448.f), __builtin_amdgcn_fmed3f(y.y, -448.f, 448.f), 0, false);
            p8 = __builtin_amdgcn_cvt_pk_fp8_f32(__builtin_amdgcn_fmed3f(y.z, -448.f, 448.f), __builtin_amdgcn_fmed3f(y.w, -448.f, 448.f), p8, true); *(int*)(o8 + c) = p8; } }
}

__device__ __forceinline__ void convert_tile(Frame& F, const float* src, int ldw, bf16* dst, int ldk, int k0, int rowA, int rowB) {
    LAS bf16* T = (LAS bf16*)F.lds;
    const int tid = F.tid, w = F.wave, lane = F.lane;
    f32x4 v[8];
#pragma unroll
    for (int j = 0; j < 8; ++j) v[j] = *(const f32x4*)(src + (size_t)(8 * w + j) * ldw + 4 * lane);
#pragma unroll
    for (int j = 0; j < 8; ++j) { u32x2 o; o.x = pk2(v[j].x, v[j].y); o.y = pk2(v[j].z, v[j].w); *(LAS u32x2*)(T + (8 * w + j) * 264 + ((4 * lane) ^ (w << 3))) = o; }
    __syncthreads();
#pragma unroll
    for (int j = 0; j < 4; ++j) { const int p = tid + NTHR * j, kc = p & 7, n = p >> 3; const LAS bf16* t = T + (8 * kc) * 264 + (n ^ (kc << 3));
        u32x4 o; o.x = (unsigned)t[0] | ((unsigned)t[264] << 16); o.y = (unsigned)t[2 * 264] | ((unsigned)t[3 * 264] << 16);
        o.z = (unsigned)t[4 * 264] | ((unsigned)t[5 * 264] << 16); o.w = (unsigned)t[6 * 264] | ((unsigned)t[7 * 264] << 16);
        const int row = n < 128 ? rowA + n : rowB + n - 128;
        *(u32x4*)(dst + (size_t)row * ldk + k0 + 8 * kc) = o; }
    __syncthreads();
}

__device__ __forceinline__ void convert_tile8(Frame& F, const float* src, int ldw, unsigned char* dst8, int ldk, int k0, int rowA, int rowB, float scl) {
    LAS bf16* T = (LAS bf16*)F.lds;
    const int tid = F.tid, w = F.wave, lane = F.lane;
    f32x4 v[8];
#pragma unroll
    for (int j = 0; j < 8; ++j) v[j] = *(const f32x4*)(src + (size_t)(8 * w + j) * ldw + 4 * lane);
#pragma unroll
    for (int j = 0; j < 8; ++j) { const f32x4 q = v[j] * scl; u32x2 o; o.x = pk2(q.x, q.y); o.y = pk2(q.z, q.w); *(LAS u32x2*)(T + (8 * w + j) * 264 + ((4 * lane) ^ (w << 3))) = o; }
    __syncthreads();
#pragma unroll
    for (int j = 0; j < 4; ++j) { const int p = tid + NTHR * j, kc = p & 7, n = p >> 3; const LAS bf16* t = T + (8 * kc) * 264 + (n ^ (kc << 3));
        float f[8];
#pragma unroll
        for (int i = 0; i < 8; ++i) f[i] = __builtin_bit_cast(float, (unsigned)t[i * 264] << 16);
        int lo = __builtin_amdgcn_cvt_pk_fp8_f32(f[0], f[1], 0, false); lo = __builtin_amdgcn_cvt_pk_fp8_f32(f[2], f[3], lo, true);
        int hi = __builtin_amdgcn_cvt_pk_fp8_f32(f[4], f[5], 0, false); hi = __builtin_amdgcn_cvt_pk_fp8_f32(f[6], f[7], hi, true);
        const int row = n < 128 ? rowA + n : rowB + n - 128;
        u32x2 o; o.x = (unsigned)lo; o.y = (unsigned)hi;
        *(u32x2*)(dst8 + (size_t)row * ldk + k0 + 8 * kc) = o; }
    __syncthreads();
}

__device__ __forceinline__ void phase_g0(Frame& F) {
    float* mod = (float*)(F.ws + WS_MOD);
    {
        LAS float* sc = (LAS float*)F.lds; LAS float* red = sc + 3072;
        for (int u = blockIdx.x; u < 192; u += F.G) {
            const int l = u / 96, n0 = (u % 96) * 64;
            for (int i = F.tid; i < 3072; i += NTHR) { const int r = i >> 10, k = i & 1023; const float c = r < 2 ? F_C(F)[r * 1024 + k] : F_CCTX(F)[k]; sc[i] = c / (1.f + __expf(-c)); }
            __syncthreads();
            const int col = F.tid & 63, kg = F.tid >> 6;
            const float* W = F.in[4] + (size_t)l * 1024 * 6144 + n0 + col;
            float a0 = 0.f, a1 = 0.f, a2 = 0.f;
#pragma unroll 8
            for (int k = kg * 128; k < kg * 128 + 128; ++k) { const float w = W[(size_t)k * 6144]; a0 += sc[k] * w; a1 += sc[1024 + k] * w; a2 += sc[2048 + k] * w; }
            red[(kg * 3 + 0) * 64 + col] = a0; red[(kg * 3 + 1) * 64 + col] = a1; red[(kg * 3 + 2) * 64 + col] = a2;
            __syncthreads();
            if (F.tid < 192) { const int r = F.tid >> 6, cc = F.tid & 63; float s = F.in[5][l * 6144 + n0 + cc];
#pragma unroll
                for (int q = 0; q < 8; ++q) s += red[(q * 3 + r) * 64 + cc];
                mod[(l * 3 + r) * 6144 + n0 + cc] = s; }
            __syncthreads();
        }
    }
    {
        constexpr int PER_L = 16 * (13 + 4 + 1);
        for (int it = blockIdx.x; it < 2 * PER_L; it += F.G) {
            const int l = it / PER_L; int r = it % PER_L; const int kb = r / 18; r %= 18;
            if (r < 13) convert_tile(F, F.in[8] + (size_t)l * 1024 * INW + (size_t)(64 * kb) * INW + 256 * r, INW, (bf16*)(F.ws + WS_WIN) + (size_t)l * INW * 1024, 1024, 64 * kb, 256 * r, 256 * r + 128);
            else if (r < 17) convert_tile(F, F.in[18] + (size_t)l * 1024 * 1024 + (size_t)(64 * kb) * 1024 + 256 * (r - 13), 1024, (bf16*)(F.ws + WS_WOUT) + (size_t)l * 1024 * 1024, 1024, 64 * kb, 256 * (r - 13), 256 * (r - 13) + 128);
            else convert_tile(F, F.in[19] + (size_t)l * 1024 * 256 + (size_t)(64 * kb) * 256, 256, (bf16*)(F.ws + WS_WR) + (size_t)l * 256 * 1024, 1024, 64 * kb, 0, 128);
        }
    }
    {
        const int gt = blockIdx.x * NTHR + F.tid, NGT = F.G * NTHR;
        bf16* Fc = (bf16*)(F.ws + WS_TAB + TAB_FC); bf16* Fs = (bf16*)(F.ws + WS_TAB + TAB_FS); bf16* CS = (bf16*)(F.ws + WS_TAB + TAB_CS);
        for (int i = gt; i < 128 * 128; i += NGT) { const int k = i >> 7, n = i & 127; float s, c; sincospif((float)((k * n) & 127) * (1.f / 64.f), &s, &c); Fc[i] = f2bf(c); Fs[i] = f2bf(s); }
        for (int i = gt; i < 64 * 128; i += NGT) { const int m = i >> 7, kap = i & 127; float s, c; sincospif((float)((m * (kap & 63)) & 63) * (1.f / 32.f), &s, &c); CS[i] = f2bf(kap < 64 ? c : s); }
        bf16* C256 = (bf16*)(F.ws + WS_TAB + TAB_C256); bf16* S256 = (bf16*)(F.ws + WS_TAB + TAB_S256);
        for (int i = gt; i < 256 * 256; i += NGT) { const int k = i >> 8, n = i & 255; float sn, cs; sincospif((float)((k * n) & 255) * (1.f / 128.f), &sn, &cs); C256[i] = f2bf(cs); S256[i] = f2bf(-sn); }
        float* lb = (float*)(F.ws + WS_TAB + TAB_LB);
        for (int i = gt; i < 1024; i += NGT) { const int l = i >> 9, ch = i & 511; lb[i] = l == 0 ? 0.f : sigmoidf_(F.in[9][512 + ch] - F.in[9][ch]); }
        bf16* lw = (bf16*)(F.ws + WS_TAB + TAB_LRUW);
        for (int i = gt; i < 2 * 2 * 4 * 128 * 64; i += NGT) {
            const int k = i & 63, n = (i >> 6) & 127, ldh = i >> 13;
            const float v = n < 64 ? F.in[13][(size_t)ldh * 4096 + k * 64 + n] : F.in[15][(size_t)ldh * 4096 + k * 64 + (n - 64)];
            lw[i] = f2bf(v); }
        float* cl = (float*)(F.ws + WS_TAB + TAB_LRUCL);
        for (int i = gt; i < 1024; i += NGT) { const float lam = F.in[17][i]; const float sp = lam > 15.f ? __expf(-lam) : log1pf(__expf(-lam)); cl[i] = 8.f * sp; }
    }
}

__device__ __forceinline__ void hprep_rows(Frame& F, int l, const float* xlat, const float* xctx, int nrows, int voff_sh, int voff_sc, const float* gain, bool with8 = false) {
    const float* mod = (const float*)(F.ws + WS_MOD) + (size_t)l * 3 * 6144;
    bf16* HB = (bf16*)(F.ws + WS_HB);
    const int gw = blockIdx.x * NWAVES + F.wave, NGW = F.G * NWAVES;
    for (int m = gw; m < nrows; m += NGW) {
        const float* xr = m < TL ? xlat + (size_t)m * D : xctx + (size_t)(m - TL) * D; const int r = m < TL ? (m >> 14) : 2;
        norm_row_bf16(xr, gain, mod + r * 6144 + voff_sc, mod + r * 6144 + voff_sh, HB + (size_t)m * D, F.lane, with8 ? F.ws + WS_HB8 + (size_t)m * D : nullptr);
    }
}

__device__ __forceinline__ void cv_tile(Frame& F, int it_all) {
    const int l = it_all >= CV_TILES ? 1 : 0, it = it_all - l * CV_TILES;
    unsigned char* wb = F.ws + (l ? WS_WEXP1 : WS_WEXP);
    unsigned char* WGU = wb; unsigned char* WD = wb + WEXP_GU_BYTES;
    const int e = it / 48, t = it % 48;
    if (t < 32) {
        const int mat = t >> 4, kb = t & 15;
        const float* src = (e < 256 ? (mat == 0 ? F.in[21] : F.in[22]) + ((size_t)l * 256 + e) * 1024 * 256 : (mat == 0 ? F.in[24] : F.in[25]) + (size_t)l * 1024 * 256) + (size_t)(64 * kb) * 256;
        convert_tile8(F, src, 256, WGU, 1024, 64 * kb, e * 512 + mat * 128, e * 512 + 256 + mat * 128, 32.f);
    } else {
        const int kb = (t - 32) >> 2, nb = (t - 32) & 3;
        const float* src = (e < 256 ? F.in[23] + ((size_t)l * 256 + e) * 256 * 1024 : F.in[26] + (size_t)l * 256 * 1024) + (size_t)(64 * kb) * 1024 + 256 * nb;
        convert_tile8(F, src, 1024, WD, 256, 64 * kb, e * 1024 + 256 * nb, e * 1024 + 256 * nb + 128, 16.f);
    }
}
__device__ __forceinline__ int cv_pull(Frame& F) {
    volatile LAS int* slot = (volatile LAS int*)(F.lds + MISC_OFF) + 16;
    if (F.tid == 0) { const unsigned t = __hip_atomic_fetch_add((unsigned*)(F.ws + WS_CTL) + CW_CVQ, 1u, __ATOMIC_RELAXED, __HIP_MEMORY_SCOPE_AGENT); slot[0] = t < (unsigned)(2 * CV_TILES) ? (int)t : -1; }
    __syncthreads(); const int t = slot[0]; __syncthreads(); return t;
}
__device__ __forceinline__ void convert_experts(Frame& F, int l) {
    for (;;) { const int t = cv_pull(F); if (t < 0) break; cv_tile(F, t); if (t >= (l + 1) * CV_TILES) break; }
}

__device__ __forceinline__ void xcd_barrier_cv(const XcdBarrier& b, Frame& F) {
    volatile LAS unsigned* st = (volatile LAS unsigned*)(F.lds + MISC_OFF) + 20;
    asm volatile("s_waitcnt vmcnt(0)" ::: "memory");
    __syncthreads();
    if (threadIdx.x == 0) {
        unsigned* bar = b.bar;
        __builtin_amdgcn_s_waitcnt(0);
        unsigned nloc = b.st[0], nx = b.st[1];
        if (nloc == 0u) { xcd_barrier_complete(bar, b.x, nloc, nx); b.st[0] = nloc; b.st[1] = nx; }
        const unsigned old = xb_add(&bar[XB_XSUB(b.x)], 1u);
        const unsigned gen = old / nloc;
        if (old + 1u == (gen + 1u) * nloc) {
            __builtin_amdgcn_fence(__ATOMIC_RELEASE, "agent");
            asm volatile("s_waitcnt vmcnt(0)" ::: "memory");
            const unsigned og = xb_add(&bar[XB_TOP], 1u);
            const unsigned tg = og / nx;
            if (og + 1u == (tg + 1u) * nx) xb_add(&bar[XB_TOPGEN], 1u);
            else XB_SPIN(xb_ld(&bar[XB_TOPGEN]) == tg, bar);
            __builtin_amdgcn_fence(__ATOMIC_ACQUIRE, "agent");
            xb_add(&bar[XB_XGEN(b.x)], 1u);
            asm volatile("s_waitcnt vmcnt(0)" ::: "memory");
            st[0] = 0u;
        } else { st[0] = 1u; st[1] = gen; }
        st[2] = 0u;
    }
    __syncthreads();
    if (st[0]) {
        unsigned spins = 0u;
        for (;;) {
            int tile = -1;
            if (threadIdx.x == 0) {
                unsigned rel = xb_ld(&b.bar[XB_XGEN(b.x)]) != st[1] ? 1u : 0u;
                if (!rel && (++spins & 255u) == 0u) { if (xb_ld(&b.bar[XB_TMO])) rel = 1u; else if (spins > XB_SPIN_CAP) { atomicAdd(&b.bar[XB_TMO], 1u); rel = 1u; } }
                st[2] = rel;
                if (!rel && st[3] == 0u) { const unsigned t = __hip_atomic_fetch_add((unsigned*)(F.ws + WS_CTL) + CW_CVQ, 1u, __ATOMIC_RELAXED, __HIP_MEMORY_SCOPE_AGENT);
                    if (t < (unsigned)(2 * CV_TILES)) tile = (int)t; else st[3] = 1u; }
                st[4] = (unsigned)tile;
            }
            __syncthreads();
            const unsigned rel = st[2]; tile = (int)st[4];
            __syncthreads();
            if (rel) break;
            if (tile >= 0) cv_tile(F, tile); else __builtin_amdgcn_s_sleep(2);
        }
        if (threadIdx.x == 0) {
            st[3] = 0u;
            __builtin_amdgcn_fence(__ATOMIC_ACQUIRE, "agent");
            asm volatile("s_waitcnt vmcnt(0)" ::: "memory");
        }
    }
    __syncthreads();
}

constexpr int QS = 144, TS = 80;
constexpr int HG_QT = 0, HG_KT = 18432, HG_KTT = 36864, HG_VT = 57344, HG_SMT = 77824, HG_PM = 114688, HG_TOT = 124928, HG_BMID = 126976, HG_BEND = 127488, HG_RSS = 128000, HG_VR = 132096;
static_assert(HG_VR + 64 * QS * 2 <= MISC_OFF, "HGRN2 LDS map");

__device__ __forceinline__ float fast_rcp(float x) { return __builtin_amdgcn_rcpf(x); }
__device__ __forceinline__ f32x4 hg_ld4(const bf16* p) { const u32x2 v = *(const u32x2*)p;
    return (f32x4){__builtin_bit_cast(float, v.x << 16), __builtin_bit_cast(float, v.x & 0xffff0000u), __builtin_bit_cast(float, v.y << 16), __builtin_bit_cast(float, v.y & 0xffff0000u)}; }


template <int VAR>
__device__ __forceinline__ void hg_chunk_c1(Frame& F, const bf16* Zc, bf16* gq, bf16* gk, float* hv, const bf16* nz, const bf16* nq, const bool has_next, u32x4 (&zq)[4], int h, int rev, const float* lbp, f32x4 (&S)[8], float& dtot) {
    LAS bf16* Qt = (LAS bf16*)(F.lds + HG_QT); LAS bf16* Kt = (LAS bf16*)(F.lds + HG_KT); LAS bf16* KtT = (LAS bf16*)(F.lds + HG_KTT);
    LAS bf16* VT = (LAS bf16*)(F.lds + HG_VT); LAS bf16* Vr = (LAS bf16*)(F.lds + HG_VR);
    LAS float* tot = (LAS float*)(F.lds + HG_TOT); LAS float* bmid = (LAS float*)(F.lds + HG_BMID); LAS float* bend = (LAS float*)(F.lds + HG_BEND);
    LAS float* ebuf = (LAS float*)(F.lds + HG_RSS);
    const int tid = F.tid, lane = F.lane, w = F.wave, li = lane & 15, lq = lane >> 4;
    u32x4 vv[2];
#pragma unroll
    for (int j = 0; j < 2; ++j) { const int p = tid + NTHR * j, row = p >> 4, c16 = p & 15;
        vv[j] = *(const u32x4*)(Zc + (size_t)row * INW + ZV + h * 128 + 8 * c16);
        *(LAS u32x4*)(Kt + row * QS + 8 * c16) = zq[j]; *(LAS u32x4*)(Qt + row * QS + 8 * c16) = zq[2 + j]; }
    LDS_BARRIER();
    const int ch = tid & 127, tq = tid >> 7;
    const float lbv = lbp[h * 128 + ch], oml = 1.f - lbv;
    float cb[16];
#pragma unroll
    for (int i = 0; i < 16; ++i) { float z = bf2f(Kt[(16 * tq + i) * QS + ch]); z = fminf(fmaxf(z, -30.f), 30.f);
        if (VAR & 1) cb[i] = z * -0.01f; else { const float e = __expf(-z), sg = fast_rcp(1.f + e); cb[i] = __logf(lbv + oml * sg);
            Kt[(16 * tq + i) * QS + ch] = f2bf(oml * e * sg); } }
    if (tq == 2) bmid[ch] = cb[0];
    float run = 0.f;
    if (!rev) {
#pragma unroll
        for (int i = 0; i < 16; ++i) { run += cb[i]; cb[i] = run; }
    } else {
#pragma unroll
        for (int i = 15; i >= 0; --i) { run += cb[i]; cb[i] = run; }
    }
    tot[tq * 128 + ch] = run;
#pragma unroll
    for (int j = 0; j < 2; ++j) { const int p = tid + NTHR * j, row = p >> 4, c16 = p & 15; *(LAS u32x4*)(Vr + row * QS + 8 * c16) = vv[j]; }
    LDS_BARRIER();
    float bm, total;
    {
        const float t0 = tot[ch], t1 = tot[128 + ch], t2 = tot[256 + ch], t3 = tot[384 + ch];
        const float off = !rev ? ((tq > 0 ? t0 : 0.f) + (tq > 1 ? t1 : 0.f) + (tq > 2 ? t2 : 0.f)) : ((tq < 3 ? t3 : 0.f) + (tq < 2 ? t2 : 0.f) + (tq < 1 ? t1 : 0.f));
#pragma unroll
        for (int i = 0; i < 16; ++i) cb[i] += off;
        total = (t0 + t1) + (t2 + t3);
        bm = !rev ? (t0 + t1) + bmid[ch] : (t2 + t3);
        if (tq == 0) dtot += total;
    }
    if (!(VAR & 2)) {
        unsigned kp[8], vp[8];
#pragma unroll
        for (int i = 0; i < 16; ++i) { const float d = fminf(fmaxf(cb[i] - bm, -80.f), 80.f);
            const float ed = __expf(d);
            Qt[(16 * tq + i) * QS + ch] = f2bf(bf2f(Qt[(16 * tq + i) * QS + ch]) * ed);
            const unsigned kb = f2bfu(bf2f(Kt[(16 * tq + i) * QS + ch]) * fast_rcp(ed)); Kt[(16 * tq + i) * QS + ch] = (bf16)kb;
            const unsigned vb = Vr[(16 * tq + i) * QS + ch];
            if (i & 1) { kp[i >> 1] |= kb << 16; vp[i >> 1] |= vb << 16; } else { kp[i >> 1] = kb; vp[i >> 1] = vb; } }
        *(LAS u32x4*)(KtT + ch * TS + 16 * tq) = (u32x4){kp[0], kp[1], kp[2], kp[3]};
        *(LAS u32x4*)(KtT + ch * TS + 16 * tq + 8) = (u32x4){kp[4], kp[5], kp[6], kp[7]};
        *(LAS u32x4*)(VT + ch * TS + 16 * tq) = (u32x4){vp[0], vp[1], vp[2], vp[3]};
        *(LAS u32x4*)(VT + ch * TS + 16 * tq + 8) = (u32x4){vp[4], vp[5], vp[6], vp[7]};
        if (tid < 128) { const float e1 = __expf(bm), e2 = __expf(total - bm); hv[tid] = e1; hv[128 + tid] = e2; ebuf[tid] = e1; ebuf[128 + tid] = e2; }
    }
    if (has_next) {
#pragma unroll
        for (int j = 0; j < 2; ++j) { const int p = tid + NTHR * j, row = p >> 4, c16 = p & 15;
            zq[j] = *(const u32x4*)(nz + (size_t)row * INW + 8 * c16); zq[2 + j] = *(const u32x4*)(nq + (size_t)row * INW + 8 * c16); }
    }
    LDS_BARRIER();
    if (!(VAR & 4))
#pragma unroll
    for (int j = 0; j < 2; ++j) { const int p = tid + NTHR * j, row = p >> 4, c16 = p & 15;
        *(u32x4*)(gq + (size_t)row * 512 + 8 * c16) = *(const LAS u32x4*)(Qt + row * QS + 8 * c16);
        *(u32x4*)(gk + (size_t)row * 512 + 8 * c16) = *(const LAS u32x4*)(Kt + row * QS + 8 * c16); }
    if (!(VAR & 8)) {
#pragma unroll
    for (int i = 0; i < 8; ++i) S[i] = S[i] * *(const LAS f32x4*)(ebuf + 16 * i + 4 * lq);
    bf16x8 bv[2];
#pragma unroll
    for (int ks = 0; ks < 2; ++ks) bv[ks] = *(const LAS bf16x8*)(VT + (16 * w + li) * TS + 32 * ks + 8 * lq);
    bf16x8 ak[2][2];
#pragma unroll
    for (int ks = 0; ks < 2; ++ks) ak[0][ks] = *(const LAS bf16x8*)(KtT + li * TS + 32 * ks + 8 * lq);
#pragma unroll
    for (int i = 0; i < 8; ++i) { const int cb_ = i & 1;
        if (i < 7) {
#pragma unroll
            for (int ks = 0; ks < 2; ++ks) ak[cb_ ^ 1][ks] = *(const LAS bf16x8*)(KtT + (16 * (i + 1) + li) * TS + 32 * ks + 8 * lq); }
        __builtin_amdgcn_sched_barrier(0);
#pragma unroll
        for (int ks = 0; ks < 2; ++ks) S[i] = MFMA16(ak[cb_][ks], bv[ks], S[i]);
        S[i] = S[i] * *(const LAS f32x4*)(ebuf + 128 + 16 * i + 4 * lq); }
    }
    LDS_BARRIER();
}

struct HgPtrs { const bf16* q; const bf16* k; const bf16* v; const float* hv; };
__device__ __forceinline__ void hg_load6(const HgPtrs& P, int tid, u32x4 (&pre)[7]) {
    pre[6] = *(const u32x4*)(P.hv + 4 * (tid & 63));
#pragma unroll
    for (int j = 0; j < 2; ++j) { const int p = tid + NTHR * j, row = p >> 4, c16 = p & 15;
        pre[j] = *(const u32x4*)(P.q + (size_t)row * 512 + 8 * c16); pre[2 + j] = *(const u32x4*)(P.k + (size_t)row * 512 + 8 * c16); pre[4 + j] = *(const u32x4*)(P.v + (size_t)row * INW + 8 * c16); }
}
template <int VAR>
__device__ __forceinline__ void hg_chunk_c3(Frame& F, const u32x4 (&cur)[7], int rev, f32x4 (&S)[8], f32x4 (&O)[4], bool do_state, const bf16* Snext) {
    LAS bf16* Qt = (LAS bf16*)(F.lds + HG_QT); LAS bf16* Kt = (LAS bf16*)(F.lds + HG_KT); LAS bf16* KtT = (LAS bf16*)(F.lds + HG_KTT);
    LAS bf16* VT = (LAS bf16*)(F.lds + HG_VT); LAS bf16* SmT = (LAS bf16*)(F.lds + HG_SMT); LAS bf16* Pm = (LAS bf16*)(F.lds + HG_PM); LAS bf16* Vr = (LAS bf16*)(F.lds + HG_VR);
    const int tid = F.tid, lane = F.lane, w = F.wave, li = lane & 15, lq = lane >> 4;
#pragma unroll
    for (int j = 0; j < 2; ++j) { const int p = tid + NTHR * j, row = p >> 4, c16 = p & 15;
        *(LAS u32x4*)(Qt + row * QS + 8 * c16) = cur[j]; *(LAS u32x4*)(Kt + row * QS + 8 * c16) = cur[2 + j]; *(LAS u32x4*)(Vr + row * QS + 8 * c16) = cur[4 + j]; }
    LAS float* ebuf = (LAS float*)(F.lds + HG_BMID);
    if (tid < 64) *(LAS u32x4*)(ebuf + 4 * tid) = cur[6];
    LDS_BARRIER();
    if (!(VAR & 2)) {
        const int ch = tid & 127, tq = tid >> 7; unsigned kp[8], vp[8];
#pragma unroll
        for (int i = 0; i < 16; ++i) { const unsigned vb = Vr[(16 * tq + i) * QS + ch], kb = do_state ? (unsigned)Kt[(16 * tq + i) * QS + ch] : 0u;
            if (i & 1) { kp[i >> 1] |= kb << 16; vp[i >> 1] |= vb << 16; } else { kp[i >> 1] = kb; vp[i >> 1] = vb; } }
        *(LAS u32x4*)(VT + ch * TS + 16 * tq) = (u32x4){vp[0], vp[1], vp[2], vp[3]};
        *(LAS u32x4*)(VT + ch * TS + 16 * tq + 8) = (u32x4){vp[4], vp[5], vp[6], vp[7]};
        if (do_state) { *(LAS u32x4*)(KtT + ch * TS + 16 * tq) = (u32x4){kp[0], kp[1], kp[2], kp[3]}; *(LAS u32x4*)(KtT + ch * TS + 16 * tq + 8) = (u32x4){kp[4], kp[5], kp[6], kp[7]}; }
    }
#pragma unroll
    for (int i = 0; i < 8; ++i) { S[i] = S[i] * *(const LAS f32x4*)(ebuf + 16 * i + 4 * lq);
        u32x2 o; o.x = pk2(S[i].x, S[i].y); o.y = pk2(S[i].z, S[i].w); *(LAS u32x2*)(SmT + (16 * w + li) * QS + 16 * i + 4 * lq) = o; }
    if (Snext) {
#pragma unroll
        for (int i = 0; i < 8; ++i) S[i] = hg_ld4(Snext + (16 * w + li) * 128 + 16 * i + 4 * lq);
    }
    if (!(VAR & 4)) {
        const int tt = w >> 1;
        bf16x8 aq[4];
#pragma unroll
        for (int ks = 0; ks < 4; ++ks) aq[ks] = *(const LAS bf16x8*)(Qt + (16 * tt + li) * QS + 32 * ks + 8 * lq);
#pragma unroll
        for (int sj = 0; sj < 2; ++sj) { const int st = 2 * (w & 1) + sj; f32x4 acc = {0.f, 0.f, 0.f, 0.f};
#pragma unroll
            for (int ks = 0; ks < 4; ++ks) acc = MFMA16(aq[ks], *(const LAS bf16x8*)(Kt + (16 * st + li) * QS + 32 * ks + 8 * lq), acc);
#pragma unroll
            for (int r = 0; r < 4; ++r) { const int t = 16 * tt + 4 * lq + r, s = 16 * st + li; const bool keep = rev ? (s >= t) : (s <= t);
                Pm[t * TS + s] = f2bf(keep ? acc[r] : 0.f); } }
    }
    LDS_BARRIER();
    if (!(VAR & 8)) {
    bf16x8 bs[4], bv[2];
#pragma unroll
    for (int ks = 0; ks < 4; ++ks) bs[ks] = *(const LAS bf16x8*)(SmT + (16 * w + li) * QS + 32 * ks + 8 * lq);
#pragma unroll
    for (int ks = 0; ks < 2; ++ks) bv[ks] = *(const LAS bf16x8*)(VT + (16 * w + li) * TS + 32 * ks + 8 * lq);
    {
        bf16x8 aq[2][4], ap[2][2];
#pragma unroll
        for (int ks = 0; ks < 4; ++ks) aq[0][ks] = *(const LAS bf16x8*)(Qt + li * QS + 32 * ks + 8 * lq);
#pragma unroll
        for (int ks = 0; ks < 2; ++ks) ap[0][ks] = *(const LAS bf16x8*)(Pm + li * TS + 32 * ks + 8 * lq);
#pragma unroll
        for (int mt = 0; mt < 4; ++mt) { const int cb_ = mt & 1;
            if (mt < 3) {
#pragma unroll
                for (int ks = 0; ks < 4; ++ks) aq[cb_ ^ 1][ks] = *(const LAS bf16x8*)(Qt + (16 * (mt + 1) + li) * QS + 32 * ks + 8 * lq);
#pragma unroll
                for (int ks = 0; ks < 2; ++ks) ap[cb_ ^ 1][ks] = *(const LAS bf16x8*)(Pm + (16 * (mt + 1) + li) * TS + 32 * ks + 8 * lq); }
            __builtin_amdgcn_sched_barrier(0);
#pragma unroll
            for (int ks = 0; ks < 4; ++ks) O[mt] = MFMA16(aq[cb_][ks], bs[ks], O[mt]);
#pragma unroll
            for (int ks = 0; ks < 2; ++ks) O[mt] = MFMA16(ap[cb_][ks], bv[ks], O[mt]);
        }
    }
    __builtin_amdgcn_sched_barrier(0);
    if (do_state) {
        bf16x8 ak[2][2];
#pragma unroll
        for (int ks = 0; ks < 2; ++ks) ak[0][ks] = *(const LAS bf16x8*)(KtT + li * TS + 32 * ks + 8 * lq);
#pragma unroll
        for (int i = 0; i < 8; ++i) { const int cb_ = i & 1;
            if (i < 7) {
#pragma unroll
                for (int ks = 0; ks < 2; ++ks) ak[cb_ ^ 1][ks] = *(const LAS bf16x8*)(KtT + (16 * (i + 1) + li) * TS + 32 * ks + 8 * lq); }
            __builtin_amdgcn_sched_barrier(0);
#pragma unroll
            for (int ks = 0; ks < 2; ++ks) S[i] = MFMA16(ak[cb_][ks], bv[ks], S[i]);
            S[i] = S[i] * *(const LAS f32x4*)(ebuf + 128 + 16 * i + 4 * lq); }
    }
    }
    LDS_BARRIER();
}

__device__ __forceinline__ int hg_rowbase(int b, int slot) { return slot < 2 ? TL + b * CTXL + slot * 128 : b * SEQ + (slot - 2) * 128; }

template <int VAR>
__device__ __forceinline__ void hgrn2_c1(Frame& F, int l, int u0, int nunits, int G) {
    const bf16* Z = (const bf16*)(F.ws + WS_Z); const float* lbp = (const float*)(F.ws + WS_TAB + TAB_LB) + l * 512;
    bf16* GQ = (bf16*)(F.ws + WS_GE); bf16* GK = (bf16*)(F.ws + WS_GK); float* HV = (float*)(F.ws + WS_HV);
    if (u0 >= nunits) return;
    u32x4 zq[4];
    {   const int chain = u0 / HG_SLOTS, slot = u0 % HG_SLOTS, dir = chain & 1, b = chain >> 3, h = (chain >> 1) & 3;
        const bf16* zp = Z + (size_t)(hg_rowbase(b, slot) + (dir ? 64 : 0)) * INW;
#pragma unroll
        for (int j = 0; j < 2; ++j) { const int p = F.tid + NTHR * j, row = p >> 4, c16 = p & 15;
            zq[j] = *(const u32x4*)(zp + (size_t)row * INW + (dir ? ZFB : ZFF) + h * 128 + 8 * c16); zq[2 + j] = *(const u32x4*)(zp + (size_t)row * INW + ZQ + h * 128 + 8 * c16); } }
#pragma unroll 1
    for (int u = u0; u < nunits; u += G) {
        const int chain = u / HG_SLOTS, slot = u % HG_SLOTS, dir = chain & 1, b = chain >> 3, h = (chain >> 1) & 3;
        const int row0 = hg_rowbase(b, slot), zcol = (dir ? ZFB : ZFF) + h * 128;
        const int un = u + G; const bool has_nu = un < nunits;
        const int nchain = un / HG_SLOTS, nslot = un % HG_SLOTS, ndir = nchain & 1, nb = nchain >> 3, nh = (nchain >> 1) & 3;
        const bf16* nup = Z + (size_t)(hg_rowbase(nb, nslot) + (ndir ? 64 : 0)) * INW;
        f32x4 S[8]; float dtot = 0.f;
#pragma unroll
        for (int i = 0; i < 8; ++i) S[i] = (f32x4){0.f, 0.f, 0.f, 0.f};
#pragma unroll 1
        for (int step = 0; step < 2; ++step) { const int c = dir ? 1 - step : step; const size_t rowc = (size_t)(row0 + 64 * c);
            const bf16* nrow = step == 0 ? Z + (size_t)(row0 + 64 * (1 - c)) * INW : nup;
            const bf16* nz = nrow + (step == 0 ? zcol : (ndir ? ZFB : ZFF) + nh * 128); const bf16* nq = nrow + ZQ + (step == 0 ? h : nh) * 128;
            hg_chunk_c1<VAR>(F, Z + rowc * INW, GQ + ((size_t)dir * TT + rowc) * 512 + h * 128, GK + ((size_t)dir * TT + rowc) * 512 + h * 128,
                        HV + ((size_t)chain * (2 * HG_SLOTS) + slot * 2 + c) * 256, nz, nq, step == 0 || has_nu, zq, h, dir, lbp, S, dtot); }
        bf16* HS = (bf16*)(F.ws + WS_HS) + ((size_t)chain * HG_SLOTS + slot) * 16384;
        const int li = F.lane & 15, lq = F.lane >> 4, v = 16 * F.wave + li;
#pragma unroll
        for (int i = 0; i < 8; ++i) { u32x2 o; o.x = pk2(S[i].x, S[i].y); o.y = pk2(S[i].z, S[i].w); *(u32x2*)(HS + v * 128 + 16 * i + 4 * lq) = o; }
        if (F.tid < 128) ((float*)(F.ws + WS_HD))[((size_t)chain * HG_SLOTS + slot) * 128 + F.tid] = __expf(dtot);
    }
}

__device__ __forceinline__ void hgrn2_c2(Frame& F) {
    bf16* HS = (bf16*)(F.ws + WS_HS); const float* HD = (const float*)(F.ws + WS_HD);
    constexpr int CB = 13;
    static_assert(HG_SLOTS % (2 * CB) == 0, "batching");
    for (int task = blockIdx.x * NTHR + F.tid; task < 16 * 8192; task += F.G * NTHR) {
        const int chain = task >> 13, e2 = task & 8191, dir = chain & 1, ch2 = (e2 & 63) * 2;
        unsigned* hs = (unsigned*)(HS + (size_t)chain * HG_SLOTS * 16384 + e2 * 2); const float* hd = HD + (size_t)chain * HG_SLOTS * 128 + ch2;
        f32x2 run = {0.f, 0.f};
        unsigned tA[CB], tB[CB]; f32x2 dA[CB], dB[CB];
#define C2_SLOT(k) (dir ? ((k) < 2 ? 1 - (k) : 131 - (k)) : (k))
#define C2_LOAD(t_, d_, k0) _Pragma("unroll") for (int j = 0; j < CB; ++j) { const int slot = C2_SLOT((k0) + j); t_[j] = hs[(size_t)slot * 8192]; d_[j] = *(const f32x2*)(hd + (size_t)slot * 128); }
#define C2_SCAN(t_, d_, k0) _Pragma("unroll") for (int j = 0; j < CB; ++j) { const int slot = C2_SLOT((k0) + j); const f32x2 tmp = {__builtin_bit_cast(float, t_[j] << 16), __builtin_bit_cast(float, t_[j] & 0xffff0000u)}; \
            hs[(size_t)slot * 8192] = pk2(run.x, run.y); run = d_[j] * run + tmp; }
        C2_LOAD(tA, dA, 0)
#pragma unroll 1
        for (int k0 = 0; k0 < HG_SLOTS; k0 += 2 * CB) {
            C2_LOAD(tB, dB, k0 + CB)
            C2_SCAN(tA, dA, k0)
            if (k0 + 2 * CB < HG_SLOTS) { C2_LOAD(tA, dA, k0 + 2 * CB) }
            C2_SCAN(tB, dB, k0 + CB)
        }
#undef C2_SLOT
#undef C2_LOAD
#undef C2_SCAN
    }
}

template <int VAR>
__device__ __forceinline__ void hgrn2_c3(Frame& F, int l, int bh, int slot) {
    const int b = bh >> 2, h = bh & 3;
    const bf16* Z = (const bf16*)(F.ws + WS_Z);
    const bf16* GQ = (const bf16*)(F.ws + WS_GE); const bf16* GK = (const bf16*)(F.ws + WS_GK); const float* HV = (const float*)(F.ws + WS_HV);
    bf16* MIX = (bf16*)(F.ws + WS_MIX);
    const int row0 = hg_rowbase(b, slot);
    const int tid = F.tid, lane = F.lane, w = F.wave, li = lane & 15, lq = lane >> 4, v = 16 * w + li;
    u32x4 pa[7], pb[7];
    const float* HVf = HV + ((size_t)(bh * 2 + 0) * (2 * HG_SLOTS) + slot * 2) * 256; const float* HVb = HV + ((size_t)(bh * 2 + 1) * (2 * HG_SLOTS) + slot * 2) * 256;
    {   const size_t r0 = (size_t)row0, r1 = (size_t)(row0 + 64);
        HgPtrs P0{GQ + r0 * 512 + h * 128, GK + r0 * 512 + h * 128, Z + r0 * INW + ZV + h * 128, HVf};
        HgPtrs P1{GQ + r1 * 512 + h * 128, GK + r1 * 512 + h * 128, Z + r1 * INW + ZV + h * 128, HVf + 256};
        hg_load6(P0, tid, pa); hg_load6(P1, tid, pb); }
    if (tid < 32) *(LAS f32x4*)((LAS float*)(F.lds + HG_RSS) + 4 * tid) = *(const f32x4*)(F.in[10] + l * 128 + 4 * tid);
    f32x4 S[8];
    const bf16* HSb = (const bf16*)(F.ws + WS_HS) + ((size_t)(bh * 2 + 1) * HG_SLOTS + slot) * 16384;
    {   const bf16* HSf = (const bf16*)(F.ws + WS_HS) + ((size_t)(bh * 2 + 0) * HG_SLOTS + slot) * 16384;
#pragma unroll
        for (int i = 0; i < 8; ++i) S[i] = hg_ld4(HSf + v * 128 + 16 * i + 4 * lq); }
    f32x4 O[2][4];
#pragma unroll
    for (int c = 0; c < 2; ++c)
#pragma unroll
        for (int mt = 0; mt < 4; ++mt) O[c][mt] = (f32x4){0.f, 0.f, 0.f, 0.f};
#pragma unroll 1
    for (int st = 0; st < 4; ++st) {
        const int dir = st >> 1, c = (st == 1 || st == 2) ? 1 : 0;
        u32x4 cur[7];
#pragma unroll
        for (int j = 0; j < 7; ++j) { cur[j] = pa[j]; pa[j] = pb[j]; }
        if ((VAR & 1)) { } else if (st < 2) {
            const size_t rn = (size_t)(row0 + (st == 0 ? 64 : 0));
            HgPtrs Pn{GQ + ((size_t)TT + rn) * 512 + h * 128, GK + ((size_t)TT + rn) * 512 + h * 128, Z + rn * INW + ZV + h * 128, HVb + (st == 0 ? 256 : 0)};
            hg_load6(Pn, tid, pb);
        } else if (st == 2) {
#pragma unroll
            for (int j = 0; j < 4; ++j) pb[j] = *(const u32x4*)(Z + (size_t)(row0 + (tid >> 2)) * INW + ZG + h * 128 + 32 * (tid & 3) + 8 * j);
        }
        hg_chunk_c3<VAR>(F, cur, dir, S, O[0], (st & 1) == 0, st == 1 ? HSb : nullptr);
        if ((st & 1) == 0) {
#pragma unroll
            for (int mt = 0; mt < 4; ++mt) { const f32x4 t = O[0][mt]; O[0][mt] = O[1][mt]; O[1][mt] = t; }
        }
    }
    if (VAR & 16) { if (O[0][0][0] == 123.456f && O[1][3][2] == 1.f && S[0][0] == 2.f) MIX[0] = 1; return; }
    LAS float* Ot = (LAS float*)F.lds;
#pragma unroll
    for (int c = 0; c < 2; ++c)
#pragma unroll
        for (int mt = 0; mt < 4; ++mt)
#pragma unroll
            for (int r = 0; r < 4; ++r) Ot[(64 * c + 16 * mt + 4 * lq + r) * 132 + v] = O[c][mt][r];
    LDS_BARRIER();
    {   const int t = tid >> 2, v0 = 32 * (tid & 3);
        f32x4 x[8]; float ss = 0.f;
#pragma unroll
        for (int j = 0; j < 8; ++j) { x[j] = *(const LAS f32x4*)(Ot + t * 132 + v0 + 4 * j); ss += (x[j].x * x[j].x + x[j].y * x[j].y) + (x[j].z * x[j].z + x[j].w * x[j].w); }
        ss += dpp_f<0xB1>(ss); ss += dpp_f<0x4E>(ss);
        const float rs = rsqrtf(ss * (1.f / 128.f) + EPS);
        const LAS float* gain = (const LAS float*)(F.lds + HG_RSS) + v0;
#pragma unroll
        for (int k = 0; k < 4; ++k) { const u32x4 gq = pb[k]; const f32x4 g0 = *(const LAS f32x4*)(gain + 8 * k), g1 = *(const LAS f32x4*)(gain + 8 * k + 4);
            float o[8];
#pragma unroll
            for (int e = 0; e < 4; ++e) { const unsigned gw = e == 0 ? gq.x : e == 1 ? gq.y : e == 2 ? gq.z : gq.w;
                const float ga = __builtin_bit_cast(float, gw << 16), gb = __builtin_bit_cast(float, gw & 0xffff0000u);
                const float xa = e < 2 ? x[2 * k][2 * e] : x[2 * k + 1][2 * e - 4], xb = e < 2 ? x[2 * k][2 * e + 1] : x[2 * k + 1][2 * e - 3];
                const float na = e < 2 ? g0[2 * e] : g1[2 * e - 4], nb = e < 2 ? g0[2 * e + 1] : g1[2 * e - 3];
                o[2 * e] = xa * rs * na * ga * fast_rcp(1.f + __expf(-ga)); o[2 * e + 1] = xb * rs * nb * gb * fast_rcp(1.f + __expf(-gb)); }
            *(u32x4*)(MIX + (size_t)(row0 + t) * 1024 + h * 128 + v0 + 8 * k) = (u32x4){pk2(o[0], o[1]), pk2(o[2], o[3]), pk2(o[4], o[5]), pk2(o[6], o[7])}; }
    }
    LDS_BARRIER();
}

constexpr int LR_XR = 0, LR_XB = 35376, LR_HS = 69632;

__device__ __forceinline__ int lru_row(bool isctx, int b, int p) { return isctx ? TL + b * CTXL + p : b * SEQ + ((p & 255) << 6) + (p >> 8); }

template <bool FINAL>
__device__ __forceinline__ void lru_unit(Frame& F, int l, int b, int slot) {
    const bool isctx = slot < 4; const int p0 = isctx ? slot * 64 : (slot - 4) * 64, L = isctx ? CTXL : SEQ;
    const bf16* Z = (const bf16*)(F.ws + WS_Z);
    LAS bf16* Xr = (LAS bf16*)(F.lds + LR_XR); LAS bf16* XB = (LAS bf16*)(F.lds + LR_XB); LAS float* Hs = (LAS float*)(F.lds + LR_HS);
    const int tid = F.tid, lane = F.lane, w = F.wave, li = lane & 15, lq = lane >> 4;
    {   u32x4 v[5];
#pragma unroll
        for (int j = 0; j < 5; ++j) { const int idx = tid + NTHR * j, rr = idx >> 5, c16 = idx & 31, p = p0 - 2 + rr; v[j] = (u32x4){0u, 0u, 0u, 0u};
            if (idx < 67 * 32 && p >= 0 && p < L) v[j] = *(const u32x4*)(Z + (size_t)lru_row(isctx, b, p) * INW + ZXB + 8 * c16); }
#pragma unroll
        for (int j = 0; j < 5; ++j) { const int idx = tid + NTHR * j, rr = idx >> 5, c16 = idx & 31; if (idx < 67 * 32) *(LAS u32x4*)(Xr + rr * 264 + 8 * c16) = v[j]; } }
    LDS_BARRIER();
    {   const int ch = tid & 255, ph = tid >> 8;
        const float* cw = F.in[11] + (size_t)l * 4 * 256; const float w0 = cw[ch], w1 = cw[256 + ch], w2 = cw[512 + ch], w3 = cw[768 + ch], cb = F.in[12][l * 256 + ch];
        float x0 = bf2f(Xr[(32 * ph + 0) * 264 + ch]), x1 = bf2f(Xr[(32 * ph + 1) * 264 + ch]), x2 = bf2f(Xr[(32 * ph + 2) * 264 + ch]);
#pragma unroll 8
        for (int p = 32 * ph; p < 32 * ph + 32; ++p) { const float x3 = bf2f(Xr[(p + 3) * 264 + ch]);
            XB[p * 264 + ch] = f2bf(cb + w0 * x0 + w1 * x1 + w2 * x2 + w3 * x3); x0 = x1; x1 = x2; x2 = x3; } }
    LDS_BARRIER();
    {
        const int hh = w >> 1;
        float* LA = (float*)(F.ws + WS_LRUC); float* LH = (float*)(F.ws + WS_LRUC + LRUC_STRIDE); const float* LI = (const float*)(F.ws + WS_LRUC + 2 * LRUC_STRIDE);
        float hsum[4][4];
        bf16x8 nbr[2], nbi[2]; float nba, nbx, ncl, nC;
#define LRU_FETCH(itn) do { const int jn_ = 2 * (w & 1) + ((itn) >> 1), d_ = (itn) & 1, ch_ = hh * 64 + 16 * jn_ + li; \
            const bf16* Wl_ = (const bf16*)(F.ws + WS_TAB + TAB_LRUW) + ((size_t)((l * 2 + d_) * 4 + hh) * 128) * 64; \
            _Pragma("unroll") for (int ks = 0; ks < 2; ++ks) { nbr[ks] = *(const bf16x8*)(Wl_ + (16 * jn_ + li) * 64 + 32 * ks + 8 * lq); nbi[ks] = *(const bf16x8*)(Wl_ + (64 + 16 * jn_ + li) * 64 + 32 * ks + 8 * lq); } \
            nba = F.in[14][(l * 2 + d_) * 256 + ch_]; nbx = F.in[16][(l * 2 + d_) * 256 + ch_]; ncl = ((const float*)(F.ws + WS_TAB + TAB_LRUCL))[(l * 2 + d_) * 256 + ch_]; \
            nC = FINAL ? LI[((size_t)(b * 2 + d_) * LR_SLOTS + slot) * 256 + ch_] : 0.f; } while (0)
        LRU_FETCH(0);
#pragma unroll 1
        for (int it = 0; it < 4; ++it) {
            const int jn = 2 * (w & 1) + (it >> 1), d = it & 1;
            const int ch = hh * 64 + 16 * jn + li;
            const size_t cidx = ((size_t)(b * 2 + d) * LR_SLOTS + slot) * 256;
            bf16x8 br[2], bi[2];
#pragma unroll
            for (int ks = 0; ks < 2; ++ks) { br[ks] = nbr[ks]; bi[ks] = nbi[ks]; }
            const float ba = nba, bx = nbx, cl = ncl;
            float C = nC;
            if (it < 3) LRU_FETCH(it + 1);
            f32x4 ar[4], ai[4];
#pragma unroll
            for (int mt = 0; mt < 4; ++mt) { ar[mt] = (f32x4){0.f, 0.f, 0.f, 0.f}; ai[mt] = (f32x4){0.f, 0.f, 0.f, 0.f};
#pragma unroll
                for (int ks = 0; ks < 2; ++ks) { const bf16x8 a = *(const LAS bf16x8*)(XB + (16 * mt + li) * 264 + hh * 64 + 32 * ks + 8 * lq);
                    ar[mt] = MFMA16(a, br[ks], ar[mt]); ai[mt] = MFMA16(a, bi[ks], ai[mt]); } }
            float PA[4][4], PB[4][4];
#pragma unroll
            for (int mt = 0; mt < 4; ++mt)
#pragma unroll
                for (int r = 0; r < 4; ++r) { const int p = 16 * mt + 4 * lq + r;
                    const float rg = sigmoidf_(ar[mt][r] + ba), ig = sigmoidf_(ai[mt][r] + bx), la = -cl * rg;
                    const float x2 = 2.f * la, e2 = __expf(x2);
                    const float om = x2 > -0.03f ? -x2 * (1.f + 0.5f * x2 * (1.f + x2 * (1.f / 3.f))) : 1.f - e2;
                    PA[mt][r] = __expf(la); PB[mt][r] = __builtin_amdgcn_sqrtf(fmaxf(om, 0.f)) * ig * bf2f(XB[p * 264 + ch]); }
            float TA[4], TB[4], EA[4], EB[4];
#pragma unroll
            for (int mt = 0; mt < 4; ++mt) {
                float pa = 1.f, pb = 0.f;
#pragma unroll
                for (int j = 0; j < 4; ++j) { const int r = d ? 3 - j : j; const float a = PA[mt][r], bb = PB[mt][r]; pb = a * pb + bb; pa = a * pa; PA[mt][r] = pa; PB[mt][r] = pb; }
                float ea = 1.f, eb = 0.f, ta = 1.f, tb = 0.f;
#pragma unroll
                for (int j = 0; j < 4; ++j) { const int k = d ? 3 - j : j; const float ga = __shfl(pa, li + 16 * k), gb = __shfl(pb, li + 16 * k);
                    const bool before = d ? (k > lq) : (k < lq);
                    if (before) { eb = ga * eb + gb; ea = ga * ea; }
                    tb = ga * tb + gb; ta = ga * ta; }
                EA[mt] = ea; EB[mt] = eb; TA[mt] = ta; TB[mt] = tb;
            }
            float Atot = 1.f, Cin[4];
#pragma unroll
            for (int j = 0; j < 4; ++j) { const int mt = d ? 3 - j : j; Cin[mt] = C; C = TA[mt] * C + TB[mt]; Atot *= TA[mt]; }
            if (!FINAL) { if (lq == 0) { LA[cidx + ch] = Atot; LH[cidx + ch] = C; } }
            else {
#pragma unroll
                for (int mt = 0; mt < 4; ++mt) { const float base = EA[mt] * Cin[mt] + EB[mt];
#pragma unroll
                    for (int r = 0; r < 4; ++r) { const float hv = PA[mt][r] * base + PB[mt][r];
                        if (d == 0) hsum[mt][r] = hv; else Hs[(16 * mt + 4 * lq + r) * 256 + ch] = hsum[mt][r] + hv; } }
            }
        }
    }
#undef LRU_FETCH
    if (FINAL) {
        LDS_BARRIER();
        bf16* MIX = (bf16*)(F.ws + WS_MIX);
        u32x4 yq[4];
#pragma unroll
        for (int j = 0; j < 4; ++j) { const int task = tid + NTHR * j, p = task >> 5, c8 = task & 31; yq[j] = *(const u32x4*)(Z + (size_t)lru_row(isctx, b, p0 + p) * INW + ZYB + 8 * c8); }
#pragma unroll
        for (int j = 0; j < 4; ++j) { const int task = tid + NTHR * j, p = task >> 5, c8 = task & 31;
            const f32x4 h0 = *(const LAS f32x4*)(Hs + p * 256 + 8 * c8), h1 = *(const LAS f32x4*)(Hs + p * 256 + 8 * c8 + 4);
            float o[8];
#pragma unroll
            for (int e = 0; e < 4; ++e) { const unsigned yw = yq[j][e];
                const float ya = __builtin_bit_cast(float, yw << 16), yb = __builtin_bit_cast(float, yw & 0xffff0000u);
                const float ua = 0.7978845608f * (ya + 0.044715f * ya * ya * ya), ub = 0.7978845608f * (yb + 0.044715f * yb * yb * yb);
                const float ta = 1.f - 2.f * fast_rcp(1.f + __expf(2.f * ua)), tb = 1.f - 2.f * fast_rcp(1.f + __expf(2.f * ub));
                const float ha = e < 2 ? h0[2 * e] : h1[2 * e - 4], hb = e < 2 ? h0[2 * e + 1] : h1[2 * e - 3];
                o[2 * e] = ha * 0.5f * ya * (1.f + ta); o[2 * e + 1] = hb * 0.5f * yb * (1.f + tb); }
            *(u32x4*)(MIX + (size_t)lru_row(isctx, b, p0 + p) * 1024 + 512 + 8 * c8) = (u32x4){pk2(o[0], o[1]), pk2(o[2], o[3]), pk2(o[4], o[5]), pk2(o[6], o[7])}; }
    }
    LDS_BARRIER();
}

__device__ __forceinline__ void lru_carry(Frame& F) {
    if (blockIdx.x >= 16 || F.wave != 0) return;
    const int chain = blockIdx.x * 64 + F.lane, bd = chain >> 8, ch = chain & 255, d = bd & 1;
    const float* LA = (const float*)(F.ws + WS_LRUC); const float* LH = (const float*)(F.ws + WS_LRUC + LRUC_STRIDE); float* LI = (float*)(F.ws + WS_LRUC + 2 * LRUC_STRIDE);
    float h = 0.f;
    constexpr int LB = 26;
    static_assert(LR_SLOTS % (2 * LB) == 0, "batching");
    float aA[LB], hA[LB], aB[LB], hB[LB];
#define LC_IDX(k) (((size_t)bd * LR_SLOTS + (d ? ((k) < 4 ? 3 - (k) : 263 - (k)) : (k))) * 256 + ch)
#define LC_LOAD(a_, h_, k0) _Pragma("unroll") for (int j = 0; j < LB; ++j) { const size_t idx = LC_IDX((k0) + j); a_[j] = LA[idx]; h_[j] = LH[idx]; }
#define LC_SCAN(a_, h_, k0) _Pragma("unroll") for (int j = 0; j < LB; ++j) { const size_t idx = LC_IDX((k0) + j); LI[idx] = h; h = a_[j] * h + h_[j]; }
    LC_LOAD(aA, hA, 0)
#pragma unroll 1
    for (int k0 = 0; k0 < LR_SLOTS; k0 += 2 * LB) {
        LC_LOAD(aB, hB, k0 + LB)
        LC_SCAN(aA, hA, k0)
        if (k0 + 2 * LB < LR_SLOTS) { LC_LOAD(aA, hA, k0 + 2 * LB) }
        LC_SCAN(aB, hB, k0 + LB)
    }
#undef LC_IDX
#undef LC_LOAD
#undef LC_SCAN
}

__device__ __forceinline__ void fft_f1(Frame& F, int b, int n2) {
    const bf16* Z = (const bf16*)(F.ws + WS_Z);
    const bf16* Fc = (const bf16*)(F.ws + WS_TAB + TAB_FC); const bf16* Fs = (const bf16*)(F.ws + WS_TAB + TAB_FS);
    bf16* FAr = (bf16*)(F.ws + WS_FA); bf16* FAi = FAr + (size_t)2 * 128 * 128 * 256;
    LAS bf16* DT = (LAS bf16*)F.lds;
    const int tid = F.tid, lane = F.lane, w = F.wave, li = lane & 15, lq = lane >> 4;
    {   const int c = tid & 255, nh = tid >> 8;
        const bf16* src = Z + ((size_t)(b * SEQ + 128 * (64 * nh) + n2)) * INW + ZU + c;
#pragma unroll 2
        for (int j = 0; j < 8; ++j) { unsigned pk[4];
#pragma unroll
            for (int i = 0; i < 4; ++i) pk[i] = (unsigned)src[(size_t)(128 * (8 * j + 2 * i)) * INW] | ((unsigned)src[(size_t)(128 * (8 * j + 2 * i + 1)) * INW] << 16);
            *(LAS u32x4*)(DT + c * 136 + 64 * nh + 8 * j) = (u32x4){pk[0], pk[1], pk[2], pk[3]}; } }
    LDS_BARRIER();
    bf16x8 fc[4], fs[4];
#pragma unroll
    for (int ks = 0; ks < 4; ++ks) { fc[ks] = *(const bf16x8*)(Fc + (16 * w + li) * 128 + 32 * ks + 8 * lq); fs[ks] = *(const bf16x8*)(Fs + (16 * w + li) * 128 + 32 * ks + 8 * lq); }
    float ct[4], st[4];
#pragma unroll
    for (int r = 0; r < 4; ++r) { const int k1 = 16 * w + 4 * lq + r; sincospif((float)((n2 * k1) & 16383) * (1.f / 8192.f), &st[r], &ct[r]); }
#pragma unroll 2
    for (int nt = 0; nt < 16; ++nt) {
        f32x4 re = {0.f, 0.f, 0.f, 0.f}, im = {0.f, 0.f, 0.f, 0.f};
#pragma unroll
        for (int ks = 0; ks < 4; ++ks) { const bf16x8 bb = *(const LAS bf16x8*)(DT + (16 * nt + li) * 136 + 32 * ks + 8 * lq); re = MFMA16(fc[ks], bb, re); im = MFMA16(fs[ks], bb, im); }
#pragma unroll
        for (int r = 0; r < 4; ++r) { const int k1 = 16 * w + 4 * lq + r, c = 16 * nt + li;
            const float R = re[r], I = -im[r];
            const size_t o = ((size_t)(b * 128 + k1) * 128 + n2) * 256 + c;
            FAr[o] = f2bf(R * ct[r] + I * st[r]); FAi[o] = f2bf(I * ct[r] - R * st[r]); }
    }
    LDS_BARRIER();
}

__device__ __forceinline__ void fft_f2(Frame& F, int b, int k1, int chalf) {
    const bf16* Fc = (const bf16*)(F.ws + WS_TAB + TAB_FC); const bf16* Fs = (const bf16*)(F.ws + WS_TAB + TAB_FS); const bf16* CS = (const bf16*)(F.ws + WS_TAB + TAB_CS);
    const bf16* FAr = (const bf16*)(F.ws + WS_FA); const bf16* FAi = FAr + (size_t)2 * 128 * 128 * 256;
    bf16* MIX = (bf16*)(F.ws + WS_MIX);
    LAS bf16* DTr = (LAS bf16*)F.lds; LAS bf16* DTi = DTr + 128 * 136;
    const int tid = F.tid, lane = F.lane, w = F.wave, li = lane & 15, lq = lane >> 4;
    LAS bf16* Wv = (LAS bf16*)(F.lds + 69632) + w * (16 * 2 * 136);
    {   u32x4 pr[4], pi[4];
#pragma unroll
        for (int j = 0; j < 4; ++j) { const int p = tid + NTHR * j, n2 = p >> 4, c8 = p & 15; const size_t o = ((size_t)(b * 128 + k1) * 128 + n2) * 256 + chalf * 128 + 8 * c8;
            pr[j] = *(const u32x4*)(FAr + o); pi[j] = *(const u32x4*)(FAi + o); }
#pragma unroll
        for (int j = 0; j < 4; ++j) { const int p = tid + NTHR * j, n2 = p >> 4, c8 = p & 15, col = n2 ^ (8 * c8);
#pragma unroll
            for (int i = 0; i < 8; ++i) { const unsigned wr_ = pr[j][i >> 1], wi_ = pi[j][i >> 1];
                DTr[(8 * c8 + i) * 136 + col] = (bf16)((i & 1) ? (wr_ >> 16) : (wr_ & 0xffffu)); DTi[(8 * c8 + i) * 136 + col] = (bf16)((i & 1) ? (wi_ >> 16) : (wi_ & 0xffffu)); } } }
    LDS_BARRIER();
    bf16x8 fc[4], fs[4];
#pragma unroll
    for (int ks = 0; ks < 4; ++ks) { fc[ks] = *(const bf16x8*)(Fc + (16 * w + li) * 128 + 32 * ks + 8 * lq); fs[ks] = *(const bf16x8*)(Fs + (16 * w + li) * 128 + 32 * ks + 8 * lq); }
#pragma unroll 2
    for (int nt = 0; nt < 8; ++nt) {
        f32x4 ur = {0.f, 0.f, 0.f, 0.f}, u1 = {0.f, 0.f, 0.f, 0.f}, u2 = {0.f, 0.f, 0.f, 0.f};
        const int sw = 2 * nt + (li >> 3);
#pragma unroll
        for (int ks = 0; ks < 4; ++ks) { const int off = (16 * nt + li) * 136 + 8 * ((4 * ks + lq) ^ sw);
            const bf16x8 br = *(const LAS bf16x8*)(DTr + off), bi = *(const LAS bf16x8*)(DTi + off);
            ur = MFMA16(fc[ks], br, ur); ur = MFMA16(fs[ks], bi, ur); u1 = MFMA16(fc[ks], bi, u1); u2 = MFMA16(fs[ks], br, u2); }
        const int gl = nt >> 2, cl = 16 * (nt & 3) + li;
#pragma unroll
        for (int r = 0; r < 4; ++r) { const int k2l = 4 * lq + r; Wv[(k2l * 2 + gl) * 136 + cl] = f2bf(ur[r]); Wv[(k2l * 2 + gl) * 136 + 64 + cl] = f2bf(u1[r] - u2[r]); }
    }
    LDS_BARRIER();
    LAS bf16* Yt = (LAS bf16*)F.lds;
#pragma unroll
    for (int gl = 0; gl < 2; ++gl)
#pragma unroll
        for (int mt = 0; mt < 4; ++mt) { f32x4 acc = {0.f, 0.f, 0.f, 0.f};
#pragma unroll
            for (int ks = 0; ks < 4; ++ks) acc = MFMA16(*(const LAS bf16x8*)(Wv + (li * 2 + gl) * 136 + 32 * ks + 8 * lq), *(const bf16x8*)(CS + (16 * mt + li) * 128 + 32 * ks + 8 * lq), acc);
#pragma unroll
            for (int r = 0; r < 4; ++r) Yt[(16 * w + 4 * lq + r) * 136 + gl * 64 + 16 * mt + li] = f2bf(acc[r] * (1.f / 1024.f)); }
    LDS_BARRIER();
#pragma unroll
    for (int j = 0; j < 4; ++j) { const int p = tid + NTHR * j, k2 = p >> 4, c8 = p & 15;
        *(u32x4*)(MIX + ((size_t)b * SEQ + k1 + 128 * k2) * 1024 + 768 + chalf * 128 + 8 * c8) = *(const LAS u32x4*)(Yt + k2 * 136 + 8 * c8); }
    LDS_BARRIER();
}

__device__ __forceinline__ void ctx_fourier(Frame& F, int b, int g) {
    const bf16* Z = (const bf16*)(F.ws + WS_Z); bf16* MIX = (bf16*)(F.ws + WS_MIX);
    const bf16* CS = (const bf16*)(F.ws + WS_TAB + TAB_CS); const bf16* C256 = (const bf16*)(F.ws + WS_TAB + TAB_C256); const bf16* S256 = (const bf16*)(F.ws + WS_TAB + TAB_S256);
    LAS bf16* PT = (LAS bf16*)F.lds; LAS bf16* QT = PT + 64 * 264;
    const int lane = F.lane, w = F.wave, li = lane & 15, lq = lane >> 4;
#pragma unroll 1
    for (int nj = 0; nj < 2; ++nj) { const int nt = 2 * w + nj;
        bf16x8 a[2];
#pragma unroll
        for (int ks = 0; ks < 2; ++ks) a[ks] = *(const bf16x8*)(Z + (size_t)(TL + b * CTXL + 16 * nt + li) * INW + ZU + g * 64 + 32 * ks + 8 * lq);
#pragma unroll
        for (int mt = 0; mt < 4; ++mt) { f32x4 p = {0.f, 0.f, 0.f, 0.f}, q = {0.f, 0.f, 0.f, 0.f};
#pragma unroll
            for (int ks = 0; ks < 2; ++ks) { p = MFMA16(a[ks], *(const bf16x8*)(CS + (16 * mt + li) * 128 + 32 * ks + 8 * lq), p); q = MFMA16(a[ks], *(const bf16x8*)(CS + (16 * mt + li) * 128 + 64 + 32 * ks + 8 * lq), q); }
            u32x2 o; o.x = pk2(p[0], p[1]); o.y = pk2(p[2], p[3]); *(LAS u32x2*)(PT + (16 * mt + li) * 264 + 16 * nt + 4 * lq) = o;
            o.x = pk2(q[0], q[1]); o.y = pk2(q[2], q[3]); *(LAS u32x2*)(QT + (16 * mt + li) * 264 + 16 * nt + 4 * lq) = o; } }
    LDS_BARRIER();
#pragma unroll 1
    for (int kj = 0; kj < 2; ++kj) { const int kt = 2 * w + kj;
        f32x4 acc[4];
#pragma unroll
        for (int mt = 0; mt < 4; ++mt) acc[mt] = (f32x4){0.f, 0.f, 0.f, 0.f};
#pragma unroll 2
        for (int ks = 0; ks < 8; ++ks) { const bf16x8 ac = *(const bf16x8*)(C256 + (16 * kt + li) * 256 + 32 * ks + 8 * lq), as = *(const bf16x8*)(S256 + (16 * kt + li) * 256 + 32 * ks + 8 * lq);
#pragma unroll
            for (int mt = 0; mt < 4; ++mt) { acc[mt] = MFMA16(ac, *(const LAS bf16x8*)(PT + (16 * mt + li) * 264 + 32 * ks + 8 * lq), acc[mt]); acc[mt] = MFMA16(as, *(const LAS bf16x8*)(QT + (16 * mt + li) * 264 + 32 * ks + 8 * lq), acc[mt]); } }
#pragma unroll
        for (int mt = 0; mt < 4; ++mt)
#pragma unroll
            for (int r = 0; r < 4; ++r) MIX[(size_t)(TL + b * CTXL + 16 * kt + 4 * lq + r) * 1024 + 768 + g * 64 + 16 * mt + li] = f2bf(acc[mt][r] * (1.f / 128.f)); }
    LDS_BARRIER();
}

template <int CTRL, int RMASK> __device__ __forceinline__ float dppm_f(float v) { const int i = __builtin_bit_cast(int, v); return __builtin_bit_cast(float, __builtin_amdgcn_update_dpp(i, i, CTRL, RMASK, 0xf, false)); }
template <int CTRL, int RMASK> __device__ __forceinline__ int dppm_i(int v) { return __builtin_amdgcn_update_dpp(v, v, CTRL, RMASK, 0xf, false); }

__device__ __forceinline__ void route_phase(Frame& F, int l, int Tl) {
    LAS unsigned* hist = (LAS unsigned*)F.lds;
    for (int i = F.tid; i < 256; i += NTHR) hist[i] = 0u;
    __syncthreads();
    const float* logits = (const float*)(F.ws + WS_LOGIT); const float* br = F.in[20] + l * 256;
    int* sel_e = (int*)(F.ws + WS_SEL); float* sel_w = (float*)(F.ws + WS_SEL + SEL_STRIDE);
    const int lane = F.lane, gw = blockIdx.x * NWAVES + F.wave, NGW = F.G * NWAVES;
    const float NEG = -__builtin_inff();
    const f32x4 bb = *(const f32x4*)(br + 4 * lane);
    f32x4 lgn = (f32x4){0.f, 0.f, 0.f, 0.f};
    if (gw < Tl) lgn = *(const f32x4*)(logits + (size_t)gw * 256 + 4 * lane);
    for (int t = gw; t < Tl; t += NGW) {
        const f32x4 lg = lgn;
        if (t + NGW < Tl) lgn = *(const f32x4*)(logits + (size_t)(t + NGW) * 256 + 4 * lane);
        float sc[4], cand[4];
#pragma unroll
        for (int i = 0; i < 4; ++i) { sc[i] = sigmoidf_(lg[i]); cand[i] = sc[i] + bb[i]; }
        float m1 = NEG, m2 = NEG;
#pragma unroll
        for (int i = 0; i < 4; ++i) { const float v = cand[i]; if (v > m1) { m2 = m1; m1 = v; } else if (v > m2) m2 = v; }
#define RT_TOP2(CTRL) { const float o1 = dpp_f<CTRL>(m1), o2 = dpp_f<CTRL>(m2); const float n1 = fmaxf(m1, o1), n2 = fmaxf(fminf(m1, o1), fmaxf(m2, o2)); m1 = n1; m2 = n2; }
        RT_TOP2(0xB1) RT_TOP2(0x4E) RT_TOP2(0x141)
#undef RT_TOP2
        const float gs = m1 + m2; const int g = lane >> 3; int rank = 0;
#pragma unroll
        for (int q = 0; q < 8; ++q) { const float v = rdlane_f(gs, 8 * q); rank += (int)((v > gs) | ((v == gs) & (q < g))); }
        const bool drop = rank >= 4;
#pragma unroll
        for (int i = 0; i < 4; ++i) cand[i] = drop ? NEG : cand[i];
        float wsum = 0.f, myw = 0.f; int mye = 0;
#pragma unroll 1
        for (int k = 0; k < TOPK; ++k) {
            float bv = __builtin_fmaxf(__builtin_fmaxf(cand[0], cand[1]), __builtin_fmaxf(cand[2], cand[3]));
            asm volatile("s_nop 1\n\tv_max_f32_dpp %0, %0, %0 quad_perm:[1,0,3,2] row_mask:0xf bank_mask:0xf\n\t"
                         "s_nop 1\n\tv_max_f32_dpp %0, %0, %0 quad_perm:[2,3,0,1] row_mask:0xf bank_mask:0xf\n\t"
                         "s_nop 1\n\tv_max_f32_dpp %0, %0, %0 row_half_mirror row_mask:0xf bank_mask:0xf\n\t"
                         "s_nop 1\n\tv_max_f32_dpp %0, %0, %0 row_mirror row_mask:0xf bank_mask:0xf\n\t"
                         "s_nop 1\n\tv_max_f32_dpp %0, %0, %0 row_bcast:15 row_mask:0xe bank_mask:0xf\n\t"
                         "s_nop 1\n\tv_max_f32_dpp %0, %0, %0 row_bcast:31 row_mask:0xc bank_mask:0xf\n\t"
                         "s_nop 1" : "+v"(bv));
            const float mx = rdlane_f(bv, 63);
            int cidx[4];
#pragma unroll
            for (int i = 0; i < 4; ++i) { const unsigned long long bm = __builtin_amdgcn_ballot_w64(cand[i] == mx); cidx[i] = bm ? 4 * (int)__builtin_ctzll(bm) + i : (1 << 20); }
            const int m01 = cidx[0] < cidx[1] ? cidx[0] : cidx[1], m23 = cidx[2] < cidx[3] ? cidx[2] : cidx[3], ui = m01 < m23 ? m01 : m23;
            float ssel = 0.f;
#pragma unroll
            for (int i = 0; i < 4; ++i) { const bool hit = (4 * lane + i == ui); ssel = hit ? sc[i] : ssel; cand[i] = hit ? NEG : cand[i]; }
            const float sw = rdlane_f(ssel, ui >> 2);
            wsum += sw; myw = (lane == k) ? sw : myw; mye = (lane == k) ? ui : mye;
        }
        if (lane < TOPK) { sel_e[(size_t)t * 8 + lane] = mye; sel_w[(size_t)t * 8 + lane] = 2.5f * myw / wsum; (void)__hip_atomic_fetch_add(&hist[mye], 1u, __ATOMIC_RELAXED, __HIP_MEMORY_SCOPE_WORKGROUP); }
    }
    __syncthreads();
    unsigned* cnt = (unsigned*)(F.ws + WS_CTL) + CW_CNT + 1024 * l;
    for (int e = F.tid; e < 256; e += NTHR) if (hist[e]) atomicAdd(cnt + e, hist[e]);
    __syncthreads();
}

__device__ __forceinline__ void assign_phase(Frame& F, int l, int Tl) {
    LAS int* cntL = (LAS int*)F.lds; LAS int* pstart = cntL + 256; LAS unsigned* hist = (LAS unsigned*)(pstart + 260); LAS unsigned* base = hist + 256; LAS unsigned* hist2 = base + 256;
    unsigned* cnt = (unsigned*)(F.ws + WS_CTL) + CW_CNT + 1024 * l; unsigned* fill = cnt + 512;
    const int tid = F.tid, lane = F.lane;
    if (tid < 256) { cntL[tid] = (int)cnt[tid]; hist[tid] = 0u; hist2[tid] = 0u; }
    __syncthreads();
    if (F.wave == 0) {
        int p[4]; int s = 0;
#pragma unroll
        for (int i = 0; i < 4; ++i) { p[i] = (cntL[4 * lane + i] + 255) & ~255; s += p[i]; }
        int inc = s;
#pragma unroll
        for (int off = 1; off < 64; off <<= 1) { const int v = __shfl_up(inc, off); if (lane >= off) inc += v; }
        int ex = inc - s;
#pragma unroll
        for (int i = 0; i < 4; ++i) { pstart[4 * lane + i] = ex; ex += p[i]; }
        if (lane == 63) pstart[256] = inc;
    }
    __syncthreads();
    const int total_rows = pstart[256], ntile_r = total_rows >> 8, ntiles = ntile_r + (Tl >> 8);
    int* meta = (int*)(F.ws + WS_META); int* tile_expert = meta + 64;
    int* row_tok = (int*)(F.ws + WS_ROWTOK); const int* sel_e = (const int*)(F.ws + WS_SEL); int* tokpos = (int*)(F.ws + WS_SEL + 2 * SEL_STRIDE);
    if (blockIdx.x == 0) {
        if (tid == 0) { meta[0] = ntiles; meta[1] = total_rows; }
        if (tid < 256) { const int rt0 = pstart[tid] >> 8; for (int rt = rt0; rt < (pstart[tid + 1] >> 8); ++rt) tile_expert[rt] = tid | ((cntL[tid] - 256 * (rt - rt0) <= 128) ? 0x10000 : 0); }
        for (int rt = ntile_r + tid; rt < ntiles; rt += NTHR) tile_expert[rt] = 256;
    }
    for (int e = blockIdx.x; e < 256; e += F.G) for (int r = pstart[e] + cntL[e] + tid; r < pstart[e + 1]; r += NTHR) row_tok[r] = 0;
    const int TPW = (Tl + F.G - 1) / F.G, t0 = blockIdx.x * TPW, t1 = (t0 + TPW < Tl) ? t0 + TPW : Tl;
    for (int t = t0 + tid; t < t1; t += NTHR) row_tok[total_rows + t] = t;
    const int npairs = t1 > t0 ? (t1 - t0) * 8 : 0;
    for (int i = tid; i < npairs; i += NTHR) (void)__hip_atomic_fetch_add(&hist[sel_e[(size_t)t0 * 8 + i]], 1u, __ATOMIC_RELAXED, __HIP_MEMORY_SCOPE_WORKGROUP);
    __syncthreads();
    if (tid < 256) base[tid] = hist[tid] ? atomicAdd(fill + tid, hist[tid]) : 0u;
    __syncthreads();
    for (int i = tid; i < npairs; i += NTHR) { const int e = sel_e[(size_t)t0 * 8 + i]; const unsigned off = __hip_atomic_fetch_add(&hist2[e], 1u, __ATOMIC_RELAXED, __HIP_MEMORY_SCOPE_WORKGROUP);
        const int pos = pstart[e] + (int)base[e] + (int)off; row_tok[pos] = t0 + (i >> 3); tokpos[(size_t)t0 * 8 + i] = pos; }
    __syncthreads();
}

__device__ __forceinline__ void combine_phase(Frame& F, int l, int Tl) {
    const int* meta = (const int*)(F.ws + WS_META); const int total_rows = meta[1];
    const unsigned char* Y = (const unsigned char*)(F.ws + WS_Y); const int* tokpos = (const int*)(F.ws + WS_SEL + 2 * SEL_STRIDE); const float* sel_w = (const float*)(F.ws + WS_SEL + SEL_STRIDE);
    const float* mod = (const float*)(F.ws + WS_MOD);
    float* XC = (float*)(F.ws + WS_XC); bf16* HB = (bf16*)(F.ws + WS_HB);
    const int lane = F.lane, gw = blockIdx.x * NWAVES + F.wave, NGW = F.G * NWAVES;
    const int c0 = 16 * lane;
    const int ca = (lane >> 4) * 256 + ((lane >> 2) & 3) * 32 + (lane & 3) * 8, cb2 = ca + 128;
    for (int t = gw; t < Tl; t += NGW) {
        const int myp = lane < 8 ? tokpos[(size_t)t * 8 + lane] : 0; const float myw = lane < 8 ? sel_w[(size_t)t * 8 + lane] : 0.f;
        float* xr = t < TL ? F.out + (size_t)t * D : XC + (size_t)(t - TL) * D; const int r = t < TL ? (t >> 14) : 2;
        u32x4 yv[9];
        yv[8] = *(const u32x4*)(Y + (size_t)(total_rows + t) * 1024 + c0);
#pragma unroll
        for (int k = 0; k < TOPK; ++k) yv[k] = *(const u32x4*)(Y + (size_t)__builtin_amdgcn_readlane(myp, k) * 1024 + c0);
        f32x4 xv[4];
        xv[0] = *(const f32x4*)(xr + ca); xv[1] = *(const f32x4*)(xr + ca + 4); xv[2] = *(const f32x4*)(xr + cb2); xv[3] = *(const f32x4*)(xr + cb2 + 4);
        float y[16];
#pragma unroll
        for (int d = 0; d < 4; ++d) { const f32x2 a = __builtin_amdgcn_cvt_pk_f32_fp8((int)yv[8][d], false), bq = __builtin_amdgcn_cvt_pk_f32_fp8((int)yv[8][d], true);
            y[4 * d] = a.x; y[4 * d + 1] = a.y; y[4 * d + 2] = bq.x; y[4 * d + 3] = bq.y; }
#pragma unroll
        for (int k = 0; k < TOPK; ++k) { const float wk = rdlane_f(myw, k);
#pragma unroll
            for (int d = 0; d < 4; ++d) { const f32x2 a = __builtin_amdgcn_cvt_pk_f32_fp8((int)yv[k][d], false), bq = __builtin_amdgcn_cvt_pk_f32_fp8((int)yv[k][d], true);
                y[4 * d] += wk * a.x; y[4 * d + 1] += wk * a.y; y[4 * d + 2] += wk * bq.x; y[4 * d + 3] += wk * bq.y; } }
        const float* g2 = mod + (size_t)(l * 3 + r) * 6144 + 5120;
        f32x4 xn[4]; float s = 0.f;
#pragma unroll
        for (int j = 0; j < 4; ++j) { const int cj = (j < 2 ? ca : cb2) + 4 * (j & 1);
            xn[j] = xv[j] + *(const f32x4*)(g2 + cj) * (f32x4){y[4 * j], y[4 * j + 1], y[4 * j + 2], y[4 * j + 3]};
            s += (xn[j].x * xn[j].x + xn[j].y * xn[j].y) + (xn[j].z * xn[j].z + xn[j].w * xn[j].w); }
        const float rstd = rsqrtf(wave_sum(s) * (1.f / D) + EPS);
        if (l == 0) {
            const float* m1 = mod + (size_t)(3 + r) * 6144; const float* gain = F.in[6] + 1024;
            unsigned o[8];
#pragma unroll
            for (int j = 0; j < 4; ++j) { const int cj = (j < 2 ? ca : cb2) + 4 * (j & 1); *(f32x4*)(xr + cj) = xn[j];
                const f32x4 yv2 = xn[j] * rstd * *(const f32x4*)(gain + cj) * (*(const f32x4*)(m1 + 1024 + cj) + 1.f) + *(const f32x4*)(m1 + cj);
                o[2 * j] = pk2(yv2.x, yv2.y); o[2 * j + 1] = pk2(yv2.z, yv2.w); }
            *(u32x4*)(HB + (size_t)t * D + ca) = (u32x4){o[0], o[1], o[2], o[3]}; *(u32x4*)(HB + (size_t)t * D + cb2) = (u32x4){o[4], o[5], o[6], o[7]};
        } else {
            const float* gain = F.in[27];
#pragma unroll
            for (int j = 0; j < 4; ++j) { const int cj = (j < 2 ? ca : cb2) + 4 * (j & 1); *(f32x4*)(F.out + (size_t)t * D + cj) = xn[j] * rstd * *(const f32x4*)(gain + cj); }
        }
    }
}


#ifndef PH_EN
#define PH_EN 0xFFFFFFFFu
#endif
#define EN(j) ((PH_EN >> (j)) & 1u)
#ifndef U_EN
#define U_EN 0xFFu
#endif
#define UEN(j) ((U_EN >> (j)) & 1u)
#ifndef DUPMASK
#define DUPMASK 0u
#endif
#define REP(j) for (int rep_ = 0; rep_ < 1 + (int)((DUPMASK >> (j)) & 1u); ++rep_)
#ifndef DUPU
#define DUPU 0u
#endif
#define REPU(j) for (int repu_ = 0; repu_ < 1 + (int)((DUPU >> (j)) & 1u); ++repu_)
#define IN(k) (lo <= (k) && (k) < hi)
#define FRESH() do { asm volatile("" : "+v"(F.tid)); F.lane = F.tid & 63; } while (0)
#define SEAM(k) do { if (lo <= (k) && (k) + 1 < hi) xcd_barrier(bar); } while (0)
#define SEAMCV(k, lcv) do { if (lo <= (k) && (k) + 1 < hi) xcd_barrier_cv(bar, F); } while (0)
template <int l>
__device__ __forceinline__ void layer_phases(Frame& F, const XcdBarrier& bar, const int lo, const int hi) {
    const int bid = blockIdx.x, G = F.G;

        const int pb = 2 + 12 * l;
        const int Tl = l == 0 ? TT : TL;
        bf16* HB = (bf16*)(F.ws + WS_HB); bf16* Zb = (bf16*)(F.ws + WS_Z); bf16* MIX = (bf16*)(F.ws + WS_MIX);
        if (EN(2) && IN(pb + 0)) REP(2) { FRESH();
            pg8::Gemm g{HB, (const bf16*)(F.ws + WS_WIN) + (size_t)l * INW * 1024, nullptr, 1024}; pg8::StaticOrder S; S.init(TT, INW, G, bid);
            pg8::EpiBf16 E{Zb, INW};
            pg8::gemm_phase<pg8::EpiBf16, pg8::StaticOrder, false>(F.lds, g, S, E, F.tid);
            SEAMCV(pb + 0, l);
        }
        if (EN(3) && IN(pb + 1)) REP(3) { FRESH();
            REPU(0) if (UEN(0)) hgrn2_c1<0>(F, l, bid, 16 * HG_SLOTS, G);
            FRESH(); REPU(1) if (UEN(1)) for (int u = (bid + G - 32) % G; u < 2 * LR_SLOTS; u += G) lru_unit<false>(F, l, u / LR_SLOTS, u % LR_SLOTS);
            FRESH(); REPU(2) if (UEN(2)) for (int u = bid; u < 256; u += G) fft_f1(F, u >> 7, u & 127);
            FRESH(); REPU(3) if (UEN(3) && l == 0) for (int u = (bid + G - 64) % G; u < 8; u += G) ctx_fourier(F, u >> 2, u & 3);
            SEAMCV(pb + 1, l);
        }
        if (EN(4) && IN(pb + 2)) REP(4) { FRESH(); hgrn2_c2(F); lru_carry(F); SEAMCV(pb + 2, l); }
        if (EN(5) && IN(pb + 3)) REP(5) { FRESH();
            const int nslot = l == 0 ? HG_SLOTS : HG_SLOTS - 2, slot0 = l == 0 ? 0 : 2;
            FRESH(); REPU(4) if (UEN(4)) for (int u = bid; u < 8 * nslot; u += G) hgrn2_c3<0>(F, l, u / nslot, slot0 + u % nslot);
            const int nls = l == 0 ? LR_SLOTS : LR_SLOTS - 4, ls0 = l == 0 ? 0 : 4;
            FRESH(); REPU(5) if (UEN(5)) for (int u = (bid + G - 32) % G; u < 2 * nls; u += G) lru_unit<true>(F, l, u / nls, ls0 + u % nls);
            FRESH(); REPU(6) if (UEN(6)) for (int u = bid; u < 512; u += G) fft_f2(F, u >> 8, (u >> 1) & 127, u & 1);
            SEAMCV(pb + 3, l);
        }
        if (EN(6) && IN(pb + 4)) REP(6) { FRESH();
            pg8::Gemm g{MIX, (const bf16*)(F.ws + WS_WOUT) + (size_t)l * 1024 * 1024, nullptr, 1024}; pg8::StaticOrder S; S.init(Tl, 1024, G, bid);
            pg8::EpiResid E{l == 0 ? F_X(F) : (const float*)F.out, F.out, F_CTX(F), (float*)(F.ws + WS_XC), (const float*)(F.ws + WS_MOD) + (size_t)l * 3 * 6144};
            pg8::gemm_phase<pg8::EpiResid, pg8::StaticOrder, false>(F.lds, g, S, E, F.tid);
            SEAMCV(pb + 4, l);
        }
        if (EN(7) && IN(pb + 5)) REP(7) { FRESH();
            hprep_rows(F, l, F.out, (const float*)(F.ws + WS_XC), Tl, 3072, 4096, F.in[7] + l * 1024, true);
            SEAMCV(pb + 5, l);
        }
        if (EN(8) && IN(pb + 6)) REP(8) { FRESH();
            pg8::Gemm g{HB, (const bf16*)(F.ws + WS_WR) + (size_t)l * 256 * 1024, nullptr, 1024}; pg8::StaticOrder S; S.init(Tl, 256, G, bid);
            pg8::EpiF32 E{(float*)(F.ws + WS_LOGIT), 256};
            pg8::gemm_phase<pg8::EpiF32, pg8::StaticOrder, false>(F.lds, g, S, E, F.tid);
            SEAMCV(pb + 6, l);
        }
        if (EN(9) && IN(pb + 7)) REP(9) { FRESH(); route_phase(F, l, Tl); SEAMCV(pb + 7, l); }
        if (EN(10) && IN(pb + 8)) REP(10) { FRESH(); assign_phase(F, l, Tl); FRESH(); convert_experts(F, l); SEAMCV(pb + 8, l); }
        if (EN(11) && IN(pb + 9)) REP(11) { FRESH();
            const int* meta = (const int*)(F.ws + WS_META);
            pg8::Gemm g{(const bf16*)(F.ws + WS_HB8), (const bf16*)(F.ws + (l ? WS_WEXP1 : WS_WEXP)), (const int*)(F.ws + WS_ROWTOK), 512, 0x7a7a7a7a, 0x7f7f7f7f}; pg8::MoeOrder<2> S{meta + 64, meta[0], G, bid};
            pg8::EpiSwiglu8 E{F.ws + WS_HBUF};
            pg8::gemm_phase<pg8::EpiSwiglu8, pg8::MoeOrder<2>, true, true>(F.lds, g, S, E, F.tid);
            SEAMCV(pb + 9, l);
        }
        if (EN(12) && IN(pb + 10)) REP(12) { FRESH();
            const int* meta = (const int*)(F.ws + WS_META);
            pg8::Gemm g{(const bf16*)(F.ws + WS_HBUF), (const bf16*)(F.ws + (l ? WS_WEXP1 : WS_WEXP) + WEXP_GU_BYTES), nullptr, 128, 0x7b7b7b7b, 0x7d7d7d7d}; pg8::MoeOrder<4> S{meta + 64, meta[0], G, bid};
            pg8::EpiFp8 E{(unsigned char*)(F.ws + WS_Y), 1024};
            pg8::gemm_phase<pg8::EpiFp8, pg8::MoeOrder<4>, false, true>(F.lds, g, S, E, F.tid);
            SEAMCV(pb + 10, l);
        }
        if (EN(13) && IN(pb + 11)) REP(13) { FRESH(); combine_phase(F, l, Tl); SEAMCV(pb + 11, l); }
    }

constexpr int NPH = 26;
#ifndef BENCH_REPS
#define BENCH_REPS 2
#endif
__global__ void __launch_bounds__(NTHR, 2) fwd_kernel(Args args) {
    extern __shared__ __attribute__((aligned(16))) unsigned char lds_raw[];
    Frame F;
    F.lds = (LAS unsigned char*)lds_raw;
    F.tid = threadIdx.x; F.lane = F.tid & 63; F.wave = __builtin_amdgcn_readfirstlane(F.tid >> 6); F.G = gridDim.x;
    F.in = (const CAS cfptr*)__builtin_amdgcn_kernarg_segment_ptr();
    F.out = args.out; F.ws = args.ws;
    volatile LAS unsigned* MISC = (volatile LAS unsigned*)(F.lds + MISC_OFF);
    if (F.tid < 64) MISC[F.tid] = 0u;
    __syncthreads();
    XcdBarrier bar = xcd_barrier_post((unsigned*)(F.ws + WS_CTL) + CW_BAR, MISC + 8);
    const int lo = args.ph_lo, hi = args.ph_hi;
    const int bid = blockIdx.x, G = F.G;

    if (EN(0) && IN(0)) { FRESH(); phase_g0(F); SEAMCV(0, 0); }
    if (EN(1) && IN(1)) { FRESH(); hprep_rows(F, 0, F_X(F), F_CTX(F), TT, 0, 1024, F.in[6]); SEAMCV(1, 0); }

    layer_phases<0>(F, bar, lo, hi);
    layer_phases<1>(F, bar, lo, hi);
#ifdef BENCH_GEMM
    if (hi == NPH) { xcd_barrier(bar); FRESH();
        _Pragma("unroll 1") for (int rep = 0; rep < BENCH_REPS; ++rep) {
            const int* meta = (const int*)(F.ws + WS_META);
            pg8::Gemm g{(const bf16*)(F.ws + WS_HBUF), (const bf16*)(F.ws + WS_WEXP + WEXP_GU_BYTES), nullptr, 256}; pg8::MoeOrder<4> S{meta + 64, meta[0], F.G, (int)blockIdx.x};
#if BENCH_GEMM == 1
            pg8::EpiFp8 E{(unsigned char*)(F.ws + WS_Y), 1024}; pg8::gemm_phase<pg8::EpiFp8, pg8::MoeOrder<4>, false>(F.lds, g, S, E, F.tid);
#else
            pg8::EpiNone E{(bf16*)(F.ws + WS_Y)}; pg8::gemm_phase<pg8::EpiNone, pg8::MoeOrder<4>, false>(F.lds, g, S, E, F.tid);
#endif
            xcd_barrier(bar); } }
#endif
#ifdef BENCH_INPROJ
    if (hi == NPH) { xcd_barrier(bar); FRESH();
        _Pragma("unroll 1") for (int rep = 0; rep < BENCH_REPS; ++rep) {
            pg8::Gemm g{(const bf16*)(F.ws + WS_HB), (const bf16*)(F.ws + WS_WIN), nullptr, 1024}; pg8::StaticOrder S; S.init(TT, INW, F.G, (int)blockIdx.x);
#if BENCH_INPROJ == 1
            pg8::EpiBf16 E{(bf16*)(F.ws + WS_Z), INW}; pg8::gemm_phase<pg8::EpiBf16, pg8::StaticOrder, false>(F.lds, g, S, E, F.tid);
#else
            pg8::EpiNone E{(bf16*)(F.ws + WS_Z)}; pg8::gemm_phase<pg8::EpiNone, pg8::StaticOrder, false>(F.lds, g, S, E, F.tid);
#endif
            xcd_barrier(bar); } }
#endif
#ifdef BENCH_MOE1
    if (hi == NPH) { xcd_barrier(bar); FRESH();
        _Pragma("unroll 1") for (int rep = 0; rep < BENCH_REPS; ++rep) {
            const int* meta = (const int*)(F.ws + WS_META);
            pg8::MoeOrder<2> S{meta + 64, meta[0], F.G, (int)blockIdx.x};
#if BENCH_MOE1 == 1
            pg8::Gemm g{(const bf16*)(F.ws + WS_HB), (const bf16*)(F.ws + WS_WEXP1), (const int*)(F.ws + WS_ROWTOK), 1024};
            pg8::EpiSwiglu E{(bf16*)(F.ws + WS_HBUF)}; pg8::gemm_phase<pg8::EpiSwiglu, pg8::MoeOrder<2>, true>(F.lds, g, S, E, F.tid);
#elif BENCH_MOE1 == 2
            pg8::Gemm g{(const bf16*)(F.ws + WS_HB), (const bf16*)(F.ws + WS_WEXP1), (const int*)(F.ws + WS_ROWTOK), 1024};
            pg8::EpiNone E{(bf16*)(F.ws + WS_HBUF)}; pg8::gemm_phase<pg8::EpiNone, pg8::MoeOrder<2>, true>(F.lds, g, S, E, F.tid);
#else
            pg8::Gemm g{(const bf16*)(F.ws + WS_HB), (const bf16*)(F.ws + WS_WEXP1), nullptr, 1024};
            pg8::EpiNone E{(bf16*)(F.ws + WS_HBUF)}; pg8::gemm_phase<pg8::EpiNone, pg8::MoeOrder<2>, false>(F.lds, g, S, E, F.tid);
#endif
            xcd_barrier(bar); } }
#endif
#ifdef BENCH_X2
    if (hi == NPH) { xcd_barrier(bar); FRESH();
        _Pragma("unroll 1") for (int rep = 0; rep < BENCH_REPS; ++rep) { if (BENCH_X2 & 1) hgrn2_c2(F); if (BENCH_X2 & 2) lru_carry(F); xcd_barrier(bar); } }
#endif
#ifdef BENCH_C1
    if (hi == NPH) { xcd_barrier(bar); FRESH();
        _Pragma("unroll 1") for (int rep = 0; rep < BENCH_REPS; ++rep) hgrn2_c1<BENCH_C1>(F, 1, (int)blockIdx.x, 16 * HG_SLOTS, F.G); }
#endif
#ifdef BENCH_VAR
    if (hi == NPH) { xcd_barrier(bar); FRESH();
        _Pragma("unroll 1") for (int rep = 0; rep < BENCH_REPS; ++rep) for (int u = blockIdx.x; u < 8 * 128; u += F.G) hgrn2_c3<BENCH_VAR>(F, 1, u >> 7, 2 + (u & 127)); }
#endif
#undef IN
#undef SEAM
}

extern "C" void kernel_launch(void* const* d_in, const int* in_sizes, int n_in, void* d_out, int out_size, void* d_ws, size_t ws_size, hipStream_t stream) {
    static int grid = 0;
    if (grid == 0) {
        if (n_in != 28 || out_size != TL * D || ws_size < WS_END) { fprintf(stderr, "kernel_launch: unexpected problem (n_in %d, out %d, ws %zu < %zu)\n", n_in, out_size, ws_size, (size_t)WS_END); grid = -1; return; }
        int dev = 0, cus = 0, per_cu = 0;
        if (hipGetDevice(&dev) != hipSuccess || hipDeviceGetAttribute(&cus, hipDeviceAttributeMultiprocessorCount, dev) != hipSuccess) { grid = -1; return; }
        if (hipFuncSetAttribute((const void*)fwd_kernel, hipFuncAttributeMaxDynamicSharedMemorySize, LDS_BYTES) != hipSuccess) { fprintf(stderr, "kernel_launch: hipFuncSetAttribute failed\n"); grid = -1; return; }
        if (hipOccupancyMaxActiveBlocksPerMultiprocessor(&per_cu, (const void*)fwd_kernel, NTHR, LDS_BYTES) != hipSuccess || per_cu < 1) { fprintf(stderr, "kernel_launch: occupancy query says %d\n", per_cu); (void)hipGetLastError(); }
        grid = cus;
    }
    if (grid < 0) return;
    (void)hipMemsetAsync((char*)d_ws + WS_CTL, 0, CTL_ZERO_BYTES, stream);
    Args a{};
    for (int i = 0; i < 28; ++i) a.in[i] = (const float*)d_in[i];
    a.out = (float*)d_out; a.ws = (unsigned char*)d_ws;
#if MK_PER_PHASE
    for (int p = 0; p < NPH; ++p) { a.ph_lo = p; a.ph_hi = p + 1; hipLaunchKernelGGL(fwd_kernel, dim3(grid), dim3(NTHR), LDS_BYTES, stream, a); }
#else
    a.ph_lo = 0; a.ph_hi = NPH; hipLaunchKernelGGL(fwd_kernel, dim3(grid), dim3(NTHR), LDS_BYTES, stream, a);
#endif
}
```

```cpp
#include <hip/hip_runtime.h>
#include <cstdio>
#include <cstdint>

#ifndef MK_PER_PHASE
#define MK_PER_PHASE 0
#endif

#define LAS __attribute__((address_space(3)))
#define GAS __attribute__((address_space(1)))
typedef unsigned short bf16;
typedef short bf16x8 __attribute__((ext_vector_type(8)));
typedef float f32x4 __attribute__((ext_vector_type(4)));
typedef float f32x2 __attribute__((ext_vector_type(2)));
typedef unsigned u32x4 __attribute__((ext_vector_type(4)));
typedef unsigned u32x2 __attribute__((ext_vector_type(2)));
typedef int i32x4 __attribute__((ext_vector_type(4)));
typedef int i32x8 __attribute__((ext_vector_type(8)));

__device__ __forceinline__ float bf2f(bf16 v) { return __builtin_bit_cast(float, ((unsigned)v) << 16); }
typedef __bf16 bf16x2_t __attribute__((ext_vector_type(2)));
__device__ __forceinline__ unsigned pk2(float lo, float hi) { bf16x2_t v; v.x = (__bf16)lo; v.y = (__bf16)hi; return __builtin_bit_cast(unsigned, v); }
__device__ __forceinline__ bf16 f2bf(float f) { const __bf16 b = (__bf16)f; return __builtin_bit_cast(unsigned short, b); }
__device__ __forceinline__ unsigned f2bfu(float f) { return (unsigned)f2bf(f); }
#define MFMA16(a, b, c) __builtin_amdgcn_mfma_f32_16x16x32_bf16((a), (b), (c), 0, 0, 0)
#define LDS_WAIT() asm volatile("s_waitcnt lgkmcnt(0)" ::: "memory")
#define LDS_BARRIER() do { asm volatile("s_waitcnt lgkmcnt(0)" ::: "memory"); __builtin_amdgcn_s_barrier(); asm volatile("" ::: "memory"); } while (0)

namespace pg8 {
typedef unsigned short bf16_t;
constexpr int BM = 256, BK = 64, HALF = 128, HTB = HALF * BK * 2, STAGE_BYTES = 8 * HTB, NXCD = 8, WGM = 8;

__host__ __device__ __forceinline__ int lds_byte(int r, int c) { const int st = (r >> 4) * 2 + (c >> 5), rr = r & 15, cc = c & 31, ob = rr * 64 + cc * 2; return st * 1024 + (ob ^ (((ob >> 9) & 1) << 5)); }
__host__ __device__ __forceinline__ void stage_rc(int b, int& R, int& C) { const int st = b / 1024, sb = b % 1024, swz = sb ^ (((sb >> 9) & 1) << 5); R = (st >> 1) * 16 + swz / 64; C = (st & 1) * 32 + (swz % 64) / 2; }
__host__ __device__ __forceinline__ int perm32(int rho) { const int n = rho >> 4, i = rho & 15; return 8 * (i >> 2) + 4 * n + (i & 3); }

struct Unit { int pm, pn, pc, half; };
struct Gemm { const bf16_t* A; const bf16_t* Bt; const int* rows; int K; int sw = 0x7f7f7f7f, sx = 0x7f7f7f7f; };

struct StaticOrder {
    int nM, nN, nwg, G, c;
    __device__ void init(int M, int N, int G_, int c_) { nM = M / BM; nN = N / BM; nwg = nM * nN; G = G_; c = c_; }
    __device__ bool next(int i, Unit& u) const {
        const long L = (long)i * G + c; if (L >= nwg) return false;
        int wgid = (int)L; { const int q = nwg / NXCD, r = nwg % NXCD, xcd = wgid % NXCD, off = wgid / NXCD; wgid = (xcd < r ? xcd * (q + 1) : r * (q + 1) + (xcd - r) * q) + off; }
        const int nig = WGM * nN, gid = wgid / nig, fm = gid * WGM, gsz = (nM - fm) < WGM ? (nM - fm) : WGM;
        u.pm = fm + ((wgid % nig) % gsz); u.pn = (wgid % nig) / gsz; u.pc = u.pn; u.half = 0; return true;
    }
};
template <int NT> struct MoeOrder {
    const int* tile_expert; int n_tiles, G, c;
    __device__ bool next(int i, Unit& u) const {
        int rt, j;
        if ((G & 7) == 0) { const int x = c & 7, jw = c >> 3, per = G >> 3; const int t0 = (int)(((long)n_tiles * x) >> 3), t1 = (int)(((long)n_tiles * (x + 1)) >> 3);
            const int Lx = i * per + jw; if (Lx >= (t1 - t0) * NT) return false; rt = t0 + Lx / NT; j = Lx % NT; }
        else { const int L = i * G + c; if (L >= n_tiles * NT) return false; rt = L / NT; j = L % NT; }
        const int te = tile_expert[rt], e = te & 0xffff;
        u.pm = rt; u.pn = e * NT + j; u.pc = j; u.half = te >> 16; return true;
    }
};

__device__ __forceinline__ unsigned cvt_pk_bf16(float lo, float hi) { return pk2(lo, hi); }

struct EpiBf16 {
    static constexpr bool PERM = true;
    bf16_t* O; int ldc;
    __device__ __forceinline__ void operator()(const f32x4 (&acc)[2][2][4][2], const Unit& u, int wr, int wc, int fr, int fq) const {
        const int row0 = u.pm * BM + wr * 64 + fr, col0 = u.pc * BM + wc * 32 + 8 * fq;
#pragma unroll
        for (int ai = 0; ai < 2; ++ai)
#pragma unroll
            for (int m = 0; m < 4; ++m) { bf16_t* rowp = O + (size_t)(row0 + ai * HALF + m * 16) * ldc + col0;
#pragma unroll
                for (int bj = 0; bj < 2; ++bj) { const f32x4 v0 = acc[ai][bj][m][0], v1 = acc[ai][bj][m][1];
                    u32x4 w; w.x = cvt_pk_bf16(v0[0], v0[1]); w.y = cvt_pk_bf16(v0[2], v0[3]); w.z = cvt_pk_bf16(v1[0], v1[1]); w.w = cvt_pk_bf16(v1[2], v1[3]);
                    *(u32x4*)(rowp + bj * HALF) = w; } }
    }
};
struct EpiFp8 {
    static constexpr bool PERM = true;
    unsigned char* O; int ldc;
    static __device__ __forceinline__ unsigned pk4(const f32x4 v) {
        const float a = __builtin_amdgcn_fmed3f(v[0], -448.f, 448.f), b = __builtin_amdgcn_fmed3f(v[1], -448.f, 448.f), c = __builtin_amdgcn_fmed3f(v[2], -448.f, 448.f), d = __builtin_amdgcn_fmed3f(v[3], -448.f, 448.f);
        int p = __builtin_amdgcn_cvt_pk_fp8_f32(a, b, 0, false); p = __builtin_amdgcn_cvt_pk_fp8_f32(c, d, p, true); return (unsigned)p; }
    __device__ __forceinline__ void operator()(const f32x4 (&acc)[2][2][4][2], const Unit& u, int wr, int wc, int fr, int fq) const {
        const int row0 = u.pm * BM + wr * 64 + fr, pos0 = u.pc * BM + wc * 64 + 16 * fq;
#pragma unroll
        for (int ai = 0; ai < 2; ++ai) { if (ai == 1 && u.half) break;
#pragma unroll
            for (int m = 0; m < 4; ++m) { u32x4 w; w.x = pk4(acc[ai][0][m][0]); w.y = pk4(acc[ai][0][m][1]); w.z = pk4(acc[ai][1][m][0]); w.w = pk4(acc[ai][1][m][1]);
                *(u32x4*)(O + (size_t)(row0 + ai * HALF + m * 16) * ldc + pos0) = w; } }
    }
};
struct EpiNone {
    static constexpr bool PERM = true;
    bf16_t* O;
    __device__ __forceinline__ void operator()(const f32x4 (&acc)[2][2][4][2], const Unit& u, int wr, int wc, int fr, int fq) const {
        float s = 0.f;
#pragma unroll
        for (int ai = 0; ai < 2; ++ai)
#pragma unroll
            for (int bj = 0; bj < 2; ++bj)
#pragma unroll
                for (int m = 0; m < 4; ++m)
#pragma unroll
                    for (int n = 0; n < 2; ++n) s += acc[ai][bj][m][n][0] + acc[ai][bj][m][n][1] + acc[ai][bj][m][n][2] + acc[ai][bj][m][n][3];
        if (s == 123.4567f) O[u.pm + wr + wc + fr + fq] = 1;
    }
};
struct EpiF32 {
    static constexpr bool PERM = false;
    float* C; int ldc;
    __device__ __forceinline__ void operator()(const f32x4 (&acc)[2][2][4][2], const Unit& u, int wr, int wc, int fr, int fq) const {
        const int row0 = u.pm * BM + wr * 64 + fr, col0 = u.pc * BM + wc * 32 + 4 * fq;
#pragma unroll
        for (int ai = 0; ai < 2; ++ai)
#pragma unroll
            for (int m = 0; m < 4; ++m) { float* rowp = C + (size_t)(row0 + ai * HALF + m * 16) * ldc + col0;
#pragma unroll
                for (int bj = 0; bj < 2; ++bj)
#pragma unroll
                    for (int n = 0; n < 2; ++n) *(f32x4*)(rowp + bj * HALF + n * 16) = acc[ai][bj][m][n]; }
    }
};
template <bool FIRST> struct EpiResid {
    static constexpr bool PERM = true;
    const float* x0; bf16_t* res; const float* src_ctx; float* dst_ctx; const float* gate;
    __device__ __forceinline__ void operator()(const f32x4 (&acc)[2][2][4][2], const Unit& u, int wr, int wc, int fr, int fq) const {
        const int col0 = u.pc * BM + wc * 32 + 8 * fq;
        const bool lat = u.pm < 128;
        const int row0 = (lat ? u.pm : u.pm - 128) * BM + wr * 64 + fr;
        const float* gv = gate + (lat ? (u.pm >> 6) : 2) * 6144 + 2048;
        f32x4 g[2][2];
#pragma unroll
        for (int bj = 0; bj < 2; ++bj)
#pragma unroll
            for (int n = 0; n < 2; ++n) g[bj][n] = *(const f32x4*)(gv + col0 + bj * HALF + n * 4);
#pragma unroll
        for (int ai = 0; ai < 2; ++ai)
#pragma unroll
            for (int m = 0; m < 4; ++m) { const size_t off = (size_t)(row0 + ai * HALF + m * 16) * 1024 + col0;
#pragma unroll
                for (int bj = 0; bj < 2; ++bj) {
                    f32x4 xa, xb;
                    if (!lat) { xa = *(const f32x4*)(src_ctx + off + bj * HALF); xb = *(const f32x4*)(src_ctx + off + bj * HALF + 4); }
                    else if (FIRST) { xa = __builtin_nontemporal_load((const f32x4*)(x0 + off + bj * HALF)); xb = __builtin_nontemporal_load((const f32x4*)(x0 + off + bj * HALF + 4)); }
                    else { const u32x4 q = __builtin_nontemporal_load((const u32x4*)(res + off + bj * HALF));
                        xa = (f32x4){__builtin_bit_cast(float, q.x << 16), __builtin_bit_cast(float, q.x & 0xffff0000u), __builtin_bit_cast(float, q.y << 16), __builtin_bit_cast(float, q.y & 0xffff0000u)};
                        xb = (f32x4){__builtin_bit_cast(float, q.z << 16), __builtin_bit_cast(float, q.z & 0xffff0000u), __builtin_bit_cast(float, q.w << 16), __builtin_bit_cast(float, q.w & 0xffff0000u)}; }
                    const f32x4 ya = xa + g[bj][0] * acc[ai][bj][m][0], yb = xb + g[bj][1] * acc[ai][bj][m][1];
                    if (!lat) { *(f32x4*)(dst_ctx + off + bj * HALF) = ya; *(f32x4*)(dst_ctx + off + bj * HALF + 4) = yb; }
                    else { u32x4 w; w.x = cvt_pk_bf16(ya[0], ya[1]); w.y = cvt_pk_bf16(ya[2], ya[3]); w.z = cvt_pk_bf16(yb[0], yb[1]); w.w = cvt_pk_bf16(yb[2], yb[3]); *(u32x4*)(res + off + bj * HALF) = w; } } }
    }
};
struct EpiSwiglu {
    static constexpr bool PERM = true;
    bf16_t* H;
    __device__ __forceinline__ void operator()(const f32x4 (&acc)[2][2][4][2], const Unit& u, int wr, int wc, int fr, int fq) const {
        const int row0 = u.pm * BM + wr * 64 + fr, col0 = u.pc * HALF + wc * 32 + 8 * fq;
#pragma unroll
        for (int ai = 0; ai < 2; ++ai) { if (ai == 1 && u.half) break;
#pragma unroll
            for (int m = 0; m < 4; ++m) { float h[8];
#pragma unroll
                for (int n = 0; n < 2; ++n)
#pragma unroll
                    for (int j = 0; j < 4; ++j) { const float g = acc[ai][0][m][n][j], up = acc[ai][1][m][n][j]; h[n * 4 + j] = g * __builtin_amdgcn_rcpf(1.f + __expf(-g)) * up; }
                u32x4 w; w.x = cvt_pk_bf16(h[0], h[1]); w.y = cvt_pk_bf16(h[2], h[3]); w.z = cvt_pk_bf16(h[4], h[5]); w.w = cvt_pk_bf16(h[6], h[7]);
                *(u32x4*)(H + (size_t)(row0 + ai * HALF + m * 16) * 256 + col0) = w; } }
    }
};

struct EpiSwiglu8 {
    static constexpr bool PERM = true;
    unsigned char* H;
    __device__ __forceinline__ void operator()(const f32x4 (&acc)[2][2][4][2], const Unit& u, int wr, int wc, int fr, int fq) const {
        const int row0 = u.pm * BM + wr * 64 + fr, col0 = u.pc * HALF + wc * 32 + 8 * fq;
#pragma unroll
        for (int ai = 0; ai < 2; ++ai) { if (ai == 1 && u.half) break;
#pragma unroll
            for (int m = 0; m < 4; ++m) { float h[8];
#pragma unroll
                for (int n = 0; n < 2; ++n)
#pragma unroll
                    for (int j = 0; j < 4; ++j) { const float g = acc[ai][0][m][n][j], up = acc[ai][1][m][n][j]; h[n * 4 + j] = __builtin_amdgcn_fmed3f(4.f * g * __builtin_amdgcn_rcpf(1.f + __expf(-g)) * up, -448.f, 448.f); }
                int lo = __builtin_amdgcn_cvt_pk_fp8_f32(h[0], h[1], 0, false); lo = __builtin_amdgcn_cvt_pk_fp8_f32(h[2], h[3], lo, true);
                int hi = __builtin_amdgcn_cvt_pk_fp8_f32(h[4], h[5], 0, false); hi = __builtin_amdgcn_cvt_pk_fp8_f32(h[6], h[7], hi, true);
                u32x2 w; w.x = (unsigned)lo; w.y = (unsigned)hi;
                *(u32x2*)(H + (size_t)(row0 + ai * HALF + m * 16) * 256 + col0) = w; } }
    }
};

template <class Epi, class Sched, bool GATHER, bool FP8 = false>
__device__ __forceinline__ void gemm_phase(LAS unsigned char* lds, const Gemm g, const Sched& S, const Epi& E, const int tid) {
    const int wid = __builtin_amdgcn_readfirstlane(tid >> 6), lane = tid & 63, wr = wid >> 2, wc = wid & 3, fr = lane & 15, fq = lane >> 4;
    const int K = g.K, nt = K / BK;
    int RA[2], CA[2]; unsigned voffB[2];
#pragma unroll
    for (int i = 0; i < 2; ++i) { int R, C; stage_rc(tid * 16 + i * 8192, R, C); const int Rb = Epi::PERM ? ((R & ~31) + perm32(R & 31)) : R;
        RA[i] = R; CA[i] = C; voffB[i] = (unsigned)(Rb * K + C) * 2u; }
    const unsigned kstep = (unsigned)(BK * 2);
    const unsigned hstep = (unsigned)HALF * (unsigned)K * 2u;
    const unsigned tstep = 2u * hstep;
    const unsigned ldsw = (unsigned)wid * 1024u;
    const int aoff = lds_byte(wr * 64 + fr, fq * 8), boff = lds_byte(wc * 32 + fr, fq * 8);
    const __amdgpu_buffer_rsrc_t srdA = __builtin_amdgcn_make_buffer_rsrc((void*)g.A, (short)0, 0x7fffffff, 0x00020000);
    const __amdgpu_buffer_rsrc_t srdB = __builtin_amdgcn_make_buffer_rsrc((void*)g.Bt, (short)0, 0x7fffffff, 0x00020000);
#define PG8_SA(b, h) (((b) * 2 + (h)) * HTB)
#define PG8_SB(b, h) ((4 + (b) * 2 + (h)) * HTB)
#define PG8_STAGE(bufoff, soff, voff) do { _Pragma("unroll") for (int _i = 0; _i < 2; ++_i) \
        __builtin_amdgcn_raw_ptr_buffer_load_lds(srdB, (LAS unsigned*)(lds + (bufoff) + ldsw + _i * 8192), 16, (int)(voff)[_i], (int)(soff), 0, 0); } while (0)
#define PG8_STAGE2(bufoff, soff, v0, v1) do { \
        __builtin_amdgcn_raw_ptr_buffer_load_lds(srdA, (LAS unsigned*)(lds + (bufoff) + ldsw), 16, (int)(v0), (int)(soff), 0, 0); \
        __builtin_amdgcn_raw_ptr_buffer_load_lds(srdA, (LAS unsigned*)(lds + (bufoff) + ldsw + 8192), 16, (int)(v1), (int)(soff), 0, 0); } while (0)
#define PG8_LDA(dst, b, h) do { _Pragma("unroll") for (int m = 0; m < 4; ++m) _Pragma("unroll") for (int k = 0; k < 2; ++k) dst[m][k] = *(const LAS bf16x8*)(lds + PG8_SA(b, h) + aoff + m * 2048 + k * 1024); } while (0)
#define PG8_LDB(dst, b, h) do { _Pragma("unroll") for (int n = 0; n < 2; ++n) _Pragma("unroll") for (int k = 0; k < 2; ++k) dst[n][k] = *(const LAS bf16x8*)(lds + PG8_SB(b, h) + boff + n * 2048 + k * 1024); } while (0)
#define PG8_MMA(ai, bj, At, Bt) do { __builtin_amdgcn_s_setprio(1); _Pragma("unroll") for (int m = 0; m < 4; ++m) _Pragma("unroll") for (int n = 0; n < 2; ++n) { \
        if constexpr (FP8) { const i32x4 b0_ = __builtin_bit_cast(i32x4, Bt[n][0]), b1_ = __builtin_bit_cast(i32x4, Bt[n][1]), a0_ = __builtin_bit_cast(i32x4, At[m][0]), a1_ = __builtin_bit_cast(i32x4, At[m][1]); \
            const i32x8 w8_ = __builtin_shufflevector(b0_, b1_, 0, 1, 2, 3, 4, 5, 6, 7), x8_ = __builtin_shufflevector(a0_, a1_, 0, 1, 2, 3, 4, 5, 6, 7); \
            asm volatile("v_mfma_scale_f32_16x16x128_f8f6f4 %0, %1, %2, %0, %3, %4 op_sel_hi:[0,0,0]" : "+v"(acc[ai][bj][m][n]) : "v"(w8_), "v"(x8_), "v"(sw_), "v"(sx_)); } \
        else { _Pragma("unroll") for (int k = 0; k < 2; ++k) acc[ai][bj][m][n] = __builtin_amdgcn_mfma_f32_16x16x32_bf16(Bt[n][k], At[m][k], acc[ai][bj][m][n], 0, 0, 0); } } __builtin_amdgcn_s_setprio(0); } while (0)
#define PG8_WAIT_V(n) asm volatile("s_waitcnt vmcnt(" #n ")" ::: "memory")
#define PG8_WAIT_L(n) asm volatile("s_waitcnt lgkmcnt(" #n ")" ::: "memory")
#define PG8_BAR __builtin_amdgcn_s_barrier()
#define PG8_SCHED __builtin_amdgcn_sched_barrier(0)
    Unit cur, nxt; int ui = 0;
    if (!S.next(0, cur)) return;
    int sw_ = g.sw, sx_ = g.sx;
    if constexpr (FP8) asm volatile("" : "+v"(sw_), "+v"(sx_));
    else { (void)sw_; (void)sx_; }
    f32x4 acc[2][2][4][2];
#pragma unroll
    for (int a = 0; a < 2; ++a)
#pragma unroll
        for (int b = 0; b < 2; ++b)
#pragma unroll
            for (int m = 0; m < 4; ++m)
#pragma unroll
                for (int n = 0; n < 2; ++n) acc[a][b][m][n] = (f32x4){0.f, 0.f, 0.f, 0.f};
    bf16x8 At[4][2], B0[2][2], B1[2][2];
    unsigned c00, c01, c10, c11, n00, n01, n10, n11;
    unsigned cA, cB = (unsigned)cur.pn * tstep;
    if constexpr (GATHER) {
        const int* rp = g.rows + (size_t)cur.pm * BM; const unsigned rb = (unsigned)K * 2u;
        c00 = (unsigned)rp[RA[0]] * rb + (unsigned)CA[0] * 2u; c01 = (unsigned)rp[RA[1]] * rb + (unsigned)CA[1] * 2u;
        c10 = (unsigned)rp[HALF + RA[0]] * rb + (unsigned)CA[0] * 2u; c11 = (unsigned)rp[HALF + RA[1]] * rb + (unsigned)CA[1] * 2u;
        cA = 0u;
    } else {
        c00 = (unsigned)(RA[0] * K + CA[0]) * 2u; c01 = (unsigned)(RA[1] * K + CA[1]) * 2u;
        c10 = (unsigned)((HALF + RA[0]) * K + CA[0]) * 2u; c11 = (unsigned)((HALF + RA[1]) * K + CA[1]) * 2u;
        cA = (unsigned)cur.pm * tstep;
    }
    n00 = c00; n01 = c01; n10 = c10; n11 = c11;
    PG8_STAGE(PG8_SB(0, 0), cB, voffB); PG8_STAGE(PG8_SB(0, 1), cB + hstep, voffB); PG8_STAGE2(PG8_SA(0, 0), cA, c00, c01); PG8_STAGE2(PG8_SA(0, 1), cA, c10, c11);
    if (wr == 1) PG8_BAR;
    PG8_WAIT_V(2); PG8_BAR;
    PG8_STAGE(PG8_SB(1, 0), cB + kstep, voffB); PG8_STAGE2(PG8_SA(1, 0), cA + kstep, c00, c01); PG8_STAGE(PG8_SB(1, 1), cB + hstep + kstep, voffB);
    PG8_WAIT_V(6); PG8_BAR;
    for (;;) {
        const bool has_next = S.next(ui + 1, nxt);
        unsigned nA; const unsigned nB = has_next ? (unsigned)nxt.pn * tstep : cB;
        if constexpr (GATHER) {
            nA = 0u;
            if (has_next) { const int* rp = g.rows + (size_t)nxt.pm * BM; const unsigned rb = (unsigned)K * 2u;
                n00 = (unsigned)rp[RA[0]] * rb + (unsigned)CA[0] * 2u; n01 = (unsigned)rp[RA[1]] * rb + (unsigned)CA[1] * 2u;
                n10 = (unsigned)rp[HALF + RA[0]] * rb + (unsigned)CA[0] * 2u; n11 = (unsigned)rp[HALF + RA[1]] * rb + (unsigned)CA[1] * 2u; }
            else { n00 = c00; n01 = c01; n10 = c10; n11 = c11; }
        } else {
            nA = has_next ? (unsigned)nxt.pm * tstep : cA;
        }
        const bool hf = cur.half != 0;
#pragma unroll 1
        for (int t = 0; t < nt; t += 2) {
            const bool last = (t == nt - 2);
            const unsigned a1 = cA + (unsigned)(t + 1) * kstep;
            const unsigned a2 = last ? nA : cA + (unsigned)(t + 2) * kstep, b2 = last ? nB : cB + (unsigned)(t + 2) * kstep;
            const unsigned a3 = a2 + kstep, b3 = b2 + kstep;
            unsigned s00 = c00, s01 = c01, s10 = c10, s11 = c11;
            if constexpr (GATHER) { s00 = last ? n00 : c00; s01 = last ? n01 : c01; s10 = last ? n10 : c10; s11 = last ? n11 : c11; }
            PG8_LDB(B0, 0, 0); PG8_LDB(B1, 0, 1); PG8_SCHED; PG8_LDA(At, 0, 0); PG8_STAGE2(PG8_SA(1, 1), a1, c10, c11);
            PG8_WAIT_V(8); PG8_WAIT_L(0); PG8_BAR; PG8_MMA(0, 0, At, B0); PG8_MMA(0, 1, At, B1); PG8_BAR; PG8_SCHED;
            if (!hf) PG8_LDA(At, 0, 1); PG8_STAGE(PG8_SB(0, 0), b2, voffB); PG8_STAGE(PG8_SB(0, 1), b2 + hstep, voffB); PG8_STAGE2(PG8_SA(0, 0), a2, s00, s01);
            PG8_WAIT_V(8); PG8_WAIT_L(0); PG8_BAR; if (!hf) { PG8_MMA(1, 0, At, B0); PG8_MMA(1, 1, At, B1); } PG8_BAR; PG8_SCHED;
            PG8_LDB(B0, 1, 0); PG8_LDB(B1, 1, 1); PG8_SCHED; PG8_LDA(At, 1, 0); PG8_STAGE2(PG8_SA(0, 1), a2, s10, s11);
            PG8_WAIT_V(8); PG8_WAIT_L(0); PG8_BAR; PG8_MMA(0, 0, At, B0); PG8_MMA(0, 1, At, B1); PG8_BAR; PG8_SCHED;
            if (!hf) PG8_LDA(At, 1, 1); PG8_STAGE(PG8_SB(1, 0), b3, voffB); PG8_STAGE(PG8_SB(1, 1), b3 + hstep, voffB); PG8_STAGE2(PG8_SA(1, 0), a3, s00, s01);
            PG8_WAIT_V(8); PG8_WAIT_L(0); PG8_BAR; if (!hf) { PG8_MMA(1, 0, At, B0); PG8_MMA(1, 1, At, B1); } PG8_BAR; PG8_SCHED;
        }
        if (wr == 0) PG8_BAR;
        if constexpr (FP8) { asm volatile("s_nop 15\n\ts_nop 7" ::: "memory"); PG8_SCHED; }
        E(acc, cur, wr, wc, fr, fq);
        if (!has_next) break;
#pragma unroll
        for (int a = 0; a < 2; ++a)
#pragma unroll
            for (int b = 0; b < 2; ++b)
#pragma unroll
                for (int m = 0; m < 4; ++m)
#pragma unroll
                    for (int n = 0; n < 2; ++n) acc[a][b][m][n] = (f32x4){0.f, 0.f, 0.f, 0.f};
        cur = nxt; cA = nA; cB = nB; ++ui;
        if constexpr (GATHER) { c00 = n00; c01 = n01; c10 = n10; c11 = n11; }
        if (wr == 1) PG8_BAR;
    }
    PG8_WAIT_V(0);
    PG8_BAR;
#undef PG8_SA
#undef PG8_SB
#undef PG8_STAGE
#undef PG8_STAGE2
#undef PG8_LDA
#undef PG8_LDB
#undef PG8_MMA
#undef PG8_WAIT_V
#undef PG8_WAIT_L
#undef PG8_BAR
#undef PG8_SCHED
}
}

#define XB_TMO      128
#define XB_XCNT(j)  (256  + 64 * (j))
#define XB_XSUB(j)  (1280 + 64 * (j))
#define XB_XGEN(j)  (2304 + 64 * (j))
#define XB_TOP      3328
#define XB_TOPGEN   3392
#define XCD_BAR_WORDS 3456
#define XB_SPIN_CAP (1u << 18)

__device__ __forceinline__ unsigned xb_ld(unsigned* p)              { return __hip_atomic_load(p, __ATOMIC_RELAXED, __HIP_MEMORY_SCOPE_AGENT); }
__device__ __forceinline__ unsigned xb_add(unsigned* p, unsigned v) { return __hip_atomic_fetch_add(p, v, __ATOMIC_RELAXED, __HIP_MEMORY_SCOPE_AGENT); }
__device__ __forceinline__ unsigned xb_xcc_id() { return (unsigned)__builtin_amdgcn_s_getreg((3 << 11) | 20) & 0xFu; }
#define XB_SPIN(cond, bar) do { unsigned _sp = 0; while (cond) { __builtin_amdgcn_s_sleep(1); \
    if ((++_sp & 255u) == 0u) { if (xb_ld(&(bar)[XB_TMO])) break; if (_sp > XB_SPIN_CAP) { atomicAdd(&(bar)[XB_TMO], 1u); break; } } } } while (0)

struct XcdBarrier { unsigned* bar; unsigned x; volatile LAS unsigned* st; };

__device__ __forceinline__ XcdBarrier xcd_barrier_post(unsigned* bar, volatile LAS unsigned* st) {
    XcdBarrier b; b.bar = bar; b.x = xb_xcc_id(); b.st = st;
    if (threadIdx.x == 0) (void)xb_add(&bar[XB_XCNT(b.x)], 1u);
    return b;
}
__device__ __forceinline__ void xcd_barrier_complete(unsigned* bar, unsigned x, unsigned& nloc, unsigned& nx) {
    const unsigned G = gridDim.x * gridDim.y * gridDim.z;
    unsigned sum, cnt, mine, sp = 0u;
    for (;;) {
        sum = 0u; cnt = 0u; mine = 0u;
#pragma unroll 1
        for (unsigned j = 0; j < 16; ++j) { const unsigned c = xb_ld(&bar[XB_XCNT(j)]); sum += c; cnt += (c > 0u) ? 1u : 0u; mine = (j == x) ? c : mine; }
        if (sum == G) break;
        __builtin_amdgcn_s_sleep(1);
        if ((++sp & 255u) == 0u) { if (xb_ld(&bar[XB_TMO])) break; if (sp > XB_SPIN_CAP) { atomicAdd(&bar[XB_TMO], 1u); break; } }
    }
    nloc = mine > 0u ? mine : 1u; nx = cnt > 0u ? cnt : 1u;
}
__device__ __forceinline__ void xcd_barrier(const XcdBarrier& b) {
    asm volatile("s_waitcnt vmcnt(0)" ::: "memory");
    __syncthreads();
    if (threadIdx.x == 0) {
        unsigned* bar = b.bar;
        __builtin_amdgcn_s_waitcnt(0);
        unsigned nloc = b.st[0], nx = b.st[1];
        if (nloc == 0u) { xcd_barrier_complete(bar, b.x, nloc, nx); b.st[0] = nloc; b.st[1] = nx; }
        const unsigned old = xb_add(&bar[XB_XSUB(b.x)], 1u);
        const unsigned gen = old / nloc;
        if (old + 1u == (gen + 1u) * nloc) {
            __builtin_amdgcn_fence(__ATOMIC_RELEASE, "agent");
            asm volatile("s_waitcnt vmcnt(0)" ::: "memory");
            const unsigned og = xb_add(&bar[XB_TOP], 1u);
            const unsigned tg = og / nx;
            if (og + 1u != (tg + 1u) * nx) XB_SPIN(xb_ld(&bar[XB_TOP]) < (tg + 1u) * nx, bar);
            __builtin_amdgcn_fence(__ATOMIC_ACQUIRE, "agent");
            xb_add(&bar[XB_XGEN(b.x)], 1u);
            asm volatile("s_waitcnt vmcnt(0)" ::: "memory");
        } else {
            XB_SPIN(xb_ld(&bar[XB_XGEN(b.x)]) == gen, bar);
            __builtin_amdgcn_fence(__ATOMIC_ACQUIRE, "agent");
            asm volatile("s_waitcnt vmcnt(0)" ::: "memory");
        }
    }
    __syncthreads();
}

constexpr int D = 1024, NBATCH = 2, SEQ = 16384, CTXL = 256;
constexpr int TL = NBATCH * SEQ, TC = NBATCH * CTXL, TT = TL + TC;
constexpr int INW = 3328;
constexpr int ZQ = 0, ZFF = 512, ZFB = 1024, ZV = 1536, ZG = 2048, ZXB = 2560, ZYB = 2816, ZU = 3072;
constexpr int NEXP = 256, TOPK = 8;
constexpr float EPS = 1e-6f;
constexpr int NWAVES = 8, NTHR = 512;
constexpr int CV_TILES = 257 * 48;
constexpr int CV_OUTP = 248 * 6;
constexpr int CV_ROUT = 126 * 10;
constexpr int HG_SLOTS = 130;
constexpr int LR_SLOTS = 260;
constexpr int MAXROWS = 364800;

constexpr size_t MiB = 1u << 20;
constexpr size_t WS_CTL = 0, CTL_ZERO_BYTES = 1 * MiB;
constexpr size_t WS_MOD = 1 * MiB;
constexpr size_t WS_TAB = 2 * MiB;
constexpr size_t TAB_FC = 0, TAB_FS = 32768, TAB_CS = 65536, TAB_LB = 81920  , TAB_LRUW = 86016  , TAB_LRUCL = 348160  , TAB_C256 = 352256  , TAB_S256 = 483328  ;
constexpr size_t WS_META = 3 * MiB;
constexpr size_t WS_WIN = 4 * MiB;
constexpr size_t WS_WOUT = 18 * MiB;
constexpr size_t WS_WR = 22 * MiB;
constexpr size_t WS_XC = 24 * MiB;
constexpr size_t WS_LRUC = 26 * MiB;
constexpr size_t LRUC_STRIDE = (size_t)2 * 2 * LR_SLOTS * 256 * 4;
constexpr size_t WS_SEL = 30 * MiB;
constexpr size_t SEL_STRIDE = (size_t)TT * 8 * 4;
constexpr size_t WS_ROWTOK = 34 * MiB;
constexpr size_t WS_HD = 36 * MiB;
constexpr size_t WS_LOGIT = 38 * MiB;
constexpr size_t WS_HB = 72 * MiB;
constexpr size_t WS_WEXP = 138 * MiB;
constexpr size_t WEXP_GU_BYTES = (size_t)257 * 512 * 1024;
constexpr size_t WS_HB8 = 340 * MiB;
constexpr size_t WS_BIG = 524 * MiB;
constexpr size_t WS_Z = WS_BIG;
constexpr size_t WS_MIX = WS_BIG + 212 * MiB;
constexpr size_t WS_HS = WS_BIG + 278 * MiB;
constexpr size_t WS_FA = WS_BIG + 410 * MiB;
constexpr size_t WS_GE = WS_BIG + 442 * MiB;
constexpr size_t WS_GK = WS_BIG + 508 * MiB;
constexpr size_t WS_HV = WS_BIG + 574 * MiB;
constexpr size_t WS_HBUF = WS_BIG;
constexpr size_t WS_Y = WS_BIG + 180 * MiB;
constexpr size_t WS_RES = 384 * MiB;
constexpr size_t WS_WEXP1 = 1104 * MiB;
constexpr size_t WS_END = WS_WEXP1 + (size_t)257 * 768 * 1024;
static_assert(WS_Y + (size_t)MAXROWS * 1024 <= WS_WEXP1 && WS_HV + (size_t)16 * 2 * HG_SLOTS * 256 * 4 <= WS_WEXP1 && WS_GK + (size_t)2 * TT * 512 * 2 <= WS_HV && WS_GE + (size_t)2 * TT * 512 * 2 <= WS_GK && WS_FA + (size_t)2 * 2 * 128 * 128 * 256 * 2 <= WS_GE, "overlay regions end below the second weight buffer");
static_assert(WS_Z + (size_t)TT * INW * 2 <= WS_MIX && WS_MIX + (size_t)TT * 1024 * 2 <= WS_HS && WS_HS + (size_t)16 * HG_SLOTS * 65536 <= WS_FA, "mixer overlay map");
static_assert(WS_HB8 + (size_t)TT * 1024 <= WS_RES && WS_RES + (size_t)TL * 2048 <= WS_BIG, "residual stream map");
static_assert(WS_HBUF + (size_t)MAXROWS * 256 * 2 <= WS_Y && WS_WEXP + (size_t)257 * 768 * 1024 <= WS_HB8 && WS_HB8 + (size_t)TT * 1024 <= WS_BIG && WS_HB + (size_t)TT * 2048 <= WS_WEXP, "moe overlay map");
constexpr int CW_BAR = 4096;
constexpr int CW_CVQ = 8192;
constexpr int CW_CNT = 16384;

constexpr int LDS_BYTES = 151552;
constexpr int MISC_OFF = 150528;

struct Args { const float* in[28]; float* out; unsigned char* ws; int ph_lo, ph_hi; };

typedef const float* cfptr;
#define CAS __attribute__((address_space(4)))
struct Frame {
    LAS unsigned char* lds;
    int tid, lane, wave, G;
    const CAS cfptr* in;
    float* out; unsigned char* ws;
};
#define F_X(F)      ((F).in[0])
#define F_C(F)      ((F).in[1])
#define F_CTX(F)    ((F).in[2])
#define F_CCTX(F)   ((F).in[3])

template <int CTRL> __device__ __forceinline__ float dpp_f(float v) { const int i = __builtin_bit_cast(int, v); return __builtin_bit_cast(float, __builtin_amdgcn_update_dpp(i, i, CTRL, 0xf, 0xf, false)); }
template <int CTRL> __device__ __forceinline__ int dpp_i(int v) { return __builtin_amdgcn_update_dpp(v, v, CTRL, 0xf, 0xf, false); }
__device__ __forceinline__ float rdlane_f(float v, int lane) { return __builtin_bit_cast(float, __builtin_amdgcn_readlane(__builtin_bit_cast(int, v), lane)); }
__device__ __forceinline__ float wave_sum(float v) {
    v += dpp_f<0xB1>(v); v += dpp_f<0x4E>(v); v += dpp_f<0x141>(v); v += dpp_f<0x140>(v);
    return (rdlane_f(v, 0) + rdlane_f(v, 16)) + (rdlane_f(v, 32) + rdlane_f(v, 48));
}
__device__ __forceinline__ float sigmoidf_(float z) { return __builtin_amdgcn_rcpf(1.f + __expf(-z)); }

__device__ __forceinline__ void transpose_item(const float* W, int ldw, int k0, int n0, bf16* WT, int ldk, int drow0, LAS float* scr, int lane) {
#pragma unroll 8
    for (int i = 0; i < 32; ++i) { const int kk = 2 * i + (lane >> 5); scr[kk * 33 + (lane & 31)] = W[(size_t)(k0 + kk) * ldw + n0 + (lane & 31)]; }
    LDS_WAIT();
    const int c = lane & 7;
#pragma unroll
    for (int j = 0; j < 4; ++j) { const int n = (lane >> 3) + 8 * j; const LAS float* s = scr + (8 * c) * 33 + n;
        u32x4 o; o.x = pk2(s[0 * 33], s[1 * 33]); o.y = pk2(s[2 * 33], s[3 * 33]); o.z = pk2(s[4 * 33], s[5 * 33]); o.w = pk2(s[6 * 33], s[7 * 33]);
        *(u32x4*)(WT + (size_t)(drow0 + n) * ldk + k0 + 8 * c) = o; }
    LDS_WAIT();
}

__device__ __forceinline__ void norm_row_bf16(const float* xrow, const float* gain, const float* scl, const float* sft, bf16* orow, int lane, unsigned char* o8 = nullptr, const bf16* xrow16 = nullptr) {
    f32x4 v[4]; float s = 0.f;
    if (xrow16) {
#pragma unroll
        for (int j = 0; j < 4; ++j) { const u32x2 q = __builtin_nontemporal_load((const u32x2*)(xrow16 + 4 * lane + 256 * j));
            v[j] = (f32x4){__builtin_bit_cast(float, q.x << 16), __builtin_bit_cast(float, q.x & 0xffff0000u), __builtin_bit_cast(float, q.y << 16), __builtin_bit_cast(float, q.y & 0xffff0000u)}; }
    } else {
#pragma unroll
        for (int j = 0; j < 4; ++j) v[j] = __builtin_nontemporal_load((const f32x4*)(xrow + 4 * lane + 256 * j));
    }
#pragma unroll
    for (int j = 0; j < 4; ++j) s += (v[j].x * v[j].x + v[j].y * v[j].y) + (v[j].z * v[j].z + v[j].w * v[j].w);
    const float rstd = rsqrtf(wave_sum(s) * (1.f / D) + EPS);
#pragma unroll
    for (int j = 0; j < 4; ++j) { const int c = 4 * lane + 256 * j;
        const f32x4 g = *(const f32x4*)(gain + c), sc = *(const f32x4*)(scl + c), sh = *(const f32x4*)(sft + c);
        const f32x4 y = v[j] * rstd * g * (sc + 1.f) + sh;
        u32x2 o; o.x = pk2(y.x, y.y); o.y = pk2(y.z, y.w); *(u32x2*)(orow + c) = o;
        if (o8) { int p8 = __builtin_amdgcn_cvt_pk_fp8_f32(__builtin_amdgcn_fmed3f(y.x, -448.f, 448.f), __builtin_amdgcn_fmed3f(y.y, -448.f, 448.f), 0, false);
            p8 = __builtin_amdgcn_cvt_pk_fp8_f32(__builtin_amdgcn_fmed3f(y.z, -448.f, 448.f), __builtin_amdgcn_fmed3f(y.w, -448.f, 448.f), p8, true); *(int*)(o8 + c) = p8; } }
}

__device__ __forceinline__ void convert_tile(Frame& F, const float* src, int ldw, bf16* dst, int ldk, int k0, int rowA, int rowB) {
    LAS bf16* T = (LAS bf16*)F.lds;
    const int tid = F.tid, w = F.wave, lane = F.lane;
    f32x4 v[8];
#pragma unroll
    for (int j = 0; j < 8; ++j) v[j] = *(const f32x4*)(src + (size_t)(8 * w + j) * ldw + 4 * lane);
#pragma unroll
    for (int j = 0; j < 8; ++j) { u32x2 o; o.x = pk2(v[j].x, v[j].y); o.y = pk2(v[j].z, v[j].w); *(LAS u32x2*)(T + (8 * w + j) * 264 + ((4 * lane) ^ (w << 3))) = o; }
    __syncthreads();
#pragma unroll
    for (int j = 0; j < 4; ++j) { const int p = tid + NTHR * j, kc = p & 7, n = p >> 3; const LAS bf16* t = T + (8 * kc) * 264 + (n ^ (kc << 3));
        u32x4 o; o.x = (unsigned)t[0] | ((unsigned)t[264] << 16); o.y = (unsigned)t[2 * 264] | ((unsigned)t[3 * 264] << 16);
        o.z = (unsigned)t[4 * 264] | ((unsigned)t[5 * 264] << 16); o.w = (unsigned)t[6 * 264] | ((unsigned)t[7 * 264] << 16);
        const int row = n < 128 ? rowA + n : rowB + n - 128;
        *(u32x4*)(dst + (size_t)row * ldk + k0 + 8 * kc) = o; }
    __syncthreads();
}

__device__ __forceinline__ void convert_tile8(Frame& F, const float* src, int ldw, unsigned char* dst8, int ldk, int k0, int rowA, int rowB, float scl) {
    LAS unsigned char* O = F.lds;
    const int tid = F.tid, w = F.wave, lane = F.lane;
    f32x4 v[8];
#pragma unroll
    for (int j = 0; j < 8; ++j) v[j] = __builtin_nontemporal_load((const f32x4*)(src + (size_t)(8 * w + j) * ldw + 4 * lane));
#pragma unroll
    for (int i = 0; i < 4; ++i) {
        int lo = __builtin_amdgcn_cvt_pk_fp8_f32(v[0][i] * scl, v[1][i] * scl, 0, false); lo = __builtin_amdgcn_cvt_pk_fp8_f32(v[2][i] * scl, v[3][i] * scl, lo, true);
        int hi = __builtin_amdgcn_cvt_pk_fp8_f32(v[4][i] * scl, v[5][i] * scl, 0, false); hi = __builtin_amdgcn_cvt_pk_fp8_f32(v[6][i] * scl, v[7][i] * scl, hi, true);
        u32x2 o; o.x = (unsigned)lo; o.y = (unsigned)hi;
        *(LAS u32x2*)(O + (i * 64 + lane) * 72 + 8 * w) = o; }
    __syncthreads();
#pragma unroll
    for (int j = 0; j < 2; ++j) { const int p = tid + NTHR * j, n = p >> 2, q = p & 3, pos = (n & 3) * 64 + (n >> 2);
        const u32x2 a = *(const LAS u32x2*)(O + pos * 72 + 16 * q), c = *(const LAS u32x2*)(O + pos * 72 + 16 * q + 8);
        const int row = n < 128 ? rowA + n : rowB + n - 128;
        __builtin_nontemporal_store((u32x4){a.x, a.y, c.x, c.y}, (u32x4*)(dst8 + (size_t)row * ldk + k0 + 16 * q)); }
    __syncthreads();
}

__device__ __forceinline__ void phase_g0(Frame& F) {
    float* mod = (float*)(F.ws + WS_MOD);
    {
        LAS float* sc = (LAS float*)F.lds; LAS float* red = sc + 3072;
        for (int u = blockIdx.x; u < 192; u += F.G) {
            const int l = u / 96, n0 = (u % 96) * 64;
            for (int i = F.tid; i < 3072; i += NTHR) { const int r = i >> 10, k = i & 1023; const float c = r < 2 ? F_C(F)[r * 1024 + k] : F_CCTX(F)[k]; sc[i] = c / (1.f + __expf(-c)); }
            __syncthreads();
            const int col = F.tid & 63, kg = F.tid >> 6;
            const float* W = F.in[4] + (size_t)l * 1024 * 6144 + n0 + col;
            float a0 = 0.f, a1 = 0.f, a2 = 0.f;
#pragma unroll 1
            for (int k0 = kg * 128; k0 < kg * 128 + 128; k0 += 32) { float wv[32];
#pragma unroll
                for (int j = 0; j < 32; ++j) wv[j] = W[(size_t)(k0 + j) * 6144];
#pragma unroll
                for (int j = 0; j < 32; ++j) { const int k = k0 + j; a0 += sc[k] * wv[j]; a1 += sc[1024 + k] * wv[j]; a2 += sc[2048 + k] * wv[j]; } }
            red[(kg * 3 + 0) * 64 + col] = a0; red[(kg * 3 + 1) * 64 + col] = a1; red[(kg * 3 + 2) * 64 + col] = a2;
            __syncthreads();
            if (F.tid < 192) { const int r = F.tid >> 6, cc = F.tid & 63; float s = F.in[5][l * 6144 + n0 + cc];
#pragma unroll
                for (int q = 0; q < 8; ++q) s += red[(q * 3 + r) * 64 + cc];
                mod[(l * 3 + r) * 6144 + n0 + cc] = s; }
            __syncthreads();
        }
    }
    {
        constexpr int PER_L = 16 * (13 + 4 + 1);
        for (int it = blockIdx.x; it < 2 * PER_L; it += F.G) {
            const int l = it / PER_L; int r = it % PER_L; const int kb = r / 18; r %= 18;
            if (r < 13) convert_tile(F, F.in[8] + (size_t)l * 1024 * INW + (size_t)(64 * kb) * INW + 256 * r, INW, (bf16*)(F.ws + WS_WIN) + (size_t)l * INW * 1024, 1024, 64 * kb, 256 * r, 256 * r + 128);
            else if (r < 17) convert_tile(F, F.in[18] + (size_t)l * 1024 * 1024 + (size_t)(64 * kb) * 1024 + 256 * (r - 13), 1024, (bf16*)(F.ws + WS_WOUT) + (size_t)l * 1024 * 1024, 1024, 64 * kb, 256 * (r - 13), 256 * (r - 13) + 128);
            else convert_tile(F, F.in[19] + (size_t)l * 1024 * 256 + (size_t)(64 * kb) * 256, 256, (bf16*)(F.ws + WS_WR) + (size_t)l * 256 * 1024, 1024, 64 * kb, 0, 128);
        }
    }
    {
        const int gt = blockIdx.x * NTHR + F.tid, NGT = F.G * NTHR;
        bf16* Fc = (bf16*)(F.ws + WS_TAB + TAB_FC); bf16* Fs = (bf16*)(F.ws + WS_TAB + TAB_FS); bf16* CS = (bf16*)(F.ws + WS_TAB + TAB_CS);
        for (int i = gt; i < 128 * 128; i += NGT) { const int k = i >> 7, n = i & 127; float s, c; sincospif((float)((k * n) & 127) * (1.f / 64.f), &s, &c); Fc[i] = f2bf(c); Fs[i] = f2bf(s); }
        for (int i = gt; i < 64 * 128; i += NGT) { const int m = i >> 7, kap = i & 127; float s, c; sincospif((float)((m * (kap & 63)) & 63) * (1.f / 32.f), &s, &c); CS[i] = f2bf(kap < 64 ? c : s); }
        bf16* C256 = (bf16*)(F.ws + WS_TAB + TAB_C256); bf16* S256 = (bf16*)(F.ws + WS_TAB + TAB_S256);
        for (int i = gt; i < 256 * 256; i += NGT) { const int k = i >> 8, n = i & 255; float sn, cs; sincospif((float)((k * n) & 255) * (1.f / 128.f), &sn, &cs); C256[i] = f2bf(cs); S256[i] = f2bf(-sn); }
        float* lb = (float*)(F.ws + WS_TAB + TAB_LB);
        for (int i = gt; i < 1024; i += NGT) { const int l = i >> 9, ch = i & 511; lb[i] = l == 0 ? 0.f : sigmoidf_(F.in[9][512 + ch] - F.in[9][ch]); }
        bf16* lw = (bf16*)(F.ws + WS_TAB + TAB_LRUW);
        for (int i = gt; i < 2 * 2 * 4 * 128 * 64; i += NGT) {
            const int k = i & 63, n = (i >> 6) & 127, ldh = i >> 13;
            const float v = n < 64 ? F.in[13][(size_t)ldh * 4096 + k * 64 + n] : F.in[15][(size_t)ldh * 4096 + k * 64 + (n - 64)];
            lw[i] = f2bf(v); }
        float* cl = (float*)(F.ws + WS_TAB + TAB_LRUCL);
        for (int i = gt; i < 1024; i += NGT) { const float lam = F.in[17][i]; const float sp = lam > 15.f ? __expf(-lam) : log1pf(__expf(-lam)); cl[i] = 8.f * sp; }
    }
}

__device__ __forceinline__ void hprep_rows(Frame& F, int l, const float* xlat, const float* xctx, int nrows, int voff_sh, int voff_sc, const float* gain, bool with8 = false, const bf16* xlat16 = nullptr) {
    const float* mod = (const float*)(F.ws + WS_MOD) + (size_t)l * 3 * 6144;
    bf16* HB = (bf16*)(F.ws + WS_HB);
    const int gw = blockIdx.x * NWAVES + F.wave, NGW = F.G * NWAVES;
    for (int m = gw; m < nrows; m += NGW) {
        const float* xr = m < TL ? xlat + (size_t)m * D : xctx + (size_t)(m - TL) * D; const int r = m < TL ? (m >> 14) : 2;
        norm_row_bf16(xr, gain, mod + r * 6144 + voff_sc, mod + r * 6144 + voff_sh, HB + (size_t)m * D, F.lane, with8 ? F.ws + WS_HB8 + (size_t)m * D : nullptr, (xlat16 && m < TL) ? xlat16 + (size_t)m * D : nullptr);
    }
}

__device__ __forceinline__ void cv_tile(Frame& F, int it_all) {
    const int l = it_all >= CV_TILES ? 1 : 0, it = it_all - l * CV_TILES;
    unsigned char* wb = F.ws + (l ? WS_WEXP1 : WS_WEXP);
    unsigned char* WGU = wb; unsigned char* WD = wb + WEXP_GU_BYTES;
    const int e = it / 48, t = it % 48;
    if (t < 32) {
        const int mat = t >> 4, kb = t & 15;
        const float* src = (e < 256 ? (mat == 0 ? F.in[21] : F.in[22]) + ((size_t)l * 256 + e) * 1024 * 256 : (mat == 0 ? F.in[24] : F.in[25]) + (size_t)l * 1024 * 256) + (size_t)(64 * kb) * 256;
        convert_tile8(F, src, 256, WGU, 1024, 64 * kb, e * 512 + mat * 128, e * 512 + 256 + mat * 128, 32.f);
    } else {
        const int kb = (t - 32) >> 2, nb = (t - 32) & 3;
        const float* src = (e < 256 ? F.in[23] + ((size_t)l * 256 + e) * 256 * 1024 : F.in[26] + (size_t)l * 256 * 1024) + (size_t)(64 * kb) * 1024 + 256 * nb;
        convert_tile8(F, src, 1024, WD, 256, 64 * kb, e * 1024 + 256 * nb, e * 1024 + 256 * nb + 128, 16.f);
    }
}
__device__ __forceinline__ int cv_pull(Frame& F) {
    volatile LAS int* slot = (volatile LAS int*)(F.lds + MISC_OFF) + 16;
    if (F.tid == 0) { const unsigned t = __hip_atomic_fetch_add((unsigned*)(F.ws + WS_CTL) + CW_CVQ, 1u, __ATOMIC_RELAXED, __HIP_MEMORY_SCOPE_AGENT); slot[0] = t < (unsigned)(2 * CV_TILES) ? (int)t : -1; }
    __syncthreads(); const int t = slot[0]; __syncthreads(); return t;
}
__device__ __forceinline__ void convert_experts(Frame& F, int l) {
    for (;;) { const int t = cv_pull(F); if (t < 0) break; cv_tile(F, t); if (t >= (l + 1) * CV_TILES) break; }
}

__device__ __forceinline__ void xcd_barrier_cv(const XcdBarrier& b, Frame& F) {
    volatile LAS unsigned* st = (volatile LAS unsigned*)(F.lds + MISC_OFF) + 20;
    asm volatile("s_waitcnt vmcnt(0)" ::: "memory");
    __syncthreads();
    if (threadIdx.x == 0) {
        unsigned* bar = b.bar;
        __builtin_amdgcn_s_waitcnt(0);
        unsigned nloc = b.st[0], nx = b.st[1];
        if (nloc == 0u) { xcd_barrier_complete(bar, b.x, nloc, nx); b.st[0] = nloc; b.st[1] = nx; }
        const unsigned old = xb_add(&bar[XB_XSUB(b.x)], 1u);
        const unsigned gen = old / nloc;
        if (old + 1u == (gen + 1u) * nloc) {
            __builtin_amdgcn_fence(__ATOMIC_RELEASE, "agent");
            asm volatile("s_waitcnt vmcnt(0)" ::: "memory");
            const unsigned og = xb_add(&bar[XB_TOP], 1u);
            const unsigned tg = og / nx;
            if (og + 1u != (tg + 1u) * nx) XB_SPIN(xb_ld(&bar[XB_TOP]) < (tg + 1u) * nx, bar);
            __builtin_amdgcn_fence(__ATOMIC_ACQUIRE, "agent");
            xb_add(&bar[XB_XGEN(b.x)], 1u);
            asm volatile("s_waitcnt vmcnt(0)" ::: "memory");
            st[0] = 0u;
        } else { st[0] = 1u; st[1] = gen; }
        st[2] = 0u;
    }
    __syncthreads();
    if (st[0]) {
        unsigned spins = 0u;
        for (;;) {
            int tile = -1;
            if (threadIdx.x == 0) {
                unsigned rel = xb_ld(&b.bar[XB_XGEN(b.x)]) != st[1] ? 1u : 0u;
                if (!rel && (++spins & 255u) == 0u) { if (xb_ld(&b.bar[XB_TMO])) rel = 1u; else if (spins > XB_SPIN_CAP) { atomicAdd(&b.bar[XB_TMO], 1u); rel = 1u; } }
                st[2] = rel;
                if (!rel && st[3] == 0u) { const unsigned t = __hip_atomic_fetch_add((unsigned*)(F.ws + WS_CTL) + CW_CVQ, 1u, __ATOMIC_RELAXED, __HIP_MEMORY_SCOPE_AGENT);
                    if (t < (unsigned)(2 * CV_TILES)) tile = (int)t; else st[3] = 1u; }
                st[4] = (unsigned)tile;
            }
            __syncthreads();
            const unsigned rel = st[2]; tile = (int)st[4];
            __syncthreads();
            if (rel) break;
            if (tile >= 0) cv_tile(F, tile); else __builtin_amdgcn_s_sleep(2);
        }
        if (threadIdx.x == 0) {
            st[3] = 0u;
            __builtin_amdgcn_fence(__ATOMIC_ACQUIRE, "agent");
            asm volatile("s_waitcnt vmcnt(0)" ::: "memory");
        }
    }
    __syncthreads();
}

constexpr int QS = 144, TS = 80;
constexpr int HG_QT = 0, HG_KT = 18432, HG_KTT = 36864, HG_VT = 57344, HG_SMT = 77824, HG_PM = 114688, HG_TOT = 124928, HG_BMID = 126976, HG_BEND = 127488, HG_RSS = 128000, HG_VR = 132096;
static_assert(HG_VR + 64 * QS * 2 <= MISC_OFF, "HGRN2 LDS map");

__device__ __forceinline__ float fast_rcp(float x) { return __builtin_amdgcn_rcpf(x); }
__device__ __forceinline__ f32x4 hg_ld4(const bf16* p) { const u32x2 v = *(const u32x2*)p;
    return (f32x4){__builtin_bit_cast(float, v.x << 16), __builtin_bit_cast(float, v.x & 0xffff0000u), __builtin_bit_cast(float, v.y << 16), __builtin_bit_cast(float, v.y & 0xffff0000u)}; }


typedef short s16x4 __attribute__((ext_vector_type(4)));
__device__ __forceinline__ bf16x8 hg_tr8(const LAS bf16* T, int r0, int c0, int li) {
    const LAS bf16* a = T + (r0 + (li >> 2)) * QS + c0 + 4 * (li & 3);
    const s16x4 lo = __builtin_amdgcn_ds_read_tr16_b64_v4i16((LAS s16x4*)a), hi = __builtin_amdgcn_ds_read_tr16_b64_v4i16((LAS s16x4*)(a + 4 * QS));
    return __builtin_shufflevector(lo, hi, 0, 1, 2, 3, 4, 5, 6, 7);
}

template <int VAR>
__device__ __forceinline__ void hg_chunk_c1(Frame& F, const bf16* Zc, bf16* gq, bf16* gk, float* hv, const bf16* nz, const bf16* nq, const bool has_next, u32x4 (&zq)[4], int h, int rev, const float* lbp, f32x4 (&S)[8], float& dtot) {
    LAS bf16* Qt = (LAS bf16*)(F.lds + HG_QT); LAS bf16* Kt = (LAS bf16*)(F.lds + HG_KT); LAS bf16* KtT = (LAS bf16*)(F.lds + HG_KTT);
    LAS bf16* VT = (LAS bf16*)(F.lds + HG_VT); LAS bf16* Vr = (LAS bf16*)(F.lds + HG_VR);
    LAS float* tot = (LAS float*)(F.lds + HG_TOT); LAS float* bmid = (LAS float*)(F.lds + HG_BMID); LAS float* bend = (LAS float*)(F.lds + HG_BEND);
    LAS float* ebuf = (LAS float*)(F.lds + HG_RSS);
    const int tid = F.tid, lane = F.lane, w = F.wave, li = lane & 15, lq = lane >> 4;
    u32x4 vv[2];
#pragma unroll
    for (int j = 0; j < 2; ++j) { const int p = tid + NTHR * j, row = p >> 4, c16 = p & 15;
        vv[j] = *(const u32x4*)(Zc + (size_t)row * INW + ZV + h * 128 + 8 * c16);
        *(LAS u32x4*)(Kt + row * QS + 8 * c16) = zq[j]; *(LAS u32x4*)(Qt + row * QS + 8 * c16) = zq[2 + j]; }
    LDS_BARRIER();
    const int ch = tid & 127, tq = tid >> 7;
    const float lbv = lbp[h * 128 + ch], oml = 1.f - lbv;
    float cb[16], kk[16];
    const LAS bf16* colz = Kt + (16 * tq + (li >> 2)) * QS + 64 * (w & 1) + 16 * lq + 4 * (li & 3);
    const LAS bf16* colq = Qt + (16 * tq + (li >> 2)) * QS + 64 * (w & 1) + 16 * lq + 4 * (li & 3);
    s16x4 zc[4];
#pragma unroll
    for (int e4 = 0; e4 < 4; ++e4) zc[e4] = __builtin_amdgcn_ds_read_tr16_b64_v4i16((LAS s16x4*)(colz + 4 * e4 * QS));
#pragma unroll
    for (int i = 0; i < 16; ++i) { float z = bf2f((bf16)zc[i >> 2][i & 3]); z = fminf(fmaxf(z, -30.f), 30.f);
        if (VAR & 1) { cb[i] = z * -0.01f; kk[i] = z; } else { const float e = __expf(-z), sg = fast_rcp(1.f + e); cb[i] = __logf(lbv + oml * sg);
            kk[i] = oml * e * sg; } }
    if (tq == 2) bmid[ch] = cb[0];
    float run = 0.f;
    if (!rev) {
#pragma unroll
        for (int i = 0; i < 16; ++i) { run += cb[i]; cb[i] = run; }
    } else {
#pragma unroll
        for (int i = 15; i >= 0; --i) { run += cb[i]; cb[i] = run; }
    }
    tot[tq * 128 + ch] = run;
#pragma unroll
    for (int j = 0; j < 2; ++j) { const int p = tid + NTHR * j, row = p >> 4, c16 = p & 15; *(LAS u32x4*)(Vr + row * QS + 8 * c16) = vv[j]; }
    LDS_BARRIER();
    float bm, total;
    {
        const float t0 = tot[ch], t1 = tot[128 + ch], t2 = tot[256 + ch], t3 = tot[384 + ch];
        const float off = !rev ? ((tq > 0 ? t0 : 0.f) + (tq > 1 ? t1 : 0.f) + (tq > 2 ? t2 : 0.f)) : ((tq < 3 ? t3 : 0.f) + (tq < 2 ? t2 : 0.f) + (tq < 1 ? t1 : 0.f));
#pragma unroll
        for (int i = 0; i < 16; ++i) cb[i] += off;
        total = (t0 + t1) + (t2 + t3);
        bm = !rev ? (t0 + t1) + bmid[ch] : (t2 + t3);
        if (tq == 0) dtot += total;
    }
    if (!(VAR & 2)) {
        s16x4 qc[4];
#pragma unroll
        for (int e4 = 0; e4 < 4; ++e4) qc[e4] = __builtin_amdgcn_ds_read_tr16_b64_v4i16((LAS s16x4*)(colq + 4 * e4 * QS));
#pragma unroll
        for (int i = 0; i < 16; ++i) { const float d = fminf(fmaxf(cb[i] - bm, -80.f), 80.f);
            const float ed = __expf(d);
            Qt[(16 * tq + i) * QS + ch] = f2bf(bf2f((bf16)qc[i >> 2][i & 3]) * ed);
            Kt[(16 * tq + i) * QS + ch] = f2bf(kk[i] * fast_rcp(ed)); }
        if (tid < 128) { const float e1 = __expf(bm), e2 = __expf(total - bm); hv[tid] = e1; hv[128 + tid] = e2; ebuf[tid] = e1; ebuf[128 + tid] = e2; }
    }
    if (has_next) {
#pragma unroll
        for (int j = 0; j < 2; ++j) { const int p = tid + NTHR * j, row = p >> 4, c16 = p & 15;
            zq[j] = __builtin_nontemporal_load((const u32x4*)(nz + (size_t)row * INW + 8 * c16)); zq[2 + j] = *(const u32x4*)(nq + (size_t)row * INW + 8 * c16); }
    }
    LDS_BARRIER();
    if (!(VAR & 4))
#pragma unroll
    for (int j = 0; j < 2; ++j) { const int p = tid + NTHR * j, row = p >> 4, c16 = p & 15;
        __builtin_nontemporal_store(*(const LAS u32x4*)(Qt + row * QS + 8 * c16), (u32x4*)(gq + (size_t)row * 512 + 8 * c16));
        __builtin_nontemporal_store(*(const LAS u32x4*)(Kt + row * QS + 8 * c16), (u32x4*)(gk + (size_t)row * 512 + 8 * c16)); }
    if (!(VAR & 8)) {
#pragma unroll
    for (int i = 0; i < 8; ++i) S[i] = S[i] * *(const LAS f32x4*)(ebuf + 16 * i + 4 * lq);
    bf16x8 bv[2];
#pragma unroll
    for (int ks = 0; ks < 2; ++ks) bv[ks] = hg_tr8(Vr, 32 * ks + 8 * lq, 16 * w, li);
    bf16x8 ak[2][2];
#pragma unroll
    for (int ks = 0; ks < 2; ++ks) ak[0][ks] = hg_tr8(Kt, 32 * ks + 8 * lq, 0, li);
#pragma unroll
    for (int i = 0; i < 8; ++i) { const int cb_ = i & 1;
        if (i < 7) {
#pragma unroll
            for (int ks = 0; ks < 2; ++ks) ak[cb_ ^ 1][ks] = hg_tr8(Kt, 32 * ks + 8 * lq, 16 * (i + 1), li); }
        __builtin_amdgcn_sched_barrier(0);
#pragma unroll
        for (int ks = 0; ks < 2; ++ks) S[i] = MFMA16(ak[cb_][ks], bv[ks], S[i]);
        S[i] = S[i] * *(const LAS f32x4*)(ebuf + 128 + 16 * i + 4 * lq); }
    }
    LDS_BARRIER();
}

struct HgPtrs { const bf16* q; const bf16* k; const bf16* v; const float* hv; };
__device__ __forceinline__ void hg_load6(const HgPtrs& P, int tid, u32x4 (&pre)[7]) {
    pre[6] = *(const u32x4*)(P.hv + 4 * (tid & 63));
#pragma unroll
    for (int j = 0; j < 2; ++j) { const int p = tid + NTHR * j, row = p >> 4, c16 = p & 15;
        pre[j] = __builtin_nontemporal_load((const u32x4*)(P.q + (size_t)row * 512 + 8 * c16)); pre[2 + j] = __builtin_nontemporal_load((const u32x4*)(P.k + (size_t)row * 512 + 8 * c16)); pre[4 + j] = *(const u32x4*)(P.v + (size_t)row * INW + 8 * c16); }
}
template <int VAR>
__device__ __forceinline__ void hg_chunk_c3(Frame& F, const u32x4 (&cur)[7], int rev, f32x4 (&S)[8], f32x4 (&O)[4], bool do_state, const bf16* Snext) {
    LAS bf16* Qt = (LAS bf16*)(F.lds + HG_QT); LAS bf16* Kt = (LAS bf16*)(F.lds + HG_KT); LAS bf16* KtT = (LAS bf16*)(F.lds + HG_KTT);
    LAS bf16* VT = (LAS bf16*)(F.lds + HG_VT); LAS bf16* SmT = (LAS bf16*)(F.lds + HG_SMT); LAS bf16* Pm = (LAS bf16*)(F.lds + HG_PM); LAS bf16* Vr = (LAS bf16*)(F.lds + HG_VR);
    const int tid = F.tid, lane = F.lane, w = F.wave, li = lane & 15, lq = lane >> 4;
#pragma unroll
    for (int j = 0; j < 2; ++j) { const int p = tid + NTHR * j, row = p >> 4, c16 = p & 15;
        *(LAS u32x4*)(Qt + row * QS + 8 * c16) = cur[j]; *(LAS u32x4*)(Kt + row * QS + 8 * c16) = cur[2 + j]; *(LAS u32x4*)(Vr + row * QS + 8 * c16) = cur[4 + j]; }
    LAS float* ebuf = (LAS float*)(F.lds + HG_BMID);
    if (tid < 64) *(LAS u32x4*)(ebuf + 4 * tid) = cur[6];
    LDS_BARRIER();
#pragma unroll
    for (int i = 0; i < 8; ++i) { S[i] = S[i] * *(const LAS f32x4*)(ebuf + 16 * i + 4 * lq);
        u32x2 o; o.x = pk2(S[i].x, S[i].y); o.y = pk2(S[i].z, S[i].w); *(LAS u32x2*)(SmT + (16 * w + li) * QS + 16 * i + 4 * lq) = o; }
    if (Snext) {
#pragma unroll
        for (int i = 0; i < 8; ++i) S[i] = hg_ld4(Snext + (16 * w + li) * 128 + 16 * i + 4 * lq);
    }
    if (!(VAR & 4)) {
        const int tt = w >> 1;
        bf16x8 aq[4];
#pragma unroll
        for (int ks = 0; ks < 4; ++ks) aq[ks] = *(const LAS bf16x8*)(Qt + (16 * tt + li) * QS + 32 * ks + 8 * lq);
#pragma unroll
        for (int sj = 0; sj < 2; ++sj) { const int st = 2 * (w & 1) + sj; f32x4 acc = {0.f, 0.f, 0.f, 0.f};
#pragma unroll
            for (int ks = 0; ks < 4; ++ks) acc = MFMA16(*(const LAS bf16x8*)(Kt + (16 * st + li) * QS + 32 * ks + 8 * lq), aq[ks], acc);
            const int t = 16 * tt + li, s0 = 16 * st + 4 * lq; float pv[4];
#pragma unroll
            for (int r = 0; r < 4; ++r) { const int s_ = s0 + r; const bool keep = rev ? (s_ >= t) : (s_ <= t); pv[r] = keep ? acc[r] : 0.f; }
            u32x2 o; o.x = pk2(pv[0], pv[1]); o.y = pk2(pv[2], pv[3]); *(LAS u32x2*)(Pm + t * TS + s0) = o; }
    }
    LDS_BARRIER();
    if (!(VAR & 8)) {
    bf16x8 bs[4], bv[2];
#pragma unroll
    for (int ks = 0; ks < 4; ++ks) bs[ks] = *(const LAS bf16x8*)(SmT + (16 * w + li) * QS + 32 * ks + 8 * lq);
#pragma unroll
    for (int ks = 0; ks < 2; ++ks) bv[ks] = hg_tr8(Vr, 32 * ks + 8 * lq, 16 * w, li);
    {
        bf16x8 aq[2][4], ap[2][2];
#pragma unroll
        for (int ks = 0; ks < 4; ++ks) aq[0][ks] = *(const LAS bf16x8*)(Qt + li * QS + 32 * ks + 8 * lq);
#pragma unroll
        for (int ks = 0; ks < 2; ++ks) ap[0][ks] = *(const LAS bf16x8*)(Pm + li * TS + 32 * ks + 8 * lq);
#pragma unroll
        for (int mt = 0; mt < 4; ++mt) { const int cb_ = mt & 1;
            if (mt < 3) {
#pragma unroll
                for (int ks = 0; ks < 4; ++ks) aq[cb_ ^ 1][ks] = *(const LAS bf16x8*)(Qt + (16 * (mt + 1) + li) * QS + 32 * ks + 8 * lq);
#pragma unroll
                for (int ks = 0; ks < 2; ++ks) ap[cb_ ^ 1][ks] = *(const LAS bf16x8*)(Pm + (16 * (mt + 1) + li) * TS + 32 * ks + 8 * lq); }
            __builtin_amdgcn_sched_barrier(0);
#pragma unroll
            for (int ks = 0; ks < 4; ++ks) O[mt] = MFMA16(aq[cb_][ks], bs[ks], O[mt]);
#pragma unroll
            for (int ks = 0; ks < 2; ++ks) O[mt] = MFMA16(ap[cb_][ks], bv[ks], O[mt]);
        }
    }
    __builtin_amdgcn_sched_barrier(0);
    if (do_state) {
        bf16x8 ak[2][2];
#pragma unroll
        for (int ks = 0; ks < 2; ++ks) ak[0][ks] = hg_tr8(Kt, 32 * ks + 8 * lq, 0, li);
#pragma unroll
        for (int i = 0; i < 8; ++i) { const int cb_ = i & 1;
            if (i < 7) {
#pragma unroll
                for (int ks = 0; ks < 2; ++ks) ak[cb_ ^ 1][ks] = hg_tr8(Kt, 32 * ks + 8 * lq, 16 * (i + 1), li); }
            __builtin_amdgcn_sched_barrier(0);
#pragma unroll
            for (int ks = 0; ks < 2; ++ks) S[i] = MFMA16(ak[cb_][ks], bv[ks], S[i]);
            S[i] = S[i] * *(const LAS f32x4*)(ebuf + 128 + 16 * i + 4 * lq); }
    }
    }
    LDS_BARRIER();
}

__device__ __forceinline__ int hg_rowbase(int b, int slot) { return slot < 2 ? TL + b * CTXL + slot * 128 : b * SEQ + (slot - 2) * 128; }

template <int VAR>
__device__ __forceinline__ void hgrn2_c1(Frame& F, int l, int u0, int nunits, int G) {
    const bf16* Z = (const bf16*)(F.ws + WS_Z); const float* lbp = (const float*)(F.ws + WS_TAB + TAB_LB) + l * 512;
    bf16* GQ = (bf16*)(F.ws + WS_GE); bf16* GK = (bf16*)(F.ws + WS_GK); float* HV = (float*)(F.ws + WS_HV);
    if (u0 >= nunits) return;
    u32x4 zq[4];
    {   const int chain = u0 / HG_SLOTS, slot = u0 % HG_SLOTS, dir = chain & 1, b = chain >> 3, h = (chain >> 1) & 3;
        const bf16* zp = Z + (size_t)(hg_rowbase(b, slot) + (dir ? 64 : 0)) * INW;
#pragma unroll
        for (int j = 0; j < 2; ++j) { const int p = F.tid + NTHR * j, row = p >> 4, c16 = p & 15;
            zq[j] = *(const u32x4*)(zp + (size_t)row * INW + (dir ? ZFB : ZFF) + h * 128 + 8 * c16); zq[2 + j] = *(const u32x4*)(zp + (size_t)row * INW + ZQ + h * 128 + 8 * c16); } }
#pragma unroll 1
    for (int u = u0; u < nunits; u += G) {
        const int chain = u / HG_SLOTS, slot = u % HG_SLOTS, dir = chain & 1, b = chain >> 3, h = (chain >> 1) & 3;
        const int row0 = hg_rowbase(b, slot), zcol = (dir ? ZFB : ZFF) + h * 128;
        const int un = u + G; const bool has_nu = un < nunits;
        const int nchain = un / HG_SLOTS, nslot = un % HG_SLOTS, ndir = nchain & 1, nb = nchain >> 3, nh = (nchain >> 1) & 3;
        const bf16* nup = Z + (size_t)(hg_rowbase(nb, nslot) + (ndir ? 64 : 0)) * INW;
        f32x4 S[8]; float dtot = 0.f;
#pragma unroll
        for (int i = 0; i < 8; ++i) S[i] = (f32x4){0.f, 0.f, 0.f, 0.f};
#pragma unroll 1
        for (int step = 0; step < 2; ++step) { const int c = dir ? 1 - step : step; const size_t rowc = (size_t)(row0 + 64 * c);
            const bf16* nrow = step == 0 ? Z + (size_t)(row0 + 64 * (1 - c)) * INW : nup;
            const bf16* nz = nrow + (step == 0 ? zcol : (ndir ? ZFB : ZFF) + nh * 128); const bf16* nq = nrow + ZQ + (step == 0 ? h : nh) * 128;
            hg_chunk_c1<VAR>(F, Z + rowc * INW, GQ + ((size_t)dir * TT + rowc) * 512 + h * 128, GK + ((size_t)dir * TT + rowc) * 512 + h * 128,
                        HV + ((size_t)chain * (2 * HG_SLOTS) + slot * 2 + c) * 256, nz, nq, step == 0 || has_nu, zq, h, dir, lbp, S, dtot); }
        bf16* HS = (bf16*)(F.ws + WS_HS) + ((size_t)chain * HG_SLOTS + slot) * 16384;
        const int li = F.lane & 15, lq = F.lane >> 4, v = 16 * F.wave + li;
#pragma unroll
        for (int i = 0; i < 8; ++i) { u32x2 o; o.x = pk2(S[i].x, S[i].y); o.y = pk2(S[i].z, S[i].w); *(u32x2*)(HS + v * 128 + 16 * i + 4 * lq) = o; }
        if (F.tid < 128) ((float*)(F.ws + WS_HD))[((size_t)chain * HG_SLOTS + slot) * 128 + F.tid] = __expf(dtot);
    }
}

__device__ __forceinline__ void hgrn2_c2(Frame& F) {
    bf16* HS = (bf16*)(F.ws + WS_HS); const float* HD = (const float*)(F.ws + WS_HD);
    constexpr int CB = 13;
    static_assert(HG_SLOTS % (2 * CB) == 0, "batching");
    for (int task = blockIdx.x * NTHR + F.tid; task < 16 * 8192; task += F.G * NTHR) {
        const int chain = task >> 13, e2 = task & 8191, dir = chain & 1, ch2 = (e2 & 63) * 2;
        unsigned* hs = (unsigned*)(HS + (size_t)chain * HG_SLOTS * 16384 + e2 * 2); const float* hd = HD + (size_t)chain * HG_SLOTS * 128 + ch2;
        f32x2 run = {0.f, 0.f};
        unsigned tA[CB], tB[CB]; f32x2 dA[CB], dB[CB];
#define C2_SLOT(k) (dir ? ((k) < 2 ? 1 - (k) : 131 - (k)) : (k))
#define C2_LOAD(t_, d_, k0) _Pragma("unroll") for (int j = 0; j < CB; ++j) { const int slot = C2_SLOT((k0) + j); t_[j] = hs[(size_t)slot * 8192]; d_[j] = *(const f32x2*)(hd + (size_t)slot * 128); }
#define C2_SCAN(t_, d_, k0) _Pragma("unroll") for (int j = 0; j < CB; ++j) { const int slot = C2_SLOT((k0) + j); const f32x2 tmp = {__builtin_bit_cast(float, t_[j] << 16), __builtin_bit_cast(float, t_[j] & 0xffff0000u)}; \
            hs[(size_t)slot * 8192] = pk2(run.x, run.y); run = d_[j] * run + tmp; }
        C2_LOAD(tA, dA, 0)
#pragma unroll 1
        for (int k0 = 0; k0 < HG_SLOTS; k0 += 2 * CB) {
            C2_LOAD(tB, dB, k0 + CB)
            C2_SCAN(tA, dA, k0)
            if (k0 + 2 * CB < HG_SLOTS) { C2_LOAD(tA, dA, k0 + 2 * CB) }
            C2_SCAN(tB, dB, k0 + CB)
        }
#undef C2_SLOT
#undef C2_LOAD
#undef C2_SCAN
    }
}

template <int VAR>
__device__ __forceinline__ void hgrn2_c3(Frame& F, int l, int bh, int slot) {
    const int b = bh >> 2, h = bh & 3;
    const bf16* Z = (const bf16*)(F.ws + WS_Z);
    const bf16* GQ = (const bf16*)(F.ws + WS_GE); const bf16* GK = (const bf16*)(F.ws + WS_GK); const float* HV = (const float*)(F.ws + WS_HV);
    bf16* MIX = (bf16*)(F.ws + WS_MIX);
    const int row0 = hg_rowbase(b, slot);
    const int tid = F.tid, lane = F.lane, w = F.wave, li = lane & 15, lq = lane >> 4, v = 16 * w + li;
    u32x4 pa[7], pb[7];
    const float* HVf = HV + ((size_t)(bh * 2 + 0) * (2 * HG_SLOTS) + slot * 2) * 256; const float* HVb = HV + ((size_t)(bh * 2 + 1) * (2 * HG_SLOTS) + slot * 2) * 256;
    {   const size_t r0 = (size_t)row0, r1 = (size_t)(row0 + 64);
        HgPtrs P0{GQ + r0 * 512 + h * 128, GK + r0 * 512 + h * 128, Z + r0 * INW + ZV + h * 128, HVf};
        HgPtrs P1{GQ + r1 * 512 + h * 128, GK + r1 * 512 + h * 128, Z + r1 * INW + ZV + h * 128, HVf + 256};
        hg_load6(P0, tid, pa); hg_load6(P1, tid, pb); }
    if (tid < 32) *(LAS f32x4*)((LAS float*)(F.lds + HG_RSS) + 4 * tid) = *(const f32x4*)(F.in[10] + l * 128 + 4 * tid);
    f32x4 S[8];
    const bf16* HSb = (const bf16*)(F.ws + WS_HS) + ((size_t)(bh * 2 + 1) * HG_SLOTS + slot) * 16384;
    {   const bf16* HSf = (const bf16*)(F.ws + WS_HS) + ((size_t)(bh * 2 + 0) * HG_SLOTS + slot) * 16384;
#pragma unroll
        for (int i = 0; i < 8; ++i) S[i] = hg_ld4(HSf + v * 128 + 16 * i + 4 * lq); }
    f32x4 O[2][4];
#pragma unroll
    for (int c = 0; c < 2; ++c)
#pragma unroll
        for (int mt = 0; mt < 4; ++mt) O[c][mt] = (f32x4){0.f, 0.f, 0.f, 0.f};
#pragma unroll 1
    for (int st = 0; st < 4; ++st) {
        const int dir = st >> 1, c = (st == 1 || st == 2) ? 1 : 0;
        u32x4 cur[7];
#pragma unroll
        for (int j = 0; j < 7; ++j) { cur[j] = pa[j]; pa[j] = pb[j]; }
        if ((VAR & 1)) { } else if (st < 2) {
            const size_t rn = (size_t)(row0 + (st == 0 ? 64 : 0));
            HgPtrs Pn{GQ + ((size_t)TT + rn) * 512 + h * 128, GK + ((size_t)TT + rn) * 512 + h * 128, Z + rn * INW + ZV + h * 128, HVb + (st == 0 ? 256 : 0)};
            hg_load6(Pn, tid, pb);
        } else if (st == 2) {
#pragma unroll
            for (int j = 0; j < 4; ++j) pb[j] = *(const u32x4*)(Z + (size_t)(row0 + (tid >> 2)) * INW + ZG + h * 128 + 32 * (tid & 3) + 8 * j);
        }
        hg_chunk_c3<VAR>(F, cur, dir, S, O[0], (st & 1) == 0, st == 1 ? HSb : nullptr);
        if ((st & 1) == 0) {
#pragma unroll
            for (int mt = 0; mt < 4; ++mt) { const f32x4 t = O[0][mt]; O[0][mt] = O[1][mt]; O[1][mt] = t; }
        }
    }
    if (VAR & 16) { if (O[0][0][0] == 123.456f && O[1][3][2] == 1.f && S[0][0] == 2.f) MIX[0] = 1; return; }
    LAS float* Ot = (LAS float*)F.lds;
#pragma unroll
    for (int c = 0; c < 2; ++c)
#pragma unroll
        for (int mt = 0; mt < 4; ++mt)
#pragma unroll
            for (int r = 0; r < 4; ++r) Ot[(64 * c + 16 * mt + 4 * lq + r) * 132 + v] = O[c][mt][r];
    LDS_BARRIER();
    {   const int t = tid >> 2, v0 = 32 * (tid & 3);
        f32x4 x[8]; float ss = 0.f;
#pragma unroll
        for (int j = 0; j < 8; ++j) { x[j] = *(const LAS f32x4*)(Ot + t * 132 + v0 + 4 * j); ss += (x[j].x * x[j].x + x[j].y * x[j].y) + (x[j].z * x[j].z + x[j].w * x[j].w); }
        ss += dpp_f<0xB1>(ss); ss += dpp_f<0x4E>(ss);
        const float rs = rsqrtf(ss * (1.f / 128.f) + EPS);
        const LAS float* gain = (const LAS float*)(F.lds + HG_RSS) + v0;
#pragma unroll
        for (int k = 0; k < 4; ++k) { const u32x4 gq = pb[k]; const f32x4 g0 = *(const LAS f32x4*)(gain + 8 * k), g1 = *(const LAS f32x4*)(gain + 8 * k + 4);
            float o[8];
#pragma unroll
            for (int e = 0; e < 4; ++e) { const unsigned gw = e == 0 ? gq.x : e == 1 ? gq.y : e == 2 ? gq.z : gq.w;
                const float ga = __builtin_bit_cast(float, gw << 16), gb = __builtin_bit_cast(float, gw & 0xffff0000u);
                const float xa = e < 2 ? x[2 * k][2 * e] : x[2 * k + 1][2 * e - 4], xb = e < 2 ? x[2 * k][2 * e + 1] : x[2 * k + 1][2 * e - 3];
                const float na = e < 2 ? g0[2 * e] : g1[2 * e - 4], nb = e < 2 ? g0[2 * e + 1] : g1[2 * e - 3];
                o[2 * e] = xa * rs * na * ga * fast_rcp(1.f + __expf(-ga)); o[2 * e + 1] = xb * rs * nb * gb * fast_rcp(1.f + __expf(-gb)); }
            *(u32x4*)(MIX + (size_t)(row0 + t) * 1024 + h * 128 + v0 + 8 * k) = (u32x4){pk2(o[0], o[1]), pk2(o[2], o[3]), pk2(o[4], o[5]), pk2(o[6], o[7])}; }
    }
    LDS_BARRIER();
}

constexpr int LR_XR = 0, LR_XB = 35376, LR_HS = 69632;

__device__ __forceinline__ int lru_row(bool isctx, int b, int p) { return isctx ? TL + b * CTXL + p : b * SEQ + ((p & 255) << 6) + (p >> 8); }

template <bool FINAL>
__device__ __forceinline__ void lru_unit(Frame& F, int l, int b, int slot) {
    const bool isctx = slot < 4; const int p0 = isctx ? slot * 64 : (slot - 4) * 64, L = isctx ? CTXL : SEQ;
    const bf16* Z = (const bf16*)(F.ws + WS_Z);
    LAS bf16* Xr = (LAS bf16*)(F.lds + LR_XR); LAS bf16* XB = (LAS bf16*)(F.lds + LR_XB); LAS float* Hs = (LAS float*)(F.lds + LR_HS);
    const int tid = F.tid, lane = F.lane, w = F.wave, li = lane & 15, lq = lane >> 4;
    {   u32x4 v[5];
#pragma unroll
        for (int j = 0; j < 5; ++j) { const int idx = tid + NTHR * j, rr = idx >> 5, c16 = idx & 31, p = p0 - 2 + rr; v[j] = (u32x4){0u, 0u, 0u, 0u};
            if (idx < 67 * 32 && p >= 0 && p < L) v[j] = *(const u32x4*)(Z + (size_t)lru_row(isctx, b, p) * INW + ZXB + 8 * c16); }
#pragma unroll
        for (int j = 0; j < 5; ++j) { const int idx = tid + NTHR * j, rr = idx >> 5, c16 = idx & 31; if (idx < 67 * 32) *(LAS u32x4*)(Xr + rr * 264 + 8 * c16) = v[j]; } }
    LDS_BARRIER();
    {   const int ch = tid & 255, ph = tid >> 8;
        const float* cw = F.in[11] + (size_t)l * 4 * 256; const float w0 = cw[ch], w1 = cw[256 + ch], w2 = cw[512 + ch], w3 = cw[768 + ch], cb = F.in[12][l * 256 + ch];
        float x0 = bf2f(Xr[(32 * ph + 0) * 264 + ch]), x1 = bf2f(Xr[(32 * ph + 1) * 264 + ch]), x2 = bf2f(Xr[(32 * ph + 2) * 264 + ch]);
#pragma unroll 8
        for (int p = 32 * ph; p < 32 * ph + 32; ++p) { const float x3 = bf2f(Xr[(p + 3) * 264 + ch]);
            XB[p * 264 + ch] = f2bf(cb + w0 * x0 + w1 * x1 + w2 * x2 + w3 * x3); x0 = x1; x1 = x2; x2 = x3; } }
    LDS_BARRIER();
    {
        const int hh = w >> 1;
        float* LA = (float*)(F.ws + WS_LRUC); float* LH = (float*)(F.ws + WS_LRUC + LRUC_STRIDE); const float* LI = (const float*)(F.ws + WS_LRUC + 2 * LRUC_STRIDE);
        float hsum[4][4];
        bf16x8 nbr[2], nbi[2]; float nba, nbx, ncl, nC;
#define LRU_FETCH(itn) do { const int jn_ = 2 * (w & 1) + ((itn) >> 1), d_ = (itn) & 1, ch_ = hh * 64 + 16 * jn_ + li; \
            const bf16* Wl_ = (const bf16*)(F.ws + WS_TAB + TAB_LRUW) + ((size_t)((l * 2 + d_) * 4 + hh) * 128) * 64; \
            _Pragma("unroll") for (int ks = 0; ks < 2; ++ks) { nbr[ks] = *(const bf16x8*)(Wl_ + (16 * jn_ + li) * 64 + 32 * ks + 8 * lq); nbi[ks] = *(const bf16x8*)(Wl_ + (64 + 16 * jn_ + li) * 64 + 32 * ks + 8 * lq); } \
            nba = F.in[14][(l * 2 + d_) * 256 + ch_]; nbx = F.in[16][(l * 2 + d_) * 256 + ch_]; ncl = ((const float*)(F.ws + WS_TAB + TAB_LRUCL))[(l * 2 + d_) * 256 + ch_]; \
            nC = FINAL ? LI[((size_t)(b * 2 + d_) * LR_SLOTS + slot) * 256 + ch_] : 0.f; } while (0)
        LRU_FETCH(0);
#pragma unroll 1
        for (int it = 0; it < 4; ++it) {
            const int jn = 2 * (w & 1) + (it >> 1), d = it & 1;
            const int ch = hh * 64 + 16 * jn + li;
            const size_t cidx = ((size_t)(b * 2 + d) * LR_SLOTS + slot) * 256;
            bf16x8 br[2], bi[2];
#pragma unroll
            for (int ks = 0; ks < 2; ++ks) { br[ks] = nbr[ks]; bi[ks] = nbi[ks]; }
            const float ba = nba, bx = nbx, cl = ncl;
            float C = nC;
            if (it < 3) LRU_FETCH(it + 1);
            f32x4 ar[4], ai[4];
#pragma unroll
            for (int mt = 0; mt < 4; ++mt) { ar[mt] = (f32x4){0.f, 0.f, 0.f, 0.f}; ai[mt] = (f32x4){0.f, 0.f, 0.f, 0.f};
#pragma unroll
                for (int ks = 0; ks < 2; ++ks) { const bf16x8 a = *(const LAS bf16x8*)(XB + (16 * mt + li) * 264 + hh * 64 + 32 * ks + 8 * lq);
                    ar[mt] = MFMA16(a, br[ks], ar[mt]); ai[mt] = MFMA16(a, bi[ks], ai[mt]); } }
            float PA[4][4], PB[4][4];
#pragma unroll
            for (int mt = 0; mt < 4; ++mt)
#pragma unroll
                for (int r = 0; r < 4; ++r) { const int p = 16 * mt + 4 * lq + r;
                    const float rg = sigmoidf_(ar[mt][r] + ba), ig = sigmoidf_(ai[mt][r] + bx), la = -cl * rg;
                    const float x2 = 2.f * la, ea_ = __expf(la), e2 = ea_ * ea_;
                    const float om = x2 > -0.03f ? -x2 * (1.f + 0.5f * x2 * (1.f + x2 * (1.f / 3.f))) : 1.f - e2;
                    PA[mt][r] = ea_; PB[mt][r] = __builtin_amdgcn_sqrtf(fmaxf(om, 0.f)) * ig * bf2f(XB[p * 264 + ch]); }
            float TA[4], TB[4], EA[4], EB[4];
#pragma unroll
            for (int mt = 0; mt < 4; ++mt) {
                float pa = 1.f, pb = 0.f;
#pragma unroll
                for (int j = 0; j < 4; ++j) { const int r = d ? 3 - j : j; const float a = PA[mt][r], bb = PB[mt][r]; pb = a * pb + bb; pa = a * pa; PA[mt][r] = pa; PB[mt][r] = pb; }
                float ea = 1.f, eb = 0.f, ta = 1.f, tb = 0.f;
#pragma unroll
                for (int j = 0; j < 4; ++j) { const int k = d ? 3 - j : j; const float ga = __shfl(pa, li + 16 * k), gb = __shfl(pb, li + 16 * k);
                    const bool before = d ? (k > lq) : (k < lq);
                    if (before) { eb = ga * eb + gb; ea = ga * ea; }
                    tb = ga * tb + gb; ta = ga * ta; }
                EA[mt] = ea; EB[mt] = eb; TA[mt] = ta; TB[mt] = tb;
            }
            float Atot = 1.f, Cin[4];
#pragma unroll
            for (int j = 0; j < 4; ++j) { const int mt = d ? 3 - j : j; Cin[mt] = C; C = TA[mt] * C + TB[mt]; Atot *= TA[mt]; }
            if (!FINAL) { if (lq == 0) { LA[cidx + ch] = Atot; LH[cidx + ch] = C; } }
            else {
#pragma unroll
                for (int mt = 0; mt < 4; ++mt) { const float base = EA[mt] * Cin[mt] + EB[mt];
#pragma unroll
                    for (int r = 0; r < 4; ++r) { const float hv = PA[mt][r] * base + PB[mt][r];
                        if (d == 0) hsum[mt][r] = hv; else Hs[(16 * mt + 4 * lq + r) * 256 + ch] = hsum[mt][r] + hv; } }
            }
        }
    }
#undef LRU_FETCH
    if (FINAL) {
        LDS_BARRIER();
        bf16* MIX = (bf16*)(F.ws + WS_MIX);
        u32x4 yq[4];
#pragma unroll
        for (int j = 0; j < 4; ++j) { const int task = tid + NTHR * j, p = task >> 5, c8 = task & 31; yq[j] = *(const u32x4*)(Z + (size_t)lru_row(isctx, b, p0 + p) * INW + ZYB + 8 * c8); }
#pragma unroll
        for (int j = 0; j < 4; ++j) { const int task = tid + NTHR * j, p = task >> 5, c8 = task & 31;
            const f32x4 h0 = *(const LAS f32x4*)(Hs + p * 256 + 8 * c8), h1 = *(const LAS f32x4*)(Hs + p * 256 + 8 * c8 + 4);
            float o[8];
#pragma unroll
            for (int e = 0; e < 4; ++e) { const unsigned yw = yq[j][e];
                const float ya = __builtin_bit_cast(float, yw << 16), yb = __builtin_bit_cast(float, yw & 0xffff0000u);
                const float ua = 0.7978845608f * (ya + 0.044715f * ya * ya * ya), ub = 0.7978845608f * (yb + 0.044715f * yb * yb * yb);
                const float ta = 1.f - 2.f * fast_rcp(1.f + __expf(2.f * ua)), tb = 1.f - 2.f * fast_rcp(1.f + __expf(2.f * ub));
                const float ha = e < 2 ? h0[2 * e] : h1[2 * e - 4], hb = e < 2 ? h0[2 * e + 1] : h1[2 * e - 3];
                o[2 * e] = ha * 0.5f * ya * (1.f + ta); o[2 * e + 1] = hb * 0.5f * yb * (1.f + tb); }
            *(u32x4*)(MIX + (size_t)lru_row(isctx, b, p0 + p) * 1024 + 512 + 8 * c8) = (u32x4){pk2(o[0], o[1]), pk2(o[2], o[3]), pk2(o[4], o[5]), pk2(o[6], o[7])}; }
    }
    LDS_BARRIER();
}

__device__ __forceinline__ void lru_carry(Frame& F) {
    if (blockIdx.x >= 16 || F.wave != 0) return;
    const int chain = blockIdx.x * 64 + F.lane, bd = chain >> 8, ch = chain & 255, d = bd & 1;
    const float* LA = (const float*)(F.ws + WS_LRUC); const float* LH = (const float*)(F.ws + WS_LRUC + LRUC_STRIDE); float* LI = (float*)(F.ws + WS_LRUC + 2 * LRUC_STRIDE);
    float h = 0.f;
    constexpr int LB = 26;
    static_assert(LR_SLOTS % (2 * LB) == 0, "batching");
    float aA[LB], hA[LB], aB[LB], hB[LB];
#define LC_IDX(k) (((size_t)bd * LR_SLOTS + (d ? ((k) < 4 ? 3 - (k) : 263 - (k)) : (k))) * 256 + ch)
#define LC_LOAD(a_, h_, k0) _Pragma("unroll") for (int j = 0; j < LB; ++j) { const size_t idx = LC_IDX((k0) + j); a_[j] = LA[idx]; h_[j] = LH[idx]; }
#define LC_SCAN(a_, h_, k0) _Pragma("unroll") for (int j = 0; j < LB; ++j) { const size_t idx = LC_IDX((k0) + j); LI[idx] = h; h = a_[j] * h + h_[j]; }
    LC_LOAD(aA, hA, 0)
#pragma unroll 1
    for (int k0 = 0; k0 < LR_SLOTS; k0 += 2 * LB) {
        LC_LOAD(aB, hB, k0 + LB)
        LC_SCAN(aA, hA, k0)
        if (k0 + 2 * LB < LR_SLOTS) { LC_LOAD(aA, hA, k0 + 2 * LB) }
        LC_SCAN(aB, hB, k0 + LB)
    }
#undef LC_IDX
#undef LC_LOAD
#undef LC_SCAN
}

__device__ __forceinline__ void fft_f1(Frame& F, int b, int n2) {
    const bf16* Z = (const bf16*)(F.ws + WS_Z);
    const bf16* Fc = (const bf16*)(F.ws + WS_TAB + TAB_FC); const bf16* Fs = (const bf16*)(F.ws + WS_TAB + TAB_FS);
    bf16* FAr = (bf16*)(F.ws + WS_FA); bf16* FAi = FAr + (size_t)2 * 128 * 128 * 256;
    LAS bf16* DT = (LAS bf16*)F.lds;
    const int tid = F.tid, lane = F.lane, w = F.wave, li = lane & 15, lq = lane >> 4;
    {   const int c = tid & 255, nh = tid >> 8;
        const bf16* src = Z + ((size_t)(b * SEQ + 128 * (64 * nh) + n2)) * INW + ZU + c;
#pragma unroll 2
        for (int j = 0; j < 8; ++j) { unsigned pk[4];
#pragma unroll
            for (int i = 0; i < 4; ++i) pk[i] = (unsigned)src[(size_t)(128 * (8 * j + 2 * i)) * INW] | ((unsigned)src[(size_t)(128 * (8 * j + 2 * i + 1)) * INW] << 16);
            *(LAS u32x4*)(DT + c * 136 + 64 * nh + 8 * j) = (u32x4){pk[0], pk[1], pk[2], pk[3]}; } }
    LDS_BARRIER();
    bf16x8 fc[4], fs[4];
#pragma unroll
    for (int ks = 0; ks < 4; ++ks) { fc[ks] = *(const bf16x8*)(Fc + (16 * w + li) * 128 + 32 * ks + 8 * lq); fs[ks] = *(const bf16x8*)(Fs + (16 * w + li) * 128 + 32 * ks + 8 * lq); }
    float ct[4], st[4];
#pragma unroll
    for (int r = 0; r < 4; ++r) { const int k1 = 16 * w + 4 * lq + r; sincospif((float)((n2 * k1) & 16383) * (1.f / 8192.f), &st[r], &ct[r]); }
#pragma unroll 2
    for (int nt = 0; nt < 16; ++nt) {
        f32x4 re = {0.f, 0.f, 0.f, 0.f}, im = {0.f, 0.f, 0.f, 0.f};
#pragma unroll
        for (int ks = 0; ks < 4; ++ks) { const bf16x8 bb = *(const LAS bf16x8*)(DT + (16 * nt + li) * 136 + 32 * ks + 8 * lq); re = MFMA16(fc[ks], bb, re); im = MFMA16(fs[ks], bb, im); }
#pragma unroll
        for (int r = 0; r < 4; ++r) { const int k1 = 16 * w + 4 * lq + r, c = 16 * nt + li;
            const float R = re[r], I = -im[r];
            const size_t o = ((size_t)(b * 128 + k1) * 128 + n2) * 256 + c;
            FAr[o] = f2bf(R * ct[r] + I * st[r]); FAi[o] = f2bf(I * ct[r] - R * st[r]); }
    }
    LDS_BARRIER();
}

__device__ __forceinline__ void fft_f2(Frame& F, int b, int k1, int chalf) {
    const bf16* Fc = (const bf16*)(F.ws + WS_TAB + TAB_FC); const bf16* Fs = (const bf16*)(F.ws + WS_TAB + TAB_FS); const bf16* CS = (const bf16*)(F.ws + WS_TAB + TAB_CS);
    const bf16* FAr = (const bf16*)(F.ws + WS_FA); const bf16* FAi = FAr + (size_t)2 * 128 * 128 * 256;
    bf16* MIX = (bf16*)(F.ws + WS_MIX);
    LAS bf16* DTr = (LAS bf16*)F.lds; LAS bf16* DTi = DTr + 128 * QS;
    const int tid = F.tid, lane = F.lane, w = F.wave, li = lane & 15, lq = lane >> 4;
    LAS bf16* Wv = (LAS bf16*)(F.lds + 73728) + w * (16 * 2 * 136);
    {   u32x4 pr[4], pi[4];
#pragma unroll
        for (int j = 0; j < 4; ++j) { const int p = tid + NTHR * j, n2 = p >> 4, c8 = p & 15; const size_t o = ((size_t)(b * 128 + k1) * 128 + n2) * 256 + chalf * 128 + 8 * c8;
            pr[j] = *(const u32x4*)(FAr + o); pi[j] = *(const u32x4*)(FAi + o); }
#pragma unroll
        for (int j = 0; j < 4; ++j) { const int p = tid + NTHR * j, n2 = p >> 4, c8 = p & 15;
            *(LAS u32x4*)(DTr + n2 * QS + 8 * c8) = pr[j]; *(LAS u32x4*)(DTi + n2 * QS + 8 * c8) = pi[j]; } }
    LDS_BARRIER();
    bf16x8 fc[4], fs[4];
#pragma unroll
    for (int ks = 0; ks < 4; ++ks) { fc[ks] = *(const bf16x8*)(Fc + (16 * w + li) * 128 + 32 * ks + 8 * lq); fs[ks] = *(const bf16x8*)(Fs + (16 * w + li) * 128 + 32 * ks + 8 * lq); }
#pragma unroll 2
    for (int nt = 0; nt < 8; ++nt) {
        f32x4 ur = {0.f, 0.f, 0.f, 0.f}, u1 = {0.f, 0.f, 0.f, 0.f}, u2 = {0.f, 0.f, 0.f, 0.f};
#pragma unroll
        for (int ks = 0; ks < 4; ++ks) {
            const bf16x8 br = hg_tr8(DTr, 32 * ks + 8 * lq, 16 * nt, li), bi = hg_tr8(DTi, 32 * ks + 8 * lq, 16 * nt, li);
            ur = MFMA16(br, fc[ks], ur); ur = MFMA16(bi, fs[ks], ur); u1 = MFMA16(bi, fc[ks], u1); u2 = MFMA16(br, fs[ks], u2); }
        const int gl = nt >> 2, cl = 16 * (nt & 3) + 4 * lq;
        { u32x2 o; o.x = pk2(ur[0], ur[1]); o.y = pk2(ur[2], ur[3]); *(LAS u32x2*)(Wv + (li * 2 + gl) * 136 + cl) = o;
          o.x = pk2(u1[0] - u2[0], u1[1] - u2[1]); o.y = pk2(u1[2] - u2[2], u1[3] - u2[3]); *(LAS u32x2*)(Wv + (li * 2 + gl) * 136 + 64 + cl) = o; }
    }
    LDS_BARRIER();
    LAS bf16* Yt = (LAS bf16*)F.lds;
#pragma unroll
    for (int gl = 0; gl < 2; ++gl)
#pragma unroll
        for (int mt = 0; mt < 4; ++mt) { f32x4 acc = {0.f, 0.f, 0.f, 0.f};
#pragma unroll
            for (int ks = 0; ks < 4; ++ks) acc = MFMA16(*(const bf16x8*)(CS + (16 * mt + li) * 128 + 32 * ks + 8 * lq), *(const LAS bf16x8*)(Wv + (li * 2 + gl) * 136 + 32 * ks + 8 * lq), acc);
            u32x2 o; o.x = pk2(acc[0] * (1.f / 1024.f), acc[1] * (1.f / 1024.f)); o.y = pk2(acc[2] * (1.f / 1024.f), acc[3] * (1.f / 1024.f));
            *(LAS u32x2*)(Yt + (16 * w + li) * 136 + gl * 64 + 16 * mt + 4 * lq) = o; }
    LDS_BARRIER();
#pragma unroll
    for (int j = 0; j < 4; ++j) { const int p = tid + NTHR * j, k2 = p >> 4, c8 = p & 15;
        *(u32x4*)(MIX + ((size_t)b * SEQ + k1 + 128 * k2) * 1024 + 768 + chalf * 128 + 8 * c8) = *(const LAS u32x4*)(Yt + k2 * 136 + 8 * c8); }
    LDS_BARRIER();
}

__device__ __forceinline__ void ctx_fourier(Frame& F, int b, int g) {
    const bf16* Z = (const bf16*)(F.ws + WS_Z); bf16* MIX = (bf16*)(F.ws + WS_MIX);
    const bf16* CS = (const bf16*)(F.ws + WS_TAB + TAB_CS); const bf16* C256 = (const bf16*)(F.ws + WS_TAB + TAB_C256); const bf16* S256 = (const bf16*)(F.ws + WS_TAB + TAB_S256);
    LAS bf16* PT = (LAS bf16*)F.lds; LAS bf16* QT = PT + 64 * 264;
    const int lane = F.lane, w = F.wave, li = lane & 15, lq = lane >> 4;
#pragma unroll 1
    for (int nj = 0; nj < 2; ++nj) { const int nt = 2 * w + nj;
        bf16x8 a[2];
#pragma unroll
        for (int ks = 0; ks < 2; ++ks) a[ks] = *(const bf16x8*)(Z + (size_t)(TL + b * CTXL + 16 * nt + li) * INW + ZU + g * 64 + 32 * ks + 8 * lq);
#pragma unroll
        for (int mt = 0; mt < 4; ++mt) { f32x4 p = {0.f, 0.f, 0.f, 0.f}, q = {0.f, 0.f, 0.f, 0.f};
#pragma unroll
            for (int ks = 0; ks < 2; ++ks) { p = MFMA16(a[ks], *(const bf16x8*)(CS + (16 * mt + li) * 128 + 32 * ks + 8 * lq), p); q = MFMA16(a[ks], *(const bf16x8*)(CS + (16 * mt + li) * 128 + 64 + 32 * ks + 8 * lq), q); }
            u32x2 o; o.x = pk2(p[0], p[1]); o.y = pk2(p[2], p[3]); *(LAS u32x2*)(PT + (16 * mt + li) * 264 + 16 * nt + 4 * lq) = o;
            o.x = pk2(q[0], q[1]); o.y = pk2(q[2], q[3]); *(LAS u32x2*)(QT + (16 * mt + li) * 264 + 16 * nt + 4 * lq) = o; } }
    LDS_BARRIER();
#pragma unroll 1
    for (int kj = 0; kj < 2; ++kj) { const int kt = 2 * w + kj;
        f32x4 acc[4];
#pragma unroll
        for (int mt = 0; mt < 4; ++mt) acc[mt] = (f32x4){0.f, 0.f, 0.f, 0.f};
#pragma unroll 2
        for (int ks = 0; ks < 8; ++ks) { const bf16x8 ac = *(const bf16x8*)(C256 + (16 * kt + li) * 256 + 32 * ks + 8 * lq), as = *(const bf16x8*)(S256 + (16 * kt + li) * 256 + 32 * ks + 8 * lq);
#pragma unroll
            for (int mt = 0; mt < 4; ++mt) { acc[mt] = MFMA16(ac, *(const LAS bf16x8*)(PT + (16 * mt + li) * 264 + 32 * ks + 8 * lq), acc[mt]); acc[mt] = MFMA16(as, *(const LAS bf16x8*)(QT + (16 * mt + li) * 264 + 32 * ks + 8 * lq), acc[mt]); } }
#pragma unroll
        for (int mt = 0; mt < 4; ++mt)
#pragma unroll
            for (int r = 0; r < 4; ++r) MIX[(size_t)(TL + b * CTXL + 16 * kt + 4 * lq + r) * 1024 + 768 + g * 64 + 16 * mt + li] = f2bf(acc[mt][r] * (1.f / 128.f)); }
    LDS_BARRIER();
}

template <int CTRL, int RMASK> __device__ __forceinline__ float dppm_f(float v) { const int i = __builtin_bit_cast(int, v); return __builtin_bit_cast(float, __builtin_amdgcn_update_dpp(i, i, CTRL, RMASK, 0xf, false)); }
template <int CTRL, int RMASK> __device__ __forceinline__ int dppm_i(int v) { return __builtin_amdgcn_update_dpp(v, v, CTRL, RMASK, 0xf, false); }

__device__ __forceinline__ void route_phase(Frame& F, int l, int Tl) {
    LAS unsigned* hist = (LAS unsigned*)F.lds;
    for (int i = F.tid; i < 256; i += NTHR) hist[i] = 0u;
    __syncthreads();
    const float* logits = (const float*)(F.ws + WS_LOGIT); const float* br = F.in[20] + l * 256;
    int* sel_e = (int*)(F.ws + WS_SEL); float* sel_w = (float*)(F.ws + WS_SEL + SEL_STRIDE);
    const int lane = F.lane, gw = blockIdx.x * NWAVES + F.wave, NGW = F.G * NWAVES;
    const float NEG = -__builtin_inff();
    const f32x4 bb = *(const f32x4*)(br + 4 * lane);
    f32x4 lgn = (f32x4){0.f, 0.f, 0.f, 0.f};
    if (gw < Tl) lgn = __builtin_nontemporal_load((const f32x4*)(logits + (size_t)gw * 256 + 4 * lane));
    for (int t = gw; t < Tl; t += NGW) {
        const f32x4 lg = lgn;
        if (t + NGW < Tl) lgn = __builtin_nontemporal_load((const f32x4*)(logits + (size_t)(t + NGW) * 256 + 4 * lane));
        float sc[4], cand[4];
#pragma unroll
        for (int i = 0; i < 4; ++i) { sc[i] = sigmoidf_(lg[i]); cand[i] = sc[i] + bb[i]; }
        float m1 = NEG, m2 = NEG;
#pragma unroll
        for (int i = 0; i < 4; ++i) { const float v = cand[i]; if (v > m1) { m2 = m1; m1 = v; } else if (v > m2) m2 = v; }
#define RT_TOP2(CTRL) { const float o1 = dpp_f<CTRL>(m1), o2 = dpp_f<CTRL>(m2); const float n1 = fmaxf(m1, o1), n2 = fmaxf(fminf(m1, o1), fmaxf(m2, o2)); m1 = n1; m2 = n2; }
        RT_TOP2(0xB1) RT_TOP2(0x4E) RT_TOP2(0x141)
#undef RT_TOP2
        const float gs = m1 + m2; const int g = lane >> 3; int rank = 0;
#pragma unroll
        for (int q = 0; q < 8; ++q) { const float v = rdlane_f(gs, 8 * q); rank += (int)((v > gs) | ((v == gs) & (q < g))); }
        const bool drop = rank >= 4;
#pragma unroll
        for (int i = 0; i < 4; ++i) cand[i] = drop ? NEG : cand[i];
        float wsum = 0.f, myw = 0.f; int mye = 0;
#pragma unroll 1
        for (int k = 0; k < TOPK; ++k) {
            float bv = __builtin_fmaxf(__builtin_fmaxf(cand[0], cand[1]), __builtin_fmaxf(cand[2], cand[3]));
            asm volatile("s_nop 1\n\tv_max_f32_dpp %0, %0, %0 quad_perm:[1,0,3,2] row_mask:0xf bank_mask:0xf\n\t"
                         "s_nop 1\n\tv_max_f32_dpp %0, %0, %0 quad_perm:[2,3,0,1] row_mask:0xf bank_mask:0xf\n\t"
                         "s_nop 1\n\tv_max_f32_dpp %0, %0, %0 row_half_mirror row_mask:0xf bank_mask:0xf\n\t"
                         "s_nop 1\n\tv_max_f32_dpp %0, %0, %0 row_mirror row_mask:0xf bank_mask:0xf\n\t"
                         "s_nop 1\n\tv_max_f32_dpp %0, %0, %0 row_bcast:15 row_mask:0xe bank_mask:0xf\n\t"
                         "s_nop 1\n\tv_max_f32_dpp %0, %0, %0 row_bcast:31 row_mask:0xc bank_mask:0xf\n\t"
                         "s_nop 1" : "+v"(bv));
            const float mx = rdlane_f(bv, 63);
            int cidx[4];
#pragma unroll
            for (int i = 0; i < 4; ++i) { const unsigned long long bm = __builtin_amdgcn_ballot_w64(cand[i] == mx); cidx[i] = bm ? 4 * (int)__builtin_ctzll(bm) + i : (1 << 20); }
            const int m01 = cidx[0] < cidx[1] ? cidx[0] : cidx[1], m23 = cidx[2] < cidx[3] ? cidx[2] : cidx[3], ui = m01 < m23 ? m01 : m23;
            float ssel = 0.f;
#pragma unroll
            for (int i = 0; i < 4; ++i) { const bool hit = (4 * lane + i == ui); ssel = hit ? sc[i] : ssel; cand[i] = hit ? NEG : cand[i]; }
            const float sw = rdlane_f(ssel, ui >> 2);
            wsum += sw; myw = (lane == k) ? sw : myw; mye = (lane == k) ? ui : mye;
        }
        if (lane < TOPK) { sel_e[(size_t)t * 8 + lane] = mye; sel_w[(size_t)t * 8 + lane] = 2.5f * myw / wsum; (void)__hip_atomic_fetch_add(&hist[mye], 1u, __ATOMIC_RELAXED, __HIP_MEMORY_SCOPE_WORKGROUP); }
    }
    __syncthreads();
    unsigned* cnt = (unsigned*)(F.ws + WS_CTL) + CW_CNT + 1024 * l;
    for (int e = F.tid; e < 256; e += NTHR) if (hist[e]) atomicAdd(cnt + e, hist[e]);
    __syncthreads();
}

__device__ __forceinline__ void assign_phase(Frame& F, int l, int Tl) {
    LAS int* cntL = (LAS int*)F.lds; LAS int* pstart = cntL + 256; LAS unsigned* hist = (LAS unsigned*)(pstart + 260); LAS unsigned* base = hist + 256; LAS unsigned* hist2 = base + 256;
    unsigned* cnt = (unsigned*)(F.ws + WS_CTL) + CW_CNT + 1024 * l; unsigned* fill = cnt + 512;
    const int tid = F.tid, lane = F.lane;
    if (tid < 256) { cntL[tid] = (int)cnt[tid]; hist[tid] = 0u; hist2[tid] = 0u; }
    __syncthreads();
    if (F.wave == 0) {
        int p[4]; int s = 0;
#pragma unroll
        for (int i = 0; i < 4; ++i) { p[i] = (cntL[4 * lane + i] + 255) & ~255; s += p[i]; }
        int inc = s;
#pragma unroll
        for (int off = 1; off < 64; off <<= 1) { const int v = __shfl_up(inc, off); if (lane >= off) inc += v; }
        int ex = inc - s;
#pragma unroll
        for (int i = 0; i < 4; ++i) { pstart[4 * lane + i] = ex; ex += p[i]; }
        if (lane == 63) pstart[256] = inc;
    }
    __syncthreads();
    const int total_rows = pstart[256], ntile_r = total_rows >> 8, ntiles = ntile_r + (Tl >> 8);
    int* meta = (int*)(F.ws + WS_META); int* tile_expert = meta + 64;
    int* row_tok = (int*)(F.ws + WS_ROWTOK); const int* sel_e = (const int*)(F.ws + WS_SEL); int* tokpos = (int*)(F.ws + WS_SEL + 2 * SEL_STRIDE);
    if (blockIdx.x == 0) {
        if (tid == 0) { meta[0] = ntiles; meta[1] = total_rows; }
        if (tid < 256) { const int rt0 = pstart[tid] >> 8; for (int rt = rt0; rt < (pstart[tid + 1] >> 8); ++rt) tile_expert[rt] = tid | ((cntL[tid] - 256 * (rt - rt0) <= 128) ? 0x10000 : 0); }
        for (int rt = ntile_r + tid; rt < ntiles; rt += NTHR) tile_expert[rt] = 256;
    }
    for (int e = blockIdx.x; e < 256; e += F.G) for (int r = pstart[e] + cntL[e] + tid; r < pstart[e + 1]; r += NTHR) row_tok[r] = 0;
    const int TPW = (Tl + F.G - 1) / F.G, t0 = blockIdx.x * TPW, t1 = (t0 + TPW < Tl) ? t0 + TPW : Tl;
    for (int t = t0 + tid; t < t1; t += NTHR) row_tok[total_rows + t] = t;
    const int npairs = t1 > t0 ? (t1 - t0) * 8 : 0;
    for (int i = tid; i < npairs; i += NTHR) (void)__hip_atomic_fetch_add(&hist[sel_e[(size_t)t0 * 8 + i]], 1u, __ATOMIC_RELAXED, __HIP_MEMORY_SCOPE_WORKGROUP);
    __syncthreads();
    if (tid < 256) base[tid] = hist[tid] ? atomicAdd(fill + tid, hist[tid]) : 0u;
    __syncthreads();
    for (int i = tid; i < npairs; i += NTHR) { const int e = sel_e[(size_t)t0 * 8 + i]; const unsigned off = __hip_atomic_fetch_add(&hist2[e], 1u, __ATOMIC_RELAXED, __HIP_MEMORY_SCOPE_WORKGROUP);
        const int pos = pstart[e] + (int)base[e] + (int)off; row_tok[pos] = t0 + (i >> 3); tokpos[(size_t)t0 * 8 + i] = pos; }
    __syncthreads();
}

__device__ __forceinline__ void combine_phase(Frame& F, int l, int Tl) {
    const int* meta = (const int*)(F.ws + WS_META); const int total_rows = meta[1];
    const unsigned char* Y = (const unsigned char*)(F.ws + WS_Y); const int* tokpos = (const int*)(F.ws + WS_SEL + 2 * SEL_STRIDE); const float* sel_w = (const float*)(F.ws + WS_SEL + SEL_STRIDE);
    const float* mod = (const float*)(F.ws + WS_MOD);
    float* XC = (float*)(F.ws + WS_XC); bf16* HB = (bf16*)(F.ws + WS_HB);
    const int lane = F.lane, gw = blockIdx.x * NWAVES + F.wave, NGW = F.G * NWAVES;
    const int c0 = 16 * lane;
    const int ca = (lane >> 4) * 256 + ((lane >> 2) & 3) * 32 + (lane & 3) * 8, cb2 = ca + 128;
    for (int t = gw; t < Tl; t += NGW) {
        const int myp = lane < 8 ? tokpos[(size_t)t * 8 + lane] : 0; const float myw = lane < 8 ? sel_w[(size_t)t * 8 + lane] : 0.f;
        const bool lat = t < TL; float* xr = XC + (size_t)(lat ? 0 : t - TL) * D; bf16* xr16 = (bf16*)(F.ws + WS_RES) + (size_t)(lat ? t : 0) * D; const int r = lat ? (t >> 14) : 2;
        u32x4 yv[9];
        yv[8] = __builtin_nontemporal_load((const u32x4*)(Y + (size_t)(total_rows + t) * 1024 + c0));
#pragma unroll
        for (int k = 0; k < TOPK; ++k) yv[k] = __builtin_nontemporal_load((const u32x4*)(Y + (size_t)__builtin_amdgcn_readlane(myp, k) * 1024 + c0));
        f32x4 xv[4];
        if (lat) { const u32x4 qa = __builtin_nontemporal_load((const u32x4*)(xr16 + ca)), qb = __builtin_nontemporal_load((const u32x4*)(xr16 + cb2));
            xv[0] = (f32x4){__builtin_bit_cast(float, qa.x << 16), __builtin_bit_cast(float, qa.x & 0xffff0000u), __builtin_bit_cast(float, qa.y << 16), __builtin_bit_cast(float, qa.y & 0xffff0000u)};
            xv[1] = (f32x4){__builtin_bit_cast(float, qa.z << 16), __builtin_bit_cast(float, qa.z & 0xffff0000u), __builtin_bit_cast(float, qa.w << 16), __builtin_bit_cast(float, qa.w & 0xffff0000u)};
            xv[2] = (f32x4){__builtin_bit_cast(float, qb.x << 16), __builtin_bit_cast(float, qb.x & 0xffff0000u), __builtin_bit_cast(float, qb.y << 16), __builtin_bit_cast(float, qb.y & 0xffff0000u)};
            xv[3] = (f32x4){__builtin_bit_cast(float, qb.z << 16), __builtin_bit_cast(float, qb.z & 0xffff0000u), __builtin_bit_cast(float, qb.w << 16), __builtin_bit_cast(float, qb.w & 0xffff0000u)}; }
        else { xv[0] = *(const f32x4*)(xr + ca); xv[1] = *(const f32x4*)(xr + ca + 4); xv[2] = *(const f32x4*)(xr + cb2); xv[3] = *(const f32x4*)(xr + cb2 + 4); }
        float y[16];
#pragma unroll
        for (int d = 0; d < 4; ++d) { const f32x2 a = __builtin_amdgcn_cvt_pk_f32_fp8((int)yv[8][d], false), bq = __builtin_amdgcn_cvt_pk_f32_fp8((int)yv[8][d], true);
            y[4 * d] = a.x; y[4 * d + 1] = a.y; y[4 * d + 2] = bq.x; y[4 * d + 3] = bq.y; }
#pragma unroll
        for (int k = 0; k < TOPK; ++k) { const float wk = rdlane_f(myw, k);
#pragma unroll
            for (int d = 0; d < 4; ++d) { const f32x2 a = __builtin_amdgcn_cvt_pk_f32_fp8((int)yv[k][d], false), bq = __builtin_amdgcn_cvt_pk_f32_fp8((int)yv[k][d], true);
                y[4 * d] += wk * a.x; y[4 * d + 1] += wk * a.y; y[4 * d + 2] += wk * bq.x; y[4 * d + 3] += wk * bq.y; } }
        const float* g2 = mod + (size_t)(l * 3 + r) * 6144 + 5120;
        f32x4 xn[4]; float s = 0.f;
#pragma unroll
        for (int j = 0; j < 4; ++j) { const int cj = (j < 2 ? ca : cb2) + 4 * (j & 1);
            xn[j] = xv[j] + *(const f32x4*)(g2 + cj) * (f32x4){y[4 * j], y[4 * j + 1], y[4 * j + 2], y[4 * j + 3]};
            s += (xn[j].x * xn[j].x + xn[j].y * xn[j].y) + (xn[j].z * xn[j].z + xn[j].w * xn[j].w); }
        const float rstd = rsqrtf(wave_sum(s) * (1.f / D) + EPS);
        if (l == 0) {
            const float* m1 = mod + (size_t)(3 + r) * 6144; const float* gain = F.in[6] + 1024;
            unsigned o[8];
#pragma unroll
            for (int j = 0; j < 4; ++j) { const int cj = (j < 2 ? ca : cb2) + 4 * (j & 1); if (!lat) *(f32x4*)(xr + cj) = xn[j];
                const f32x4 yv2 = xn[j] * rstd * *(const f32x4*)(gain + cj) * (*(const f32x4*)(m1 + 1024 + cj) + 1.f) + *(const f32x4*)(m1 + cj);
                o[2 * j] = pk2(yv2.x, yv2.y); o[2 * j + 1] = pk2(yv2.z, yv2.w); }
            *(u32x4*)(HB + (size_t)t * D + ca) = (u32x4){o[0], o[1], o[2], o[3]}; *(u32x4*)(HB + (size_t)t * D + cb2) = (u32x4){o[4], o[5], o[6], o[7]};
            if (lat) { *(u32x4*)(xr16 + ca) = (u32x4){pk2(xn[0].x, xn[0].y), pk2(xn[0].z, xn[0].w), pk2(xn[1].x, xn[1].y), pk2(xn[1].z, xn[1].w)};
                *(u32x4*)(xr16 + cb2) = (u32x4){pk2(xn[2].x, xn[2].y), pk2(xn[2].z, xn[2].w), pk2(xn[3].x, xn[3].y), pk2(xn[3].z, xn[3].w)}; }
        } else {
            const float* gain = F.in[27];
#pragma unroll
            for (int j = 0; j < 4; ++j) { const int cj = (j < 2 ? ca : cb2) + 4 * (j & 1); *(f32x4*)(F.out + (size_t)t * D + cj) = xn[j] * rstd * *(const f32x4*)(gain + cj); }
        }
    }
}


#ifndef PH_EN
#define PH_EN 0xFFFFFFFFu
#endif
#define EN(j) ((PH_EN >> (j)) & 1u)
#ifndef U_EN
#define U_EN 0xFFu
#endif
#define UEN(j) ((U_EN >> (j)) & 1u)
#ifndef DUPMASK
#define DUPMASK 0u
#endif
#define REP(j) for (int rep_ = 0; rep_ < 1 + (int)((DUPMASK >> (j)) & 1u); ++rep_)
#ifndef DUPU
#define DUPU 0u
#endif
#define REPU(j) for (int repu_ = 0; repu_ < 1 + (int)((DUPU >> (j)) & 1u); ++repu_)
#define IN(k) (lo <= (k) && (k) < hi)
#define FRESH() do { asm volatile("" : "+v"(F.tid)); F.lane = F.tid & 63; } while (0)
#define SEAM(k) do { if (lo <= (k) && (k) + 1 < hi) xcd_barrier(bar); } while (0)
#define SEAMCV(k, lcv) do { if (lo <= (k) && (k) + 1 < hi) xcd_barrier_cv(bar, F); } while (0)
template <int l>
__device__ __forceinline__ void layer_phases(Frame& F, const XcdBarrier& bar, const int lo, const int hi) {
    const int bid = blockIdx.x, G = F.G;

        const int pb = 2 + 12 * l;
        const int Tl = l == 0 ? TT : TL;
        bf16* HB = (bf16*)(F.ws + WS_HB); bf16* Zb = (bf16*)(F.ws + WS_Z); bf16* MIX = (bf16*)(F.ws + WS_MIX);
        if (EN(2) && IN(pb + 0)) REP(2) { FRESH();
            pg8::Gemm g{HB, (const bf16*)(F.ws + WS_WIN) + (size_t)l * INW * 1024, nullptr, 1024}; pg8::StaticOrder S; S.init(TT, INW, G, bid);
            pg8::EpiBf16 E{Zb, INW};
            pg8::gemm_phase<pg8::EpiBf16, pg8::StaticOrder, false>(F.lds, g, S, E, F.tid);
            SEAMCV(pb + 0, l);
        }
        if (EN(3) && IN(pb + 1)) REP(3) { FRESH();
            REPU(0) if (UEN(0)) hgrn2_c1<0>(F, l, bid, 16 * HG_SLOTS, G);
            FRESH(); REPU(1) if (UEN(1)) for (int u = (bid + G - 32) % G; u < 2 * LR_SLOTS; u += G) lru_unit<false>(F, l, u / LR_SLOTS, u % LR_SLOTS);
            FRESH(); REPU(2) if (UEN(2)) for (int u = bid; u < 256; u += G) fft_f1(F, u >> 7, u & 127);
            FRESH(); REPU(3) if (UEN(3) && l == 0) for (int u = (bid + G - 64) % G; u < 8; u += G) ctx_fourier(F, u >> 2, u & 3);
            SEAMCV(pb + 1, l);
        }
        if (EN(4) && IN(pb + 2)) REP(4) { FRESH(); hgrn2_c2(F); lru_carry(F); SEAMCV(pb + 2, l); }
        if (EN(5) && IN(pb + 3)) REP(5) { FRESH();
            const int nslot = l == 0 ? HG_SLOTS : HG_SLOTS - 2, slot0 = l == 0 ? 0 : 2;
            FRESH(); REPU(4) if (UEN(4)) for (int u = bid; u < 8 * nslot; u += G) hgrn2_c3<0>(F, l, u / nslot, slot0 + u % nslot);
            const int nls = l == 0 ? LR_SLOTS : LR_SLOTS - 4, ls0 = l == 0 ? 0 : 4;
            FRESH(); REPU(5) if (UEN(5)) for (int u = (bid + G - 32) % G; u < 2 * nls; u += G) lru_unit<true>(F, l, u / nls, ls0 + u % nls);
            FRESH(); REPU(6) if (UEN(6)) for (int u = bid; u < 512; u += G) fft_f2(F, u >> 8, (u >> 1) & 127, u & 1);
            SEAMCV(pb + 3, l);
        }
        if (EN(6) && IN(pb + 4)) REP(6) { FRESH();
            pg8::Gemm g{MIX, (const bf16*)(F.ws + WS_WOUT) + (size_t)l * 1024 * 1024, nullptr, 1024}; pg8::StaticOrder S; S.init(Tl, 1024, G, bid);
            pg8::EpiResid<l == 0> E{F_X(F), (bf16*)(F.ws + WS_RES), F_CTX(F), (float*)(F.ws + WS_XC), (const float*)(F.ws + WS_MOD) + (size_t)l * 3 * 6144};
            pg8::gemm_phase<pg8::EpiResid<l == 0>, pg8::StaticOrder, false>(F.lds, g, S, E, F.tid);
            SEAMCV(pb + 4, l);
        }
        if (EN(7) && IN(pb + 5)) REP(7) { FRESH();
            hprep_rows(F, l, F.out, (const float*)(F.ws + WS_XC), Tl, 3072, 4096, F.in[7] + l * 1024, true, (const bf16*)(F.ws + WS_RES));
            SEAMCV(pb + 5, l);
        }
        if (EN(8) && IN(pb + 6)) REP(8) { FRESH();
            pg8::Gemm g{HB, (const bf16*)(F.ws + WS_WR) + (size_t)l * 256 * 1024, nullptr, 1024}; pg8::StaticOrder S; S.init(Tl, 256, G, bid);
            pg8::EpiF32 E{(float*)(F.ws + WS_LOGIT), 256};
            pg8::gemm_phase<pg8::EpiF32, pg8::StaticOrder, false>(F.lds, g, S, E, F.tid);
            SEAMCV(pb + 6, l);
        }
        if (EN(9) && IN(pb + 7)) REP(9) { FRESH(); route_phase(F, l, Tl); SEAMCV(pb + 7, l); }
        if (EN(10) && IN(pb + 8)) REP(10) { FRESH(); assign_phase(F, l, Tl); FRESH(); convert_experts(F, l); SEAMCV(pb + 8, l); }
        if (EN(11) && IN(pb + 9)) REP(11) { FRESH();
            const int* meta = (const int*)(F.ws + WS_META);
            pg8::Gemm g{(const bf16*)(F.ws + WS_HB8), (const bf16*)(F.ws + (l ? WS_WEXP1 : WS_WEXP)), (const int*)(F.ws + WS_ROWTOK), 512, 0x7a7a7a7a, 0x7f7f7f7f}; pg8::MoeOrder<2> S{meta + 64, meta[0], G, bid};
            pg8::EpiSwiglu8 E{F.ws + WS_HBUF};
            pg8::gemm_phase<pg8::EpiSwiglu8, pg8::MoeOrder<2>, true, true>(F.lds, g, S, E, F.tid);
            SEAMCV(pb + 9, l);
        }
        if (EN(12) && IN(pb + 10)) REP(12) { FRESH();
            const int* meta = (const int*)(F.ws + WS_META);
            pg8::Gemm g{(const bf16*)(F.ws + WS_HBUF), (const bf16*)(F.ws + (l ? WS_WEXP1 : WS_WEXP) + WEXP_GU_BYTES), nullptr, 128, 0x7b7b7b7b, 0x7d7d7d7d}; pg8::MoeOrder<4> S{meta + 64, meta[0], G, bid};
            pg8::EpiFp8 E{(unsigned char*)(F.ws + WS_Y), 1024};
            pg8::gemm_phase<pg8::EpiFp8, pg8::MoeOrder<4>, false, true>(F.lds, g, S, E, F.tid);
            SEAMCV(pb + 10, l);
        }
        if (EN(13) && IN(pb + 11)) REP(13) { FRESH(); combine_phase(F, l, Tl); SEAMCV(pb + 11, l); }
    }

constexpr int NPH = 26;
#ifndef BENCH_REPS
#define BENCH_REPS 2
#endif
__global__ void __launch_bounds__(NTHR, 2) fwd_kernel(Args args) {
    extern __shared__ __attribute__((aligned(16))) unsigned char lds_raw[];
    Frame F;
    F.lds = (LAS unsigned char*)lds_raw;
    F.tid = threadIdx.x; F.lane = F.tid & 63; F.wave = __builtin_amdgcn_readfirstlane(F.tid >> 6); F.G = gridDim.x;
    F.in = (const CAS cfptr*)__builtin_amdgcn_kernarg_segment_ptr();
    F.out = args.out; F.ws = args.ws;
    volatile LAS unsigned* MISC = (volatile LAS unsigned*)(F.lds + MISC_OFF);
    if (F.tid < 64) MISC[F.tid] = 0u;
    __syncthreads();
    XcdBarrier bar = xcd_barrier_post((unsigned*)(F.ws + WS_CTL) + CW_BAR, MISC + 8);
    const int lo = args.ph_lo, hi = args.ph_hi;
    const int bid = blockIdx.x, G = F.G;

    if (EN(0) && IN(0)) { FRESH(); phase_g0(F); SEAMCV(0, 0); }
    if (EN(1) && IN(1)) { FRESH(); hprep_rows(F, 0, F_X(F), F_CTX(F), TT, 0, 1024, F.in[6]); SEAMCV(1, 0); }

    layer_phases<0>(F, bar, lo, hi);
    layer_phases<1>(F, bar, lo, hi);
#ifdef BENCH_GEMM
    if (hi == NPH) { xcd_barrier(bar); FRESH();
        _Pragma("unroll 1") for (int rep = 0; rep < BENCH_REPS; ++rep) {
            const int* meta = (const int*)(F.ws + WS_META);
            pg8::Gemm g{(const bf16*)(F.ws + WS_HBUF), (const bf16*)(F.ws + WS_WEXP + WEXP_GU_BYTES), nullptr, 256}; pg8::MoeOrder<4> S{meta + 64, meta[0], F.G, (int)blockIdx.x};
#if BENCH_GEMM == 1
            pg8::EpiFp8 E{(unsigned char*)(F.ws + WS_Y), 1024}; pg8::gemm_phase<pg8::EpiFp8, pg8::MoeOrder<4>, false>(F.lds, g, S, E, F.tid);
#else
            pg8::EpiNone E{(bf16*)(F.ws + WS_Y)}; pg8::gemm_phase<pg8::EpiNone, pg8::MoeOrder<4>, false>(F.lds, g, S, E, F.tid);
#endif
            xcd_barrier(bar); } }
#endif
#ifdef BENCH_INPROJ
    if (hi == NPH) { xcd_barrier(bar); FRESH();
        _Pragma("unroll 1") for (int rep = 0; rep < BENCH_REPS; ++rep) {
            pg8::Gemm g{(const bf16*)(F.ws + WS_HB), (const bf16*)(F.ws + WS_WIN), nullptr, 1024}; pg8::StaticOrder S; S.init(TT, INW, F.G, (int)blockIdx.x);
#if BENCH_INPROJ == 1
            pg8::EpiBf16 E{(bf16*)(F.ws + WS_Z), INW}; pg8::gemm_phase<pg8::EpiBf16, pg8::StaticOrder, false>(F.lds, g, S, E, F.tid);
#else
            pg8::EpiNone E{(bf16*)(F.ws + WS_Z)}; pg8::gemm_phase<pg8::EpiNone, pg8::StaticOrder, false>(F.lds, g, S, E, F.tid);
#endif
            xcd_barrier(bar); } }
#endif
#ifdef BENCH_MOE1
    if (hi == NPH) { xcd_barrier(bar); FRESH();
        _Pragma("unroll 1") for (int rep = 0; rep < BENCH_REPS; ++rep) {
            const int* meta = (const int*)(F.ws + WS_META);
            pg8::MoeOrder<2> S{meta + 64, meta[0], F.G, (int)blockIdx.x};
#if BENCH_MOE1 == 1
            pg8::Gemm g{(const bf16*)(F.ws + WS_HB), (const bf16*)(F.ws + WS_WEXP1), (const int*)(F.ws + WS_ROWTOK), 1024};
            pg8::EpiSwiglu E{(bf16*)(F.ws + WS_HBUF)}; pg8::gemm_phase<pg8::EpiSwiglu, pg8::MoeOrder<2>, true>(F.lds, g, S, E, F.tid);
#elif BENCH_MOE1 == 2
            pg8::Gemm g{(const bf16*)(F.ws + WS_HB), (const bf16*)(F.ws + WS_WEXP1), (const int*)(F.ws + WS_ROWTOK), 1024};
            pg8::EpiNone E{(bf16*)(F.ws + WS_HBUF)}; pg8::gemm_phase<pg8::EpiNone, pg8::MoeOrder<2>, true>(F.lds, g, S, E, F.tid);
#else
            pg8::Gemm g{(const bf16*)(F.ws + WS_HB), (const bf16*)(F.ws + WS_WEXP1), nullptr, 1024};
            pg8::EpiNone E{(bf16*)(F.ws + WS_HBUF)}; pg8::gemm_phase<pg8::EpiNone, pg8::MoeOrder<2>, false>(F.lds, g, S, E, F.tid);
#endif
            xcd_barrier(bar); } }
#endif
#ifdef BENCH_X2
    if (hi == NPH) { xcd_barrier(bar); FRESH();
        _Pragma("unroll 1") for (int rep = 0; rep < BENCH_REPS; ++rep) { if (BENCH_X2 & 1) hgrn2_c2(F); if (BENCH_X2 & 2) lru_carry(F); xcd_barrier(bar); } }
#endif
#ifdef BENCH_C1
    if (hi == NPH) { xcd_barrier(bar); FRESH();
        _Pragma("unroll 1") for (int rep = 0; rep < BENCH_REPS; ++rep) hgrn2_c1<BENCH_C1>(F, 1, (int)blockIdx.x, 16 * HG_SLOTS, F.G); }
#endif
#ifdef BENCH_VAR
    if (hi == NPH) { xcd_barrier(bar); FRESH();
        _Pragma("unroll 1") for (int rep = 0; rep < BENCH_REPS; ++rep) for (int u = blockIdx.x; u < 8 * 128; u += F.G) hgrn2_c3<BENCH_VAR>(F, 1, u >> 7, 2 + (u & 127)); }
#endif
#undef IN
#undef SEAM
}

extern "C" void kernel_launch(void* const* d_in, const int* in_sizes, int n_in, void* d_out, int out_size, void* d_ws, size_t ws_size, hipStream_t stream) {
    static int grid = 0;
    if (grid == 0) {
        if (n_in != 28 || out_size != TL * D || ws_size < WS_END) { fprintf(stderr, "kernel_launch: unexpected problem (n_in %d, out %d, ws %zu < %zu)\n", n_in, out_size, ws_size, (size_t)WS_END); grid = -1; return; }
        int dev = 0, cus = 0, per_cu = 0;
        if (hipGetDevice(&dev) != hipSuccess || hipDeviceGetAttribute(&cus, hipDeviceAttributeMultiprocessorCount, dev) != hipSuccess) { grid = -1; return; }
        if (hipFuncSetAttribute((const void*)fwd_kernel, hipFuncAttributeMaxDynamicSharedMemorySize, LDS_BYTES) != hipSuccess) { fprintf(stderr, "kernel_launch: hipFuncSetAttribute failed\n"); grid = -1; return; }
        if (hipOccupancyMaxActiveBlocksPerMultiprocessor(&per_cu, (const void*)fwd_kernel, NTHR, LDS_BYTES) != hipSuccess || per_cu < 1) { fprintf(stderr, "kernel_launch: occupancy query says %d\n", per_cu); (void)hipGetLastError(); }
        grid = cus;
    }
    if (grid < 0) return;
    (void)hipMemsetAsync((char*)d_ws + WS_CTL, 0, CTL_ZERO_BYTES, stream);
    Args a{};
    for (int i = 0; i < 28; ++i) a.in[i] = (const float*)d_in[i];
    a.out = (float*)d_out; a.ws = (unsigned char*)d_ws;
#if MK_PER_PHASE
    for (int p = 0; p < NPH; ++p) { a.ph_lo = p; a.ph_hi = p + 1; hipLaunchKernelGGL(fwd_kernel, dim3(grid), dim3(NTHR), LDS_BYTES, stream, a); }
#else
    a.ph_lo = 0; a.ph_hi = NPH; hipLaunchKernelGGL(fwd_kernel, dim3(grid), dim3(NTHR), LDS_BYTES, stream, a);
#endif
}
```
